# Optimizing an MI355X kernel written in HIP

```python
import jax
import jax.numpy as jnp
from jax import lax
import numpy as np

D_MODEL = 1024
BATCH = 4
SEQ = 4096
DEPTH = 2
DEC_BATCH = 128
DEC_SEQ = 1
PAST_LEN = 2048
PAGE_SIZE = 128

N_A_LAYERS = DEPTH // 2
N_B_LAYERS = DEPTH - N_A_LAYERS
POOL_WINDOWS = (2, 4, 8, 16)
N_POOL_GROUPS = len(POOL_WINDOWS)
POOL_GROUP_DIM = D_MODEL // N_POOL_GROUPS
POOL_BUF = max(POOL_WINDOWS) - 1
N_HEADS = 16
HEAD_DIM = D_MODEL // N_HEADS
N_KV_HEADS = 4
Q_PER_KV = N_HEADS // N_KV_HEADS
N_BRANCH = 3
CMP_BLOCK = 32
CMP_STRIDE = 16
CMP_HIDDEN = 2 * HEAD_DIM
SEL_BLOCK = 64
N_SELECT = 16
WINDOW = 512
D_FF = 4 * D_MODEL
Q_BLOCK = 64
RMS_EPS = 1e-6
FORCED_PRIORITY = 1e6

kernel_name = 'yoco_pool_nsa_decoder_step'


def _rmsnorm(x, g):
    xf = x.astype(jnp.float32)
    y = xf * lax.rsqrt(jnp.mean(xf * xf, axis=-1, keepdims=True) + RMS_EPS)
    return (y * g.astype(jnp.float32)).astype(x.dtype)


def _mlp_block(x, g, w_up, w_down):
    h = jnp.square(jax.nn.relu(_rmsnorm(x, g) @ w_up))
    return x + h @ w_down


def _alibi_slopes():
    return jnp.exp2(-8.0 * (jnp.arange(N_HEADS, dtype=jnp.float32) + 1.0) / N_HEADS)


def _pool_mix(u, w, scale):
    b, l, _ = u.shape
    uf = u.astype(jnp.float32).reshape(b, l, N_POOL_GROUPS, POOL_GROUP_DIM)
    cs = jnp.concatenate([jnp.zeros_like(uf[:, :1]), jnp.cumsum(uf, axis=1)], axis=1)
    t = jnp.arange(l)
    means = []
    for gi, win in enumerate(POOL_WINDOWS):
        lo = jnp.maximum(t + 1 - win, 0)
        cnt = jnp.minimum(t + 1, win).astype(jnp.float32)
        means.append((cs[:, 1:, gi] - cs[:, lo, gi]) / cnt[None, :, None])
    diff = (jnp.stack(means, axis=2) - uf).astype(u.dtype)
    y = jnp.einsum('blgc,gcd->blgd', diff, w).reshape(b, l, D_MODEL)
    return y * scale


def _pool_layer(x, past_rows, g, w, scale):
    u = _rmsnorm(x, g)
    t = x.shape[1]
    ucat = u if past_rows is None else jnp.concatenate([past_rows.astype(u.dtype), u], axis=1)
    y = _pool_mix(ucat, w, scale)[:, -t:]
    return x + y, ucat[:, -POOL_BUF:]


def _shared_kv(x, g, w_kv):
    b, t, _ = x.shape
    return (_rmsnorm(x, g) @ w_kv).reshape(b, t, N_BRANCH, 2, N_KV_HEADS, HEAD_DIM)


def _compress(rows, pe, w1, w2):
    b, l, g, d = rows.shape
    r = CMP_BLOCK // CMP_STRIDE
    n_sub = l // CMP_STRIDE
    n_cmp = n_sub - r + 1
    sub = rows[:, : n_sub * CMP_STRIDE].reshape(b, n_sub, CMP_STRIDE, g, d)
    blocks = jnp.concatenate([sub[:, k:k + n_cmp] for k in range(r)], axis=2)
    blocks = blocks + pe[None, None, :, None, :].astype(rows.dtype)
    flat = blocks.transpose(0, 1, 3, 2, 4).reshape(b, n_cmp, g, CMP_BLOCK * d)
    return jax.nn.silu(flat @ w1) @ w2


def _sel_blocks(rows):
    b, l, g, d = rows.shape
    n_sel = -(-l // SEL_BLOCK)
    rows = jnp.pad(rows, ((0, 0), (0, n_sel * SEL_BLOCK - l), (0, 0), (0, 0)))
    return rows.reshape(b, n_sel, SEL_BLOCK, g, d).transpose(0, 3, 1, 2, 4)


def _kv_summaries(rows, cmp_pe, cmp_w1, cmp_w2):
    kc = _compress(rows[:, :, 0, 0], cmp_pe[0], cmp_w1[0], cmp_w2[0])
    vc = _compress(rows[:, :, 0, 1], cmp_pe[1], cmp_w1[1], cmp_w2[1])
    ks = _sel_blocks(rows[:, :, 1, 0])
    vs = _sel_blocks(rows[:, :, 1, 1])
    return kc, vc, ks, vs


def _masked_softmax(s, mask):
    s = jnp.where(mask, s, -jnp.inf)
    m = jnp.max(s, axis=-1, keepdims=True)
    m = jnp.where(jnp.isfinite(m), m, 0.0)
    e = jnp.where(mask, jnp.exp(s - m), 0.0)
    return e / jnp.maximum(jnp.sum(e, axis=-1, keepdims=True), 1e-30)


def _query_side(x, g, w_qg, b_gate):
    b, t, _ = x.shape
    h = _rmsnorm(x, g) @ w_qg
    q = h[..., : N_HEADS * HEAD_DIM].reshape(b, t, N_HEADS, HEAD_DIM)
    gate = jax.nn.sigmoid((h[..., N_HEADS * HEAD_DIM:] + b_gate).astype(jnp.float32))
    return q, gate.reshape(b, t, N_HEADS, N_BRANCH)


def _nsa_attend(q, gate, pos_q, kc, vc, ks_blk, vs_blk, kw, vw, pos_w, slopes):
    b, c = q.shape[:2]
    n_cmp = kc.shape[1]
    n_sel = ks_blk.shape[2]
    dt = q.dtype
    f32 = jnp.float32
    qg = (q * HEAD_DIM ** -0.5).reshape(b, c, N_KV_HEADS, Q_PER_KV, HEAD_DIM)
    sl = slopes.reshape(N_KV_HEADS, Q_PER_KV)[None, None, :, :, None]
    tq = pos_q[:, None]

    cmp_end = jnp.arange(n_cmp) * CMP_STRIDE + (CMP_BLOCK - 1)
    dist_c = (tq - cmp_end[None, :]).astype(f32)
    s_c = jnp.einsum('bcgrd,bngd->bcgrn', qg, kc).astype(f32) - sl * dist_c[None, :, None, None, :]
    p_c = _masked_softmax(s_c, (dist_c >= 0)[None, :, None, None, :])
    o_c = jnp.einsum('bcgrn,bngd->bcgrd', p_c.astype(dt), vc)

    sub = jnp.arange(n_cmp)[:, None] + jnp.arange(CMP_BLOCK // CMP_STRIDE)[None, :]
    cmp_to_sel = jax.nn.one_hot(sub * CMP_STRIDE // SEL_BLOCK, n_sel, dtype=f32).sum(axis=1)
    imp = jnp.einsum('bcgrn,ns->bcgs', p_c, cmp_to_sel)
    blk = jnp.arange(n_sel)[None, :]
    cur = (pos_q // SEL_BLOCK)[:, None]
    forced = (blk == 0) | (blk == cur) | (blk == cur - 1)
    valid = blk * SEL_BLOCK <= tq
    pri = jnp.where(valid[None, :, None, :], jnp.where(forced[None, :, None, :], FORCED_PRIORITY, imp), -1.0)
    _, idx = lax.top_k(pri, min(N_SELECT, n_sel))
    n_k = idx.shape[-1]
    bi = jnp.arange(b)[:, None, None, None]
    gi = jnp.arange(N_KV_HEADS)[None, None, :, None]
    kb = ks_blk[bi, gi, idx]
    vb = vs_blk[bi, gi, idx]
    kpos = idx[..., None] * SEL_BLOCK + jnp.arange(SEL_BLOCK)
    dist_s = (pos_q[None, :, None, None, None] - kpos).astype(f32)[:, :, :, None]
    s_s = jnp.einsum('bcgrd,bcgkjd->bcgrkj', qg, kb).astype(f32) - sl[..., None] * dist_s
    p_s = _masked_softmax(s_s.reshape(b, c, N_KV_HEADS, Q_PER_KV, n_k * SEL_BLOCK),
                          (dist_s >= 0).reshape(b, c, N_KV_HEADS, 1, n_k * SEL_BLOCK))
    o_s = jnp.einsum('bcgrm,bcgmd->bcgrd', p_s.astype(dt),
                     vb.reshape(b, c, N_KV_HEADS, n_k * SEL_BLOCK, HEAD_DIM))

    dist_w = tq - pos_w[None, :]
    mask_w = (dist_w >= 0) & (dist_w < WINDOW) & (pos_w[None, :] >= 0)
    s_w = jnp.einsum('bcgrd,blgd->bcgrl', qg, kw).astype(f32) - sl * dist_w.astype(f32)[None, :, None, None, :]
    p_w = _masked_softmax(s_w, mask_w[None, :, None, None, :])
    o_w = jnp.einsum('bcgrl,blgd->bcgrd', p_w.astype(dt), vw)

    g = gate.reshape(b, c, N_KV_HEADS, Q_PER_KV, N_BRANCH)
    o = (g[..., 0:1] * o_c.astype(f32) + g[..., 1:2] * o_s.astype(f32) + g[..., 2:3] * o_w.astype(f32))
    return o.astype(dt).reshape(b, c, N_HEADS * HEAD_DIM)


def _nsa_prompt(q, gate, kc, vc, ks_blk, vs_blk, win_rows, slopes):
    b, t = q.shape[:2]
    n_chunks = t // Q_BLOCK
    win_pad = jnp.pad(win_rows, ((0, 0), (WINDOW, 0), (0, 0), (0, 0), (0, 0)))

    def chunk(args):
        ci, qc, gc = args
        c0 = ci * Q_BLOCK
        w = lax.dynamic_slice_in_dim(win_pad, c0, WINDOW + Q_BLOCK, axis=1)
        pos_q = c0 + jnp.arange(Q_BLOCK)
        pos_w = c0 - WINDOW + jnp.arange(WINDOW + Q_BLOCK)
        return _nsa_attend(qc, gc, pos_q, kc, vc, ks_blk, vs_blk, w[:, :, 0], w[:, :, 1], pos_w, slopes)

    qc = q.reshape(b, n_chunks, Q_BLOCK, N_HEADS, HEAD_DIM).swapaxes(0, 1)
    gc = gate.reshape(b, n_chunks, Q_BLOCK, N_HEADS, N_BRANCH).swapaxes(0, 1)
    out = lax.map(chunk, (jnp.arange(n_chunks, dtype=jnp.int32), qc, gc))
    return out.swapaxes(0, 1).reshape(b, t, N_HEADS * HEAD_DIM)


def setup_inputs(seed: int = 0) -> dict:
    key = jax.random.key(seed)
    ks = jax.random.split(key, 24)
    nrm = jax.random.normal
    f32 = jnp.float32
    n_pages = PAST_LEN // PAGE_SIZE
    n_used = DEC_BATCH * n_pages
    n_phys = n_used + n_used // 4
    win_buf = min(WINDOW, PAST_LEN)
    qg_out = N_HEADS * HEAD_DIM + N_BRANCH * N_HEADS
    kv_out = N_BRANCH * 2 * N_KV_HEADS * HEAD_DIM
    page_table = jax.random.permutation(ks[5], n_phys)[:n_used].astype(jnp.int32).reshape(DEC_BATCH, n_pages)
    return {
        'x_prompt': nrm(ks[0], (BATCH, SEQ, D_MODEL), f32),
        'x_sample': nrm(ks[1], (DEC_BATCH, DEC_SEQ, D_MODEL), f32),
        'state_pool': nrm(ks[2], (DEC_BATCH, N_A_LAYERS, POOL_BUF, D_MODEL), f32),
        'cache_kv_pages': nrm(ks[3], (n_phys, PAGE_SIZE, 2, 2, N_KV_HEADS, HEAD_DIM), f32),
        'state_win': nrm(ks[4], (DEC_BATCH, win_buf, 2, N_KV_HEADS, HEAD_DIM), f32),
        'page_table': page_table,
        'norm_mix': 1.0 + 0.02 * nrm(ks[6], (DEPTH, D_MODEL), f32),
        'norm_mlp': 1.0 + 0.02 * nrm(ks[7], (DEPTH, D_MODEL), f32),
        'w_up': nrm(ks[8], (DEPTH, D_MODEL, D_FF), f32) * D_MODEL ** -0.5,
        'w_down': nrm(ks[9], (DEPTH, D_FF, D_MODEL), f32) * D_FF ** -0.5,
        'pool_w': nrm(ks[10], (N_A_LAYERS, N_POOL_GROUPS, POOL_GROUP_DIM, POOL_GROUP_DIM), f32) * POOL_GROUP_DIM ** -0.5,
        'pool_scale': 1.0 + 0.02 * nrm(ks[11], (N_A_LAYERS, D_MODEL), f32),
        'norm_kv': 1.0 + 0.02 * nrm(ks[12], (D_MODEL,), f32),
        'w_kv': nrm(ks[13], (D_MODEL, kv_out), f32) * D_MODEL ** -0.5,
        'cmp_pe': 0.1 * nrm(ks[14], (2, CMP_BLOCK, HEAD_DIM), f32),
        'cmp_w1': nrm(ks[15], (2, CMP_BLOCK * HEAD_DIM, CMP_HIDDEN), f32) * (CMP_BLOCK * HEAD_DIM) ** -0.5,
        'cmp_w2': nrm(ks[16], (2, CMP_HIDDEN, HEAD_DIM), f32) * CMP_HIDDEN ** -0.5,
        'w_qg': nrm(ks[17], (N_B_LAYERS, D_MODEL, qg_out), f32) * D_MODEL ** -0.5,
        'b_gate': 0.01 * nrm(ks[18], (N_B_LAYERS, N_BRANCH * N_HEADS), f32),
        'w_o': nrm(ks[19], (N_B_LAYERS, N_HEADS * HEAD_DIM, D_MODEL), f32) * (N_HEADS * HEAD_DIM) ** -0.5,
        'norm_final': 1.0 + 0.02 * nrm(ks[20], (D_MODEL,), f32),
    }


def reference(x_prompt, x_sample, state_pool, cache_kv_pages, state_win, page_table,
              norm_mix, norm_mlp, w_up, w_down, pool_w, pool_scale, norm_kv, w_kv,
              cmp_pe, cmp_w1, cmp_w2, w_qg, b_gate, w_o, norm_final):
    slopes = _alibi_slopes()

    xp = x_prompt
    pool_p = []
    for layer in range(DEPTH):
        if layer < N_A_LAYERS:
            xp, rows = _pool_layer(xp, None, norm_mix[layer], pool_w[layer], pool_scale[layer])
            pool_p.append(rows)
        else:
            if layer == N_A_LAYERS:
                kv_p = _shared_kv(xp, norm_kv, w_kv)
                kv_rows_p = kv_p[:, :, :2]
                kc_p, vc_p, ks_p, vs_p = _kv_summaries(kv_rows_p, cmp_pe, cmp_w1, cmp_w2)
                win_rows_p = kv_p[:, :, 2]
                win_new_p = win_rows_p[:, -min(WINDOW, xp.shape[1]):]
            j = layer - N_A_LAYERS
            q, gate = _query_side(xp, norm_mix[layer], w_qg[j], b_gate[j])
            o = _nsa_prompt(q, gate, kc_p, vc_p, ks_p, vs_p, win_rows_p, slopes)
            xp = xp + o @ w_o[j]
        xp = _mlp_block(xp, norm_mlp[layer], w_up[layer], w_down[layer])
    y_prompt = _rmsnorm(xp, norm_final)

    xs = x_sample
    dec_b, dec_t, _ = xs.shape
    past_len = page_table.shape[1] * cache_kv_pages.shape[1]
    pos_s = past_len + jnp.arange(dec_t)
    wb = state_win.shape[1]
    pool_s = []
    for layer in range(DEPTH):
        if layer < N_A_LAYERS:
            xs, rows = _pool_layer(xs, state_pool[:, layer], norm_mix[layer], pool_w[layer], pool_scale[layer])
            pool_s.append(rows)
        else:
            if layer == N_A_LAYERS:
                kv_s = _shared_kv(xs, norm_kv, w_kv)
                kv_rows_s = kv_s[:, :, :2]
                past = cache_kv_pages[page_table].reshape((dec_b, past_len) + cache_kv_pages.shape[2:]).astype(xs.dtype)
                kc_s, vc_s, ks_s, vs_s = _kv_summaries(jnp.concatenate([past, kv_rows_s], axis=1), cmp_pe, cmp_w1, cmp_w2)
                win_all = jnp.concatenate([state_win.astype(xs.dtype), kv_s[:, :, 2]], axis=1)
                win_new_s = win_all[:, -wb:]
                pos_w = past_len - wb + jnp.arange(wb + dec_t)
            j = layer - N_A_LAYERS
            q, gate = _query_side(xs, norm_mix[layer], w_qg[j], b_gate[j])
            o = _nsa_attend(q, gate, pos_s, kc_s, vc_s, ks_s, vs_s, win_all[:, :, 0], win_all[:, :, 1], pos_w, slopes)
            xs = xs + o @ w_o[j]
        xs = _mlp_block(xs, norm_mlp[layer], w_up[layer], w_down[layer])
    y_sample = _rmsnorm(xs, norm_final)

    return (y_prompt, y_sample, jnp.stack(pool_p, axis=1), jnp.stack(pool_s, axis=1),
            kv_rows_p, kv_rows_s, win_new_p, win_new_s)
```

```cpp
#include <hip/hip_runtime.h>
#include <hip/hip_bf16.h>
#include <cstdio>
#include <cstdint>
#include <cmath>

#ifndef MK_MULTI
#define MK_MULTI 0
#endif

constexpr int D = 1024, FF = 4096, SEQ = 4096, NB = 4, DB = 128, PAST = 2048;
constexpr int MP = NB * SEQ;
constexpr int MT = MP + DB;
constexpr int MPAD = 16640;
constexpr int NKVQG = 2816;
constexpr int CMP_ROWS_P = NB * 256 * 4;
constexpr int CMP_ROWS_S = DB * 128 * 4;
constexpr int CMP_ROWS = CMP_ROWS_P + CMP_ROWS_S;
constexpr float RMS_EPS = 1e-6f;
constexpr float LOG2E = 1.4426950408889634f;
constexpr float QSCALE = 0.125f * LOG2E;

namespace pg8 {
#define PG8_LAS __attribute__((address_space(3)))
typedef unsigned short bf16_t;
typedef short bf16x8 __attribute__((ext_vector_type(8)));
typedef float f32x4 __attribute__((ext_vector_type(4)));
typedef float f32x2 __attribute__((ext_vector_type(2)));
typedef unsigned u32x4 __attribute__((ext_vector_type(4)));
typedef unsigned u32x2 __attribute__((ext_vector_type(2)));
constexpr int BM = 256, BK = 64, HALF = 128, HTB = HALF * BK * 2, STAGE_BYTES = 8 * HTB, NXCD = 8, WGM = 8;

__host__ __device__ __forceinline__ int lds_byte(int r, int c) { const int st = (r >> 4) * 2 + (c >> 5), rr = r & 15, cc = c & 31, ob = rr * 64 + cc * 2; return st * 1024 + (ob ^ (((ob >> 9) & 1) << 5)); }
__host__ __device__ __forceinline__ void stage_rc(int b, int& R, int& C) { const int st = b / 1024, sb = b % 1024, swz = sb ^ (((sb >> 9) & 1) << 5); R = (st >> 1) * 16 + swz / 64; C = (st & 1) * 32 + (swz % 64) / 2; }
__host__ __device__ __forceinline__ int perm32(int rho) { const int n = rho >> 4, i = rho & 15; return 8 * (i >> 2) + 4 * n + (i & 3); }

struct Unit { int pm, pn; };
struct Gemm { const bf16_t* A; const bf16_t* Bt; int M, N, K, lda, ldb; size_t a_pn_off; };

struct StaticOrder {
    int nM, nN, nwg, G, c;
    __host__ __device__ void init(int M, int N, int G_, int c_) { nM = M / BM; nN = N / BM; nwg = nM * nN; G = G_; c = c_; }
    __host__ __device__ bool next(int i, Unit& u) const {
        const long L = (long)i * G + c; if (L >= nwg) return false;
        int wgid = (int)L; { const int q = nwg / NXCD, r = nwg % NXCD, xcd = wgid % NXCD, off = wgid / NXCD; wgid = (xcd < r ? xcd * (q + 1) : r * (q + 1) + (xcd - r) * q) + off; }
        const int nig = WGM * nN, gid = wgid / nig, fm = gid * WGM, gsz = (nM - fm) < WGM ? (nM - fm) : WGM;
        u.pm = fm + ((wgid % nig) % gsz); u.pn = (wgid % nig) / gsz; return true;
    }
    __device__ __forceinline__ void a_ready(const Unit&) const {}
    __device__ __forceinline__ void done(const Unit&) const {}
};

__device__ __forceinline__ unsigned cvt_pk_bf16(float lo, float hi) { unsigned r; asm volatile("v_cvt_pk_bf16_f32 %0, %1, %2" : "=v"(r) : "v"(lo), "v"(hi)); return r; }

__device__ __forceinline__ float row_rstd(const float* rs, int row) {
    const f32x4* p = (const f32x4*)(rs + (size_t)row * 16); const f32x4 a = p[0], b = p[1], c = p[2], d = p[3];
    const float s = ((a[0] + a[1]) + (a[2] + a[3])) + ((b[0] + b[1]) + (b[2] + b[3])) + ((c[0] + c[1]) + (c[2] + c[3])) + ((d[0] + d[1]) + (d[2] + d[3]));
    return 1.0f / sqrtf(s * (1.0f / 1024.0f) + RMS_EPS);
}

struct EpiResid {
    static constexpr bool PERM = false, AFTER_DRAIN = false;
    const float* base_p; const float* base_s;
    float* X; bf16_t* XB; float* RS; const float* scale;
    __device__ __forceinline__ void operator()(const f32x4 (&acc)[2][2][4][2], const Unit& u, int wr, int wc, int fr, int fq) const {
        const int col0 = u.pn * BM + wc * 32 + 4 * fq;
        f32x4 sc[2][2];
#pragma unroll
        for (int bj = 0; bj < 2; ++bj)
#pragma unroll
            for (int n = 0; n < 2; ++n) sc[bj][n] = scale ? *(const f32x4*)(scale + col0 + bj * HALF + n * 16) : (f32x4){1.f, 1.f, 1.f, 1.f};
#pragma unroll
        for (int ai = 0; ai < 2; ++ai) {
            if (u.pm * BM + ai * HALF >= MT) continue;
#pragma unroll
            for (int m = 0; m < 4; ++m) {
                const int row = u.pm * BM + ai * HALF + wr * 64 + m * 16 + fr;
                const float* bp = (row < MP) ? base_p + (size_t)row * D : base_s + (size_t)(row - MP) * D;
                float ss = 0.f;
#pragma unroll
                for (int bj = 0; bj < 2; ++bj)
#pragma unroll
                    for (int n = 0; n < 2; ++n) {
                        const int col = col0 + bj * HALF + n * 16;
                        const f32x4 v = *(const f32x4*)(bp + col) + acc[ai][bj][m][n] * sc[bj][n];
                        *(f32x4*)(X + (size_t)row * D + col) = v;
                        u32x2 w; w.x = cvt_pk_bf16(v[0], v[1]); w.y = cvt_pk_bf16(v[2], v[3]);
                        *(u32x2*)(XB + (size_t)row * D + col) = w;
                        ss += (v[0] * v[0] + v[1] * v[1]) + (v[2] * v[2] + v[3] * v[3]);
                    }
                ss += __shfl_xor(ss, 16); ss += __shfl_xor(ss, 32);
                if (fq == 0) RS[(size_t)row * 16 + u.pn * 4 + wc] = ss;
            }
        }
    }
};

struct EpiUp {
    static constexpr bool PERM = true, AFTER_DRAIN = false;
    bf16_t* H; const float* RS;
    __device__ __forceinline__ void operator()(const f32x4 (&acc)[2][2][4][2], const Unit& u, int wr, int wc, int fr, int fq) const {
        const int col0 = u.pn * BM + wc * 32 + 8 * fq;
#pragma unroll
        for (int ai = 0; ai < 2; ++ai) {
            if (u.pm * BM + ai * HALF >= MT) continue;
#pragma unroll
            for (int m = 0; m < 4; ++m) {
                const int row = u.pm * BM + ai * HALF + wr * 64 + m * 16 + fr;
                const float rstd = row_rstd(RS, row);
#pragma unroll
                for (int bj = 0; bj < 2; ++bj) {
                    f32x4 v0 = acc[ai][bj][m][0] * rstd, v1 = acc[ai][bj][m][1] * rstd;
#pragma unroll
                    for (int e = 0; e < 4; ++e) { const float a = fmaxf(v0[e], 0.f), b = fmaxf(v1[e], 0.f); v0[e] = a * a; v1[e] = b * b; }
                    u32x4 w; w.x = cvt_pk_bf16(v0[0], v0[1]); w.y = cvt_pk_bf16(v0[2], v0[3]); w.z = cvt_pk_bf16(v1[0], v1[1]); w.w = cvt_pk_bf16(v1[2], v1[3]);
                    *(u32x4*)(H + (size_t)row * FF + col0 + bj * HALF) = w;
                }
            }
        }
    }
};

struct EpiKvqg {
    static constexpr bool PERM = true, AFTER_DRAIN = false;
    const float* RS; const float* bgate;
    float* kv_p; float* kv_s; float* win_p; float* win_s;
    bf16_t* CMPA; bf16_t* KVS; bf16_t* KVW; bf16_t* Q; float* GATE;
    __device__ __forceinline__ void operator()(const f32x4 (&acc)[2][2][4][2], const Unit& u, int wr, int wc, int fr, int fq) const {
        const int pn = u.pn;
#pragma unroll
        for (int ai = 0; ai < 2; ++ai) {
            if (u.pm * BM + ai * HALF >= MT) continue;
#pragma unroll
            for (int m = 0; m < 4; ++m) {
                const int row = u.pm * BM + ai * HALF + wr * 64 + m * 16 + fr;
                const float rstd = row_rstd(RS, row);
                const bool prompt = row < MP; const int b = prompt ? (row >> 12) : (row - MP), t = row & (SEQ - 1);
#pragma unroll
                for (int bj = 0; bj < 2; ++bj) {
                    const int cin = bj * HALF + wc * 32 + 8 * fq;
                    const f32x4 v0 = acc[ai][bj][m][0] * rstd, v1 = acc[ai][bj][m][1] * rstd;
                    u32x4 w; w.x = cvt_pk_bf16(v0[0], v0[1]); w.y = cvt_pk_bf16(v0[2], v0[3]); w.z = cvt_pk_bf16(v1[0], v1[1]); w.w = cvt_pk_bf16(v1[2], v1[3]);
                    if (pn < 4) {
                        float* o = prompt ? kv_p + (size_t)row * D : kv_s + (size_t)b * D;
                        *(f32x4*)(o + pn * BM + cin) = v0; *(f32x4*)(o + pn * BM + cin + 4) = v1;
                        if (pn < 2) {
                            if (prompt) { const int g = cin >> 6, d = cin & 63;
                                *(u32x4*)(CMPA + (size_t)pn * CMP_ROWS * D + (size_t)(((b * 256 + (t >> 4)) * 4 + g)) * D + (t & 15) * 64 + d) = w; }
                        } else *(u32x4*)(KVS + (size_t)row * 512 + (pn - 2) * BM + cin) = w;
                    } else if (pn < 6) {
                        const int c = (pn - 4) * BM + cin;
                        *(u32x4*)(KVW + (size_t)row * 512 + c) = w;
                        if (prompt) { if (t >= SEQ - 512) { float* o = win_p + ((size_t)b * 512 + (t - (SEQ - 512))) * 512 + c; *(f32x4*)o = v0; *(f32x4*)(o + 4) = v1; } }
                        else { float* o = win_s + ((size_t)b * 512 + 511) * 512 + c; *(f32x4*)o = v0; *(f32x4*)(o + 4) = v1; }
                    } else if (pn < 10) {
                        *(u32x4*)(Q + (size_t)row * D + (pn - 6) * BM + cin) = w;
                    } else {
                        if (cin < 48) {
#pragma unroll
                            for (int e = 0; e < 4; ++e) { GATE[(size_t)row * 48 + cin + e] = 1.0f / (1.0f + __expf(-(v0[e] + bgate[cin + e]))); GATE[(size_t)row * 48 + cin + 4 + e] = 1.0f / (1.0f + __expf(-(v1[e] + bgate[cin + 4 + e]))); }
                        }
                    }
                }
            }
        }
    }
};

struct EpiCmp {
    static constexpr bool PERM = false, AFTER_DRAIN = false;
    float* P;
    __device__ __forceinline__ void operator()(const f32x4 (&acc)[2][2][4][2], const Unit& u, int wr, int wc, int fr, int fq) const {
        float* base = P + (size_t)u.pn * CMP_ROWS * 256;
#pragma unroll
        for (int ai = 0; ai < 2; ++ai)
#pragma unroll
            for (int m = 0; m < 4; ++m) {
                const int row = u.pm * BM + ai * HALF + wr * 64 + m * 16 + fr;
#pragma unroll
                for (int bj = 0; bj < 2; ++bj)
#pragma unroll
                    for (int n = 0; n < 2; ++n) *(f32x4*)(base + (size_t)row * 256 + bj * HALF + wc * 32 + n * 16 + 4 * fq) = acc[ai][bj][m][n];
            }
    }
};

template <class Epi, class Sched, bool ALIGN_EPI = false, bool SP2 = false>
__device__ __forceinline__ void gemm_phase(PG8_LAS unsigned char* lds, const Gemm g, const Sched& S, const Epi& E) {
    const int tid = threadIdx.x, wid = __builtin_amdgcn_readfirstlane(tid >> 6), lane = tid & 63, wr = wid >> 2, wc = wid & 3, fr = lane & 15, fq = lane >> 4;
    const int K = g.K, nt = K / BK;
    unsigned voffA[2], voffB[2];
#pragma unroll
    for (int i = 0; i < 2; ++i) { int R, C; stage_rc(tid * 16 + i * 8192, R, C); const int Rb = Epi::PERM ? ((R & ~31) + perm32(R & 31)) : R;
        voffA[i] = (unsigned)(R * g.lda + C) * 2u; voffB[i] = (unsigned)(Rb * g.ldb + C) * 2u; }
    const size_t kstep = (size_t)(BK * 2);
    const size_t hstepA = (size_t)HALF * g.lda * 2, hstepB = (size_t)HALF * g.ldb * 2;
    const size_t tstepA = 2 * hstepA, tstepB = 2 * hstepB;
    const unsigned ldsw = (unsigned)wid * 1024u;
    const int aoff = lds_byte(wr * 64 + fr, fq * 8), boff = lds_byte(wc * 32 + fr, fq * 8);
#define PG8_SA(b, h) (((b) * 2 + (h)) * HTB)
#define PG8_SB(b, h) ((4 + (b) * 2 + (h)) * HTB)
#define PG8_STAGE(bufoff, gbase, voff) do { _Pragma("unroll") for (int _i = 0; _i < 2; ++_i) \
        __builtin_amdgcn_global_load_lds((const unsigned*)((const char*)(gbase) + (voff)[_i]), (PG8_LAS unsigned*)(lds + (bufoff) + ldsw + _i * 8192), 16, 0, 0); } while (0)
#define PG8_LDA(dst, b, h) do { _Pragma("unroll") for (int m = 0; m < 4; ++m) _Pragma("unroll") for (int k = 0; k < 2; ++k) dst[m][k] = *(const PG8_LAS bf16x8*)(lds + PG8_SA(b, h) + aoff + m * 2048 + k * 1024); } while (0)
#define PG8_LDB(dst, b, h) do { _Pragma("unroll") for (int n = 0; n < 2; ++n) _Pragma("unroll") for (int k = 0; k < 2; ++k) dst[n][k] = *(const PG8_LAS bf16x8*)(lds + PG8_SB(b, h) + boff + n * 2048 + k * 1024); } while (0)
#define PG8_MMA(ai, bj, At, Bt) do { __builtin_amdgcn_s_setprio(1); _Pragma("unroll") for (int m = 0; m < 4; ++m) _Pragma("unroll") for (int n = 0; n < 2; ++n) _Pragma("unroll") for (int k = 0; k < 2; ++k) \
        acc[ai][bj][m][n] = __builtin_amdgcn_mfma_f32_16x16x32_bf16(Bt[n][k], At[m][k], acc[ai][bj][m][n], 0, 0, 0); __builtin_amdgcn_s_setprio(0); } while (0)
#define PG8_WAIT_V(n) asm volatile("s_waitcnt vmcnt(" #n ")" ::: "memory")
#define PG8_WAIT_L(n) asm volatile("s_waitcnt lgkmcnt(" #n ")" ::: "memory")
#define PG8_BAR __builtin_amdgcn_s_barrier()
#define PG8_SCHED __builtin_amdgcn_sched_barrier(0)
    Unit cur, nxt; int ui = 0;
    if (!S.next(0, cur)) return;
    f32x4 acc[2][2][4][2];
#pragma unroll
    for (int a = 0; a < 2; ++a)
#pragma unroll
        for (int b = 0; b < 2; ++b)
#pragma unroll
            for (int m = 0; m < 4; ++m)
#pragma unroll
                for (int n = 0; n < 2; ++n) acc[a][b][m][n] = (f32x4){0.f, 0.f, 0.f, 0.f};
    bf16x8 At[4][2], B0[2][2], B1[2][2];
    const char* cA = (const char*)g.A + (size_t)cur.pm * tstepA + (size_t)cur.pn * g.a_pn_off; const char* cB = (const char*)g.Bt + (size_t)cur.pn * tstepB;
    S.a_ready(cur);
    if constexpr (SP2) {
        PG8_STAGE(PG8_SB(0, 0), cB, voffB); PG8_STAGE(PG8_SB(0, 1), cB + hstepB, voffB); PG8_STAGE(PG8_SA(0, 0), cA, voffA); PG8_STAGE(PG8_SA(0, 1), cA + hstepA, voffA);
        if (wr == 1) PG8_BAR;
        PG8_WAIT_V(2); PG8_BAR;
        PG8_STAGE(PG8_SB(1, 0), cB + kstep, voffB); PG8_STAGE(PG8_SA(1, 0), cA + kstep, voffA); PG8_STAGE(PG8_SB(1, 1), cB + hstepB + kstep, voffB);
        PG8_WAIT_V(6); PG8_BAR;
    } else {
        PG8_STAGE(PG8_SB(0, 0), cB, voffB); PG8_STAGE(PG8_SA(0, 0), cA, voffA); PG8_STAGE(PG8_SB(0, 1), cB + hstepB, voffB); PG8_STAGE(PG8_SA(0, 1), cA + hstepA, voffA);
        if (wr == 1) PG8_BAR;
        PG8_WAIT_V(4); PG8_BAR;
        PG8_STAGE(PG8_SB(1, 0), cB + kstep, voffB); PG8_STAGE(PG8_SA(1, 0), cA + kstep, voffA); PG8_STAGE(PG8_SB(1, 1), cB + hstepB + kstep, voffB);
        PG8_WAIT_V(6); PG8_BAR;
    }
    for (;;) {
        const bool has_next = S.next(ui + 1, nxt);
        const char* nA = has_next ? (const char*)g.A + (size_t)nxt.pm * tstepA + (size_t)nxt.pn * g.a_pn_off : cA; const char* nB = has_next ? (const char*)g.Bt + (size_t)nxt.pn * tstepB : cB;
        for (int t = 0; t < nt; t += 2) {
            const bool last = (t == nt - 2);
            const char* a1 = cA + (size_t)(t + 1) * kstep;
            const char* a2 = last ? nA : cA + (size_t)(t + 2) * kstep; const char* b2 = last ? nB : cB + (size_t)(t + 2) * kstep;
            const char* a3 = a2 + kstep; const char* b3 = b2 + kstep;
            if (last && has_next) S.a_ready(nxt);
            if constexpr (SP2) {
            PG8_LDB(B0, 0, 0); PG8_LDB(B1, 0, 1); PG8_SCHED; PG8_LDA(At, 0, 0); PG8_STAGE(PG8_SA(1, 1), a1 + hstepA, voffA);
            PG8_WAIT_V(8); PG8_WAIT_L(0); PG8_BAR; PG8_MMA(0, 0, At, B0); PG8_MMA(0, 1, At, B1); PG8_BAR; PG8_SCHED;
            PG8_LDA(At, 0, 1); PG8_STAGE(PG8_SB(0, 0), b2, voffB); PG8_STAGE(PG8_SB(0, 1), b2 + hstepB, voffB); PG8_STAGE(PG8_SA(0, 0), a2, voffA);
            PG8_WAIT_V(8); PG8_WAIT_L(0); PG8_BAR; PG8_MMA(1, 0, At, B0); PG8_MMA(1, 1, At, B1); PG8_BAR; PG8_SCHED;
            PG8_LDB(B0, 1, 0); PG8_LDB(B1, 1, 1); PG8_SCHED; PG8_LDA(At, 1, 0); PG8_STAGE(PG8_SA(0, 1), a2 + hstepA, voffA);
            PG8_WAIT_V(8); PG8_WAIT_L(0); PG8_BAR; PG8_MMA(0, 0, At, B0); PG8_MMA(0, 1, At, B1); PG8_BAR; PG8_SCHED;
            PG8_LDA(At, 1, 1); PG8_STAGE(PG8_SB(1, 0), b3, voffB); PG8_STAGE(PG8_SB(1, 1), b3 + hstepB, voffB); PG8_STAGE(PG8_SA(1, 0), a3, voffA);
            PG8_WAIT_V(8); PG8_WAIT_L(0); PG8_BAR; PG8_MMA(1, 0, At, B0); PG8_MMA(1, 1, At, B1); PG8_BAR; PG8_SCHED;
            } else {
            PG8_LDB(B0, 0, 0); PG8_SCHED; PG8_LDA(At, 0, 0); PG8_STAGE(PG8_SA(1, 1), a1 + hstepA, voffA);
            PG8_WAIT_L(8); PG8_BAR; PG8_WAIT_L(0); PG8_MMA(0, 0, At, B0); PG8_BAR; PG8_SCHED;
            PG8_LDB(B1, 0, 1); PG8_STAGE(PG8_SB(0, 0), b2, voffB);
            PG8_BAR; PG8_WAIT_L(0); PG8_MMA(0, 1, At, B1); PG8_BAR;
            PG8_LDA(At, 0, 1); PG8_STAGE(PG8_SA(0, 0), a2, voffA);
            PG8_BAR; PG8_WAIT_L(0); PG8_MMA(1, 0, At, B0); PG8_BAR; PG8_SCHED;
            PG8_STAGE(PG8_SB(0, 1), b2 + hstepB, voffB);
            PG8_WAIT_V(6); PG8_BAR; PG8_MMA(1, 1, At, B1); PG8_BAR;
            PG8_LDB(B0, 1, 0); PG8_SCHED; PG8_LDA(At, 1, 0); PG8_STAGE(PG8_SA(0, 1), a2 + hstepA, voffA);
            PG8_WAIT_L(8); PG8_BAR; PG8_WAIT_L(0); PG8_MMA(0, 0, At, B0); PG8_BAR; PG8_SCHED;
            PG8_LDB(B1, 1, 1); PG8_STAGE(PG8_SB(1, 0), b3, voffB);
            PG8_BAR; PG8_WAIT_L(0); PG8_MMA(0, 1, At, B1); PG8_BAR;
            PG8_LDA(At, 1, 1); PG8_STAGE(PG8_SA(1, 0), a3, voffA);
            PG8_BAR; PG8_WAIT_L(0); PG8_MMA(1, 0, At, B0); PG8_BAR; PG8_SCHED;
            PG8_STAGE(PG8_SB(1, 1), b3 + hstepB, voffB);
            PG8_WAIT_V(6); PG8_BAR; PG8_MMA(1, 1, At, B1); PG8_BAR;
            }
        }
        if constexpr (ALIGN_EPI) { if (wr == 0) PG8_BAR; }
        if constexpr (!Epi::AFTER_DRAIN) { E(acc, cur, wr, wc, fr, fq); S.done(cur); }
        if (!has_next) break;
#pragma unroll
        for (int a = 0; a < 2; ++a)
#pragma unroll
            for (int b = 0; b < 2; ++b)
#pragma unroll
                for (int m = 0; m < 4; ++m)
#pragma unroll
                    for (int n = 0; n < 2; ++n) acc[a][b][m][n] = (f32x4){0.f, 0.f, 0.f, 0.f};
        cur = nxt; cA = nA; cB = nB; ++ui;
        if constexpr (ALIGN_EPI) { if (wr == 1) PG8_BAR; }
    }
    PG8_WAIT_V(0);
    if constexpr (!ALIGN_EPI) { if (wr == 0) PG8_BAR; }
    PG8_BAR;
    if constexpr (Epi::AFTER_DRAIN) { E.fused(acc, cur, wr, wc, fr, fq, lds, wid, lane); S.done(cur); }
#undef PG8_SA
#undef PG8_SB
#undef PG8_STAGE
#undef PG8_LDA
#undef PG8_LDB
#undef PG8_MMA
#undef PG8_WAIT_V
#undef PG8_WAIT_L
#undef PG8_BAR
#undef PG8_SCHED
}
}

#define GAS __attribute__((address_space(1)))
#define LAS __attribute__((address_space(3)))
typedef unsigned short bf16;
typedef unsigned v4u __attribute__((ext_vector_type(4)));
typedef unsigned v2u __attribute__((ext_vector_type(2)));
typedef float f32x4 __attribute__((ext_vector_type(4)));
typedef float f32x2 __attribute__((ext_vector_type(2)));
typedef float f32x16 __attribute__((ext_vector_type(16)));
typedef short bf16x8 __attribute__((ext_vector_type(8)));
typedef short v4i16_t __attribute__((ext_vector_type(4)));
typedef GAS unsigned gu32;
typedef GAS unsigned long long gu64;
#define RLX_AGENT __ATOMIC_RELAXED, __HIP_MEMORY_SCOPE_AGENT
#define LDS_WAIT() asm volatile("s_waitcnt lgkmcnt(0)" ::: "memory")
#define VM_WAIT() asm volatile("s_waitcnt vmcnt(0)" ::: "memory")
__device__ __forceinline__ unsigned f2bf(float f) { unsigned u = __builtin_bit_cast(unsigned, f); return (u + 0x7fffu + ((u >> 16) & 1u)) >> 16; }
__device__ __forceinline__ unsigned pk2(float lo, float hi) { return f2bf(lo) | (f2bf(hi) << 16); }
__device__ __forceinline__ float bf2f(unsigned short h) { return __builtin_bit_cast(float, (unsigned)h << 16); }

#define XB_TMO      128
#define XB_XCNT(j)  (256  + 64 * (j))
#define XB_XSUB(j)  (1280 + 64 * (j))
#define XB_XGEN(j)  (2304 + 64 * (j))
#define XB_TOP      3328
#define XB_TOPGEN   3392
#define XCD_BAR_WORDS 3456
#define XB_SPIN_CAP (1u << 18)

__device__ __forceinline__ unsigned xb_ld(unsigned* p)              { return __hip_atomic_load(p, __ATOMIC_RELAXED, __HIP_MEMORY_SCOPE_AGENT); }
__device__ __forceinline__ unsigned xb_add(unsigned* p, unsigned v) { return __hip_atomic_fetch_add(p, v, __ATOMIC_RELAXED, __HIP_MEMORY_SCOPE_AGENT); }
__device__ __forceinline__ unsigned xb_xcc_id() { return (unsigned)__builtin_amdgcn_s_getreg((3 << 11) | 20) & 0xFu; }
#define XB_SPIN(cond, bar) do { unsigned _sp = 0; while (cond) { __builtin_amdgcn_s_sleep(1); \
    if ((++_sp & 255u) == 0u) { if (xb_ld(&(bar)[XB_TMO])) break; if (_sp > XB_SPIN_CAP) { atomicAdd(&(bar)[XB_TMO], 1u); break; } } } } while (0)

struct XcdBarrier {
    unsigned* bar; unsigned x;
    volatile LAS unsigned* st;
};

__device__ __forceinline__ XcdBarrier xcd_barrier_post(unsigned* bar, volatile LAS unsigned* st) {
    XcdBarrier b; b.bar = bar; b.x = xb_xcc_id(); b.st = st;
    if (threadIdx.x == 0) (void)xb_add(&bar[XB_XCNT(b.x)], 1u);
    return b;
}
__device__ __forceinline__ void xcd_barrier_complete(unsigned* bar, unsigned x, unsigned& nloc, unsigned& nx) {
    const unsigned G = gridDim.x * gridDim.y * gridDim.z;
    unsigned sum, cnt, mine, sp = 0u;
    for (;;) {
        sum = 0u; cnt = 0u; mine = 0u;
#pragma unroll
        for (unsigned j = 0; j < 16; ++j) { const unsigned c = xb_ld(&bar[XB_XCNT(j)]); sum += c; cnt += (c > 0u) ? 1u : 0u; mine = (j == x) ? c : mine; }
        if (sum == G) break;
        __builtin_amdgcn_s_sleep(1);
        if ((++sp & 255u) == 0u) { if (xb_ld(&bar[XB_TMO])) break; if (sp > XB_SPIN_CAP) { atomicAdd(&bar[XB_TMO], 1u); break; } }
    }
    nloc = mine > 0u ? mine : 1u; nx = cnt > 0u ? cnt : 1u;
}

__device__ __forceinline__ void xcd_barrier(const XcdBarrier& b) {
    asm volatile("s_waitcnt vmcnt(0)" ::: "memory");
    __syncthreads();
    if (threadIdx.x == 0) {
        unsigned* bar = b.bar;
        __builtin_amdgcn_s_waitcnt(0);
        unsigned nloc = b.st[0], nx = b.st[1];
        if (nloc == 0u) { xcd_barrier_complete(bar, b.x, nloc, nx); b.st[0] = nloc; b.st[1] = nx; }
        const unsigned old = xb_add(&bar[XB_XSUB(b.x)], 1u);
        const unsigned gen = old / nloc;
        if (old + 1u == (gen + 1u) * nloc) {
            __builtin_amdgcn_fence(__ATOMIC_RELEASE, "agent");
            asm volatile("s_waitcnt vmcnt(0)" ::: "memory");
            const unsigned og = xb_add(&bar[XB_TOP], 1u);
            const unsigned tg = og / nx;
            if (og + 1u == (tg + 1u) * nx) xb_add(&bar[XB_TOPGEN], 1u);
            else XB_SPIN(xb_ld(&bar[XB_TOPGEN]) == tg, bar);
            __builtin_amdgcn_fence(__ATOMIC_ACQUIRE, "agent");
            xb_add(&bar[XB_XGEN(b.x)], 1u);
            asm volatile("s_waitcnt vmcnt(0)" ::: "memory");
        } else {
            XB_SPIN(xb_ld(&bar[XB_XGEN(b.x)]) == gen, bar);
            __builtin_amdgcn_fence(__ATOMIC_ACQUIRE, "agent");
            asm volatile("s_waitcnt vmcnt(0)" ::: "memory");
        }
    }
    __syncthreads();
}

constexpr size_t MiB = 1u << 20;
constexpr size_t WS_CTL = 0, CTL_ZERO_BYTES = 1 * MiB;
constexpr size_t WS_WUP = 2 * MiB;
constexpr size_t WS_WDN = 18 * MiB;
constexpr size_t WS_WKVQG = 34 * MiB;
constexpr size_t WS_WO = 40 * MiB;
constexpr size_t WS_WPOOL = 42 * MiB;
constexpr size_t WS_W1CAT = 43 * MiB;
constexpr size_t WS_CBIAS = 44 * MiB;
constexpr size_t WS_RS = 45 * MiB;
constexpr size_t WS_GATE = 47 * MiB;
constexpr size_t WS_X = 52 * MiB;
constexpr size_t WS_XB = 118 * MiB;
constexpr size_t WS_DIFF = 152 * MiB;
constexpr size_t WS_Q = 186 * MiB;
constexpr size_t WS_KVS = 220 * MiB;
constexpr size_t WS_KVW = 238 * MiB;
constexpr size_t WS_KC = 256 * MiB;
constexpr size_t WS_KCS = 258 * MiB;
constexpr size_t WS_H = 292 * MiB;
constexpr size_t WS_CMPA = 424 * MiB;
constexpr size_t WS_CMPP = 700 * MiB;
constexpr size_t WS_END = 840 * MiB;
constexpr int CW_BAR = 4096;

constexpr size_t OUT_Y_P = 0, OUT_Y_S = 16777216, OUT_POOL_P = 16908288, OUT_POOL_S = 16969728, OUT_KV_P = 18935808, OUT_KV_S = 35713024, OUT_WIN_P = 35844096, OUT_WIN_S = 36892672, OUT_TOTAL = 70447104;

constexpr int NWAVES = 8;
constexpr int RING_BYTES = 131072, MISC_OFF = RING_BYTES + 320, LDS_BYTES = 147456;

struct Frame {
    LAS unsigned char* lds;
    int tid, lane, wave, vcu, G;
    const float *x_p, *x_s, *state_pool, *cache, *state_win; const int* page_table;
    const float *norm_mix, *norm_mlp, *w_up, *w_down, *pool_w, *pool_scale, *norm_kv, *w_kv, *cmp_pe, *cmp_w1, *cmp_w2, *w_qg, *b_gate, *w_o, *norm_final;
    float* out; unsigned char* ws;
};
#define WSP(T, off) ((T*)(F.ws + (off)))

__device__ __forceinline__ float wave_sum(float v) {
#pragma unroll
    for (int o = 1; o < 64; o <<= 1) v += __shfl_xor(v, o);
    return v;
}
__device__ __forceinline__ float wave_max(float v) {
#pragma unroll
    for (int o = 1; o < 64; o <<= 1) v = fmaxf(v, __shfl_xor(v, o));
    return v;
}

__device__ __forceinline__ void transpose_item(const float* W, int N, bf16* WT, int ldt, int row_off, const float* kscale, float scale, LAS float* scr, int kb, int nb, int lane) {
    const int k0 = 64 * kb, n0 = 32 * nb; const int n = n0 + (lane & 31);
#pragma unroll 8
    for (int i = 0; i < 32; ++i) { const int kk = 2 * i + (lane >> 5); float v = (n < N) ? W[(size_t)(k0 + kk) * N + n] : 0.f; if (kscale) v *= kscale[k0 + kk]; scr[kk * 33 + (lane & 31)] = v * scale; }
    LDS_WAIT(); asm volatile("" ::: "memory");
    const int c = lane & 7;
#pragma unroll
    for (int j = 0; j < 4; ++j) { const int nn = (lane >> 3) + 8 * j; const LAS float* s = scr + (8 * c) * 33 + nn;
        v4u o; o.x = pk2(s[0 * 33], s[1 * 33]); o.y = pk2(s[2 * 33], s[3 * 33]); o.z = pk2(s[4 * 33], s[5 * 33]); o.w = pk2(s[6 * 33], s[7 * 33]);
        if (n0 + nn < N) *(v4u*)(WT + (size_t)(row_off + n0 + nn) * ldt + k0 + 8 * c) = o; }
    LDS_WAIT(); asm volatile("" ::: "memory");
}

__device__ __forceinline__ void p0_prologue(Frame& F) {
    LAS float* scr = (LAS float*)(F.lds + F.wave * 16384);
    const int gw = F.vcu * NWAVES + F.wave, NGW = F.G * NWAVES, lane = F.lane;
    bf16* WUP = WSP(bf16, WS_WUP); bf16* WDN = WSP(bf16, WS_WDN); bf16* WKVQG = WSP(bf16, WS_WKVQG); bf16* WO = WSP(bf16, WS_WO); bf16* WPOOL = WSP(bf16, WS_WPOOL); bf16* W1CAT = WSP(bf16, WS_W1CAT);
    constexpr int I_UP = 2048, I_DN = 2048, I_KV = 768, I_QG = 544, I_WO = 512, I_PL = 32, I_C1 = 64;
    constexpr int NITEMS = 2 * I_UP + 2 * I_DN + I_KV + I_QG + I_WO + 4 * I_PL + 4 * I_C1;
    for (int it = gw; it < NITEMS; it += NGW) {
        int r = it;
        if (r < 2 * I_UP) { const int l = r / I_UP; r %= I_UP; transpose_item(F.w_up + (size_t)l * D * FF, FF, WUP + (size_t)l * FF * D, D, 0, F.norm_mlp + l * D, 1.f, scr, r / 128, r % 128, lane); continue; } r -= 2 * I_UP;
        if (r < 2 * I_DN) { const int l = r / I_DN; r %= I_DN; transpose_item(F.w_down + (size_t)l * FF * D, D, WDN + (size_t)l * D * FF, FF, 0, nullptr, 1.f, scr, r / 32, r % 32, lane); continue; } r -= 2 * I_DN;
        if (r < I_KV) { transpose_item(F.w_kv, 1536, WKVQG, D, 0, F.norm_kv, 1.f, scr, r / 48, r % 48, lane); continue; } r -= I_KV;
        if (r < I_QG) { const int nb = r % 34; transpose_item(F.w_qg, 1072, WKVQG, D, 1536, F.norm_mix + D, nb < 32 ? QSCALE : 1.f, scr, r / 34, nb, lane); continue; } r -= I_QG;
        if (r < I_WO) { transpose_item(F.w_o, D, WO, D, 0, nullptr, 1.f, scr, r / 32, r % 32, lane); continue; } r -= I_WO;
        if (r < 4 * I_PL) { const int g = r / I_PL; r %= I_PL; transpose_item(F.pool_w + (size_t)g * 65536, 256, WPOOL + (size_t)g * 65536, 256, 0, nullptr, 1.f, scr, r / 8, r % 8, lane); continue; } r -= 4 * I_PL;
        { const int kvh = r / I_C1; r %= I_C1; const int kv = kvh >> 1, half = kvh & 1;
          transpose_item(F.cmp_w1 + (size_t)kv * 2048 * 128 + (size_t)half * 1024 * 128, 128, W1CAT + (size_t)kv * 256 * D, D, half * 128, nullptr, 1.f, scr, r / 4, r % 4, lane); }
    }
    { const int gt = F.vcu * 512 + F.tid, NT = F.G * 512; v4u* z = (v4u*)(WKVQG + (size_t)2608 * D);
      for (int i = gt; i < 208 * D / 8; i += NT) z[i] = (v4u){0u, 0u, 0u, 0u}; }
    { float* CB = WSP(float, WS_CBIAS);
      for (int it = gw; it < 256; it += NGW) { const int kv = it >> 7, n = it & 127; float s = 0.f;
          for (int k = lane; k < 2048; k += 64) s += F.cmp_pe[kv * 2048 + k] * F.cmp_w1[((size_t)kv * 2048 + k) * 128 + n];
          s = wave_sum(s); if (lane == 0) CB[it] = s; } }
    bf16* DIFF = WSP(bf16, WS_DIFF);
    for (int b = gw; b < DB; b += NGW) {
        const f32x4* xr = (const f32x4*)(F.x_s + (size_t)b * D) + lane; f32x4 v[4]; float ss = 0.f;
#pragma unroll
        for (int j = 0; j < 4; ++j) { v[j] = xr[64 * j]; ss += (v[j][0] * v[j][0] + v[j][1] * v[j][1]) + (v[j][2] * v[j][2] + v[j][3] * v[j][3]); }
        const float rstd = 1.0f / sqrtf(wave_sum(ss) * (1.0f / D) + RMS_EPS);
        const float* sp = F.state_pool + (size_t)b * 15 * D; float* ps = F.out + OUT_POOL_S + (size_t)b * 15 * D;
#pragma unroll
        for (int j = 0; j < 4; ++j) {
            const int col = 256 * j + 4 * lane; const f32x4 gg = *(const f32x4*)(F.norm_mix + col); const f32x4 u = v[j] * rstd * gg;
            f32x4 sum = u; const int w = 2 << j;
            for (int r = 0; r < w - 1; ++r) sum += *(const f32x4*)(sp + (size_t)(14 - r) * D + col);
            const f32x4 df = sum * (1.0f / (float)w) - u;
            v2u o; o.x = pk2(df[0], df[1]); o.y = pk2(df[2], df[3]); *(v2u*)(DIFF + (size_t)(MP + b) * D + col) = o;
            *(f32x4*)(ps + (size_t)14 * D + col) = u;
            for (int r = 0; r < 14; ++r) *(f32x4*)(ps + (size_t)r * D + col) = *(const f32x4*)(sp + (size_t)(r + 1) * D + col);
        }
    }
    { bf16* CA = WSP(bf16, WS_CMPA);
      for (int task = F.vcu; task < DB * 128; task += F.G) { const int b = task >> 7, j = task & 127; const int page = F.page_table[b * 16 + (j >> 3)];
          const float* src = F.cache + ((size_t)page * 128 + (j & 7) * 16) * 1024;
#pragma unroll
          for (int i = 0; i < 4; ++i) { const int idx = F.tid + 512 * i, tt = idx >> 7, e = idx & 127, kv = e >> 6, g = (e >> 4) & 3, d = (e & 15) * 4;
              const f32x4 v = *(const f32x4*)(src + (size_t)tt * 1024 + e * 4);
              v2u o; o.x = pk2(v[0], v[1]); o.y = pk2(v[2], v[3]);
              *(v2u*)(CA + (size_t)kv * CMP_ROWS * D + (size_t)(CMP_ROWS_P + (b * 128 + j) * 4 + g) * D + tt * 64 + d) = o; } } }
    { const size_t gt = (size_t)F.vcu * 512 + F.tid, NT = (size_t)F.G * 512; const f32x4* src = (const f32x4*)F.state_win; f32x4* dst = (f32x4*)(F.out + OUT_WIN_S);
      for (size_t e = gt; e < (size_t)DB * 511 * 128; e += NT) { const size_t b = e / (511 * 128), rem = e - b * (511 * 128); dst[b * 65536 + rem] = src[b * 65536 + rem + 128]; } }
    __syncthreads();
    LAS float* U = (LAS float*)F.lds;
    for (int chunk = F.vcu; chunk < MP / 16; chunk += F.G) {
        const int b = chunk >> 8, t0 = (chunk & 255) * 16;
        for (int i = F.wave; i < 31; i += NWAVES) {
            const int t = t0 - 15 + i;
            f32x4 u[4];
            if (t >= 0) {
                const f32x4* xr = (const f32x4*)(F.x_p + ((size_t)b * SEQ + t) * D) + lane; float ss = 0.f;
#pragma unroll
                for (int j = 0; j < 4; ++j) { u[j] = xr[64 * j]; ss += (u[j][0] * u[j][0] + u[j][1] * u[j][1]) + (u[j][2] * u[j][2] + u[j][3] * u[j][3]); }
                const float rstd = 1.0f / sqrtf(wave_sum(ss) * (1.0f / D) + RMS_EPS);
#pragma unroll
                for (int j = 0; j < 4; ++j) u[j] = u[j] * rstd * *(const f32x4*)(F.norm_mix + 256 * j + 4 * lane);
            } else {
#pragma unroll
                for (int j = 0; j < 4; ++j) u[j] = (f32x4){0.f, 0.f, 0.f, 0.f};
            }
#pragma unroll
            for (int j = 0; j < 4; ++j) *(LAS f32x4*)(U + i * 1024 + 256 * j + 4 * lane) = u[j];
            if (t >= SEQ - 15) {
#pragma unroll
                for (int j = 0; j < 4; ++j) *(f32x4*)(F.out + OUT_POOL_P + ((size_t)b * 15 + (t - (SEQ - 15))) * D + 256 * j + 4 * lane) = u[j];
            }
        }
        __syncthreads();
        { const int c = 2 * F.tid, w = 2 << (F.tid >> 7);
          for (int tt = 0; tt < 16; ++tt) { const int i = 15 + tt, t = t0 + tt; const int cnt = (t + 1 < w) ? (t + 1) : w;
              f32x2 s = (f32x2){0.f, 0.f};
              for (int j = 0; j < w; ++j) s += *(const LAS f32x2*)(U + (i - j) * 1024 + c);
              const f32x2 cur = *(const LAS f32x2*)(U + i * 1024 + c); const float inv = 1.0f / (float)cnt;
              *(unsigned*)(DIFF + ((size_t)b * SEQ + t) * D + c) = pk2(s[0] * inv - cur[0], s[1] * inv - cur[1]); } }
        __syncthreads();
    }
}

__device__ __forceinline__ void p6_combine(Frame& F) {
    LAS float* W2 = (LAS float*)F.lds;
    LAS float* HID = (LAS float*)(F.lds + 65536);
    LAS float* CBL = (LAS float*)(F.lds + 65536 + 16384);
    const float* P = WSP(float, WS_CMPP); bf16* KC = WSP(bf16, WS_KC); float* KCS = WSP(float, WS_KCS);
    for (int i = F.tid; i < 2 * 128 * 64; i += 512) W2[i] = F.cmp_w2[i];
    if (F.tid < 256) CBL[F.tid] = WSP(float, WS_CBIAS)[F.tid];
    __syncthreads();
    constexpr int NTASK_P = CMP_ROWS_P / 32, NTASK_S = CMP_ROWS_S / 32, NTASK = 2 * (NTASK_P + NTASK_S);
    for (int task = F.vcu; task < NTASK; task += F.G) {
        int r = task; const int kv = r / (NTASK_P + NTASK_S); r %= (NTASK_P + NTASK_S);
        const bool prompt = r < NTASK_P; const int r0 = prompt ? r * 32 : (r - NTASK_P) * 32;
        const int prow0 = prompt ? r0 : CMP_ROWS_P + r0; const int nimask = prompt ? 255 : 127;
        const float* Pk = P + (size_t)kv * CMP_ROWS * 256;
#pragma unroll
        for (int e = 0; e < 8; ++e) { const int idx = F.tid + 512 * e, rr = idx >> 7, n = idx & 127; const int i_blk = ((r0 + rr) >> 2) & nimask;
            float h = 0.f;
            if (i_blk < nimask) { const float z = Pk[(size_t)(prow0 + rr) * 256 + n] + Pk[(size_t)(prow0 + rr + 4) * 256 + 128 + n] + CBL[kv * 128 + n]; h = z / (1.0f + __expf(-z)); }
            HID[rr * 128 + n] = h; }
        __syncthreads();
        { const int d = F.lane, rb = F.wave * 4; float a0 = 0.f, a1 = 0.f, a2 = 0.f, a3 = 0.f; const LAS float* w2 = W2 + kv * 8192 + d;
#pragma unroll 8
          for (int n = 0; n < 128; ++n) { const float w = w2[n * 64]; a0 += HID[(rb + 0) * 128 + n] * w; a1 += HID[(rb + 1) * 128 + n] * w; a2 += HID[(rb + 2) * 128 + n] * w; a3 += HID[(rb + 3) * 128 + n] * w; }
          const float av[4] = {a0, a1, a2, a3};
#pragma unroll
          for (int q = 0; q < 4; ++q) { const int ro = r0 + rb + q, g = ro & 3;
              if (prompt) { const int b = ro >> 10, i_blk = (ro >> 2) & 255; KC[((size_t)((kv * 4 + b) * 4 + g) * 256 + i_blk) * 64 + d] = (bf16)f2bf(av[q]); }
              else { const int b = ro >> 9, i_blk = (ro >> 2) & 127; KCS[((size_t)((kv * 128 + b) * 4 + g) * 128 + i_blk) * 64 + d] = av[q]; } } }
        __syncthreads();
    }
}

constexpr int KSTR = 144;
constexpr int AT_K = 0, AT_V = 64 * KSTR, AT_T = 2 * 64 * KSTR, AT_TS = 66, AT_U = AT_T + 64 * AT_TS * 4, AT_SEL = AT_U + 64 * AT_TS * 4, AT_WUNI = AT_SEL + 512, AT_END = AT_WUNI + 64;
static_assert(AT_END <= RING_BYTES, "attention LDS");

__device__ __forceinline__ unsigned cvtpk(float lo, float hi) { typedef __bf16 bf16x2_t __attribute__((ext_vector_type(2))); f32x2 v = {lo, hi}; bf16x2_t b = __builtin_convertvector(v, bf16x2_t); return __builtin_bit_cast(unsigned, b); }
__device__ __forceinline__ v4i16_t vtr(const LAS unsigned char* p) { return __builtin_amdgcn_ds_read_tr16_b64_v4i16((LAS v4i16_t*)p); }

__device__ __forceinline__ void stage_kv(Frame& F, const bf16* ksrc, const bf16* vsrc, int pitch) {
    const int key = F.tid >> 3, ch = F.tid & 7;
    const v4u kk = *(const v4u*)(ksrc + (size_t)key * pitch + ch * 8);
    const v4u vv = *(const v4u*)(vsrc + (size_t)key * pitch + ch * 8);
    *(LAS v4u*)(F.lds + AT_K + key * KSTR + ch * 16) = kk;
    *(LAS v4u*)(F.lds + AT_V + key * KSTR + ch * 16) = vv;
}

template <int MODE>
__device__ __forceinline__ void attn_tile(Frame& F, const bf16x8 (&qf)[4], int relb, float slope2, bool rowok, float& m, float& l, f32x16& o0, f32x16& o1,
                                          float mfin, float invl, LAS float* Tq, LAS float* Uq, int sig0) {
    const int lane = F.lane, r = lane & 31, h = lane >> 5;
    const LAS unsigned char* Kt = F.lds + AT_K; const LAS unsigned char* Vt = F.lds + AT_V;
    f32x16 p0, p1;
#pragma unroll
    for (int i = 0; i < 16; ++i) { p0[i] = 0.f; p1[i] = 0.f; }
#pragma unroll
    for (int ks = 0; ks < 4; ++ks) {
        const bf16x8 a0 = *(const LAS bf16x8*)(Kt + r * KSTR + ks * 32 + h * 16);
        const bf16x8 a1 = *(const LAS bf16x8*)(Kt + (32 + r) * KSTR + ks * 32 + h * 16);
        p0 = __builtin_amdgcn_mfma_f32_32x32x16_bf16(a0, qf[ks], p0, 0, 0, 0);
        p1 = __builtin_amdgcn_mfma_f32_32x32x16_bf16(a1, qf[ks], p1, 0, 0, 0);
    }
    constexpr int PM = (MODE <= 1) ? 16 : 1;
    const float NEG = -INFINITY;
    float mx = NEG;
#pragma unroll
    for (int i = 0; i < 16; ++i) {
        const int kofs = PM * ((i & 3) + 8 * (i >> 2));
        const int rel0 = relb + kofs, rel1 = rel0 + PM * 32;
        bool ok0 = rowok && rel0 <= 0, ok1 = rowok && rel1 <= 0;
        if (MODE == 3) { ok0 = ok0 && rel0 > -512; ok1 = ok1 && rel1 > -512; }
        p0[i] = ok0 ? fmaf(slope2, (float)rel0, p0[i]) : NEG;
        p1[i] = ok1 ? fmaf(slope2, (float)rel1, p1[i]) : NEG;
        mx = fmaxf(mx, fmaxf(p0[i], p1[i]));
    }
    if (MODE == 0) {
        mx = fmaxf(mx, __shfl_xor(mx, 32));
        const float mn = fmaxf(m, mx), mu = (mn == NEG) ? 0.f : mn;
        float rs = 0.f;
#pragma unroll
        for (int i = 0; i < 16; ++i) rs += __builtin_amdgcn_exp2f(p0[i] - mu) + __builtin_amdgcn_exp2f(p1[i] - mu);
        l = l * __builtin_amdgcn_exp2f(m - mu) + rs; m = mn;
        return;
    }
    if (MODE == 1) {
        const float mu = (mfin == NEG) ? 0.f : mfin;
#pragma unroll
        for (int i = 0; i < 16; ++i) { p0[i] = __builtin_amdgcn_exp2f(p0[i] - mu) * invl; p1[i] = __builtin_amdgcn_exp2f(p1[i] - mu) * invl; }
#pragma unroll
        for (int hf = 0; hf < 2; ++hf)
#pragma unroll
            for (int g4 = 0; g4 < 4; ++g4) {
                const float pa = hf ? p1[4 * g4] : p0[4 * g4], pb = hf ? p1[4 * g4 + 1] : p0[4 * g4 + 1], pc = hf ? p1[4 * g4 + 2] : p0[4 * g4 + 2], pd = hf ? p1[4 * g4 + 3] : p0[4 * g4 + 3];
                float tv = 2.f * ((pa + pb) + pc) + pd, uv = pd;
                tv += __shfl_xor(tv, 1); uv += __shfl_xor(uv, 1); tv += __shfl_xor(tv, 2); uv += __shfl_xor(uv, 2);
                const int sg = sig0 + 8 * hf + 2 * g4 + h;
                if ((lane & 3) == 0) { Tq[sg] = tv; Uq[sg + 1] = uv; }
            }
    } else {
        mx = fmaxf(mx, __shfl_xor(mx, 32));
        const float mn = fmaxf(m, mx), mu = (mn == NEG) ? 0.f : mn;
        const float alpha = __builtin_amdgcn_exp2f(m - mu);
        float rs = 0.f;
#pragma unroll
        for (int i = 0; i < 16; ++i) { p0[i] = __builtin_amdgcn_exp2f(p0[i] - mu); p1[i] = __builtin_amdgcn_exp2f(p1[i] - mu); rs += p0[i] + p1[i]; }
        l = l * alpha + rs; m = mn;
#pragma unroll
        for (int i = 0; i < 16; ++i) { o0[i] *= alpha; o1[i] *= alpha; }
    }
    const LAS unsigned char* vb = Vt + (((lane & 15) >> 2) + 4 * h) * KSTR + (16 * ((lane >> 4) & 1) + 4 * (lane & 3)) * 2;
#pragma unroll
    for (int sp = 0; sp < 4; ++sp) {
        v4u pw;
        if (sp < 2) { const int b8 = 8 * sp; pw.x = cvtpk(p0[b8], p0[b8 + 1]); pw.y = cvtpk(p0[b8 + 2], p0[b8 + 3]); pw.z = cvtpk(p0[b8 + 4], p0[b8 + 5]); pw.w = cvtpk(p0[b8 + 6], p0[b8 + 7]); }
        else { const int b8 = 8 * (sp - 2); pw.x = cvtpk(p1[b8], p1[b8 + 1]); pw.y = cvtpk(p1[b8 + 2], p1[b8 + 3]); pw.z = cvtpk(p1[b8 + 4], p1[b8 + 5]); pw.w = cvtpk(p1[b8 + 6], p1[b8 + 7]); }
        const bf16x8 pbf = __builtin_bit_cast(bf16x8, pw);
#pragma unroll
        for (int db = 0; db < 2; ++db) {
            const v4i16_t lo = vtr(vb + (16 * sp) * KSTR + 64 * db), hi = vtr(vb + (16 * sp + 8) * KSTR + 64 * db);
            const bf16x8 vf = (bf16x8){lo[0], lo[1], lo[2], lo[3], hi[0], hi[1], hi[2], hi[3]};
            if (db == 0) o0 = __builtin_amdgcn_mfma_f32_32x32x16_bf16(vf, pbf, o0, 0, 0, 0);
            else o1 = __builtin_amdgcn_mfma_f32_32x32x16_bf16(vf, pbf, o1, 0, 0, 0);
        }
    }
}

__device__ __forceinline__ void attn_prompt_unit(Frame& F, int b, int g, int qb) {
    const int lane = F.lane, r = lane & 31, h = lane >> 5, w = F.wave;
    const int c0 = qb * 64, cur = qb, ql = 8 * w + (r >> 2), tq = c0 + ql, hd = g * 4 + (r & 3);
    const bf16* Q = WSP(bf16, WS_Q); const bf16* KVS = WSP(bf16, WS_KVS); const bf16* KVW = WSP(bf16, WS_KVW); const bf16* KC = WSP(bf16, WS_KC); const float* GATE = WSP(float, WS_GATE);
    bf16* O = WSP(bf16, WS_DIFF);
    const size_t row = (size_t)b * SEQ + tq;
    bf16x8 qf[4];
#pragma unroll
    for (int ks = 0; ks < 4; ++ks) qf[ks] = *(const bf16x8*)(Q + row * D + hd * 64 + ks * 16 + h * 8);
    const float slope2 = exp2f(-0.5f * (float)(hd + 1)) * LOG2E;
    const float g0 = GATE[row * 48 + hd * 3 + 0], g1 = GATE[row * 48 + hd * 3 + 1], g2 = GATE[row * 48 + hd * 3 + 2];
    LAS float* T = (LAS float*)(F.lds + AT_T); LAS float* U = (LAS float*)(F.lds + AT_U);
    LAS unsigned* SELM = (LAS unsigned*)(F.lds + AT_SEL); LAS unsigned* WUNI = (LAS unsigned*)(F.lds + AT_WUNI);
    for (int i = F.tid; i < 2 * 64 * AT_TS; i += 512) T[i] = 0.f;
    f32x16 of0, of1, o0, o1;
#pragma unroll
    for (int i = 0; i < 16; ++i) { of0[i] = 0.f; of1[i] = 0.f; o0[i] = 0.f; o1[i] = 0.f; }
    const float NEG = -INFINITY;
    const int nmax = c0 / 16 + 2;
    const int ntile = (nmax >= 255 ? 254 : nmax) / 64 + 1;
    const bf16* kc = KC + (size_t)((0 * 4 + b) * 4 + g) * 256 * 64; const bf16* vc = KC + (size_t)((1 * 4 + b) * 4 + g) * 256 * 64;
    float m = NEG, l = 0.f;
    for (int tl = 0; tl < ntile; ++tl) {
        __syncthreads();
        stage_kv(F, kc + (size_t)tl * 64 * 64, vc + (size_t)tl * 64 * 64, 64);
        __syncthreads();
        attn_tile<0>(F, qf, 16 * 64 * tl + 31 + 16 * 4 * h - tq, slope2, true, m, l, o0, o1, 0.f, 0.f, nullptr, nullptr, 0);
    }
    { const float lt = l + __shfl_xor(l, 32); const float invl = lt > 0.f ? 1.0f / lt : 0.f;
      LAS float* Tq = T + ql * AT_TS; LAS float* Uq = U + ql * AT_TS;
      for (int tl = 0; tl < ntile; ++tl) {
          __syncthreads();
          stage_kv(F, kc + (size_t)tl * 64 * 64, vc + (size_t)tl * 64 * 64, 64);
          __syncthreads();
          attn_tile<1>(F, qf, 16 * 64 * tl + 31 + 16 * 4 * h - tq, slope2, true, m, l, o0, o1, m, invl, Tq, Uq, 16 * tl);
      }
#pragma unroll
      for (int i = 0; i < 16; ++i) { of0[i] = g0 * o0[i]; of1[i] = g0 * o1[i]; o0[i] = 0.f; o1[i] = 0.f; } }
    __syncthreads();
    unsigned long long wuni = 0ull;
    for (int qq = 8 * w; qq < 8 * w + 8; ++qq) {
        unsigned long long msk;
        if (cur <= 15) msk = (cur == 63) ? ~0ull : ((1ull << (cur + 1)) - 1ull);
        else {
            const float v = T[qq * AT_TS + lane] + U[qq * AT_TS + lane];
            T[qq * AT_TS + lane] = v;
            LDS_WAIT(); asm volatile("" ::: "memory");
            int rank = 0;
            for (int s2 = 1; s2 <= cur - 2; ++s2) { const float o = T[qq * AT_TS + s2]; rank += (o > v || (o == v && s2 < lane)) ? 1 : 0; }
            const bool sel = (lane <= cur) && (lane == 0 || lane >= cur - 1 || rank < 13);
            msk = __ballot(sel);
        }
        if (lane == 0) { SELM[2 * qq] = (unsigned)msk; SELM[2 * qq + 1] = (unsigned)(msk >> 32); }
        wuni |= msk;
    }
    wuni = ((unsigned long long)(unsigned)__builtin_amdgcn_readfirstlane((int)(unsigned)(wuni >> 32)) << 32) | (unsigned long long)(unsigned)__builtin_amdgcn_readfirstlane((int)(unsigned)wuni);
    if (lane == 0) { WUNI[2 * w] = (unsigned)wuni; WUNI[2 * w + 1] = (unsigned)(wuni >> 32); }
    __syncthreads();
    unsigned long long guni = 0ull;
#pragma unroll
    for (int i = 0; i < 8; ++i) guni |= (unsigned long long)WUNI[2 * i] | ((unsigned long long)WUNI[2 * i + 1] << 32);
    const unsigned long long mym = (unsigned long long)SELM[2 * ql] | ((unsigned long long)SELM[2 * ql + 1] << 32);
    m = NEG; l = 0.f;
    { const bf16* ks = KVS + (size_t)b * SEQ * 512 + g * 64; const bf16* vs = ks + 256;
      unsigned long long rem = guni;
      while (rem) {
          const int s = __builtin_ctzll(rem); rem &= rem - 1ull;
          __syncthreads();
          stage_kv(F, ks + (size_t)s * 64 * 512, vs + (size_t)s * 64 * 512, 512);
          __syncthreads();
          if ((wuni >> s) & 1ull) attn_tile<2>(F, qf, 64 * s + 4 * h - tq, slope2, ((mym >> s) & 1ull) != 0ull, m, l, o0, o1, 0.f, 0.f, nullptr, nullptr, 0);
      }
      const float lt = l + __shfl_xor(l, 32); const float sc = lt > 0.f ? g1 / lt : 0.f;
#pragma unroll
      for (int i = 0; i < 16; ++i) { of0[i] += sc * o0[i]; of1[i] += sc * o1[i]; o0[i] = 0.f; o1[i] = 0.f; } }
    m = NEG; l = 0.f;
    { const bf16* kw = KVW + (size_t)b * SEQ * 512 + g * 64; const bf16* vw = kw + 256;
      for (int j = 0; j < 9; ++j) {
          const int pos0 = c0 - 512 + 64 * j; if (pos0 < 0) continue;
          __syncthreads();
          stage_kv(F, kw + (size_t)pos0 * 512, vw + (size_t)pos0 * 512, 512);
          __syncthreads();
          attn_tile<3>(F, qf, pos0 + 4 * h - tq, slope2, true, m, l, o0, o1, 0.f, 0.f, nullptr, nullptr, 0);
      }
      const float lt = l + __shfl_xor(l, 32); const float sc = lt > 0.f ? g2 / lt : 0.f;
#pragma unroll
      for (int i = 0; i < 16; ++i) { of0[i] += sc * o0[i]; of1[i] += sc * o1[i]; } }
    bf16* orow = O + row * D + hd * 64;
#pragma unroll
    for (int g4 = 0; g4 < 4; ++g4) {
        v2u a; a.x = cvtpk(of0[4 * g4], of0[4 * g4 + 1]); a.y = cvtpk(of0[4 * g4 + 2], of0[4 * g4 + 3]);
        v2u c; c.x = cvtpk(of1[4 * g4], of1[4 * g4 + 1]); c.y = cvtpk(of1[4 * g4 + 2], of1[4 * g4 + 3]);
        *(v2u*)(orow + 8 * g4 + 4 * h) = a; *(v2u*)(orow + 32 + 8 * g4 + 4 * h) = c;
    }
    __syncthreads();
}

constexpr int SA_QS = 0, SA_S = 1024, SA_SN = 1040, SA_IMP = SA_S + 4 * SA_SN * 4, SA_LIST = SA_IMP + 256, SA_BLK = SA_LIST + 64, SA_OP = SA_BLK + 128, SA_END = SA_OP + 2 * 256 * 4;
static_assert(SA_END <= RING_BYTES, "sample attention LDS");

__device__ __forceinline__ bf16x8 cvt8(const f32x4 a, const f32x4 b) { v4u w; w.x = cvtpk(a[0], a[1]); w.y = cvtpk(a[2], a[3]); w.z = cvtpk(b[0], b[1]); w.w = cvtpk(b[2], b[3]); return __builtin_bit_cast(bf16x8, w); }

__device__ __forceinline__ void sa_softmax(Frame& F, LAS float* S, int nk) {
    if (F.wave < 4) { LAS float* s = S + F.wave * SA_SN; float mx = -INFINITY;
        for (int i = F.lane; i < nk; i += 64) mx = fmaxf(mx, s[i]);
        mx = wave_max(mx); if (mx == -INFINITY) mx = 0.f;
        float sum = 0.f;
        for (int i = F.lane; i < nk; i += 64) { const float e = __builtin_amdgcn_exp2f(s[i] - mx); s[i] = e; sum += e; }
        sum = wave_sum(sum); const float inv = sum > 0.f ? 1.0f / sum : 0.f;
        for (int i = F.lane; i < nk; i += 64) s[i] *= inv; }
}

__device__ __forceinline__ void attn_sample_unit(Frame& F, int b, int g) {
    const int tid = F.tid, lane = F.lane, w = F.wave; const int row = MP + b;
    const bf16* Q = WSP(bf16, WS_Q); const bf16* KVS = WSP(bf16, WS_KVS); const bf16* KVW = WSP(bf16, WS_KVW); const float* KCS = WSP(float, WS_KCS); const float* GATE = WSP(float, WS_GATE);
    bf16* O = WSP(bf16, WS_DIFF);
    LAS float* QS = (LAS float*)(F.lds + SA_QS); LAS float* S = (LAS float*)(F.lds + SA_S); LAS float* IMP = (LAS float*)(F.lds + SA_IMP);
    LAS int* LIST = (LAS int*)(F.lds + SA_LIST); LAS int* BLK = (LAS int*)(F.lds + SA_BLK); LAS float* OP = (LAS float*)(F.lds + SA_OP);
    __syncthreads();
    if (tid < 256) QS[tid] = bf2f(Q[(size_t)row * D + g * 256 + tid]);
    bf16x8 af[2];
#pragma unroll
    for (int ks = 0; ks < 2; ++ks) { af[ks] = (bf16x8){0, 0, 0, 0, 0, 0, 0, 0}; if ((lane & 15) < 4) af[ks] = *(const bf16x8*)(Q + (size_t)row * D + (g * 4 + (lane & 15)) * 64 + 32 * ks + 8 * (lane >> 4)); }
    float sl2[4];
#pragma unroll
    for (int i = 0; i < 4; ++i) sl2[i] = exp2f(-0.5f * (float)(g * 4 + i + 1)) * LOG2E;
    const int ohd = (tid >> 6) & 3, od = tid & 63, half = tid >> 8;
    float ofin = 0.f;
    const float gt0 = GATE[(size_t)row * 48 + (g * 4 + ohd) * 3 + 0], gt1 = GATE[(size_t)row * 48 + (g * 4 + ohd) * 3 + 1], gt2 = GATE[(size_t)row * 48 + (g * 4 + ohd) * 3 + 2];
    __syncthreads();
    { const float* kc = KCS + (size_t)((0 * 128 + b) * 4 + g) * 128 * 64; const float* vc = KCS + (size_t)((1 * 128 + b) * 4 + g) * 128 * 64;
      { const int n = 16 * w + (lane & 15); const float* kr = kc + (size_t)n * 64 + 8 * (lane >> 4);
        f32x4 acc = (f32x4){0.f, 0.f, 0.f, 0.f};
#pragma unroll
        for (int ks = 0; ks < 2; ++ks) { const bf16x8 bfr = cvt8(*(const f32x4*)(kr + 32 * ks), *(const f32x4*)(kr + 32 * ks + 4)); acc = __builtin_amdgcn_mfma_f32_16x16x32_bf16(af[ks], bfr, acc, 0, 0, 0); }
        if (lane < 16) {
#pragma unroll
            for (int i = 0; i < 4; ++i) S[i * SA_SN + n] = (n < 127) ? acc[i] + sl2[i] * (float)(16 * n + 31 - PAST) : -INFINITY; } }
      __syncthreads();
      sa_softmax(F, S, 128);
      __syncthreads();
      if (tid < 33) { float a = 0.f;
          for (int i = 0; i < 4; ++i) for (int dn = -1; dn <= 3; ++dn) { const int n = 4 * tid + dn; if (n >= 0 && n < 127) a += ((dn == -1 || dn == 3) ? 1.f : 2.f) * S[i * SA_SN + n]; }
          IMP[tid] = a; }
      if (tid < 256) { float a = 0.f;
#pragma unroll 8
          for (int n = 0; n < 127; ++n) a += S[ohd * SA_SN + n] * vc[(size_t)n * 64 + od];
          ofin = gt0 * a; }
      __syncthreads(); }
    if (w == 0) { const float v = (lane <= 32) ? IMP[lane] : 0.f; int rank = 0;
        for (int s2 = 1; s2 <= 30; ++s2) { const float o = IMP[s2]; rank += (o > v || (o == v && s2 < lane)) ? 1 : 0; }
        const bool sel = (lane == 0) || (lane == 31) || (lane >= 1 && lane <= 30 && rank < 13);
        const unsigned long long msk = __ballot(sel);
        if (sel) { const int pos = __builtin_popcountll(msk & ((1ull << lane) - 1ull)); LIST[pos] = lane;
            const int page = F.page_table[b * 16 + (lane >> 1)]; BLK[pos] = page * 128 + (lane & 1) * 64; } }
    __syncthreads();
    { for (int st = w; st < 60; st += NWAVES) { const int bi = st >> 2, kk = 16 * (st & 3) + (lane & 15); const int s = LIST[bi]; const int pos = 64 * s + kk;
          const float* kr = F.cache + ((size_t)(BLK[bi] + kk) * 4 + 2) * 256 + g * 64 + 8 * (lane >> 4);
          f32x4 acc = (f32x4){0.f, 0.f, 0.f, 0.f};
#pragma unroll
          for (int ks = 0; ks < 2; ++ks) { const bf16x8 bfr = cvt8(*(const f32x4*)(kr + 32 * ks), *(const f32x4*)(kr + 32 * ks + 4)); acc = __builtin_amdgcn_mfma_f32_16x16x32_bf16(af[ks], bfr, acc, 0, 0, 0); }
          if (lane < 16) {
#pragma unroll
              for (int i = 0; i < 4; ++i) S[i * SA_SN + 64 * bi + kk] = acc[i] + sl2[i] * (float)(pos - PAST); } }
      if (w < 4) { float pr = QS[w * 64 + lane] * bf2f(KVS[(size_t)row * 512 + g * 64 + lane]); pr = wave_sum(pr); if (lane == 0) S[w * SA_SN + 960] = pr; }
      __syncthreads();
      sa_softmax(F, S, 961);
      __syncthreads();
      { float a = 0.f; const int k0 = half * 480;
        for (int k = k0; k < k0 + 480; ++k) { const int bi = k >> 6, kk = k & 63;
            a += S[ohd * SA_SN + k] * F.cache[((size_t)(BLK[bi] + kk) * 4 + 3) * 256 + g * 64 + od]; }
        if (half) a += S[ohd * SA_SN + 960] * bf2f(KVS[(size_t)row * 512 + 256 + g * 64 + od]);
        OP[half * 256 + ohd * 64 + od] = a; }
      __syncthreads();
      if (tid < 256) ofin += gt1 * (OP[tid] + OP[256 + tid]);
      __syncthreads(); }
    { const float* sw = F.state_win + (size_t)b * 512 * 512;
      for (int st = w; st < 32; st += NWAVES) { const int i = 16 * st + (lane & 15);
          const float* kr = sw + (size_t)i * 512 + g * 64 + 8 * (lane >> 4);
          f32x4 acc = (f32x4){0.f, 0.f, 0.f, 0.f};
#pragma unroll
          for (int ks = 0; ks < 2; ++ks) { const bf16x8 bfr = cvt8(*(const f32x4*)(kr + 32 * ks), *(const f32x4*)(kr + 32 * ks + 4)); acc = __builtin_amdgcn_mfma_f32_16x16x32_bf16(af[ks], bfr, acc, 0, 0, 0); }
          if (lane < 16) {
#pragma unroll
              for (int q = 0; q < 4; ++q) S[q * SA_SN + i] = (i >= 1) ? acc[q] + sl2[q] * (float)(i - 512) : -INFINITY; } }
      if (w < 4) { float pr = QS[w * 64 + lane] * bf2f(KVW[(size_t)row * 512 + g * 64 + lane]); pr = wave_sum(pr); if (lane == 0) S[w * SA_SN + 512] = pr; }
      __syncthreads();
      sa_softmax(F, S, 513);
      __syncthreads();
      { float a = 0.f; const int k0 = half * 256;
        for (int k = k0; k < k0 + 256; ++k) a += S[ohd * SA_SN + k] * sw[(size_t)k * 512 + 256 + g * 64 + od];
        if (half) a += S[ohd * SA_SN + 512] * bf2f(KVW[(size_t)row * 512 + 256 + g * 64 + od]);
        OP[half * 256 + ohd * 64 + od] = a; }
      __syncthreads();
      if (tid < 256) { ofin += gt2 * (OP[tid] + OP[256 + tid]); O[(size_t)row * D + (g * 4 + ohd) * 64 + od] = (bf16)f2bf(ofin); }
      __syncthreads(); }
}

__device__ __forceinline__ void p7_attention(Frame& F) {
    for (int i = F.vcu; i < 1024; i += F.G) { const int k = i >> 8, c = i & 255, bg = c >> 4, s = c & 15; const int qb = (k == 0) ? s : (k == 1) ? 31 - s : (k == 2) ? 32 + s : 63 - s;
        attn_prompt_unit(F, bg >> 2, bg & 3, qb); }
    for (int i = F.vcu; i < DB * 4; i += F.G) attn_sample_unit(F, i >> 2, i & 3);
}

__device__ __forceinline__ void p11_final(Frame& F) {
    const int gw = F.vcu * NWAVES + F.wave, NGW = F.G * NWAVES, lane = F.lane; const float* X = WSP(float, WS_X);
    for (int row = gw; row < MT; row += NGW) {
        const f32x4* xr = (const f32x4*)(X + (size_t)row * D) + lane; f32x4 v[4]; float ss = 0.f;
#pragma unroll
        for (int j = 0; j < 4; ++j) { v[j] = xr[64 * j]; ss += (v[j][0] * v[j][0] + v[j][1] * v[j][1]) + (v[j][2] * v[j][2] + v[j][3] * v[j][3]); }
        const float rstd = 1.0f / sqrtf(wave_sum(ss) * (1.0f / D) + RMS_EPS);
        float* o = (row < MP) ? F.out + OUT_Y_P + (size_t)row * D : F.out + OUT_Y_S + (size_t)(row - MP) * D;
#pragma unroll
        for (int j = 0; j < 4; ++j) *((f32x4*)o + lane + 64 * j) = v[j] * rstd * *((const f32x4*)F.norm_final + lane + 64 * j);
    }
}

constexpr int NPHASE = 12;
struct Args { const void* in[21]; float* out; unsigned char* ws; int ph_lo, ph_hi; };
__global__ void __launch_bounds__(NWAVES * 64, 2) yoco_fwd(Args args) {
    extern __shared__ __attribute__((aligned(16))) unsigned char lds[];
    Frame F;
    F.lds = (LAS unsigned char*)lds;
    F.tid = threadIdx.x; F.lane = F.tid & 63; F.wave = __builtin_amdgcn_readfirstlane(F.tid >> 6);
    F.G = gridDim.x; { const int bx = blockIdx.x; F.vcu = (F.G % 8 == 0) ? (bx % 8) * (F.G / 8) + bx / 8 : bx; }
    F.x_p = (const float*)args.in[0]; F.x_s = (const float*)args.in[1]; F.state_pool = (const float*)args.in[2]; F.cache = (const float*)args.in[3]; F.state_win = (const float*)args.in[4];
    F.page_table = (const int*)args.in[5]; F.norm_mix = (const float*)args.in[6]; F.norm_mlp = (const float*)args.in[7]; F.w_up = (const float*)args.in[8]; F.w_down = (const float*)args.in[9];
    F.pool_w = (const float*)args.in[10]; F.pool_scale = (const float*)args.in[11]; F.norm_kv = (const float*)args.in[12]; F.w_kv = (const float*)args.in[13]; F.cmp_pe = (const float*)args.in[14];
    F.cmp_w1 = (const float*)args.in[15]; F.cmp_w2 = (const float*)args.in[16]; F.w_qg = (const float*)args.in[17]; F.b_gate = (const float*)args.in[18]; F.w_o = (const float*)args.in[19];
    F.norm_final = (const float*)args.in[20]; F.out = args.out; F.ws = args.ws;
    volatile LAS unsigned* MISC = (volatile LAS unsigned*)(F.lds + MISC_OFF);
    for (int u = F.tid; u < (LDS_BYTES - RING_BYTES) / 4; u += NWAVES * 64) ((LAS unsigned*)(F.lds + RING_BYTES))[u] = 0u;
    __syncthreads();
    unsigned* ctl = (unsigned*)(F.ws + WS_CTL);
#if MK_MULTI
#define GRID_BAR() do { } while (0)
#else
    XcdBarrier bar = xcd_barrier_post(ctl + CW_BAR, MISC + 8);
#define GRID_BAR() xcd_barrier(bar)
#endif
    const int lo = args.ph_lo, hi = args.ph_hi;
#define IN(k) (lo <= (k) && (k) < hi)
#define SEAM(k) do { if (IN(k) && IN((k) + 1)) GRID_BAR(); } while (0)
    using namespace pg8;
    float* X = WSP(float, WS_X); bf16* XB = WSP(bf16, WS_XB); float* RS = WSP(float, WS_RS);

    if (IN(0)) { p0_prologue(F); } SEAM(0);
    if (IN(1)) {
        Gemm g{WSP(bf16_t, WS_DIFF), WSP(bf16_t, WS_WPOOL), MPAD, 1024, 256, 1024, 256, (size_t)512}; StaticOrder S; S.init(MPAD, 1024, F.G, (int)blockIdx.x);
        EpiResid E{F.x_p, F.x_s, X, XB, RS, F.pool_scale};
        gemm_phase<EpiResid, StaticOrder, true, true>(F.lds, g, S, E);
    } SEAM(1);
    if (IN(2)) {
        Gemm g{XB, WSP(bf16_t, WS_WUP), MPAD, FF, D, D, D, (size_t)0}; StaticOrder S; S.init(MPAD, FF, F.G, (int)blockIdx.x);
        EpiUp E{WSP(bf16_t, WS_H), RS};
        gemm_phase<EpiUp, StaticOrder, true, true>(F.lds, g, S, E);
    } SEAM(2);
    if (IN(3)) {
        Gemm g{WSP(bf16_t, WS_H), WSP(bf16_t, WS_WDN), MPAD, D, FF, FF, FF, (size_t)0}; StaticOrder S; S.init(MPAD, D, F.G, (int)blockIdx.x);
        EpiResid E{X, X + (size_t)MP * D, X, XB, RS, nullptr};
        gemm_phase<EpiResid, StaticOrder, true, true>(F.lds, g, S, E);
    } SEAM(3);
    if (IN(4)) {
        Gemm g{XB, WSP(bf16_t, WS_WKVQG), MPAD, NKVQG, D, D, D, (size_t)0}; StaticOrder S; S.init(MPAD, NKVQG, F.G, (int)blockIdx.x);
        EpiKvqg E{RS, F.b_gate, F.out + OUT_KV_P, F.out + OUT_KV_S, F.out + OUT_WIN_P, F.out + OUT_WIN_S, WSP(bf16_t, WS_CMPA), WSP(bf16_t, WS_KVS), WSP(bf16_t, WS_KVW), WSP(bf16_t, WS_Q), WSP(float, WS_GATE)};
        gemm_phase<EpiKvqg, StaticOrder, true, true>(F.lds, g, S, E);
    } SEAM(4);
    if (IN(5)) {
        Gemm g{WSP(bf16_t, WS_CMPA), WSP(bf16_t, WS_W1CAT), CMP_ROWS, 512, D, D, D, (size_t)CMP_ROWS * D * 2}; StaticOrder S; S.init(CMP_ROWS, 512, F.G, (int)blockIdx.x);
        EpiCmp E{WSP(float, WS_CMPP)};
        gemm_phase<EpiCmp, StaticOrder, true, true>(F.lds, g, S, E);
    } SEAM(5);
    if (IN(6)) { p6_combine(F); } SEAM(6);
    if (IN(7)) { p7_attention(F); } SEAM(7);
    if (IN(8)) {
        Gemm g{WSP(bf16_t, WS_DIFF), WSP(bf16_t, WS_WO), MPAD, D, D, D, D, (size_t)0}; StaticOrder S; S.init(MPAD, D, F.G, (int)blockIdx.x);
        EpiResid E{X, X + (size_t)MP * D, X, XB, RS, nullptr};
        gemm_phase<EpiResid, StaticOrder, true, true>(F.lds, g, S, E);
    } SEAM(8);
    if (IN(9)) {
        Gemm g{XB, WSP(bf16_t, WS_WUP) + (size_t)FF * D, MPAD, FF, D, D, D, (size_t)0}; StaticOrder S; S.init(MPAD, FF, F.G, (int)blockIdx.x);
        EpiUp E{WSP(bf16_t, WS_H), RS};
        gemm_phase<EpiUp, StaticOrder, true, true>(F.lds, g, S, E);
    } SEAM(9);
    if (IN(10)) {
        Gemm g{WSP(bf16_t, WS_H), WSP(bf16_t, WS_WDN) + (size_t)D * FF, MPAD, D, FF, FF, FF, (size_t)0}; StaticOrder S; S.init(MPAD, D, F.G, (int)blockIdx.x);
        EpiResid E{X, X + (size_t)MP * D, X, XB, RS, nullptr};
        gemm_phase<EpiResid, StaticOrder, true, true>(F.lds, g, S, E);
    } SEAM(10);
    if (IN(11)) { p11_final(F); }
#undef IN
#undef SEAM
}

extern "C" void kernel_launch(void* const* d_in, const int* in_sizes, int n_in, void* d_out, int out_size, void* d_ws, size_t ws_size, hipStream_t stream) {
    static int grid = 0;
    if (grid == 0) {
        if (n_in != 21 || (size_t)out_size != OUT_TOTAL || ws_size < WS_END) { fprintf(stderr, "kernel_launch: unexpected sizes n_in %d out %d ws %zu\n", n_in, out_size, ws_size); grid = -1; return; }
        int dev = 0, cus = 0, per_cu = 0;
        if (hipGetDevice(&dev) != hipSuccess || hipDeviceGetAttribute(&cus, hipDeviceAttributeMultiprocessorCount, dev) != hipSuccess) { grid = -1; return; }
        if (hipFuncSetAttribute((const void*)yoco_fwd, hipFuncAttributeMaxDynamicSharedMemorySize, LDS_BYTES) != hipSuccess) { fprintf(stderr, "kernel_launch: hipFuncSetAttribute failed\n"); grid = -1; return; }
        if (hipOccupancyMaxActiveBlocksPerMultiprocessor(&per_cu, (const void*)yoco_fwd, NWAVES * 64, LDS_BYTES) != hipSuccess || per_cu < 1) fprintf(stderr, "kernel_launch: occupancy query says %d\n", per_cu);
        (void)hipGetLastError();
        grid = cus;
    }
    if (grid < 0) return;
    (void)hipMemsetAsync((char*)d_ws + WS_CTL, 0, CTL_ZERO_BYTES, stream);
    Args a{};
    for (int i = 0; i < 21; ++i) a.in[i] = d_in[i];
    a.out = (float*)d_out; a.ws = (unsigned char*)d_ws;
#if MK_MULTI
    for (int p = 0; p < NPHASE; ++p) { a.ph_lo = p; a.ph_hi = p + 1; hipLaunchKernelGGL(yoco_fwd, dim3(grid), dim3(NWAVES * 64), LDS_BYTES, stream, a); }
#else
    a.ph_lo = 0; a.ph_hi = NPHASE;
    hipLaunchKernelGGL(yoco_fwd, dim3(grid), dim3(NWAVES * 64), LDS_BYTES, stream, a);
#endif
    const hipError_t le = hipPeekAtLastError();
    if (le != hipSuccess) fprintf(stderr, "kernel_launch: launch failed: %s\n", hipGetErrorName(le));
}
```

```cpp
#include <hip/hip_runtime.h>
#include <hip/hip_bf16.h>
#include <cstdio>
#include <cstdint>
#include <cmath>

#ifndef MK_MULTI
#define MK_MULTI 0
#endif

constexpr int D = 1024, FF = 4096, SEQ = 4096, NB = 4, DB = 128, PAST = 2048;
constexpr int MP = NB * SEQ;
constexpr int MT = MP + DB;
constexpr int MPAD = 16640;
constexpr int NKVQG = 2816;
constexpr int CMP_ROWS_P = NB * 256 * 4;
constexpr int CMP_ROWS_S = DB * 128 * 4;
constexpr int CMP_ROWS = CMP_ROWS_P + CMP_ROWS_S;
constexpr float RMS_EPS = 1e-6f;
constexpr float LOG2E = 1.4426950408889634f;
constexpr float QSCALE = 0.125f * LOG2E;

namespace pg8 {
#define PG8_LAS __attribute__((address_space(3)))
typedef unsigned short bf16_t;
typedef short bf16x8 __attribute__((ext_vector_type(8)));
typedef float f32x4 __attribute__((ext_vector_type(4)));
typedef float f32x2 __attribute__((ext_vector_type(2)));
typedef unsigned u32x4 __attribute__((ext_vector_type(4)));
typedef unsigned u32x2 __attribute__((ext_vector_type(2)));
constexpr int BM = 256, BK = 64, HALF = 128, HTB = HALF * BK * 2, STAGE_BYTES = 8 * HTB, NXCD = 8, WGM = 8;

__host__ __device__ __forceinline__ int lds_byte(int r, int c) { const int st = (r >> 4) * 2 + (c >> 5), rr = r & 15, cc = c & 31, ob = rr * 64 + cc * 2; return st * 1024 + (ob ^ (((ob >> 9) & 1) << 5)); }
__host__ __device__ __forceinline__ void stage_rc(int b, int& R, int& C) { const int st = b / 1024, sb = b % 1024, swz = sb ^ (((sb >> 9) & 1) << 5); R = (st >> 1) * 16 + swz / 64; C = (st & 1) * 32 + (swz % 64) / 2; }
__host__ __device__ __forceinline__ int perm32(int rho) { const int n = rho >> 4, i = rho & 15; return 8 * (i >> 2) + 4 * n + (i & 3); }

struct Unit { int pm, pn; };
struct Gemm { const bf16_t* A; const bf16_t* Bt; int M, N, K, lda, ldb; size_t a_pn_off; };

struct StaticOrder {
    int nM, nN, nwg, G, c;
    __host__ __device__ void init(int M, int N, int G_, int c_) { nM = M / BM; nN = N / BM; nwg = nM * nN; G = G_; c = c_; }
    __host__ __device__ bool next(int i, Unit& u) const {
        const long L = (long)i * G + c; if (L >= nwg) return false;
        int wgid = (int)L; { const int q = nwg / NXCD, r = nwg % NXCD, xcd = wgid % NXCD, off = wgid / NXCD; wgid = (xcd < r ? xcd * (q + 1) : r * (q + 1) + (xcd - r) * q) + off; }
        const int nig = WGM * nN, gid = wgid / nig, fm = gid * WGM, gsz = (nM - fm) < WGM ? (nM - fm) : WGM;
        u.pm = fm + ((wgid % nig) % gsz); u.pn = (wgid % nig) / gsz; return true;
    }
    __device__ __forceinline__ void a_ready(const Unit&) const {}
    __device__ __forceinline__ void done(const Unit&) const {}
};

__device__ __forceinline__ unsigned cvt_pk_bf16(float lo, float hi) { unsigned r; asm volatile("v_cvt_pk_bf16_f32 %0, %1, %2" : "=v"(r) : "v"(lo), "v"(hi)); return r; }

__device__ __forceinline__ float row_rstd(const float* rs, int row) {
    const f32x4* p = (const f32x4*)(rs + (size_t)row * 16); const f32x4 a = p[0], b = p[1], c = p[2], d = p[3];
    const float s = ((a[0] + a[1]) + (a[2] + a[3])) + ((b[0] + b[1]) + (b[2] + b[3])) + ((c[0] + c[1]) + (c[2] + c[3])) + ((d[0] + d[1]) + (d[2] + d[3]));
    return 1.0f / sqrtf(s * (1.0f / 1024.0f) + RMS_EPS);
}

struct EpiResid {
    static constexpr bool PERM = false, AFTER_DRAIN = false;
    const float* base_p; const float* base_s;
    float* X; bf16_t* XB; float* RS; const float* scale;
    __device__ __forceinline__ void operator()(const f32x4 (&acc)[2][2][4][2], const Unit& u, int wr, int wc, int fr, int fq) const {
        const int col0 = u.pn * BM + wc * 32 + 4 * fq;
        f32x4 sc[2][2];
#pragma unroll
        for (int bj = 0; bj < 2; ++bj)
#pragma unroll
            for (int n = 0; n < 2; ++n) sc[bj][n] = scale ? *(const f32x4*)(scale + col0 + bj * HALF + n * 16) : (f32x4){1.f, 1.f, 1.f, 1.f};
#pragma unroll
        for (int ai = 0; ai < 2; ++ai) {
            if (u.pm * BM + ai * HALF >= MT) continue;
#pragma unroll
            for (int m = 0; m < 4; ++m) {
                const int row = u.pm * BM + ai * HALF + wr * 64 + m * 16 + fr;
                const float* bp = (row < MP) ? base_p + (size_t)row * D : base_s + (size_t)(row - MP) * D;
                float ss = 0.f;
#pragma unroll
                for (int bj = 0; bj < 2; ++bj)
#pragma unroll
                    for (int n = 0; n < 2; ++n) {
                        const int col = col0 + bj * HALF + n * 16;
                        const f32x4 v = *(const f32x4*)(bp + col) + acc[ai][bj][m][n] * sc[bj][n];
                        *(f32x4*)(X + (size_t)row * D + col) = v;
                        u32x2 w; w.x = cvt_pk_bf16(v[0], v[1]); w.y = cvt_pk_bf16(v[2], v[3]);
                        *(u32x2*)(XB + (size_t)row * D + col) = w;
                        ss += (v[0] * v[0] + v[1] * v[1]) + (v[2] * v[2] + v[3] * v[3]);
                    }
                ss += __shfl_xor(ss, 16); ss += __shfl_xor(ss, 32);
                if (fq == 0) RS[(size_t)row * 16 + u.pn * 4 + wc] = ss;
            }
        }
    }
};

struct EpiUp {
    static constexpr bool PERM = true, AFTER_DRAIN = false;
    bf16_t* H; const float* RS;
    __device__ __forceinline__ void operator()(const f32x4 (&acc)[2][2][4][2], const Unit& u, int wr, int wc, int fr, int fq) const {
        const int col0 = u.pn * BM + wc * 32 + 8 * fq;
#pragma unroll
        for (int ai = 0; ai < 2; ++ai) {
            if (u.pm * BM + ai * HALF >= MT) continue;
#pragma unroll
            for (int m = 0; m < 4; ++m) {
                const int row = u.pm * BM + ai * HALF + wr * 64 + m * 16 + fr;
                const float rstd = row_rstd(RS, row);
#pragma unroll
                for (int bj = 0; bj < 2; ++bj) {
                    f32x4 v0 = acc[ai][bj][m][0] * rstd, v1 = acc[ai][bj][m][1] * rstd;
#pragma unroll
                    for (int e = 0; e < 4; ++e) { const float a = fmaxf(v0[e], 0.f), b = fmaxf(v1[e], 0.f); v0[e] = a * a; v1[e] = b * b; }
                    u32x4 w; w.x = cvt_pk_bf16(v0[0], v0[1]); w.y = cvt_pk_bf16(v0[2], v0[3]); w.z = cvt_pk_bf16(v1[0], v1[1]); w.w = cvt_pk_bf16(v1[2], v1[3]);
                    *(u32x4*)(H + (size_t)row * FF + col0 + bj * HALF) = w;
                }
            }
        }
    }
};

struct EpiKvqg {
    static constexpr bool PERM = true, AFTER_DRAIN = false;
    const float* RS; const float* bgate;
    float* kv_p; float* kv_s; float* win_p; float* win_s;
    bf16_t* CMPA; bf16_t* KVS; bf16_t* KVW; bf16_t* Q; float* GATE;
    __device__ __forceinline__ void operator()(const f32x4 (&acc)[2][2][4][2], const Unit& u, int wr, int wc, int fr, int fq) const {
        const int pn = u.pn;
#pragma unroll
        for (int ai = 0; ai < 2; ++ai) {
            if (u.pm * BM + ai * HALF >= MT) continue;
#pragma unroll
            for (int m = 0; m < 4; ++m) {
                const int row = u.pm * BM + ai * HALF + wr * 64 + m * 16 + fr;
                const float rstd = row_rstd(RS, row);
                const bool prompt = row < MP; const int b = prompt ? (row >> 12) : (row - MP), t = row & (SEQ - 1);
#pragma unroll
                for (int bj = 0; bj < 2; ++bj) {
                    const int cin = bj * HALF + wc * 32 + 8 * fq;
                    const f32x4 v0 = acc[ai][bj][m][0] * rstd, v1 = acc[ai][bj][m][1] * rstd;
                    u32x4 w; w.x = cvt_pk_bf16(v0[0], v0[1]); w.y = cvt_pk_bf16(v0[2], v0[3]); w.z = cvt_pk_bf16(v1[0], v1[1]); w.w = cvt_pk_bf16(v1[2], v1[3]);
                    if (pn < 4) {
                        float* o = prompt ? kv_p + (size_t)row * D : kv_s + (size_t)b * D;
                        *(f32x4*)(o + pn * BM + cin) = v0; *(f32x4*)(o + pn * BM + cin + 4) = v1;
                        if (pn < 2) {
                            if (prompt) { const int g = cin >> 6, d = cin & 63;
                                *(u32x4*)(CMPA + (size_t)pn * CMP_ROWS * D + (size_t)(((b * 256 + (t >> 4)) * 4 + g)) * D + (t & 15) * 64 + d) = w; }
                        } else *(u32x4*)(KVS + (size_t)row * 512 + (pn - 2) * BM + cin) = w;
                    } else if (pn < 6) {
                        const int c = (pn - 4) * BM + cin;
                        *(u32x4*)(KVW + (size_t)row * 512 + c) = w;
                        if (prompt) { if (t >= SEQ - 512) { float* o = win_p + ((size_t)b * 512 + (t - (SEQ - 512))) * 512 + c; *(f32x4*)o = v0; *(f32x4*)(o + 4) = v1; } }
                        else { float* o = win_s + ((size_t)b * 512 + 511) * 512 + c; *(f32x4*)o = v0; *(f32x4*)(o + 4) = v1; }
                    } else if (pn < 10) {
                        *(u32x4*)(Q + (size_t)row * D + (pn - 6) * BM + cin) = w;
                    } else {
                        if (cin < 48) {
#pragma unroll
                            for (int e = 0; e < 4; ++e) { GATE[(size_t)row * 48 + cin + e] = 1.0f / (1.0f + __expf(-(v0[e] + bgate[cin + e]))); GATE[(size_t)row * 48 + cin + 4 + e] = 1.0f / (1.0f + __expf(-(v1[e] + bgate[cin + 4 + e]))); }
                        }
                    }
                }
            }
        }
    }
};

struct EpiCmp {
    static constexpr bool PERM = false, AFTER_DRAIN = false;
    float* P;
    __device__ __forceinline__ void operator()(const f32x4 (&acc)[2][2][4][2], const Unit& u, int wr, int wc, int fr, int fq) const {
        float* base = P + (size_t)u.pn * CMP_ROWS * 256;
#pragma unroll
        for (int ai = 0; ai < 2; ++ai)
#pragma unroll
            for (int m = 0; m < 4; ++m) {
                const int row = u.pm * BM + ai * HALF + wr * 64 + m * 16 + fr;
#pragma unroll
                for (int bj = 0; bj < 2; ++bj)
#pragma unroll
                    for (int n = 0; n < 2; ++n) *(f32x4*)(base + (size_t)row * 256 + bj * HALF + wc * 32 + n * 16 + 4 * fq) = acc[ai][bj][m][n];
            }
    }
};

template <class Epi, class Sched, bool ALIGN_EPI = false, bool SP2 = false>
__device__ __forceinline__ void gemm_phase(PG8_LAS unsigned char* lds, const Gemm g, const Sched& S, const Epi& E) {
    const int tid = threadIdx.x, wid = __builtin_amdgcn_readfirstlane(tid >> 6), lane = tid & 63, wr = wid >> 2, wc = wid & 3, fr = lane & 15, fq = lane >> 4;
    const int K = g.K, nt = K / BK;
    unsigned voffA[2], voffB[2];
#pragma unroll
    for (int i = 0; i < 2; ++i) { int R, C; stage_rc(tid * 16 + i * 8192, R, C); const int Rb = Epi::PERM ? ((R & ~31) + perm32(R & 31)) : R;
        voffA[i] = (unsigned)(R * g.lda + C) * 2u; voffB[i] = (unsigned)(Rb * g.ldb + C) * 2u; }
    const size_t kstep = (size_t)(BK * 2);
    const size_t hstepA = (size_t)HALF * g.lda * 2, hstepB = (size_t)HALF * g.ldb * 2;
    const size_t tstepA = 2 * hstepA, tstepB = 2 * hstepB;
    const unsigned ldsw = (unsigned)wid * 1024u;
    const int aoff = lds_byte(wr * 64 + fr, fq * 8), boff = lds_byte(wc * 32 + fr, fq * 8);
#define PG8_SA(b, h) (((b) * 2 + (h)) * HTB)
#define PG8_SB(b, h) ((4 + (b) * 2 + (h)) * HTB)
#define PG8_STAGE(bufoff, gbase, voff) do { _Pragma("unroll") for (int _i = 0; _i < 2; ++_i) \
        __builtin_amdgcn_global_load_lds((const unsigned*)((const char*)(gbase) + (voff)[_i]), (PG8_LAS unsigned*)(lds + (bufoff) + ldsw + _i * 8192), 16, 0, 0); } while (0)
#define PG8_LDA(dst, b, h) do { _Pragma("unroll") for (int m = 0; m < 4; ++m) _Pragma("unroll") for (int k = 0; k < 2; ++k) dst[m][k] = *(const PG8_LAS bf16x8*)(lds + PG8_SA(b, h) + aoff + m * 2048 + k * 1024); } while (0)
#define PG8_LDB(dst, b, h) do { _Pragma("unroll") for (int n = 0; n < 2; ++n) _Pragma("unroll") for (int k = 0; k < 2; ++k) dst[n][k] = *(const PG8_LAS bf16x8*)(lds + PG8_SB(b, h) + boff + n * 2048 + k * 1024); } while (0)
#define PG8_MMA(ai, bj, At, Bt) do { __builtin_amdgcn_s_setprio(1); _Pragma("unroll") for (int m = 0; m < 4; ++m) _Pragma("unroll") for (int n = 0; n < 2; ++n) _Pragma("unroll") for (int k = 0; k < 2; ++k) \
        acc[ai][bj][m][n] = __builtin_amdgcn_mfma_f32_16x16x32_bf16(Bt[n][k], At[m][k], acc[ai][bj][m][n], 0, 0, 0); __builtin_amdgcn_s_setprio(0); } while (0)
#define PG8_WAIT_V(n) asm volatile("s_waitcnt vmcnt(" #n ")" ::: "memory")
#define PG8_WAIT_L(n) asm volatile("s_waitcnt lgkmcnt(" #n ")" ::: "memory")
#define PG8_BAR __builtin_amdgcn_s_barrier()
#define PG8_SCHED __builtin_amdgcn_sched_barrier(0)
    Unit cur, nxt; int ui = 0;
    if (!S.next(0, cur)) return;
    f32x4 acc[2][2][4][2];
#pragma unroll
    for (int a = 0; a < 2; ++a)
#pragma unroll
        for (int b = 0; b < 2; ++b)
#pragma unroll
            for (int m = 0; m < 4; ++m)
#pragma unroll
                for (int n = 0; n < 2; ++n) acc[a][b][m][n] = (f32x4){0.f, 0.f, 0.f, 0.f};
    bf16x8 At[4][2], B0[2][2], B1[2][2];
    const char* cA = (const char*)g.A + (size_t)cur.pm * tstepA + (size_t)cur.pn * g.a_pn_off; const char* cB = (const char*)g.Bt + (size_t)cur.pn * tstepB;
    S.a_ready(cur);
    if constexpr (SP2) {
        PG8_STAGE(PG8_SB(0, 0), cB, voffB); PG8_STAGE(PG8_SB(0, 1), cB + hstepB, voffB); PG8_STAGE(PG8_SA(0, 0), cA, voffA); PG8_STAGE(PG8_SA(0, 1), cA + hstepA, voffA);
        if (wr == 1) PG8_BAR;
        PG8_WAIT_V(2); PG8_BAR;
        PG8_STAGE(PG8_SB(1, 0), cB + kstep, voffB); PG8_STAGE(PG8_SA(1, 0), cA + kstep, voffA); PG8_STAGE(PG8_SB(1, 1), cB + hstepB + kstep, voffB);
        PG8_WAIT_V(6); PG8_BAR;
    } else {
        PG8_STAGE(PG8_SB(0, 0), cB, voffB); PG8_STAGE(PG8_SA(0, 0), cA, voffA); PG8_STAGE(PG8_SB(0, 1), cB + hstepB, voffB); PG8_STAGE(PG8_SA(0, 1), cA + hstepA, voffA);
        if (wr == 1) PG8_BAR;
        PG8_WAIT_V(4); PG8_BAR;
        PG8_STAGE(PG8_SB(1, 0), cB + kstep, voffB); PG8_STAGE(PG8_SA(1, 0), cA + kstep, voffA); PG8_STAGE(PG8_SB(1, 1), cB + hstepB + kstep, voffB);
        PG8_WAIT_V(6); PG8_BAR;
    }
    for (;;) {
        const bool has_next = S.next(ui + 1, nxt);
        const char* nA = has_next ? (const char*)g.A + (size_t)nxt.pm * tstepA + (size_t)nxt.pn * g.a_pn_off : cA; const char* nB = has_next ? (const char*)g.Bt + (size_t)nxt.pn * tstepB : cB;
        for (int t = 0; t < nt; t += 2) {
            const bool last = (t == nt - 2);
            const char* a1 = cA + (size_t)(t + 1) * kstep;
            const char* a2 = last ? nA : cA + (size_t)(t + 2) * kstep; const char* b2 = last ? nB : cB + (size_t)(t + 2) * kstep;
            const char* a3 = a2 + kstep; const char* b3 = b2 + kstep;
            if (last && has_next) S.a_ready(nxt);
            if constexpr (SP2) {
            PG8_LDB(B0, 0, 0); PG8_LDB(B1, 0, 1); PG8_SCHED; PG8_LDA(At, 0, 0); PG8_STAGE(PG8_SA(1, 1), a1 + hstepA, voffA);
            PG8_WAIT_V(8); PG8_WAIT_L(0); PG8_BAR; PG8_MMA(0, 0, At, B0); PG8_MMA(0, 1, At, B1); PG8_BAR; PG8_SCHED;
            PG8_LDA(At, 0, 1); PG8_STAGE(PG8_SB(0, 0), b2, voffB); PG8_STAGE(PG8_SB(0, 1), b2 + hstepB, voffB); PG8_STAGE(PG8_SA(0, 0), a2, voffA);
            PG8_WAIT_V(8); PG8_WAIT_L(0); PG8_BAR; PG8_MMA(1, 0, At, B0); PG8_MMA(1, 1, At, B1); PG8_BAR; PG8_SCHED;
            PG8_LDB(B0, 1, 0); PG8_LDB(B1, 1, 1); PG8_SCHED; PG8_LDA(At, 1, 0); PG8_STAGE(PG8_SA(0, 1), a2 + hstepA, voffA);
            PG8_WAIT_V(8); PG8_WAIT_L(0); PG8_BAR; PG8_MMA(0, 0, At, B0); PG8_MMA(0, 1, At, B1); PG8_BAR; PG8_SCHED;
            PG8_LDA(At, 1, 1); PG8_STAGE(PG8_SB(1, 0), b3, voffB); PG8_STAGE(PG8_SB(1, 1), b3 + hstepB, voffB); PG8_STAGE(PG8_SA(1, 0), a3, voffA);
            PG8_WAIT_V(8); PG8_WAIT_L(0); PG8_BAR; PG8_MMA(1, 0, At, B0); PG8_MMA(1, 1, At, B1); PG8_BAR; PG8_SCHED;
            } else {
            PG8_LDB(B0, 0, 0); PG8_SCHED; PG8_LDA(At, 0, 0); PG8_STAGE(PG8_SA(1, 1), a1 + hstepA, voffA);
            PG8_WAIT_L(8); PG8_BAR; PG8_WAIT_L(0); PG8_MMA(0, 0, At, B0); PG8_BAR; PG8_SCHED;
            PG8_LDB(B1, 0, 1); PG8_STAGE(PG8_SB(0, 0), b2, voffB);
            PG8_BAR; PG8_WAIT_L(0); PG8_MMA(0, 1, At, B1); PG8_BAR;
            PG8_LDA(At, 0, 1); PG8_STAGE(PG8_SA(0, 0), a2, voffA);
            PG8_BAR; PG8_WAIT_L(0); PG8_MMA(1, 0, At, B0); PG8_BAR; PG8_SCHED;
            PG8_STAGE(PG8_SB(0, 1), b2 + hstepB, voffB);
            PG8_WAIT_V(6); PG8_BAR; PG8_MMA(1, 1, At, B1); PG8_BAR;
            PG8_LDB(B0, 1, 0); PG8_SCHED; PG8_LDA(At, 1, 0); PG8_STAGE(PG8_SA(0, 1), a2 + hstepA, voffA);
            PG8_WAIT_L(8); PG8_BAR; PG8_WAIT_L(0); PG8_MMA(0, 0, At, B0); PG8_BAR; PG8_SCHED;
            PG8_LDB(B1, 1, 1); PG8_STAGE(PG8_SB(1, 0), b3, voffB);
            PG8_BAR; PG8_WAIT_L(0); PG8_MMA(0, 1, At, B1); PG8_BAR;
            PG8_LDA(At, 1, 1); PG8_STAGE(PG8_SA(1, 0), a3, voffA);
            PG8_BAR; PG8_WAIT_L(0); PG8_MMA(1, 0, At, B0); PG8_BAR; PG8_SCHED;
            PG8_STAGE(PG8_SB(1, 1), b3 + hstepB, voffB);
            PG8_WAIT_V(6); PG8_BAR; PG8_MMA(1, 1, At, B1); PG8_BAR;
            }
        }
        if constexpr (ALIGN_EPI) { if (wr == 0) PG8_BAR; }
        if constexpr (!Epi::AFTER_DRAIN) { E(acc, cur, wr, wc, fr, fq); S.done(cur); }
        if (!has_next) break;
#pragma unroll
        for (int a = 0; a < 2; ++a)
#pragma unroll
            for (int b = 0; b < 2; ++b)
#pragma unroll
                for (int m = 0; m < 4; ++m)
#pragma unroll
                    for (int n = 0; n < 2; ++n) acc[a][b][m][n] = (f32x4){0.f, 0.f, 0.f, 0.f};
        cur = nxt; cA = nA; cB = nB; ++ui;
        if constexpr (ALIGN_EPI) { if (wr == 1) PG8_BAR; }
    }
    PG8_WAIT_V(0);
    if constexpr (!ALIGN_EPI) { if (wr == 0) PG8_BAR; }
    PG8_BAR;
    if constexpr (Epi::AFTER_DRAIN) { E.fused(acc, cur, wr, wc, fr, fq, lds, wid, lane); S.done(cur); }
#undef PG8_SA
#undef PG8_SB
#undef PG8_STAGE
#undef PG8_LDA
#undef PG8_LDB
#undef PG8_MMA
#undef PG8_WAIT_V
#undef PG8_WAIT_L
#undef PG8_BAR
#undef PG8_SCHED
}
}

#define GAS __attribute__((address_space(1)))
#define LAS __attribute__((address_space(3)))
typedef unsigned short bf16;
typedef unsigned v4u __attribute__((ext_vector_type(4)));
typedef unsigned v2u __attribute__((ext_vector_type(2)));
typedef float f32x4 __attribute__((ext_vector_type(4)));
typedef float f32x2 __attribute__((ext_vector_type(2)));
typedef float f32x16 __attribute__((ext_vector_type(16)));
typedef short bf16x8 __attribute__((ext_vector_type(8)));
typedef short v4i16_t __attribute__((ext_vector_type(4)));
typedef GAS unsigned gu32;
typedef GAS unsigned long long gu64;
#define RLX_AGENT __ATOMIC_RELAXED, __HIP_MEMORY_SCOPE_AGENT
#define LDS_WAIT() asm volatile("s_waitcnt lgkmcnt(0)" ::: "memory")
#define VM_WAIT() asm volatile("s_waitcnt vmcnt(0)" ::: "memory")
__device__ __forceinline__ unsigned f2bf(float f) { unsigned u = __builtin_bit_cast(unsigned, f); return (u + 0x7fffu + ((u >> 16) & 1u)) >> 16; }
__device__ __forceinline__ unsigned pk2(float lo, float hi) { return f2bf(lo) | (f2bf(hi) << 16); }
__device__ __forceinline__ float bf2f(unsigned short h) { return __builtin_bit_cast(float, (unsigned)h << 16); }

#define XB_TMO      128
#define XB_XCNT(j)  (256  + 64 * (j))
#define XB_XSUB(j)  (1280 + 64 * (j))
#define XB_XGEN(j)  (2304 + 64 * (j))
#define XB_TOP      3328
#define XB_TOPGEN   3392
#define XCD_BAR_WORDS 3456
#define XB_SPIN_CAP (1u << 18)

__device__ __forceinline__ unsigned xb_ld(unsigned* p)              { return __hip_atomic_load(p, __ATOMIC_RELAXED, __HIP_MEMORY_SCOPE_AGENT); }
__device__ __forceinline__ unsigned xb_add(unsigned* p, unsigned v) { return __hip_atomic_fetch_add(p, v, __ATOMIC_RELAXED, __HIP_MEMORY_SCOPE_AGENT); }
__device__ __forceinline__ unsigned xb_xcc_id() { return (unsigned)__builtin_amdgcn_s_getreg((3 << 11) | 20) & 0xFu; }
#define XB_SPIN(cond, bar) do { unsigned _sp = 0; while (cond) { __builtin_amdgcn_s_sleep(1); \
    if ((++_sp & 255u) == 0u) { if (xb_ld(&(bar)[XB_TMO])) break; if (_sp > XB_SPIN_CAP) { atomicAdd(&(bar)[XB_TMO], 1u); break; } } } } while (0)

struct XcdBarrier {
    unsigned* bar; unsigned x;
    volatile LAS unsigned* st;
};

__device__ __forceinline__ XcdBarrier xcd_barrier_post(unsigned* bar, volatile LAS unsigned* st) {
    XcdBarrier b; b.bar = bar; b.x = xb_xcc_id(); b.st = st;
    if (threadIdx.x == 0) (void)xb_add(&bar[XB_XCNT(b.x)], 1u);
    return b;
}
__device__ __forceinline__ void xcd_barrier_complete(unsigned* bar, unsigned x, unsigned& nloc, unsigned& nx) {
    const unsigned G = gridDim.x * gridDim.y * gridDim.z;
    unsigned sum, cnt, mine, sp = 0u;
    for (;;) {
        sum = 0u; cnt = 0u; mine = 0u;
#pragma unroll
        for (unsigned j = 0; j < 16; ++j) { const unsigned c = xb_ld(&bar[XB_XCNT(j)]); sum += c; cnt += (c > 0u) ? 1u : 0u; mine = (j == x) ? c : mine; }
        if (sum == G) break;
        __builtin_amdgcn_s_sleep(1);
        if ((++sp & 255u) == 0u) { if (xb_ld(&bar[XB_TMO])) break; if (sp > XB_SPIN_CAP) { atomicAdd(&bar[XB_TMO], 1u); break; } }
    }
    nloc = mine > 0u ? mine : 1u; nx = cnt > 0u ? cnt : 1u;
}

__device__ __forceinline__ void xcd_barrier(const XcdBarrier& b) {
    asm volatile("s_waitcnt vmcnt(0)" ::: "memory");
    __syncthreads();
    if (threadIdx.x == 0) {
        unsigned* bar = b.bar;
        __builtin_amdgcn_s_waitcnt(0);
        unsigned nloc = b.st[0], nx = b.st[1];
        if (nloc == 0u) { xcd_barrier_complete(bar, b.x, nloc, nx); b.st[0] = nloc; b.st[1] = nx; }
        const unsigned old = xb_add(&bar[XB_XSUB(b.x)], 1u);
        const unsigned gen = old / nloc;
        if (old + 1u == (gen + 1u) * nloc) {
            __builtin_amdgcn_fence(__ATOMIC_RELEASE, "agent");
            asm volatile("s_waitcnt vmcnt(0)" ::: "memory");
            const unsigned og = xb_add(&bar[XB_TOP], 1u);
            const unsigned tg = og / nx;
            if (og + 1u == (tg + 1u) * nx) xb_add(&bar[XB_TOPGEN], 1u);
            else XB_SPIN(xb_ld(&bar[XB_TOPGEN]) == tg, bar);
            __builtin_amdgcn_fence(__ATOMIC_ACQUIRE, "agent");
            xb_add(&bar[XB_XGEN(b.x)], 1u);
            asm volatile("s_waitcnt vmcnt(0)" ::: "memory");
        } else {
            XB_SPIN(xb_ld(&bar[XB_XGEN(b.x)]) == gen, bar);
            __builtin_amdgcn_fence(__ATOMIC_ACQUIRE, "agent");
            asm volatile("s_waitcnt vmcnt(0)" ::: "memory");
        }
    }
    __syncthreads();
}

constexpr size_t MiB = 1u << 20;
constexpr size_t WS_CTL = 0, CTL_ZERO_BYTES = 1 * MiB;
constexpr size_t WS_WUP = 2 * MiB;
constexpr size_t WS_WDN = 18 * MiB;
constexpr size_t WS_WKVQG = 34 * MiB;
constexpr size_t WS_WO = 40 * MiB;
constexpr size_t WS_WPOOL = 42 * MiB;
constexpr size_t WS_W1CAT = 43 * MiB;
constexpr size_t WS_CBIAS = 44 * MiB;
constexpr size_t WS_RS = 45 * MiB;
constexpr size_t WS_GATE = 47 * MiB;
constexpr size_t WS_X = 52 * MiB;
constexpr size_t WS_XB = 118 * MiB;
constexpr size_t WS_DIFF = 152 * MiB;
constexpr size_t WS_Q = 186 * MiB;
constexpr size_t WS_KVS = 220 * MiB;
constexpr size_t WS_KVW = 238 * MiB;
constexpr size_t WS_KC = 256 * MiB;
constexpr size_t WS_KCS = 258 * MiB;
constexpr size_t WS_H = 292 * MiB;
constexpr size_t WS_CMPA = 424 * MiB;
constexpr size_t WS_CMPP = 700 * MiB;
constexpr size_t WS_END = 840 * MiB;
constexpr int CW_BAR = 4096;

constexpr size_t OUT_Y_P = 0, OUT_Y_S = 16777216, OUT_POOL_P = 16908288, OUT_POOL_S = 16969728, OUT_KV_P = 18935808, OUT_KV_S = 35713024, OUT_WIN_P = 35844096, OUT_WIN_S = 36892672, OUT_TOTAL = 70447104;

#ifndef PROBE_DUP
#define PROBE_DUP 0
#endif
#define REP(k) (1 + ((PROBE_DUP >> (k)) & 1))
constexpr int NWAVES = 8;
constexpr int RING_BYTES = 131072, MISC_OFF = RING_BYTES + 320, LDS_BYTES = 147456;

struct Frame {
    LAS unsigned char* lds;
    int tid, lane, wave, vcu, G;
    const float *x_p, *x_s, *state_pool, *cache, *state_win; const int* page_table;
    const float *norm_mix, *norm_mlp, *w_up, *w_down, *pool_w, *pool_scale, *norm_kv, *w_kv, *cmp_pe, *cmp_w1, *cmp_w2, *w_qg, *b_gate, *w_o, *norm_final;
    float* out; unsigned char* ws;
};
#define WSP(T, off) ((T*)(F.ws + (off)))

__device__ __forceinline__ unsigned cvtpk(float lo, float hi) { typedef __bf16 bf16x2_t __attribute__((ext_vector_type(2))); f32x2 v = {lo, hi}; bf16x2_t b = __builtin_convertvector(v, bf16x2_t); return __builtin_bit_cast(unsigned, b); }
__device__ __forceinline__ bf16x8 cvt8(const f32x4 a, const f32x4 b) { v4u w; w.x = cvtpk(a[0], a[1]); w.y = cvtpk(a[2], a[3]); w.z = cvtpk(b[0], b[1]); w.w = cvtpk(b[2], b[3]); return __builtin_bit_cast(bf16x8, w); }
__device__ __forceinline__ float wave_sum(float v) {
#pragma unroll
    for (int o = 1; o < 64; o <<= 1) v += __shfl_xor(v, o);
    return v;
}
__device__ __forceinline__ float wave_max(float v) {
#pragma unroll
    for (int o = 1; o < 64; o <<= 1) v = fmaxf(v, __shfl_xor(v, o));
    return v;
}

__device__ __forceinline__ void transpose_item(const float* W, int N, bf16* WT, int ldt, int row_off, const float* kscale, float scale, LAS float* scr, int kb, int nb, int lane) {
    const int k0 = 64 * kb, n0 = 32 * nb; const int n = n0 + (lane & 31);
#pragma unroll 8
    for (int i = 0; i < 32; ++i) { const int kk = 2 * i + (lane >> 5); float v = (n < N) ? W[(size_t)(k0 + kk) * N + n] : 0.f; if (kscale) v *= kscale[k0 + kk]; scr[kk * 33 + (lane & 31)] = v * scale; }
    LDS_WAIT(); asm volatile("" ::: "memory");
    const int c = lane & 7;
#pragma unroll
    for (int j = 0; j < 4; ++j) { const int nn = (lane >> 3) + 8 * j; const LAS float* s = scr + (8 * c) * 33 + nn;
        v4u o; o.x = pk2(s[0 * 33], s[1 * 33]); o.y = pk2(s[2 * 33], s[3 * 33]); o.z = pk2(s[4 * 33], s[5 * 33]); o.w = pk2(s[6 * 33], s[7 * 33]);
        if (n0 + nn < N) *(v4u*)(WT + (size_t)(row_off + n0 + nn) * ldt + k0 + 8 * c) = o; }
    LDS_WAIT(); asm volatile("" ::: "memory");
}

__device__ __forceinline__ void p0_prologue(Frame& F) {
    LAS float* scr = (LAS float*)(F.lds + F.wave * 16384);
    const int gw = F.vcu * NWAVES + F.wave, NGW = F.G * NWAVES, lane = F.lane;
    bf16* WUP = WSP(bf16, WS_WUP); bf16* WDN = WSP(bf16, WS_WDN); bf16* WKVQG = WSP(bf16, WS_WKVQG); bf16* WO = WSP(bf16, WS_WO); bf16* WPOOL = WSP(bf16, WS_WPOOL); bf16* W1CAT = WSP(bf16, WS_W1CAT);
    constexpr int I_UP = 2048, I_DN = 2048, I_KV = 768, I_QG = 544, I_WO = 512, I_PL = 32, I_C1 = 64;
    constexpr int NITEMS = 2 * I_UP + 2 * I_DN + I_KV + I_QG + I_WO + 4 * I_PL + 4 * I_C1;
    for (int rep = 0; rep < REP(17); ++rep)
    for (int it = gw; it < NITEMS; it += NGW) {
        int r = it;
        if (r < 2 * I_UP) { const int l = r / I_UP; r %= I_UP; transpose_item(F.w_up + (size_t)l * D * FF, FF, WUP + (size_t)l * FF * D, D, 0, F.norm_mlp + l * D, 1.f, scr, r / 128, r % 128, lane); continue; } r -= 2 * I_UP;
        if (r < 2 * I_DN) { const int l = r / I_DN; r %= I_DN; transpose_item(F.w_down + (size_t)l * FF * D, D, WDN + (size_t)l * D * FF, FF, 0, nullptr, 1.f, scr, r / 32, r % 32, lane); continue; } r -= 2 * I_DN;
        if (r < I_KV) { transpose_item(F.w_kv, 1536, WKVQG, D, 0, F.norm_kv, 1.f, scr, r / 48, r % 48, lane); continue; } r -= I_KV;
        if (r < I_QG) { const int nb = r % 34; transpose_item(F.w_qg, 1072, WKVQG, D, 1536, F.norm_mix + D, nb < 32 ? QSCALE : 1.f, scr, r / 34, nb, lane); continue; } r -= I_QG;
        if (r < I_WO) { transpose_item(F.w_o, D, WO, D, 0, nullptr, 1.f, scr, r / 32, r % 32, lane); continue; } r -= I_WO;
        if (r < 4 * I_PL) { const int g = r / I_PL; r %= I_PL; transpose_item(F.pool_w + (size_t)g * 65536, 256, WPOOL + (size_t)g * 65536, 256, 0, nullptr, 1.f, scr, r / 8, r % 8, lane); continue; } r -= 4 * I_PL;
        { const int kvh = r / I_C1; r %= I_C1; const int kv = kvh >> 1, half = kvh & 1;
          transpose_item(F.cmp_w1 + (size_t)kv * 2048 * 128 + (size_t)half * 1024 * 128, 128, W1CAT + (size_t)kv * 256 * D, D, half * 128, nullptr, 1.f, scr, r / 4, r % 4, lane); }
    }
    { const int gt = F.vcu * 512 + F.tid, NT = F.G * 512; v4u* z = (v4u*)(WKVQG + (size_t)2608 * D);
      for (int i = gt; i < 208 * D / 8; i += NT) z[i] = (v4u){0u, 0u, 0u, 0u}; }
    { float* CB = WSP(float, WS_CBIAS);
      for (int it = gw; it < 256; it += NGW) { const int kv = it >> 7, n = it & 127; float s = 0.f;
          for (int k = lane; k < 2048; k += 64) s += F.cmp_pe[kv * 2048 + k] * F.cmp_w1[((size_t)kv * 2048 + k) * 128 + n];
          s = wave_sum(s); if (lane == 0) CB[it] = s; } }
    bf16* DIFF = WSP(bf16, WS_DIFF);
    for (int b = gw; b < DB; b += NGW) {
        const f32x4* xr = (const f32x4*)(F.x_s + (size_t)b * D) + lane; f32x4 v[4]; float ss = 0.f;
#pragma unroll
        for (int j = 0; j < 4; ++j) { v[j] = xr[64 * j]; ss += (v[j][0] * v[j][0] + v[j][1] * v[j][1]) + (v[j][2] * v[j][2] + v[j][3] * v[j][3]); }
        const float rstd = 1.0f / sqrtf(wave_sum(ss) * (1.0f / D) + RMS_EPS);
        const float* sp = F.state_pool + (size_t)b * 15 * D; float* ps = F.out + OUT_POOL_S + (size_t)b * 15 * D;
#pragma unroll
        for (int j = 0; j < 4; ++j) {
            const int col = 256 * j + 4 * lane; const f32x4 gg = *(const f32x4*)(F.norm_mix + col); const f32x4 u = v[j] * rstd * gg;
            f32x4 sum = u; const int w = 2 << j;
            for (int r = 0; r < w - 1; ++r) sum += *(const f32x4*)(sp + (size_t)(14 - r) * D + col);
            const f32x4 df = sum * (1.0f / (float)w) - u;
            v2u o; o.x = pk2(df[0], df[1]); o.y = pk2(df[2], df[3]); *(v2u*)(DIFF + (size_t)(MP + b) * D + col) = o;
            *(f32x4*)(ps + (size_t)14 * D + col) = u;
            for (int r = 0; r < 14; ++r) *(f32x4*)(ps + (size_t)r * D + col) = *(const f32x4*)(sp + (size_t)(r + 1) * D + col);
        }
    }
    { bf16* CA = WSP(bf16, WS_CMPA);
      for (int rep = 0; rep < REP(18); ++rep)
      for (int task = F.vcu; task < DB * 128; task += 2 * F.G) {
          f32x4 v[2][4]; size_t dsti[2][4];
#pragma unroll
          for (int u = 0; u < 2; ++u) { const int tk = task + u * F.G; if (tk < DB * 128) { const int b = tk >> 7, j = tk & 127; const int page = F.page_table[b * 16 + (j >> 3)];
              const float* src = F.cache + ((size_t)page * 128 + (j & 7) * 16) * 1024;
#pragma unroll
              for (int i = 0; i < 4; ++i) { const int idx = F.tid + 512 * i, tt = idx >> 7, e = idx & 127, kv = e >> 6, g = (e >> 4) & 3, d = (e & 15) * 4;
                  v[u][i] = *(const f32x4*)(src + (size_t)tt * 1024 + e * 4);
                  dsti[u][i] = (size_t)kv * CMP_ROWS * D + (size_t)(CMP_ROWS_P + (b * 128 + j) * 4 + g) * D + tt * 64 + d; } } }
#pragma unroll
          for (int u = 0; u < 2; ++u) { const int tk = task + u * F.G; if (tk < DB * 128) {
#pragma unroll
              for (int i = 0; i < 4; ++i) { v2u o; o.x = pk2(v[u][i][0], v[u][i][1]); o.y = pk2(v[u][i][2], v[u][i][3]); *(v2u*)(CA + dsti[u][i]) = o; } } } } }
    { const size_t gt = (size_t)F.vcu * 512 + F.tid, NT = (size_t)F.G * 512; const f32x4* src = (const f32x4*)F.state_win; f32x4* dst = (f32x4*)(F.out + OUT_WIN_S);
      for (int rep = 0; rep < REP(19); ++rep)
      for (size_t e = gt; e < (size_t)DB * 511 * 128; e += NT) { const size_t b = e / (511 * 128), rem = e - b * (511 * 128); dst[b * 65536 + rem] = src[b * 65536 + rem + 128]; } }
    __syncthreads();
    LAS float* U = (LAS float*)F.lds;
    for (int rep = 0; rep < REP(20); ++rep)
    for (int chunk = F.vcu; chunk < MP / 16; chunk += F.G) {
        const int b = chunk >> 8, t0 = (chunk & 255) * 16;
        for (int i = F.wave; i < 31; i += NWAVES) {
            const int t = t0 - 15 + i;
            f32x4 u[4];
            if (t >= 0) {
                const f32x4* xr = (const f32x4*)(F.x_p + ((size_t)b * SEQ + t) * D) + lane; float ss = 0.f;
#pragma unroll
                for (int j = 0; j < 4; ++j) { u[j] = xr[64 * j]; ss += (u[j][0] * u[j][0] + u[j][1] * u[j][1]) + (u[j][2] * u[j][2] + u[j][3] * u[j][3]); }
                const float rstd = 1.0f / sqrtf(wave_sum(ss) * (1.0f / D) + RMS_EPS);
#pragma unroll
                for (int j = 0; j < 4; ++j) u[j] = u[j] * rstd * *(const f32x4*)(F.norm_mix + 256 * j + 4 * lane);
            } else {
#pragma unroll
                for (int j = 0; j < 4; ++j) u[j] = (f32x4){0.f, 0.f, 0.f, 0.f};
            }
#pragma unroll
            for (int j = 0; j < 4; ++j) *(LAS f32x4*)(U + i * 1024 + 256 * j + 4 * lane) = u[j];
            if (t >= SEQ - 15) {
#pragma unroll
                for (int j = 0; j < 4; ++j) *(f32x4*)(F.out + OUT_POOL_P + ((size_t)b * 15 + (t - (SEQ - 15))) * D + 256 * j + 4 * lane) = u[j];
            }
        }
        __syncthreads();
        { const int c = 2 * F.tid, w = 2 << (F.tid >> 7);
          for (int tt = 0; tt < 16; ++tt) { const int i = 15 + tt, t = t0 + tt; const int cnt = (t + 1 < w) ? (t + 1) : w;
              f32x2 s = (f32x2){0.f, 0.f};
              for (int j = 0; j < w; ++j) s += *(const LAS f32x2*)(U + (i - j) * 1024 + c);
              const f32x2 cur = *(const LAS f32x2*)(U + i * 1024 + c); const float inv = 1.0f / (float)cnt;
              *(unsigned*)(DIFF + ((size_t)b * SEQ + t) * D + c) = pk2(s[0] * inv - cur[0], s[1] * inv - cur[1]); } }
        __syncthreads();
    }
}

constexpr int W2T_STR = 136;
__device__ __forceinline__ void p6_combine(Frame& F) {
    LAS bf16* W2T = (LAS bf16*)F.lds;
    LAS float* CBL = (LAS float*)(F.lds + 2 * 64 * W2T_STR * 2);
    const float* P = WSP(float, WS_CMPP); bf16* KC = WSP(bf16, WS_KC); float* KCS = WSP(float, WS_KCS);
    for (int i = F.tid; i < 2 * 128 * 64; i += 512) { const int kv = i >> 13, k = (i >> 6) & 127, d = i & 63; W2T[(kv * 64 + d) * W2T_STR + k] = (bf16)f2bf(F.cmp_w2[i]); }
    if (F.tid < 256) CBL[F.tid] = WSP(float, WS_CBIAS)[F.tid];
    __syncthreads();
    const int lane = F.lane, ml = lane & 15, fq = lane >> 4;
    const int gw = F.vcu * NWAVES + F.wave, NGW = F.G * NWAVES;
    constexpr int NT_P = CMP_ROWS_P / 16, NT_S = CMP_ROWS_S / 16, NT = 2 * (NT_P + NT_S);
    for (int task = gw; task < NT; task += NGW) {
        int r = task; const int kv = r / (NT_P + NT_S); r %= (NT_P + NT_S);
        const bool prompt = r < NT_P; const int r0 = prompt ? r * 16 : (r - NT_P) * 16;
        const int prow = (prompt ? r0 : CMP_ROWS_P + r0) + ml; const int nimask = prompt ? 255 : 127;
        const int ro = r0 + ml, i_blk = (ro >> 2) & nimask; const bool valid = i_blk < nimask;
        const float* plo = P + (size_t)kv * CMP_ROWS * 256 + (size_t)prow * 256 + 8 * fq; const float* phi = plo + 4 * 256 + 128;
        f32x4 lo[4][2], hi[4][2];
#pragma unroll
        for (int ks = 0; ks < 4; ++ks) { lo[ks][0] = *(const f32x4*)(plo + 32 * ks); lo[ks][1] = *(const f32x4*)(plo + 32 * ks + 4); hi[ks][0] = *(const f32x4*)(phi + 32 * ks); hi[ks][1] = *(const f32x4*)(phi + 32 * ks + 4); }
        bf16x8 hb[4];
#pragma unroll
        for (int ks = 0; ks < 4; ++ks) { f32x4 z[2];
#pragma unroll
            for (int e = 0; e < 2; ++e) { z[e] = lo[ks][e] + hi[ks][e] + *(const LAS f32x4*)(CBL + kv * 128 + 32 * ks + 8 * fq + 4 * e);
#pragma unroll
                for (int q = 0; q < 4; ++q) { const float zz = z[e][q]; z[e][q] = valid ? zz / (1.0f + __expf(-zz)) : 0.f; } }
            hb[ks] = cvt8(z[0], z[1]); }
#pragma unroll
        for (int db = 0; db < 4; ++db) { f32x4 acc = (f32x4){0.f, 0.f, 0.f, 0.f};
#pragma unroll
            for (int ks = 0; ks < 4; ++ks) { const bf16x8 a = *(const LAS bf16x8*)(W2T + (kv * 64 + 16 * db + ml) * W2T_STR + 32 * ks + 8 * fq); acc = __builtin_amdgcn_mfma_f32_16x16x32_bf16(a, hb[ks], acc, 0, 0, 0); }
            const int g = ro & 3, d0 = 16 * db + 4 * fq;
            if (prompt) { const int b = ro >> 10; v2u o; o.x = cvtpk(acc[0], acc[1]); o.y = cvtpk(acc[2], acc[3]); *(v2u*)(KC + ((size_t)((kv * 4 + b) * 4 + g) * 256 + i_blk) * 64 + d0) = o; }
            else { const int b = ro >> 9; *(f32x4*)(KCS + ((size_t)((kv * 128 + b) * 4 + g) * 128 + i_blk) * 64 + d0) = acc; } }
    }
}

constexpr int KSTR = 144;
constexpr int AT_K = 0, AT_V = 64 * KSTR, AT_T = 2 * 64 * KSTR, AT_TS = 66, AT_U = AT_T + 64 * AT_TS * 4, AT_SEL = AT_U + 64 * AT_TS * 4, AT_WUNI = AT_SEL + 512, AT_END = AT_WUNI + 64;
static_assert(AT_END <= RING_BYTES, "attention LDS");

__device__ __forceinline__ v4i16_t vtr(const LAS unsigned char* p) { return __builtin_amdgcn_ds_read_tr16_b64_v4i16((LAS v4i16_t*)p); }

__device__ __forceinline__ void stage_kv(Frame& F, const bf16* ksrc, const bf16* vsrc, int pitch) {
    const int key = F.tid >> 3, ch = F.tid & 7;
    const v4u kk = *(const v4u*)(ksrc + (size_t)key * pitch + ch * 8);
    const v4u vv = *(const v4u*)(vsrc + (size_t)key * pitch + ch * 8);
    *(LAS v4u*)(F.lds + AT_K + key * KSTR + ch * 16) = kk;
    *(LAS v4u*)(F.lds + AT_V + key * KSTR + ch * 16) = vv;
}

template <int MODE>
__device__ __forceinline__ void attn_tile(Frame& F, const bf16x8 (&qf)[4], int relb, float slope2, bool rowok, float& m, float& l, f32x16& o0, f32x16& o1,
                                          float mfin, float invl, LAS float* Tq, LAS float* Uq, int sig0) {
    const int lane = F.lane, r = lane & 31, h = lane >> 5;
    const LAS unsigned char* Kt = F.lds + AT_K; const LAS unsigned char* Vt = F.lds + AT_V;
    f32x16 p0, p1;
#pragma unroll
    for (int i = 0; i < 16; ++i) { p0[i] = 0.f; p1[i] = 0.f; }
#pragma unroll
    for (int ks = 0; ks < 4; ++ks) {
        const bf16x8 a0 = *(const LAS bf16x8*)(Kt + r * KSTR + ks * 32 + h * 16);
        const bf16x8 a1 = *(const LAS bf16x8*)(Kt + (32 + r) * KSTR + ks * 32 + h * 16);
        p0 = __builtin_amdgcn_mfma_f32_32x32x16_bf16(a0, qf[ks], p0, 0, 0, 0);
        p1 = __builtin_amdgcn_mfma_f32_32x32x16_bf16(a1, qf[ks], p1, 0, 0, 0);
    }
    constexpr int PM = (MODE <= 1) ? 16 : 1;
    const float NEG = -INFINITY;
    float mx = NEG;
#pragma unroll
    for (int i = 0; i < 16; ++i) {
        const int kofs = PM * ((i & 3) + 8 * (i >> 2));
        const int rel0 = relb + kofs, rel1 = rel0 + PM * 32;
        bool ok0 = rowok && rel0 <= 0, ok1 = rowok && rel1 <= 0;
        if (MODE == 3) { ok0 = ok0 && rel0 > -512; ok1 = ok1 && rel1 > -512; }
        p0[i] = ok0 ? fmaf(slope2, (float)rel0, p0[i]) : NEG;
        p1[i] = ok1 ? fmaf(slope2, (float)rel1, p1[i]) : NEG;
        mx = fmaxf(mx, fmaxf(p0[i], p1[i]));
    }
    if (MODE == 0) {
        mx = fmaxf(mx, __shfl_xor(mx, 32));
        const float mn = fmaxf(m, mx), mu = (mn == NEG) ? 0.f : mn;
        float rs = 0.f;
#pragma unroll
        for (int i = 0; i < 16; ++i) rs += __builtin_amdgcn_exp2f(p0[i] - mu) + __builtin_amdgcn_exp2f(p1[i] - mu);
        l = l * __builtin_amdgcn_exp2f(m - mu) + rs; m = mn;
        return;
    }
    if (MODE == 1) {
        const float mu = (mfin == NEG) ? 0.f : mfin;
#pragma unroll
        for (int i = 0; i < 16; ++i) { p0[i] = __builtin_amdgcn_exp2f(p0[i] - mu) * invl; p1[i] = __builtin_amdgcn_exp2f(p1[i] - mu) * invl; }
#pragma unroll
        for (int hf = 0; hf < 2; ++hf)
#pragma unroll
            for (int g4 = 0; g4 < 4; ++g4) {
                const float pa = hf ? p1[4 * g4] : p0[4 * g4], pb = hf ? p1[4 * g4 + 1] : p0[4 * g4 + 1], pc = hf ? p1[4 * g4 + 2] : p0[4 * g4 + 2], pd = hf ? p1[4 * g4 + 3] : p0[4 * g4 + 3];
                float tv = 2.f * ((pa + pb) + pc) + pd, uv = pd;
                tv += __shfl_xor(tv, 1); uv += __shfl_xor(uv, 1); tv += __shfl_xor(tv, 2); uv += __shfl_xor(uv, 2);
                const int sg = sig0 + 8 * hf + 2 * g4 + h;
                if ((lane & 3) == 0) { Tq[sg] = tv; Uq[sg + 1] = uv; }
            }
    } else {
        mx = fmaxf(mx, __shfl_xor(mx, 32));
        const float mn = fmaxf(m, mx), mu = (mn == NEG) ? 0.f : mn;
        const float alpha = __builtin_amdgcn_exp2f(m - mu);
        float rs = 0.f;
#pragma unroll
        for (int i = 0; i < 16; ++i) { p0[i] = __builtin_amdgcn_exp2f(p0[i] - mu); p1[i] = __builtin_amdgcn_exp2f(p1[i] - mu); rs += p0[i] + p1[i]; }
        l = l * alpha + rs; m = mn;
#pragma unroll
        for (int i = 0; i < 16; ++i) { o0[i] *= alpha; o1[i] *= alpha; }
    }
    const LAS unsigned char* vb = Vt + (((lane & 15) >> 2) + 4 * h) * KSTR + (16 * ((lane >> 4) & 1) + 4 * (lane & 3)) * 2;
#pragma unroll
    for (int sp = 0; sp < 4; ++sp) {
        v4u pw;
        if (sp < 2) { const int b8 = 8 * sp; pw.x = cvtpk(p0[b8], p0[b8 + 1]); pw.y = cvtpk(p0[b8 + 2], p0[b8 + 3]); pw.z = cvtpk(p0[b8 + 4], p0[b8 + 5]); pw.w = cvtpk(p0[b8 + 6], p0[b8 + 7]); }
        else { const int b8 = 8 * (sp - 2); pw.x = cvtpk(p1[b8], p1[b8 + 1]); pw.y = cvtpk(p1[b8 + 2], p1[b8 + 3]); pw.z = cvtpk(p1[b8 + 4], p1[b8 + 5]); pw.w = cvtpk(p1[b8 + 6], p1[b8 + 7]); }
        const bf16x8 pbf = __builtin_bit_cast(bf16x8, pw);
#pragma unroll
        for (int db = 0; db < 2; ++db) {
            const v4i16_t lo = vtr(vb + (16 * sp) * KSTR + 64 * db), hi = vtr(vb + (16 * sp + 8) * KSTR + 64 * db);
            const bf16x8 vf = (bf16x8){lo[0], lo[1], lo[2], lo[3], hi[0], hi[1], hi[2], hi[3]};
            if (db == 0) o0 = __builtin_amdgcn_mfma_f32_32x32x16_bf16(vf, pbf, o0, 0, 0, 0);
            else o1 = __builtin_amdgcn_mfma_f32_32x32x16_bf16(vf, pbf, o1, 0, 0, 0);
        }
    }
}

__device__ __forceinline__ void attn_prompt_unit(Frame& F, int b, int g, int qb) {
    const int lane = F.lane, r = lane & 31, h = lane >> 5, w = F.wave;
    const int c0 = qb * 64, cur = qb, ql = 8 * w + (r >> 2), tq = c0 + ql, hd = g * 4 + (r & 3);
    const bf16* Q = WSP(bf16, WS_Q); const bf16* KVS = WSP(bf16, WS_KVS); const bf16* KVW = WSP(bf16, WS_KVW); const bf16* KC = WSP(bf16, WS_KC); const float* GATE = WSP(float, WS_GATE);
    bf16* O = WSP(bf16, WS_DIFF);
    const size_t row = (size_t)b * SEQ + tq;
    bf16x8 qf[4];
#pragma unroll
    for (int ks = 0; ks < 4; ++ks) qf[ks] = *(const bf16x8*)(Q + row * D + hd * 64 + ks * 16 + h * 8);
    const float slope2 = exp2f(-0.5f * (float)(hd + 1)) * LOG2E;
    const float g0 = GATE[row * 48 + hd * 3 + 0], g1 = GATE[row * 48 + hd * 3 + 1], g2 = GATE[row * 48 + hd * 3 + 2];
    LAS float* T = (LAS float*)(F.lds + AT_T); LAS float* U = (LAS float*)(F.lds + AT_U);
    LAS unsigned* SELM = (LAS unsigned*)(F.lds + AT_SEL); LAS unsigned* WUNI = (LAS unsigned*)(F.lds + AT_WUNI);
    for (int i = F.tid; i < 2 * 64 * AT_TS; i += 512) T[i] = 0.f;
    f32x16 of0, of1, o0, o1;
#pragma unroll
    for (int i = 0; i < 16; ++i) { of0[i] = 0.f; of1[i] = 0.f; o0[i] = 0.f; o1[i] = 0.f; }
    const float NEG = -INFINITY;
    const int nmax = c0 / 16 + 2;
    const int ntile = (nmax >= 255 ? 254 : nmax) / 64 + 1;
    const bf16* kc = KC + (size_t)((0 * 4 + b) * 4 + g) * 256 * 64; const bf16* vc = KC + (size_t)((1 * 4 + b) * 4 + g) * 256 * 64;
    float m = NEG, l = 0.f;
    for (int tl = 0; tl < ntile; ++tl) {
        __syncthreads();
        stage_kv(F, kc + (size_t)tl * 64 * 64, vc + (size_t)tl * 64 * 64, 64);
        __syncthreads();
        attn_tile<0>(F, qf, 16 * 64 * tl + 31 + 16 * 4 * h - tq, slope2, true, m, l, o0, o1, 0.f, 0.f, nullptr, nullptr, 0);
    }
    { const float lt = l + __shfl_xor(l, 32); const float invl = lt > 0.f ? 1.0f / lt : 0.f;
      LAS float* Tq = T + ql * AT_TS; LAS float* Uq = U + ql * AT_TS;
      for (int tl = 0; tl < ntile; ++tl) {
          __syncthreads();
          stage_kv(F, kc + (size_t)tl * 64 * 64, vc + (size_t)tl * 64 * 64, 64);
          __syncthreads();
          attn_tile<1>(F, qf, 16 * 64 * tl + 31 + 16 * 4 * h - tq, slope2, true, m, l, o0, o1, m, invl, Tq, Uq, 16 * tl);
      }
#pragma unroll
      for (int i = 0; i < 16; ++i) { of0[i] = g0 * o0[i]; of1[i] = g0 * o1[i]; o0[i] = 0.f; o1[i] = 0.f; } }
    __syncthreads();
    unsigned long long wuni = 0ull;
    for (int qq = 8 * w; qq < 8 * w + 8; ++qq) {
        unsigned long long msk;
        if (cur <= 15) msk = (cur == 63) ? ~0ull : ((1ull << (cur + 1)) - 1ull);
        else {
            const float v = T[qq * AT_TS + lane] + U[qq * AT_TS + lane];
            T[qq * AT_TS + lane] = v;
            LDS_WAIT(); asm volatile("" ::: "memory");
            int rank = 0;
            for (int s2 = 1; s2 <= cur - 2; ++s2) { const float o = T[qq * AT_TS + s2]; rank += (o > v || (o == v && s2 < lane)) ? 1 : 0; }
            const bool sel = (lane <= cur) && (lane == 0 || lane >= cur - 1 || rank < 13);
            msk = __ballot(sel);
        }
        if (lane == 0) { SELM[2 * qq] = (unsigned)msk; SELM[2 * qq + 1] = (unsigned)(msk >> 32); }
        wuni |= msk;
    }
    wuni = ((unsigned long long)(unsigned)__builtin_amdgcn_readfirstlane((int)(unsigned)(wuni >> 32)) << 32) | (unsigned long long)(unsigned)__builtin_amdgcn_readfirstlane((int)(unsigned)wuni);
    if (lane == 0) { WUNI[2 * w] = (unsigned)wuni; WUNI[2 * w + 1] = (unsigned)(wuni >> 32); }
    __syncthreads();
    unsigned long long guni = 0ull;
#pragma unroll
    for (int i = 0; i < 8; ++i) guni |= (unsigned long long)WUNI[2 * i] | ((unsigned long long)WUNI[2 * i + 1] << 32);
    const unsigned long long mym = (unsigned long long)SELM[2 * ql] | ((unsigned long long)SELM[2 * ql + 1] << 32);
    m = NEG; l = 0.f;
    { const bf16* ks = KVS + (size_t)b * SEQ * 512 + g * 64; const bf16* vs = ks + 256;
      unsigned long long rem = guni;
      while (rem) {
          const int s = __builtin_ctzll(rem); rem &= rem - 1ull;
          __syncthreads();
          stage_kv(F, ks + (size_t)s * 64 * 512, vs + (size_t)s * 64 * 512, 512);
          __syncthreads();
          if ((wuni >> s) & 1ull) attn_tile<2>(F, qf, 64 * s + 4 * h - tq, slope2, ((mym >> s) & 1ull) != 0ull, m, l, o0, o1, 0.f, 0.f, nullptr, nullptr, 0);
      }
      const float lt = l + __shfl_xor(l, 32); const float sc = lt > 0.f ? g1 / lt : 0.f;
#pragma unroll
      for (int i = 0; i < 16; ++i) { of0[i] += sc * o0[i]; of1[i] += sc * o1[i]; o0[i] = 0.f; o1[i] = 0.f; } }
    m = NEG; l = 0.f;
    { const bf16* kw = KVW + (size_t)b * SEQ * 512 + g * 64; const bf16* vw = kw + 256;
      for (int j = 0; j < 9; ++j) {
          const int pos0 = c0 - 512 + 64 * j; if (pos0 < 0) continue;
          __syncthreads();
          stage_kv(F, kw + (size_t)pos0 * 512, vw + (size_t)pos0 * 512, 512);
          __syncthreads();
          attn_tile<3>(F, qf, pos0 + 4 * h - tq, slope2, true, m, l, o0, o1, 0.f, 0.f, nullptr, nullptr, 0);
      }
      const float lt = l + __shfl_xor(l, 32); const float sc = lt > 0.f ? g2 / lt : 0.f;
#pragma unroll
      for (int i = 0; i < 16; ++i) { of0[i] += sc * o0[i]; of1[i] += sc * o1[i]; } }
    bf16* orow = O + row * D + hd * 64;
#pragma unroll
    for (int g4 = 0; g4 < 4; ++g4) {
        v2u a; a.x = cvtpk(of0[4 * g4], of0[4 * g4 + 1]); a.y = cvtpk(of0[4 * g4 + 2], of0[4 * g4 + 3]);
        v2u c; c.x = cvtpk(of1[4 * g4], of1[4 * g4 + 1]); c.y = cvtpk(of1[4 * g4 + 2], of1[4 * g4 + 3]);
        *(v2u*)(orow + 8 * g4 + 4 * h) = a; *(v2u*)(orow + 32 + 8 * g4 + 4 * h) = c;
    }
    __syncthreads();
}

constexpr int SA_QS = 0, SA_SC = 1024, SA_NK = 1664, SA_IMP = SA_SC + SA_NK * 16, SA_LIST = SA_IMP + 256, SA_BLK = SA_LIST + 64, SA_RED = SA_BLK + 128, SA_END = SA_RED + 512 * 64;
constexpr int SK_CMP = 0, SK_SEL = 128, SK_WIN = 1088, SK_NSEL = 1600, SK_NWIN = 1601;
static_assert(SA_END <= RING_BYTES, "sample attention LDS");

__device__ __forceinline__ f32x4 wave_max4(f32x4 v) {
#pragma unroll
    for (int o = 1; o < 64; o <<= 1) { v[0] = fmaxf(v[0], __shfl_xor(v[0], o)); v[1] = fmaxf(v[1], __shfl_xor(v[1], o)); v[2] = fmaxf(v[2], __shfl_xor(v[2], o)); v[3] = fmaxf(v[3], __shfl_xor(v[3], o)); }
    return v;
}
__device__ __forceinline__ f32x4 wave_sum4(f32x4 v) {
#pragma unroll
    for (int o = 1; o < 64; o <<= 1) { v[0] += __shfl_xor(v[0], o); v[1] += __shfl_xor(v[1], o); v[2] += __shfl_xor(v[2], o); v[3] += __shfl_xor(v[3], o); }
    return v;
}
__device__ __forceinline__ void sa_softmax4(LAS f32x4* SC, int k0, int nk, int kx, f32x4 post, int lane) {
    f32x4 mx = (f32x4){-INFINITY, -INFINITY, -INFINITY, -INFINITY};
    for (int i = lane; i < nk; i += 64) { const f32x4 s = SC[k0 + i]; mx[0] = fmaxf(mx[0], s[0]); mx[1] = fmaxf(mx[1], s[1]); mx[2] = fmaxf(mx[2], s[2]); mx[3] = fmaxf(mx[3], s[3]); }
    if (kx >= 0) { const f32x4 s = SC[kx]; mx[0] = fmaxf(mx[0], s[0]); mx[1] = fmaxf(mx[1], s[1]); mx[2] = fmaxf(mx[2], s[2]); mx[3] = fmaxf(mx[3], s[3]); }
    mx = wave_max4(mx);
#pragma unroll
    for (int q = 0; q < 4; ++q) if (mx[q] == -INFINITY) mx[q] = 0.f;
    f32x4 sum = (f32x4){0.f, 0.f, 0.f, 0.f};
    for (int i = lane; i < nk; i += 64) { f32x4 s = SC[k0 + i];
#pragma unroll
        for (int q = 0; q < 4; ++q) s[q] = __builtin_amdgcn_exp2f(s[q] - mx[q]);
        SC[k0 + i] = s; sum += s; }
    sum = wave_sum4(sum);
    f32x4 ex = (f32x4){0.f, 0.f, 0.f, 0.f};
    if (kx >= 0) { const f32x4 s = SC[kx];
#pragma unroll
        for (int q = 0; q < 4; ++q) ex[q] = __builtin_amdgcn_exp2f(s[q] - mx[q]);
        sum += ex; }
    f32x4 sc;
#pragma unroll
    for (int q = 0; q < 4; ++q) sc[q] = sum[q] > 0.f ? post[q] / sum[q] : 0.f;
    LDS_WAIT(); asm volatile("" ::: "memory");
    for (int i = lane; i < nk; i += 64) SC[k0 + i] = SC[k0 + i] * sc;
    if (kx >= 0 && lane == 0) SC[kx] = ex * sc;
}

#define SA_LOADK(dst, kr) do { dst[0] = *(const f32x4*)(kr); dst[1] = *(const f32x4*)((kr) + 4); dst[2] = *(const f32x4*)((kr) + 32); dst[3] = *(const f32x4*)((kr) + 36); } while (0)
#define SA_SCORE(acc, kf) do { acc = __builtin_amdgcn_mfma_f32_16x16x32_bf16(af[0], cvt8(kf[0], kf[1]), (f32x4){0.f, 0.f, 0.f, 0.f}, 0, 0, 0); acc = __builtin_amdgcn_mfma_f32_16x16x32_bf16(af[1], cvt8(kf[2], kf[3]), acc, 0, 0, 0); } while (0)

__device__ __forceinline__ void attn_sample_unit(Frame& F, int b, int g) {
    const int tid = F.tid, lane = F.lane, w = F.wave; const int row = MP + b;
    const bf16* Q = WSP(bf16, WS_Q); const bf16* KVS = WSP(bf16, WS_KVS); const bf16* KVW = WSP(bf16, WS_KVW); const float* KCS = WSP(float, WS_KCS); const float* GATE = WSP(float, WS_GATE);
    bf16* O = WSP(bf16, WS_DIFF);
    LAS f32x4* SC = (LAS f32x4*)(F.lds + SA_SC); LAS float* IMP = (LAS float*)(F.lds + SA_IMP);
    LAS int* LIST = (LAS int*)(F.lds + SA_LIST); LAS int* BLK = (LAS int*)(F.lds + SA_BLK); LAS float* RED = (LAS float*)(F.lds + SA_RED);
    const float* kc = KCS + (size_t)((0 * 128 + b) * 4 + g) * 128 * 64; const float* vc = KCS + (size_t)((1 * 128 + b) * 4 + g) * 128 * 64;
    const float* sw = F.state_win + (size_t)b * 512 * 512;
    __syncthreads();
    bf16x8 af[2];
#pragma unroll
    for (int ks = 0; ks < 2; ++ks) { af[ks] = (bf16x8){0, 0, 0, 0, 0, 0, 0, 0}; if ((lane & 15) < 4) af[ks] = *(const bf16x8*)(Q + (size_t)row * D + (g * 4 + (lane & 15)) * 64 + 32 * ks + 8 * (lane >> 4)); }
    f32x4 sl2;
#pragma unroll
    for (int i = 0; i < 4; ++i) sl2[i] = exp2f(-0.5f * (float)(g * 4 + i + 1)) * LOG2E;
    f32x4 gt0, gt1, gt2;
    { const float* gp = GATE + (size_t)row * 48 + g * 12;
#pragma unroll
      for (int i = 0; i < 4; ++i) { gt0[i] = gp[i * 3 + 0]; gt1[i] = gp[i * 3 + 1]; gt2[i] = gp[i * 3 + 2]; } }
    const int kl = lane & 15, kc8 = 8 * (lane >> 4);
    { f32x4 kf[5][4];
      { const float* kr = kc + (size_t)(16 * w + kl) * 64 + kc8; SA_LOADK(kf[0], kr); }
#pragma unroll
      for (int j = 1; j < 5; ++j) { const float* kr = sw + (size_t)(16 * (w + 8 * (j - 1)) + kl) * 512 + g * 64 + kc8; SA_LOADK(kf[j], kr); }
      f32x4 acc;
      SA_SCORE(acc, kf[0]);
      if (lane < 16) { const int n = 16 * w + kl; const float rel = (float)(16 * n + 31 - PAST); f32x4 s;
#pragma unroll
          for (int i = 0; i < 4; ++i) s[i] = (n < 127) ? acc[i] + sl2[i] * rel : -INFINITY;
          SC[SK_CMP + n] = s; }
#pragma unroll
      for (int j = 1; j < 5; ++j) { SA_SCORE(acc, kf[j]);
          if (lane < 16) { const int i2 = 16 * (w + 8 * (j - 1)) + kl; const float rel = (float)(i2 - 512); f32x4 s;
#pragma unroll
              for (int i = 0; i < 4; ++i) s[i] = (i2 >= 1) ? acc[i] + sl2[i] * rel : -INFINITY;
              SC[SK_WIN + i2] = s; } }
      if (w == 7) {
          f32x4 a, c2; const float kwn = bf2f(KVW[(size_t)row * 512 + g * 64 + lane]), ksn = bf2f(KVS[(size_t)row * 512 + g * 64 + lane]);
#pragma unroll
          for (int i = 0; i < 4; ++i) { const float qv = bf2f(Q[(size_t)row * D + (g * 4 + i) * 64 + lane]); a[i] = qv * kwn; c2[i] = qv * ksn; }
          a = wave_sum4(a); c2 = wave_sum4(c2);
          if (lane == 0) { SC[SK_NWIN] = a; SC[SK_NSEL] = c2; }
      }
    }
    __syncthreads();
    if (w == 0) {
        sa_softmax4(SC, SK_CMP, 128, -1, (f32x4){1.f, 1.f, 1.f, 1.f}, lane);
        LDS_WAIT(); asm volatile("" ::: "memory");
        if (lane < 33) { float a = 0.f;
#pragma unroll
            for (int dn = -1; dn <= 3; ++dn) { const int n = 4 * lane + dn; if (n >= 0 && n < 127) { const f32x4 p = SC[SK_CMP + n]; a += ((dn == -1 || dn == 3) ? 1.f : 2.f) * ((p[0] + p[1]) + (p[2] + p[3])); } }
            IMP[lane] = a; }
        LDS_WAIT(); asm volatile("" ::: "memory");
        const float v = (lane <= 32) ? IMP[lane] : 0.f; int rank = 0;
        for (int s2 = 1; s2 <= 30; ++s2) { const float o = IMP[s2]; rank += (o > v || (o == v && s2 < lane)) ? 1 : 0; }
        const bool sel = (lane == 0) || (lane == 31) || (lane >= 1 && lane <= 30 && rank < 13);
        const unsigned long long msk = __ballot(sel);
        if (sel) { const int pos = __builtin_popcountll(msk & ((1ull << lane) - 1ull)); LIST[pos] = lane;
            const int page = F.page_table[b * 16 + (lane >> 1)]; BLK[pos] = page * 128 + (lane & 1) * 64; }
        LDS_WAIT(); asm volatile("" ::: "memory");
        for (int i = lane; i < 128; i += 64) SC[SK_CMP + i] = SC[SK_CMP + i] * gt0;
    }
    __syncthreads();
#pragma unroll
    for (int bt = 0; bt < 2; ++bt) {
        f32x4 kf[4][4];
#pragma unroll
        for (int j = 0; j < 4; ++j) { const int st = w + 8 * (4 * bt + j); if (st < 60) { const int bi = st >> 2, kk = 16 * (st & 3) + kl;
            const float* kr = F.cache + ((size_t)(BLK[bi] + kk) * 4 + 2) * 256 + g * 64 + kc8; SA_LOADK(kf[j], kr); } }
#pragma unroll
        for (int j = 0; j < 4; ++j) { const int st = w + 8 * (4 * bt + j); if (st < 60) { const int bi = st >> 2, kk = 16 * (st & 3) + kl; f32x4 acc; SA_SCORE(acc, kf[j]);
            if (lane < 16) { const float rel = (float)(64 * LIST[bi] + kk - PAST); f32x4 s;
#pragma unroll
                for (int i = 0; i < 4; ++i) s[i] = acc[i] + sl2[i] * rel;
                SC[SK_SEL + 64 * bi + kk] = s; } } }
    }
    if (w == 1) sa_softmax4(SC, SK_WIN, 512, SK_NWIN, gt2, lane);
    __syncthreads();
    if (w == 0) sa_softmax4(SC, SK_SEL, 960, SK_NSEL, gt1, lane);
    __syncthreads();
    { const int kq = lane >> 4, c4 = 4 * (lane & 15);
      f32x4 acc[4];
#pragma unroll
      for (int i = 0; i < 4; ++i) acc[i] = (f32x4){0.f, 0.f, 0.f, 0.f};
      { f32x4 vv[4];
#pragma unroll
        for (int it = 0; it < 4; ++it) vv[it] = *(const f32x4*)(vc + (size_t)(32 * it + 4 * w + kq) * 64 + c4);
#pragma unroll
        for (int it = 0; it < 4; ++it) { const f32x4 p = SC[SK_CMP + 32 * it + 4 * w + kq];
#pragma unroll
            for (int i = 0; i < 4; ++i) acc[i] += vv[it] * p[i]; } }
#pragma unroll
      for (int bt = 0; bt < 2; ++bt) { f32x4 vv[8];
#pragma unroll
        for (int j = 0; j < 8; ++j) vv[j] = *(const f32x4*)(sw + (size_t)(32 * (8 * bt + j) + 4 * w + kq) * 512 + 256 + g * 64 + c4);
#pragma unroll
        for (int j = 0; j < 8; ++j) { const f32x4 p = SC[SK_WIN + 32 * (8 * bt + j) + 4 * w + kq];
#pragma unroll
            for (int i = 0; i < 4; ++i) acc[i] += vv[j] * p[i]; } }
#pragma unroll
      for (int bt = 0; bt < 3; ++bt) { f32x4 vv[10];
#pragma unroll
        for (int j = 0; j < 10; ++j) { const int k = 32 * (10 * bt + j) + 4 * w + kq; vv[j] = *(const f32x4*)(F.cache + ((size_t)(BLK[k >> 6] + (k & 63)) * 4 + 3) * 256 + g * 64 + c4); }
#pragma unroll
        for (int j = 0; j < 10; ++j) { const f32x4 p = SC[SK_SEL + 32 * (10 * bt + j) + 4 * w + kq];
#pragma unroll
            for (int i = 0; i < 4; ++i) acc[i] += vv[j] * p[i]; } }
#pragma unroll
      for (int i = 0; i < 4; ++i) *(LAS f32x4*)(RED + tid * 16 + 4 * i) = acc[i];
    }
    __syncthreads();
    if (tid < 256) { const int hd = tid >> 6, d = tid & 63; float a = 0.f;
#pragma unroll 8
        for (int j = 0; j < 32; ++j) a += RED[((j >> 2) * 64 + (j & 3) * 16 + (d >> 2)) * 16 + hd * 4 + (d & 3)];
        { const f32x4 ps = SC[SK_NSEL], pw = SC[SK_NWIN];
          a += ps[hd] * bf2f(KVS[(size_t)row * 512 + 256 + g * 64 + d]) + pw[hd] * bf2f(KVW[(size_t)row * 512 + 256 + g * 64 + d]); }
        O[(size_t)row * D + (g * 4 + hd) * 64 + d] = (bf16)f2bf(a); }
    __syncthreads();
}

__device__ __forceinline__ void p7_attention(Frame& F) {
    for (int rep = 0; rep < REP(13); ++rep)
    for (int i = F.vcu; i < 1024; i += F.G) { const int k = i >> 8, c = i & 255, bg = c >> 4, s = c & 15; const int qb = (k == 0) ? s : (k == 1) ? 31 - s : (k == 2) ? 32 + s : 63 - s;
        attn_prompt_unit(F, bg >> 2, bg & 3, qb); }
    for (int rep = 0; rep < REP(12); ++rep)
    for (int i = F.vcu; i < DB * 4; i += F.G) attn_sample_unit(F, i >> 2, i & 3);
}

enum { SG_POOL = 0, SG_UP = 1, SG_DOWN = 2, SG_KVQG = 3, SG_WO = 4 };
template <int KIND>
__device__ __forceinline__ void small_gemm(Frame& F, int layer) {
    constexpr bool F32B = (KIND == SG_UP || KIND == SG_KVQG);
    constexpr int KSPLIT = (KIND == SG_DOWN || KIND == SG_WO) ? 4 : 1;
    constexpr int KC = (KIND == SG_POOL) ? 256 : (KIND == SG_WO) ? 256 : 1024;
    constexpr int NSL = (KIND == SG_POOL) ? 64 : (KIND == SG_UP) ? 256 : (KIND == SG_KVQG) ? 163 : 64;
    const int lane = F.lane, w = F.wave, ml = lane & 15, fq = lane >> 4, kc8 = 8 * fq;
    const int row = MP + 16 * w + ml, b = 16 * w + ml;
    float* X = WSP(float, WS_X);
    for (int item = F.vcu; item < NSL * KSPLIT; item += F.G) {
        const int ns = item / KSPLIT, kq = item % KSPLIT;
        int n0 = ns * 16; const bf16* wrow; const bf16* b16 = nullptr; const float* b32 = nullptr;
        if (KIND == SG_POOL) { const int g = ns >> 4; n0 = (ns & 15) * 16; wrow = WSP(bf16, WS_WPOOL) + (size_t)g * 65536 + (size_t)(n0 + ml) * 256 + kc8; b16 = WSP(bf16, WS_DIFF) + (size_t)row * D + g * 256 + kc8; n0 += g * 256; }
        else if (KIND == SG_UP) { wrow = WSP(bf16, WS_WUP) + (size_t)layer * FF * D + (size_t)(n0 + ml) * D + kc8; b32 = X + (size_t)row * D + kc8; }
        else if (KIND == SG_DOWN) { wrow = WSP(bf16, WS_WDN) + (size_t)layer * D * FF + (size_t)(n0 + ml) * FF + kq * KC + kc8; b16 = WSP(bf16, WS_H) + (size_t)row * FF + kq * KC + kc8; }
        else if (KIND == SG_KVQG) { wrow = WSP(bf16, WS_WKVQG) + (size_t)(n0 + ml) * D + kc8; b32 = X + (size_t)row * D + kc8; }
        else { wrow = WSP(bf16, WS_WO) + (size_t)(n0 + ml) * D + kq * KC + kc8; b16 = WSP(bf16, WS_DIFF) + (size_t)row * D + kq * KC + kc8; }
        f32x4 acc = (f32x4){0.f, 0.f, 0.f, 0.f}; float ssq = 0.f;
#pragma unroll 1
        for (int kb = 0; kb < KC; kb += 256) {
            bf16x8 a[8], bb[8]; f32x4 x0[8], x1[8];
#pragma unroll
            for (int j = 0; j < 8; ++j) a[j] = *(const bf16x8*)(wrow + kb + 32 * j);
            if (F32B) {
#pragma unroll
                for (int j = 0; j < 8; ++j) { x0[j] = *(const f32x4*)(b32 + kb + 32 * j); x1[j] = *(const f32x4*)(b32 + kb + 32 * j + 4); }
#pragma unroll
                for (int j = 0; j < 8; ++j) { ssq += (x0[j][0] * x0[j][0] + x0[j][1] * x0[j][1]) + (x0[j][2] * x0[j][2] + x0[j][3] * x0[j][3]) + (x1[j][0] * x1[j][0] + x1[j][1] * x1[j][1]) + (x1[j][2] * x1[j][2] + x1[j][3] * x1[j][3]); bb[j] = cvt8(x0[j], x1[j]); }
            } else {
#pragma unroll
                for (int j = 0; j < 8; ++j) bb[j] = *(const bf16x8*)(b16 + kb + 32 * j);
            }
#pragma unroll
            for (int j = 0; j < 8; ++j) acc = __builtin_amdgcn_mfma_f32_16x16x32_bf16(a[j], bb[j], acc, 0, 0, 0);
        }
        const int col = n0 + 4 * fq;
        float rstd = 1.f;
        if (F32B) { ssq += __shfl_xor(ssq, 16); ssq += __shfl_xor(ssq, 32); rstd = 1.0f / sqrtf(ssq * (1.0f / D) + RMS_EPS); }
        if (KIND == SG_POOL) {
            const f32x4 v = *(const f32x4*)(F.x_s + (size_t)b * D + col) + acc * *(const f32x4*)(F.pool_scale + col);
            *(f32x4*)(X + (size_t)row * D + col) = v;
        } else if (KIND == SG_UP) {
            f32x4 v = acc * rstd;
#pragma unroll
            for (int e = 0; e < 4; ++e) { const float t = fmaxf(v[e], 0.f); v[e] = t * t; }
            v2u o; o.x = cvtpk(v[0], v[1]); o.y = cvtpk(v[2], v[3]); *(v2u*)(WSP(bf16, WS_H) + (size_t)row * FF + col) = o;
        } else if (KIND == SG_DOWN || KIND == SG_WO) {
#pragma unroll
            for (int e = 0; e < 4; ++e) unsafeAtomicAdd(X + (size_t)row * D + col + e, acc[e]);
        } else {
            const f32x4 v = acc * rstd; v2u o; o.x = cvtpk(v[0], v[1]); o.y = cvtpk(v[2], v[3]);
            if (n0 < 1024) { *(f32x4*)(F.out + OUT_KV_S + (size_t)b * D + col) = v; if (n0 >= 512) *(v2u*)(WSP(bf16, WS_KVS) + (size_t)row * 512 + col - 512) = o; }
            else if (n0 < 1536) { *(v2u*)(WSP(bf16, WS_KVW) + (size_t)row * 512 + col - 1024) = o; *(f32x4*)(F.out + OUT_WIN_S + ((size_t)b * 512 + 511) * 512 + col - 1024) = v; }
            else if (n0 < 2560) { *(v2u*)(WSP(bf16, WS_Q) + (size_t)row * D + col - 1536) = o; }
            else { float* gp = WSP(float, WS_GATE) + (size_t)row * 48 + col - 2560;
#pragma unroll
                for (int e = 0; e < 4; ++e) gp[e] = 1.0f / (1.0f + __expf(-(v[e] + F.b_gate[col - 2560 + e]))); }
        }
    }    VM_WAIT();
}

__device__ __forceinline__ void p11_final(Frame& F) {
    const int gw = F.vcu * NWAVES + F.wave, NGW = F.G * NWAVES, lane = F.lane; const float* X = WSP(float, WS_X);
    for (int row = gw; row < MT; row += NGW) {
        const f32x4* xr = (const f32x4*)(X + (size_t)row * D) + lane; f32x4 v[4]; float ss = 0.f;
#pragma unroll
        for (int j = 0; j < 4; ++j) { v[j] = xr[64 * j]; ss += (v[j][0] * v[j][0] + v[j][1] * v[j][1]) + (v[j][2] * v[j][2] + v[j][3] * v[j][3]); }
        const float rstd = 1.0f / sqrtf(wave_sum(ss) * (1.0f / D) + RMS_EPS);
        float* o = (row < MP) ? F.out + OUT_Y_P + (size_t)row * D : F.out + OUT_Y_S + (size_t)(row - MP) * D;
#pragma unroll
        for (int j = 0; j < 4; ++j) *((f32x4*)o + lane + 64 * j) = v[j] * rstd * *((const f32x4*)F.norm_final + lane + 64 * j);
    }
}

constexpr int NPHASE = 12;
struct Args { const void* in[21]; float* out; unsigned char* ws; int ph_lo, ph_hi; };
__global__ void __launch_bounds__(NWAVES * 64, 2) yoco_fwd(Args args) {
    extern __shared__ __attribute__((aligned(16))) unsigned char lds[];
    Frame F;
    F.lds = (LAS unsigned char*)lds;
    F.tid = threadIdx.x; F.lane = F.tid & 63; F.wave = __builtin_amdgcn_readfirstlane(F.tid >> 6);
    F.G = gridDim.x; { const int bx = blockIdx.x; F.vcu = (F.G % 8 == 0) ? (bx % 8) * (F.G / 8) + bx / 8 : bx; }
    F.x_p = (const float*)args.in[0]; F.x_s = (const float*)args.in[1]; F.state_pool = (const float*)args.in[2]; F.cache = (const float*)args.in[3]; F.state_win = (const float*)args.in[4];
    F.page_table = (const int*)args.in[5]; F.norm_mix = (const float*)args.in[6]; F.norm_mlp = (const float*)args.in[7]; F.w_up = (const float*)args.in[8]; F.w_down = (const float*)args.in[9];
    F.pool_w = (const float*)args.in[10]; F.pool_scale = (const float*)args.in[11]; F.norm_kv = (const float*)args.in[12]; F.w_kv = (const float*)args.in[13]; F.cmp_pe = (const float*)args.in[14];
    F.cmp_w1 = (const float*)args.in[15]; F.cmp_w2 = (const float*)args.in[16]; F.w_qg = (const float*)args.in[17]; F.b_gate = (const float*)args.in[18]; F.w_o = (const float*)args.in[19];
    F.norm_final = (const float*)args.in[20]; F.out = args.out; F.ws = args.ws;
    volatile LAS unsigned* MISC = (volatile LAS unsigned*)(F.lds + MISC_OFF);
    for (int u = F.tid; u < (LDS_BYTES - RING_BYTES) / 4; u += NWAVES * 64) ((LAS unsigned*)(F.lds + RING_BYTES))[u] = 0u;
    __syncthreads();
    unsigned* ctl = (unsigned*)(F.ws + WS_CTL);
#if MK_MULTI
#define GRID_BAR() do { } while (0)
#else
    XcdBarrier bar = xcd_barrier_post(ctl + CW_BAR, MISC + 8);
#define GRID_BAR() xcd_barrier(bar)
#endif
    const int lo = args.ph_lo, hi = args.ph_hi;
#define IN(k) (lo <= (k) && (k) < hi)
#define SEAM(k) do { if (IN(k) && IN((k) + 1)) GRID_BAR(); } while (0)
    using namespace pg8;
    float* X = WSP(float, WS_X); bf16* XB = WSP(bf16, WS_XB); float* RS = WSP(float, WS_RS);

    if (IN(0)) { for (int rep = 0; rep < REP(0); ++rep) { p0_prologue(F); __syncthreads(); } } SEAM(0);
    if (IN(1)) {
        for (int rep = 0; rep < REP(16); ++rep) small_gemm<SG_POOL>(F, 0);
        Gemm g{WSP(bf16_t, WS_DIFF), WSP(bf16_t, WS_WPOOL), MP, 1024, 256, 1024, 256, (size_t)512}; StaticOrder S; S.init(MP, 1024, F.G, (int)blockIdx.x);
        EpiResid E{F.x_p, F.x_s, X, XB, RS, F.pool_scale};
        gemm_phase<EpiResid, StaticOrder, true, true>(F.lds, g, S, E);
    } SEAM(1);
    if (IN(2)) {
        for (int rep = 0; rep < REP(14); ++rep) small_gemm<SG_UP>(F, 0);
        Gemm g{XB, WSP(bf16_t, WS_WUP), MP, FF, D, D, D, (size_t)0}; StaticOrder S; S.init(MP, FF, F.G, (int)blockIdx.x);
        EpiUp E{WSP(bf16_t, WS_H), RS};
        for (int rep = 0; rep < REP(2); ++rep) { gemm_phase<EpiUp, StaticOrder, true, true>(F.lds, g, S, E); __syncthreads(); }
    } SEAM(2);
    if (IN(3)) {
        small_gemm<SG_DOWN>(F, 0);
        Gemm g{WSP(bf16_t, WS_H), WSP(bf16_t, WS_WDN), MP, D, FF, FF, FF, (size_t)0}; StaticOrder S; S.init(MP, D, F.G, (int)blockIdx.x);
        EpiResid E{X, X + (size_t)MP * D, X, XB, RS, nullptr};
        gemm_phase<EpiResid, StaticOrder, true, true>(F.lds, g, S, E);
    } SEAM(3);
    if (IN(4)) {
        for (int rep = 0; rep < REP(15); ++rep) small_gemm<SG_KVQG>(F, 0);
        Gemm g{XB, WSP(bf16_t, WS_WKVQG), MP, NKVQG, D, D, D, (size_t)0}; StaticOrder S; S.init(MP, NKVQG, F.G, (int)blockIdx.x);
        EpiKvqg E{RS, F.b_gate, F.out + OUT_KV_P, F.out + OUT_KV_S, F.out + OUT_WIN_P, F.out + OUT_WIN_S, WSP(bf16_t, WS_CMPA), WSP(bf16_t, WS_KVS), WSP(bf16_t, WS_KVW), WSP(bf16_t, WS_Q), WSP(float, WS_GATE)};
        gemm_phase<EpiKvqg, StaticOrder, true, true>(F.lds, g, S, E);
    } SEAM(4);
    if (IN(5)) {
        Gemm g{WSP(bf16_t, WS_CMPA), WSP(bf16_t, WS_W1CAT), CMP_ROWS, 512, D, D, D, (size_t)CMP_ROWS * D * 2}; StaticOrder S; S.init(CMP_ROWS, 512, F.G, (int)blockIdx.x);
        EpiCmp E{WSP(float, WS_CMPP)};
        gemm_phase<EpiCmp, StaticOrder, true, true>(F.lds, g, S, E);
    } SEAM(5);
    if (IN(6)) { for (int rep = 0; rep < REP(6); ++rep) { p6_combine(F); __syncthreads(); } } SEAM(6);
    if (IN(7)) { p7_attention(F); } SEAM(7);
    if (IN(8)) {
        small_gemm<SG_WO>(F, 0);
        Gemm g{WSP(bf16_t, WS_DIFF), WSP(bf16_t, WS_WO), MP, D, D, D, D, (size_t)0}; StaticOrder S; S.init(MP, D, F.G, (int)blockIdx.x);
        EpiResid E{X, X + (size_t)MP * D, X, XB, RS, nullptr};
        gemm_phase<EpiResid, StaticOrder, true, true>(F.lds, g, S, E);
    } SEAM(8);
    if (IN(9)) {
        small_gemm<SG_UP>(F, 1);
        Gemm g{XB, WSP(bf16_t, WS_WUP) + (size_t)FF * D, MP, FF, D, D, D, (size_t)0}; StaticOrder S; S.init(MP, FF, F.G, (int)blockIdx.x);
        EpiUp E{WSP(bf16_t, WS_H), RS};
        gemm_phase<EpiUp, StaticOrder, true, true>(F.lds, g, S, E);
    } SEAM(9);
    if (IN(10)) {
        small_gemm<SG_DOWN>(F, 1);
        Gemm g{WSP(bf16_t, WS_H), WSP(bf16_t, WS_WDN) + (size_t)D * FF, MP, D, FF, FF, FF, (size_t)0}; StaticOrder S; S.init(MP, D, F.G, (int)blockIdx.x);
        EpiResid E{X, X + (size_t)MP * D, X, XB, RS, nullptr};
        gemm_phase<EpiResid, StaticOrder, true, true>(F.lds, g, S, E);
    } SEAM(10);
    if (IN(11)) { p11_final(F); }
#undef IN
#undef SEAM
}

extern "C" void kernel_launch(void* const* d_in, const int* in_sizes, int n_in, void* d_out, int out_size, void* d_ws, size_t ws_size, hipStream_t stream) {
    static int grid = 0;
    if (grid == 0) {
        if (n_in != 21 || (size_t)out_size != OUT_TOTAL || ws_size < WS_END) { fprintf(stderr, "kernel_launch: unexpected sizes n_in %d out %d ws %zu\n", n_in, out_size, ws_size); grid = -1; return; }
        int dev = 0, cus = 0, per_cu = 0;
        if (hipGetDevice(&dev) != hipSuccess || hipDeviceGetAttribute(&cus, hipDeviceAttributeMultiprocessorCount, dev) != hipSuccess) { grid = -1; return; }
        if (hipFuncSetAttribute((const void*)yoco_fwd, hipFuncAttributeMaxDynamicSharedMemorySize, LDS_BYTES) != hipSuccess) { fprintf(stderr, "kernel_launch: hipFuncSetAttribute failed\n"); grid = -1; return; }
        if (hipOccupancyMaxActiveBlocksPerMultiprocessor(&per_cu, (const void*)yoco_fwd, NWAVES * 64, LDS_BYTES) != hipSuccess || per_cu < 1) fprintf(stderr, "kernel_launch: occupancy query says %d\n", per_cu);
        (void)hipGetLastError();
        grid = cus;
    }
    if (grid < 0) return;
    (void)hipMemsetAsync((char*)d_ws + WS_CTL, 0, CTL_ZERO_BYTES, stream);
    Args a{};
    for (int i = 0; i < 21; ++i) a.in[i] = d_in[i];
    a.out = (float*)d_out; a.ws = (unsigned char*)d_ws;
#if MK_MULTI
    for (int p = 0; p < NPHASE; ++p) { a.ph_lo = p; a.ph_hi = p + 1; hipLaunchKernelGGL(yoco_fwd, dim3(grid), dim3(NWAVES * 64), LDS_BYTES, stream, a); }
#else
    a.ph_lo = 0; a.ph_hi = NPHASE;
    hipLaunchKernelGGL(yoco_fwd, dim3(grid), dim3(NWAVES * 64), LDS_BYTES, stream, a);
#endif
    const hipError_t le = hipPeekAtLastError();
    if (le != hipSuccess) fprintf(stderr, "kernel_launch: launch failed: %s\n", hipGetErrorName(le));
}
```

```cpp
#include <hip/hip_runtime.h>
#include <hip/hip_bf16.h>
#include <cstdio>
#include <cstdint>
#include <cmath>

#ifndef MK_MULTI
#define MK_MULTI 0
#endif

constexpr int D = 1024, FF = 4096, SEQ = 4096, NB = 4, DB = 128, PAST = 2048;
constexpr int MP = NB * SEQ;
constexpr int MT = MP + DB;
constexpr int MPAD = 16640;
constexpr int NKVQG = 2816;
constexpr int CMP_ROWS_P = NB * 256 * 4;
constexpr int CMP_ROWS_S = DB * 128 * 4;
constexpr int CMP_ROWS = CMP_ROWS_P + CMP_ROWS_S;
constexpr float RMS_EPS = 1e-6f;
constexpr float LOG2E = 1.4426950408889634f;
constexpr float QSCALE = 0.125f * LOG2E;

namespace pg8 {
#define PG8_LAS __attribute__((address_space(3)))
typedef unsigned short bf16_t;
typedef short bf16x8 __attribute__((ext_vector_type(8)));
typedef float f32x4 __attribute__((ext_vector_type(4)));
typedef float f32x2 __attribute__((ext_vector_type(2)));
typedef unsigned u32x4 __attribute__((ext_vector_type(4)));
typedef unsigned u32x2 __attribute__((ext_vector_type(2)));
constexpr int BM = 256, BK = 64, HALF = 128, HTB = HALF * BK * 2, STAGE_BYTES = 8 * HTB, NXCD = 8, WGM = 8;

__host__ __device__ __forceinline__ int lds_byte(int r, int c) { const int st = (r >> 4) * 2 + (c >> 5), rr = r & 15, cc = c & 31, ob = rr * 64 + cc * 2; return st * 1024 + (ob ^ (((ob >> 9) & 1) << 5)); }
__host__ __device__ __forceinline__ void stage_rc(int b, int& R, int& C) { const int st = b / 1024, sb = b % 1024, swz = sb ^ (((sb >> 9) & 1) << 5); R = (st >> 1) * 16 + swz / 64; C = (st & 1) * 32 + (swz % 64) / 2; }
__host__ __device__ __forceinline__ int perm32(int rho) { const int n = rho >> 4, i = rho & 15; return 8 * (i >> 2) + 4 * n + (i & 3); }

struct Unit { int pm, pn; };
struct Gemm { const bf16_t* A; const bf16_t* Bt; int M, N, K, lda, ldb; size_t a_pn_off; };

struct StaticOrder {
    int nM, nN, nwg, G, c;
    __host__ __device__ void init(int M, int N, int G_, int c_) { nM = M / BM; nN = N / BM; nwg = nM * nN; G = G_; c = c_; }
    __host__ __device__ bool next(int i, Unit& u) const {
        const long L = (long)i * G + c; if (L >= nwg) return false;
        int wgid = (int)L; { const int q = nwg / NXCD, r = nwg % NXCD, xcd = wgid % NXCD, off = wgid / NXCD; wgid = (xcd < r ? xcd * (q + 1) : r * (q + 1) + (xcd - r) * q) + off; }
        const int nig = WGM * nN, gid = wgid / nig, fm = gid * WGM, gsz = (nM - fm) < WGM ? (nM - fm) : WGM;
        u.pm = fm + ((wgid % nig) % gsz); u.pn = (wgid % nig) / gsz; return true;
    }
    __device__ __forceinline__ void a_ready(const Unit&) const {}
    __device__ __forceinline__ void done(const Unit&) const {}
};

__device__ __forceinline__ unsigned cvt_pk_bf16(float lo, float hi) { unsigned r; asm volatile("v_cvt_pk_bf16_f32 %0, %1, %2" : "=v"(r) : "v"(lo), "v"(hi)); return r; }

__device__ __forceinline__ float row_rstd(const float* rs, int row) {
    const f32x4* p = (const f32x4*)(rs + (size_t)row * 16); const f32x4 a = p[0], b = p[1], c = p[2], d = p[3];
    const float s = ((a[0] + a[1]) + (a[2] + a[3])) + ((b[0] + b[1]) + (b[2] + b[3])) + ((c[0] + c[1]) + (c[2] + c[3])) + ((d[0] + d[1]) + (d[2] + d[3]));
    return 1.0f / sqrtf(s * (1.0f / 1024.0f) + RMS_EPS);
}

struct EpiResid {
    static constexpr bool PERM = false, AFTER_DRAIN = false;
    const float* base_p; const float* base_s;
    float* X; bf16_t* XB; float* RS; const float* scale;
    __device__ __forceinline__ void operator()(const f32x4 (&acc)[2][2][4][2], const Unit& u, int wr, int wc, int fr, int fq) const {
        const int col0 = u.pn * BM + wc * 32 + 4 * fq;
        f32x4 sc[2][2];
#pragma unroll
        for (int bj = 0; bj < 2; ++bj)
#pragma unroll
            for (int n = 0; n < 2; ++n) sc[bj][n] = scale ? *(const f32x4*)(scale + col0 + bj * HALF + n * 16) : (f32x4){1.f, 1.f, 1.f, 1.f};
#pragma unroll
        for (int ai = 0; ai < 2; ++ai) {
            if (u.pm * BM + ai * HALF >= MT) continue;
#pragma unroll
            for (int m = 0; m < 4; ++m) {
                const int row = u.pm * BM + ai * HALF + wr * 64 + m * 16 + fr;
                const float* bp = (row < MP) ? base_p + (size_t)row * D : base_s + (size_t)(row - MP) * D;
                float ss = 0.f;
#pragma unroll
                for (int bj = 0; bj < 2; ++bj)
#pragma unroll
                    for (int n = 0; n < 2; ++n) {
                        const int col = col0 + bj * HALF + n * 16;
                        const f32x4 v = *(const f32x4*)(bp + col) + acc[ai][bj][m][n] * sc[bj][n];
                        *(f32x4*)(X + (size_t)row * D + col) = v;
                        u32x2 w; w.x = cvt_pk_bf16(v[0], v[1]); w.y = cvt_pk_bf16(v[2], v[3]);
                        *(u32x2*)(XB + (size_t)row * D + col) = w;
                        ss += (v[0] * v[0] + v[1] * v[1]) + (v[2] * v[2] + v[3] * v[3]);
                    }
                ss += __shfl_xor(ss, 16); ss += __shfl_xor(ss, 32);
                if (fq == 0) RS[(size_t)row * 16 + u.pn * 4 + wc] = ss;
            }
        }
    }
};

struct EpiUp {
    static constexpr bool PERM = true, AFTER_DRAIN = false;
    bf16_t* H; const float* RS;
    __device__ __forceinline__ void operator()(const f32x4 (&acc)[2][2][4][2], const Unit& u, int wr, int wc, int fr, int fq) const {
        const int col0 = u.pn * BM + wc * 32 + 8 * fq;
#pragma unroll
        for (int ai = 0; ai < 2; ++ai) {
            if (u.pm * BM + ai * HALF >= MT) continue;
#pragma unroll
            for (int m = 0; m < 4; ++m) {
                const int row = u.pm * BM + ai * HALF + wr * 64 + m * 16 + fr;
                const float rstd = row_rstd(RS, row);
#pragma unroll
                for (int bj = 0; bj < 2; ++bj) {
                    f32x4 v0 = acc[ai][bj][m][0] * rstd, v1 = acc[ai][bj][m][1] * rstd;
#pragma unroll
                    for (int e = 0; e < 4; ++e) { const float a = fmaxf(v0[e], 0.f), b = fmaxf(v1[e], 0.f); v0[e] = a * a; v1[e] = b * b; }
                    u32x4 w; w.x = cvt_pk_bf16(v0[0], v0[1]); w.y = cvt_pk_bf16(v0[2], v0[3]); w.z = cvt_pk_bf16(v1[0], v1[1]); w.w = cvt_pk_bf16(v1[2], v1[3]);
                    *(u32x4*)(H + (size_t)row * FF + col0 + bj * HALF) = w;
                }
            }
        }
    }
};

struct EpiKvqg {
    static constexpr bool PERM = true, AFTER_DRAIN = false;
    const float* RS; const float* bgate;
    float* kv_p; float* kv_s; float* win_p; float* win_s;
    bf16_t* CMPA; bf16_t* KVS; bf16_t* KVW; bf16_t* Q; float* GATE;
    __device__ __forceinline__ void operator()(const f32x4 (&acc)[2][2][4][2], const Unit& u, int wr, int wc, int fr, int fq) const {
        const int pn = u.pn;
#pragma unroll
        for (int ai = 0; ai < 2; ++ai) {
            if (u.pm * BM + ai * HALF >= MT) continue;
#pragma unroll
            for (int m = 0; m < 4; ++m) {
                const int row = u.pm * BM + ai * HALF + wr * 64 + m * 16 + fr;
                const float rstd = row_rstd(RS, row);
                const bool prompt = row < MP; const int b = prompt ? (row >> 12) : (row - MP), t = row & (SEQ - 1);
#pragma unroll
                for (int bj = 0; bj < 2; ++bj) {
                    const int cin = bj * HALF + wc * 32 + 8 * fq;
                    const f32x4 v0 = acc[ai][bj][m][0] * rstd, v1 = acc[ai][bj][m][1] * rstd;
                    u32x4 w; w.x = cvt_pk_bf16(v0[0], v0[1]); w.y = cvt_pk_bf16(v0[2], v0[3]); w.z = cvt_pk_bf16(v1[0], v1[1]); w.w = cvt_pk_bf16(v1[2], v1[3]);
                    if (pn < 4) {
                        float* o = prompt ? kv_p + (size_t)row * D : kv_s + (size_t)b * D;
                        *(f32x4*)(o + pn * BM + cin) = v0; *(f32x4*)(o + pn * BM + cin + 4) = v1;
                        if (pn < 2) {
                            if (prompt) { const int g = cin >> 6, d = cin & 63;
                                *(u32x4*)(CMPA + (size_t)pn * CMP_ROWS * D + (size_t)(((b * 256 + (t >> 4)) * 4 + g)) * D + (t & 15) * 64 + d) = w; }
                        } else *(u32x4*)(KVS + (size_t)row * 512 + (pn - 2) * BM + cin) = w;
                    } else if (pn < 6) {
                        const int c = (pn - 4) * BM + cin;
                        *(u32x4*)(KVW + (size_t)row * 512 + c) = w;
                        if (prompt) { if (t >= SEQ - 512) { float* o = win_p + ((size_t)b * 512 + (t - (SEQ - 512))) * 512 + c; *(f32x4*)o = v0; *(f32x4*)(o + 4) = v1; } }
                        else { float* o = win_s + ((size_t)b * 512 + 511) * 512 + c; *(f32x4*)o = v0; *(f32x4*)(o + 4) = v1; }
                    } else if (pn < 10) {
                        *(u32x4*)(Q + (size_t)row * D + (pn - 6) * BM + cin) = w;
                    } else {
                        if (cin < 48) {
#pragma unroll
                            for (int e = 0; e < 4; ++e) { GATE[(size_t)row * 48 + cin + e] = 1.0f / (1.0f + __expf(-(v0[e] + bgate[cin + e]))); GATE[(size_t)row * 48 + cin + 4 + e] = 1.0f / (1.0f + __expf(-(v1[e] + bgate[cin + 4 + e]))); }
                        }
                    }
                }
            }
        }
    }
};

struct EpiCmp {
    static constexpr bool PERM = false, AFTER_DRAIN = false;
    float* P;
    __device__ __forceinline__ void operator()(const f32x4 (&acc)[2][2][4][2], const Unit& u, int wr, int wc, int fr, int fq) const {
        float* base = P + (size_t)u.pn * CMP_ROWS * 256;
#pragma unroll
        for (int ai = 0; ai < 2; ++ai)
#pragma unroll
            for (int m = 0; m < 4; ++m) {
                const int row = u.pm * BM + ai * HALF + wr * 64 + m * 16 + fr;
#pragma unroll
                for (int bj = 0; bj < 2; ++bj)
#pragma unroll
                    for (int n = 0; n < 2; ++n) *(f32x4*)(base + (size_t)row * 256 + bj * HALF + wc * 32 + n * 16 + 4 * fq) = acc[ai][bj][m][n];
            }
    }
};

template <class Epi, class Sched, bool ALIGN_EPI = false, bool SP2 = false>
__device__ __forceinline__ void gemm_phase(PG8_LAS unsigned char* lds, const Gemm g, const Sched& S, const Epi& E) {
    const int tid = threadIdx.x, wid = __builtin_amdgcn_readfirstlane(tid >> 6), lane = tid & 63, wr = wid >> 2, wc = wid & 3, fr = lane & 15, fq = lane >> 4;
    const int K = g.K, nt = K / BK;
    unsigned voffA[2], voffB[2];
#pragma unroll
    for (int i = 0; i < 2; ++i) { int R, C; stage_rc(tid * 16 + i * 8192, R, C); const int Rb = Epi::PERM ? ((R & ~31) + perm32(R & 31)) : R;
        voffA[i] = (unsigned)(R * g.lda + C) * 2u; voffB[i] = (unsigned)(Rb * g.ldb + C) * 2u; }
    const size_t kstep = (size_t)(BK * 2);
    const size_t hstepA = (size_t)HALF * g.lda * 2, hstepB = (size_t)HALF * g.ldb * 2;
    const size_t tstepA = 2 * hstepA, tstepB = 2 * hstepB;
    const unsigned ldsw = (unsigned)wid * 1024u;
    const int aoff = lds_byte(wr * 64 + fr, fq * 8), boff = lds_byte(wc * 32 + fr, fq * 8);
#define PG8_SA(b, h) (((b) * 2 + (h)) * HTB)
#define PG8_SB(b, h) ((4 + (b) * 2 + (h)) * HTB)
#define PG8_STAGE(bufoff, gbase, voff) do { _Pragma("unroll") for (int _i = 0; _i < 2; ++_i) \
        __builtin_amdgcn_global_load_lds((const unsigned*)((const char*)(gbase) + (voff)[_i]), (PG8_LAS unsigned*)(lds + (bufoff) + ldsw + _i * 8192), 16, 0, 0); } while (0)
#define PG8_LDA(dst, b, h) do { _Pragma("unroll") for (int m = 0; m < 4; ++m) _Pragma("unroll") for (int k = 0; k < 2; ++k) dst[m][k] = *(const PG8_LAS bf16x8*)(lds + PG8_SA(b, h) + aoff + m * 2048 + k * 1024); } while (0)
#define PG8_LDB(dst, b, h) do { _Pragma("unroll") for (int n = 0; n < 2; ++n) _Pragma("unroll") for (int k = 0; k < 2; ++k) dst[n][k] = *(const PG8_LAS bf16x8*)(lds + PG8_SB(b, h) + boff + n * 2048 + k * 1024); } while (0)
#define PG8_MMA(ai, bj, At, Bt) do { __builtin_amdgcn_s_setprio(1); _Pragma("unroll") for (int m = 0; m < 4; ++m) _Pragma("unroll") for (int n = 0; n < 2; ++n) _Pragma("unroll") for (int k = 0; k < 2; ++k) \
        acc[ai][bj][m][n] = __builtin_amdgcn_mfma_f32_16x16x32_bf16(Bt[n][k], At[m][k], acc[ai][bj][m][n], 0, 0, 0); __builtin_amdgcn_s_setprio(0); } while (0)
#define PG8_WAIT_V(n) asm volatile("s_waitcnt vmcnt(" #n ")" ::: "memory")
#define PG8_WAIT_L(n) asm volatile("s_waitcnt lgkmcnt(" #n ")" ::: "memory")
#define PG8_BAR __builtin_amdgcn_s_barrier()
#define PG8_SCHED __builtin_amdgcn_sched_barrier(0)
    Unit cur, nxt; int ui = 0;
    if (!S.next(0, cur)) return;
    f32x4 acc[2][2][4][2];
#pragma unroll
    for (int a = 0; a < 2; ++a)
#pragma unroll
        for (int b = 0; b < 2; ++b)
#pragma unroll
            for (int m = 0; m < 4; ++m)
#pragma unroll
                for (int n = 0; n < 2; ++n) acc[a][b][m][n] = (f32x4){0.f, 0.f, 0.f, 0.f};
    bf16x8 At[4][2], B0[2][2], B1[2][2];
    const char* cA = (const char*)g.A + (size_t)cur.pm * tstepA + (size_t)cur.pn * g.a_pn_off; const char* cB = (const char*)g.Bt + (size_t)cur.pn * tstepB;
    S.a_ready(cur);
    if constexpr (SP2) {
        PG8_STAGE(PG8_SB(0, 0), cB, voffB); PG8_STAGE(PG8_SB(0, 1), cB + hstepB, voffB); PG8_STAGE(PG8_SA(0, 0), cA, voffA); PG8_STAGE(PG8_SA(0, 1), cA + hstepA, voffA);
        if (wr == 1) PG8_BAR;
        PG8_WAIT_V(2); PG8_BAR;
        PG8_STAGE(PG8_SB(1, 0), cB + kstep, voffB); PG8_STAGE(PG8_SA(1, 0), cA + kstep, voffA); PG8_STAGE(PG8_SB(1, 1), cB + hstepB + kstep, voffB);
        PG8_WAIT_V(6); PG8_BAR;
    } else {
        PG8_STAGE(PG8_SB(0, 0), cB, voffB); PG8_STAGE(PG8_SA(0, 0), cA, voffA); PG8_STAGE(PG8_SB(0, 1), cB + hstepB, voffB); PG8_STAGE(PG8_SA(0, 1), cA + hstepA, voffA);
        if (wr == 1) PG8_BAR;
        PG8_WAIT_V(4); PG8_BAR;
        PG8_STAGE(PG8_SB(1, 0), cB + kstep, voffB); PG8_STAGE(PG8_SA(1, 0), cA + kstep, voffA); PG8_STAGE(PG8_SB(1, 1), cB + hstepB + kstep, voffB);
        PG8_WAIT_V(6); PG8_BAR;
    }
    for (;;) {
        const bool has_next = S.next(ui + 1, nxt);
        const char* nA = has_next ? (const char*)g.A + (size_t)nxt.pm * tstepA + (size_t)nxt.pn * g.a_pn_off : cA; const char* nB = has_next ? (const char*)g.Bt + (size_t)nxt.pn * tstepB : cB;
        for (int t = 0; t < nt; t += 2) {
            const bool last = (t == nt - 2);
            const char* a1 = cA + (size_t)(t + 1) * kstep;
            const char* a2 = last ? nA : cA + (size_t)(t + 2) * kstep; const char* b2 = last ? nB : cB + (size_t)(t + 2) * kstep;
            const char* a3 = a2 + kstep; const char* b3 = b2 + kstep;
            if (last && has_next) S.a_ready(nxt);
            if constexpr (SP2) {
            PG8_LDB(B0, 0, 0); PG8_LDB(B1, 0, 1); PG8_SCHED; PG8_LDA(At, 0, 0); PG8_STAGE(PG8_SA(1, 1), a1 + hstepA, voffA);
            PG8_WAIT_V(8); PG8_WAIT_L(0); PG8_BAR; PG8_MMA(0, 0, At, B0); PG8_MMA(0, 1, At, B1); PG8_BAR; PG8_SCHED;
            PG8_LDA(At, 0, 1); PG8_STAGE(PG8_SB(0, 0), b2, voffB); PG8_STAGE(PG8_SB(0, 1), b2 + hstepB, voffB); PG8_STAGE(PG8_SA(0, 0), a2, voffA);
            PG8_WAIT_V(8); PG8_WAIT_L(0); PG8_BAR; PG8_MMA(1, 0, At, B0); PG8_MMA(1, 1, At, B1); PG8_BAR; PG8_SCHED;
            PG8_LDB(B0, 1, 0); PG8_LDB(B1, 1, 1); PG8_SCHED; PG8_LDA(At, 1, 0); PG8_STAGE(PG8_SA(0, 1), a2 + hstepA, voffA);
            PG8_WAIT_V(8); PG8_WAIT_L(0); PG8_BAR; PG8_MMA(0, 0, At, B0); PG8_MMA(0, 1, At, B1); PG8_BAR; PG8_SCHED;
            PG8_LDA(At, 1, 1); PG8_STAGE(PG8_SB(1, 0), b3, voffB); PG8_STAGE(PG8_SB(1, 1), b3 + hstepB, voffB); PG8_STAGE(PG8_SA(1, 0), a3, voffA);
            PG8_WAIT_V(8); PG8_WAIT_L(0); PG8_BAR; PG8_MMA(1, 0, At, B0); PG8_MMA(1, 1, At, B1); PG8_BAR; PG8_SCHED;
            } else {
            PG8_LDB(B0, 0, 0); PG8_SCHED; PG8_LDA(At, 0, 0); PG8_STAGE(PG8_SA(1, 1), a1 + hstepA, voffA);
            PG8_WAIT_L(8); PG8_BAR; PG8_WAIT_L(0); PG8_MMA(0, 0, At, B0); PG8_BAR; PG8_SCHED;
            PG8_LDB(B1, 0, 1); PG8_STAGE(PG8_SB(0, 0), b2, voffB);
            PG8_BAR; PG8_WAIT_L(0); PG8_MMA(0, 1, At, B1); PG8_BAR;
            PG8_LDA(At, 0, 1); PG8_STAGE(PG8_SA(0, 0), a2, voffA);
            PG8_BAR; PG8_WAIT_L(0); PG8_MMA(1, 0, At, B0); PG8_BAR; PG8_SCHED;
            PG8_STAGE(PG8_SB(0, 1), b2 + hstepB, voffB);
            PG8_WAIT_V(6); PG8_BAR; PG8_MMA(1, 1, At, B1); PG8_BAR;
            PG8_LDB(B0, 1, 0); PG8_SCHED; PG8_LDA(At, 1, 0); PG8_STAGE(PG8_SA(0, 1), a2 + hstepA, voffA);
            PG8_WAIT_L(8); PG8_BAR; PG8_WAIT_L(0); PG8_MMA(0, 0, At, B0); PG8_BAR; PG8_SCHED;
            PG8_LDB(B1, 1, 1); PG8_STAGE(PG8_SB(1, 0), b3, voffB);
            PG8_BAR; PG8_WAIT_L(0); PG8_MMA(0, 1, At, B1); PG8_BAR;
            PG8_LDA(At, 1, 1); PG8_STAGE(PG8_SA(1, 0), a3, voffA);
            PG8_BAR; PG8_WAIT_L(0); PG8_MMA(1, 0, At, B0); PG8_BAR; PG8_SCHED;
            PG8_STAGE(PG8_SB(1, 1), b3 + hstepB, voffB);
            PG8_WAIT_V(6); PG8_BAR; PG8_MMA(1, 1, At, B1); PG8_BAR;
            }
        }
        if constexpr (ALIGN_EPI) { if (wr == 0) PG8_BAR; }
        if constexpr (!Epi::AFTER_DRAIN) { E(acc, cur, wr, wc, fr, fq); S.done(cur); }
        if (!has_next) break;
#pragma unroll
        for (int a = 0; a < 2; ++a)
#pragma unroll
            for (int b = 0; b < 2; ++b)
#pragma unroll
                for (int m = 0; m < 4; ++m)
#pragma unroll
                    for (int n = 0; n < 2; ++n) acc[a][b][m][n] = (f32x4){0.f, 0.f, 0.f, 0.f};
        cur = nxt; cA = nA; cB = nB; ++ui;
        if constexpr (ALIGN_EPI) { if (wr == 1) PG8_BAR; }
    }
    PG8_WAIT_V(0);
    if constexpr (!ALIGN_EPI) { if (wr == 0) PG8_BAR; }
    PG8_BAR;
    if constexpr (Epi::AFTER_DRAIN) { E.fused(acc, cur, wr, wc, fr, fq, lds, wid, lane); S.done(cur); }
#undef PG8_SA
#undef PG8_SB
#undef PG8_STAGE
#undef PG8_LDA
#undef PG8_LDB
#undef PG8_MMA
#undef PG8_WAIT_V
#undef PG8_WAIT_L
#undef PG8_BAR
#undef PG8_SCHED
}
}

#define GAS __attribute__((address_space(1)))
#define LAS __attribute__((address_space(3)))
typedef unsigned short bf16;
typedef unsigned v4u __attribute__((ext_vector_type(4)));
typedef unsigned v2u __attribute__((ext_vector_type(2)));
typedef float f32x4 __attribute__((ext_vector_type(4)));
typedef float f32x2 __attribute__((ext_vector_type(2)));
typedef float f32x16 __attribute__((ext_vector_type(16)));
typedef short bf16x8 __attribute__((ext_vector_type(8)));
typedef short v4i16_t __attribute__((ext_vector_type(4)));
typedef GAS unsigned gu32;
typedef GAS unsigned long long gu64;
#define RLX_AGENT __ATOMIC_RELAXED, __HIP_MEMORY_SCOPE_AGENT
#define LDS_WAIT() asm volatile("s_waitcnt lgkmcnt(0)" ::: "memory")
#define VM_WAIT() asm volatile("s_waitcnt vmcnt(0)" ::: "memory")
__device__ __forceinline__ unsigned f2bf(float f) { unsigned u = __builtin_bit_cast(unsigned, f); return (u + 0x7fffu + ((u >> 16) & 1u)) >> 16; }
__device__ __forceinline__ unsigned pk2(float lo, float hi) { return f2bf(lo) | (f2bf(hi) << 16); }
__device__ __forceinline__ float bf2f(unsigned short h) { return __builtin_bit_cast(float, (unsigned)h << 16); }

#define XB_TMO      128
#define XB_XCNT(j)  (256  + 64 * (j))
#define XB_XSUB(j)  (1280 + 64 * (j))
#define XB_XGEN(j)  (2304 + 64 * (j))
#define XB_TOP      3328
#define XB_TOPGEN   3392
#define XCD_BAR_WORDS 3456
#define XB_SPIN_CAP (1u << 18)

__device__ __forceinline__ unsigned xb_ld(unsigned* p)              { return __hip_atomic_load(p, __ATOMIC_RELAXED, __HIP_MEMORY_SCOPE_AGENT); }
__device__ __forceinline__ unsigned xb_add(unsigned* p, unsigned v) { return __hip_atomic_fetch_add(p, v, __ATOMIC_RELAXED, __HIP_MEMORY_SCOPE_AGENT); }
__device__ __forceinline__ unsigned xb_xcc_id() { return (unsigned)__builtin_amdgcn_s_getreg((3 << 11) | 20) & 0xFu; }
#define XB_SPIN(cond, bar) do { unsigned _sp = 0; while (cond) { __builtin_amdgcn_s_sleep(1); \
    if ((++_sp & 255u) == 0u) { if (xb_ld(&(bar)[XB_TMO])) break; if (_sp > XB_SPIN_CAP) { atomicAdd(&(bar)[XB_TMO], 1u); break; } } } } while (0)

struct XcdBarrier {
    unsigned* bar; unsigned x;
    volatile LAS unsigned* st;
};

__device__ __forceinline__ XcdBarrier xcd_barrier_post(unsigned* bar, volatile LAS unsigned* st) {
    XcdBarrier b; b.bar = bar; b.x = xb_xcc_id(); b.st = st;
    if (threadIdx.x == 0) (void)xb_add(&bar[XB_XCNT(b.x)], 1u);
    return b;
}
__device__ __forceinline__ void xcd_barrier_complete(unsigned* bar, unsigned x, unsigned& nloc, unsigned& nx) {
    const unsigned G = gridDim.x * gridDim.y * gridDim.z;
    unsigned sum, cnt, mine, sp = 0u;
    for (;;) {
        sum = 0u; cnt = 0u; mine = 0u;
#pragma unroll
        for (unsigned j = 0; j < 16; ++j) { const unsigned c = xb_ld(&bar[XB_XCNT(j)]); sum += c; cnt += (c > 0u) ? 1u : 0u; mine = (j == x) ? c : mine; }
        if (sum == G) break;
        __builtin_amdgcn_s_sleep(1);
        if ((++sp & 255u) == 0u) { if (xb_ld(&bar[XB_TMO])) break; if (sp > XB_SPIN_CAP) { atomicAdd(&bar[XB_TMO], 1u); break; } }
    }
    nloc = mine > 0u ? mine : 1u; nx = cnt > 0u ? cnt : 1u;
}

__device__ __forceinline__ void xcd_barrier(const XcdBarrier& b) {
    asm volatile("s_waitcnt vmcnt(0)" ::: "memory");
    __syncthreads();
    if (threadIdx.x == 0) {
        unsigned* bar = b.bar;
        __builtin_amdgcn_s_waitcnt(0);
        unsigned nloc = b.st[0], nx = b.st[1];
        if (nloc == 0u) { xcd_barrier_complete(bar, b.x, nloc, nx); b.st[0] = nloc; b.st[1] = nx; }
        const unsigned old = xb_add(&bar[XB_XSUB(b.x)], 1u);
        const unsigned gen = old / nloc;
        if (old + 1u == (gen + 1u) * nloc) {
            __builtin_amdgcn_fence(__ATOMIC_RELEASE, "agent");
            asm volatile("s_waitcnt vmcnt(0)" ::: "memory");
            const unsigned og = xb_add(&bar[XB_TOP], 1u);
            const unsigned tg = og / nx;
            if (og + 1u == (tg + 1u) * nx) xb_add(&bar[XB_TOPGEN], 1u);
            else XB_SPIN(xb_ld(&bar[XB_TOPGEN]) == tg, bar);
            __builtin_amdgcn_fence(__ATOMIC_ACQUIRE, "agent");
            xb_add(&bar[XB_XGEN(b.x)], 1u);
            asm volatile("s_waitcnt vmcnt(0)" ::: "memory");
        } else {
            XB_SPIN(xb_ld(&bar[XB_XGEN(b.x)]) == gen, bar);
            __builtin_amdgcn_fence(__ATOMIC_ACQUIRE, "agent");
            asm volatile("s_waitcnt vmcnt(0)" ::: "memory");
        }
    }
    __syncthreads();
}

constexpr size_t MiB = 1u << 20;
constexpr size_t WS_CTL = 0, CTL_ZERO_BYTES = 1 * MiB;
constexpr size_t WS_WUP = 2 * MiB;
constexpr size_t WS_WDN = 18 * MiB;
constexpr size_t WS_WKVQG = 34 * MiB;
constexpr size_t WS_WO = 40 * MiB;
constexpr size_t WS_WPOOL = 42 * MiB;
constexpr size_t WS_W1CAT = 43 * MiB;
constexpr size_t WS_CBIAS = 44 * MiB;
constexpr size_t WS_RS = 45 * MiB;
constexpr size_t WS_GATE = 47 * MiB;
constexpr size_t WS_X = 52 * MiB;
constexpr size_t WS_XB = 118 * MiB;
constexpr size_t WS_DIFF = 152 * MiB;
constexpr size_t WS_Q = 186 * MiB;
constexpr size_t WS_KVS = 220 * MiB;
constexpr size_t WS_KVW = 238 * MiB;
constexpr size_t WS_KC = 256 * MiB;
constexpr size_t WS_KCS = 258 * MiB;
constexpr size_t WS_H = 292 * MiB;
constexpr size_t WS_CMPA = 424 * MiB;
constexpr size_t WS_CMPP = 700 * MiB;
constexpr size_t WS_END = 840 * MiB;
constexpr int CW_BAR = 4096;

constexpr size_t OUT_Y_P = 0, OUT_Y_S = 16777216, OUT_POOL_P = 16908288, OUT_POOL_S = 16969728, OUT_KV_P = 18935808, OUT_KV_S = 35713024, OUT_WIN_P = 35844096, OUT_WIN_S = 36892672, OUT_TOTAL = 70447104;

#ifndef PROBE_DUP
#define PROBE_DUP 0
#endif
#define REP(k) (1 + ((PROBE_DUP >> (k)) & 1))
constexpr int NWAVES = 8;
constexpr int RING_BYTES = 131072, MISC_OFF = RING_BYTES + 320, LDS_BYTES = 147456;

struct Frame {
    LAS unsigned char* lds;
    int tid, lane, wave, vcu, G;
    const float *x_p, *x_s, *state_pool, *cache, *state_win; const int* page_table;
    const float *norm_mix, *norm_mlp, *w_up, *w_down, *pool_w, *pool_scale, *norm_kv, *w_kv, *cmp_pe, *cmp_w1, *cmp_w2, *w_qg, *b_gate, *w_o, *norm_final;
    float* out; unsigned char* ws;
};
#define WSP(T, off) ((T*)(F.ws + (off)))

__device__ __forceinline__ unsigned cvtpk(float lo, float hi) { typedef __bf16 bf16x2_t __attribute__((ext_vector_type(2))); f32x2 v = {lo, hi}; bf16x2_t b = __builtin_convertvector(v, bf16x2_t); return __builtin_bit_cast(unsigned, b); }
__device__ __forceinline__ bf16x8 cvt8(const f32x4 a, const f32x4 b) { v4u w; w.x = cvtpk(a[0], a[1]); w.y = cvtpk(a[2], a[3]); w.z = cvtpk(b[0], b[1]); w.w = cvtpk(b[2], b[3]); return __builtin_bit_cast(bf16x8, w); }
__device__ __forceinline__ float wave_sum(float v) {
#pragma unroll
    for (int o = 1; o < 64; o <<= 1) v += __shfl_xor(v, o);
    return v;
}
__device__ __forceinline__ float wave_max(float v) {
#pragma unroll
    for (int o = 1; o < 64; o <<= 1) v = fmaxf(v, __shfl_xor(v, o));
    return v;
}

__device__ __forceinline__ void transpose_item(const float* W, int N, bf16* WT, int ldt, int row_off, const float* kscale, float scale, LAS float* scr, int kb, int nb, int lane) {
    const int k0 = 64 * kb, n0 = 32 * nb; const int n = n0 + (lane & 31);
#pragma unroll 8
    for (int i = 0; i < 32; ++i) { const int kk = 2 * i + (lane >> 5); float v = (n < N) ? W[(size_t)(k0 + kk) * N + n] : 0.f; if (kscale) v *= kscale[k0 + kk]; scr[kk * 33 + (lane & 31)] = v * scale; }
    LDS_WAIT(); asm volatile("" ::: "memory");
    const int c = lane & 7;
#pragma unroll
    for (int j = 0; j < 4; ++j) { const int nn = (lane >> 3) + 8 * j; const LAS float* s = scr + (8 * c) * 33 + nn;
        v4u o; o.x = pk2(s[0 * 33], s[1 * 33]); o.y = pk2(s[2 * 33], s[3 * 33]); o.z = pk2(s[4 * 33], s[5 * 33]); o.w = pk2(s[6 * 33], s[7 * 33]);
        if (n0 + nn < N) *(v4u*)(WT + (size_t)(row_off + n0 + nn) * ldt + k0 + 8 * c) = o; }
    LDS_WAIT(); asm volatile("" ::: "memory");
}

__device__ __forceinline__ void p0_prologue(Frame& F) {
    LAS float* scr = (LAS float*)(F.lds + F.wave * 16384);
    const int gw = F.vcu * NWAVES + F.wave, NGW = F.G * NWAVES, lane = F.lane;
    bf16* WUP = WSP(bf16, WS_WUP); bf16* WDN = WSP(bf16, WS_WDN); bf16* WKVQG = WSP(bf16, WS_WKVQG); bf16* WO = WSP(bf16, WS_WO); bf16* WPOOL = WSP(bf16, WS_WPOOL); bf16* W1CAT = WSP(bf16, WS_W1CAT);
    constexpr int I_UP = 2048, I_DN = 2048, I_KV = 768, I_QG = 544, I_WO = 512, I_PL = 32, I_C1 = 64;
    constexpr int NITEMS = 2 * I_UP + 2 * I_DN + I_KV + I_QG + I_WO + 4 * I_PL + 4 * I_C1;
    for (int rep = 0; rep < REP(17); ++rep)
    for (int it = gw; it < NITEMS; it += NGW) {
        int r = it;
        if (r < 2 * I_UP) { const int l = r / I_UP; r %= I_UP; transpose_item(F.w_up + (size_t)l * D * FF, FF, WUP + (size_t)l * FF * D, D, 0, F.norm_mlp + l * D, 1.f, scr, r / 128, r % 128, lane); continue; } r -= 2 * I_UP;
        if (r < 2 * I_DN) { const int l = r / I_DN; r %= I_DN; transpose_item(F.w_down + (size_t)l * FF * D, D, WDN + (size_t)l * D * FF, FF, 0, nullptr, 1.f, scr, r / 32, r % 32, lane); continue; } r -= 2 * I_DN;
        if (r < I_KV) { transpose_item(F.w_kv, 1536, WKVQG, D, 0, F.norm_kv, 1.f, scr, r / 48, r % 48, lane); continue; } r -= I_KV;
        if (r < I_QG) { const int nb = r % 34; transpose_item(F.w_qg, 1072, WKVQG, D, 1536, F.norm_mix + D, nb < 32 ? QSCALE : 1.f, scr, r / 34, nb, lane); continue; } r -= I_QG;
        if (r < I_WO) { transpose_item(F.w_o, D, WO, D, 0, nullptr, 1.f, scr, r / 32, r % 32, lane); continue; } r -= I_WO;
        if (r < 4 * I_PL) { const int g = r / I_PL; r %= I_PL; transpose_item(F.pool_w + (size_t)g * 65536, 256, WPOOL + (size_t)g * 65536, 256, 0, nullptr, 1.f, scr, r / 8, r % 8, lane); continue; } r -= 4 * I_PL;
        { const int kvh = r / I_C1; r %= I_C1; const int kv = kvh >> 1, half = kvh & 1;
          transpose_item(F.cmp_w1 + (size_t)kv * 2048 * 128 + (size_t)half * 1024 * 128, 128, W1CAT + (size_t)kv * 256 * D, D, half * 128, nullptr, 1.f, scr, r / 4, r % 4, lane); }
    }
    { const int gt = F.vcu * 512 + F.tid, NT = F.G * 512; v4u* z = (v4u*)(WKVQG + (size_t)2608 * D);
      for (int i = gt; i < 208 * D / 8; i += NT) z[i] = (v4u){0u, 0u, 0u, 0u}; }
    { float* CB = WSP(float, WS_CBIAS);
      for (int it = gw; it < 256; it += NGW) { const int kv = it >> 7, n = it & 127; float s = 0.f;
          for (int k = lane; k < 2048; k += 64) s += F.cmp_pe[kv * 2048 + k] * F.cmp_w1[((size_t)kv * 2048 + k) * 128 + n];
          s = wave_sum(s); if (lane == 0) CB[it] = s; } }
    bf16* DIFF = WSP(bf16, WS_DIFF);
    for (int b = gw; b < DB; b += NGW) {
        const f32x4* xr = (const f32x4*)(F.x_s + (size_t)b * D) + lane; f32x4 v[4]; float ss = 0.f;
#pragma unroll
        for (int j = 0; j < 4; ++j) { v[j] = xr[64 * j]; ss += (v[j][0] * v[j][0] + v[j][1] * v[j][1]) + (v[j][2] * v[j][2] + v[j][3] * v[j][3]); }
        const float rstd = 1.0f / sqrtf(wave_sum(ss) * (1.0f / D) + RMS_EPS);
        const float* sp = F.state_pool + (size_t)b * 15 * D; float* ps = F.out + OUT_POOL_S + (size_t)b * 15 * D;
#pragma unroll
        for (int j = 0; j < 4; ++j) {
            const int col = 256 * j + 4 * lane; const f32x4 gg = *(const f32x4*)(F.norm_mix + col); const f32x4 u = v[j] * rstd * gg;
            f32x4 sum = u; const int w = 2 << j;
            for (int r = 0; r < w - 1; ++r) sum += *(const f32x4*)(sp + (size_t)(14 - r) * D + col);
            const f32x4 df = sum * (1.0f / (float)w) - u;
            v2u o; o.x = pk2(df[0], df[1]); o.y = pk2(df[2], df[3]); *(v2u*)(DIFF + (size_t)(MP + b) * D + col) = o;
            *(f32x4*)(ps + (size_t)14 * D + col) = u;
            for (int r = 0; r < 14; ++r) *(f32x4*)(ps + (size_t)r * D + col) = *(const f32x4*)(sp + (size_t)(r + 1) * D + col);
        }
    }
    if (F.G != 256) { const size_t gt = (size_t)F.vcu * 512 + F.tid, NT = (size_t)F.G * 512; const f32x4* src = (const f32x4*)F.state_win; f32x4* dst = (f32x4*)(F.out + OUT_WIN_S);
      for (int rep = 0; rep < REP(19); ++rep)
      for (size_t e = gt; e < (size_t)DB * 511 * 128; e += NT) { const size_t b = e / (511 * 128), rem = e - b * (511 * 128); dst[b * 65536 + rem] = src[b * 65536 + rem + 128]; } }
    __syncthreads();
    LAS float* U = (LAS float*)F.lds;
    for (int rep = 0; rep < REP(20); ++rep)
    for (int task = F.vcu; task < MP / 64; task += F.G) {
        const int b = task >> 6, t0 = (task & 63) * 64;
        const float* xb = F.x_p + (size_t)b * SEQ * D;
        f32x4 gmix[4];
#pragma unroll
        for (int j = 0; j < 4; ++j) gmix[j] = *(const f32x4*)(F.norm_mix + 256 * j + 4 * lane);
        f32x4 ra[4], rb2[4];
#define DF_LOAD(T) do { const int ta_ = (T) + 2 * F.wave, tb_ = ta_ + 1; _Pragma("unroll") for (int j = 0; j < 4; ++j) { \
            ra[j] = (ta_ >= 0) ? *((const f32x4*)(xb + (size_t)ta_ * D) + lane + 64 * j) : (f32x4){0.f, 0.f, 0.f, 0.f}; rb2[j] = (tb_ >= 0) ? *((const f32x4*)(xb + (size_t)tb_ * D) + lane + 64 * j) : (f32x4){0.f, 0.f, 0.f, 0.f}; } } while (0)
#define DF_STORE1(rr, tt_) do { float ss = 0.f; _Pragma("unroll") for (int j = 0; j < 4; ++j) ss += (rr[j][0] * rr[j][0] + rr[j][1] * rr[j][1]) + (rr[j][2] * rr[j][2] + rr[j][3] * rr[j][3]); \
            const float rstd = 1.0f / sqrtf(wave_sum(ss) * (1.0f / D) + RMS_EPS); \
            _Pragma("unroll") for (int j = 0; j < 4; ++j) { const f32x4 u = rr[j] * rstd * gmix[j]; *(LAS f32x4*)(U + ((tt_) & 31) * 1024 + 256 * j + 4 * lane) = u; \
                if ((tt_) >= SEQ - 15) *(f32x4*)(F.out + OUT_POOL_P + ((size_t)b * 15 + ((tt_) - (SEQ - 15))) * D + 256 * j + 4 * lane) = u; } } while (0)
#define DF_STORE(T) do { const int ta_ = (T) + 2 * F.wave; DF_STORE1(ra, ta_); DF_STORE1(rb2, ta_ + 1); } while (0)
        DF_LOAD(t0 - 16); DF_STORE(t0 - 16);
        DF_LOAD(t0);
        const int c = 2 * F.tid, w = 2 << (F.tid >> 7);
        f32x2 S = (f32x2){0.f, 0.f};
        for (int sub = 0; sub < 4; ++sub) {
            const int T = t0 + 16 * sub;
            DF_STORE(T);
            __syncthreads();
            if (sub < 3) DF_LOAD(T + 16);
            if (sub == 0) { for (int j = 1; j < w; ++j) S += *(const LAS f32x2*)(U + ((T - j) & 31) * 1024 + c); }
            for (int tt = 0; tt < 16; ++tt) { const int t = T + tt; const int cnt = (t + 1 < w) ? (t + 1) : w;
                const f32x2 cur = *(const LAS f32x2*)(U + (t & 31) * 1024 + c);
                S += cur; const float inv = 1.0f / (float)cnt;
                *(unsigned*)(DIFF + ((size_t)b * SEQ + t) * D + c) = pk2(S[0] * inv - cur[0], S[1] * inv - cur[1]);
                S -= *(const LAS f32x2*)(U + ((t - w + 1) & 31) * 1024 + c); }
            __syncthreads();
        }
#undef DF_LOAD
#undef DF_STORE1
#undef DF_STORE
    }
}

constexpr int KSTR = 144;
constexpr int SC_ACT = 0, SC_W = 128 * KSTR, SC_BUF = SC_W + 256 * KSTR, SC_UNIT = 2 * SC_BUF, CW_QUEUE = 8192;
static_assert(SC_UNIT + 64 <= RING_BYTES, "sample compress LDS");
__device__ __forceinline__ void p5_sample_compress(Frame& F, unsigned* qctr, int quota) {
    LAS int* UNIT = (LAS int*)(F.lds + SC_UNIT);
    const int tid = F.tid, lane = F.lane, w = F.wave, r = lane & 31, h = lane >> 5, rb = w & 3, nh = w >> 2;
    float* P = WSP(float, WS_CMPP); const bf16* W1 = WSP(bf16, WS_W1CAT);
    for (int nu = 0; nu < quota; ++nu) {
        __syncthreads();
        if (tid == 0) UNIT[0] = (int)atomicAdd(qctr, 1u);
        __syncthreads();
        const int u = UNIT[0]; if (u >= DB * 8) break;
        const int b = u >> 3, jb = (u >> 1) & 3, kv = u & 1;
        size_t aoff[4]; const bf16* wsrc = W1 + ((size_t)kv * 256 + (tid >> 3)) * D + 8 * (tid & 7);
#pragma unroll
        for (int e = 0; e < 4; ++e) { const int j = 32 * jb + (tid >> 6) + 8 * e; const int page = F.page_table[b * 16 + (j >> 3)]; aoff[e] = ((size_t)page * 128 + (j & 7) * 16) * 1024 + kv * 256 + 4 * (tid & 63); }
        f32x4 av0[4], av1[4]; v4u wv0[4], wv1[4];
#define SC_LOAD(av, wv, tt) do { _Pragma("unroll") for (int e = 0; e < 4; ++e) { av[e] = *(const f32x4*)(F.cache + aoff[e] + (size_t)(tt) * 1024); wv[e] = *(const v4u*)(wsrc + (size_t)e * 64 * D + 64 * (tt)); } } while (0)
#define SC_STORE(av, wv, bf) do { _Pragma("unroll") for (int e = 0; e < 4; ++e) { v2u o; o.x = cvtpk(av[e][0], av[e][1]); o.y = cvtpk(av[e][2], av[e][3]); \
            *(LAS v2u*)(F.lds + (bf) * SC_BUF + SC_ACT + ((((tid >> 6) + 8 * e) << 2) + ((tid & 63) >> 4)) * KSTR + 8 * (tid & 15)) = o; *(LAS v4u*)(F.lds + (bf) * SC_BUF + SC_W + ((tid >> 3) + 64 * e) * KSTR + 16 * (tid & 7)) = wv[e]; } } while (0)
#define SC_COMPUTE(bf) do { const LAS unsigned char* At = F.lds + (bf) * SC_BUF + SC_ACT + (32 * rb + r) * KSTR + h * 16; const LAS unsigned char* Wt = F.lds + (bf) * SC_BUF + SC_W + (128 * nh + r) * KSTR + h * 16; \
            _Pragma("unroll") for (int ks = 0; ks < 4; ++ks) { const bf16x8 bfr = *(const LAS bf16x8*)(At + ks * 32); \
                _Pragma("unroll") for (int nt = 0; nt < 4; ++nt) { const bf16x8 afr = *(const LAS bf16x8*)(Wt + 32 * nt * KSTR + ks * 32); acc[nt] = __builtin_amdgcn_mfma_f32_32x32x16_bf16(afr, bfr, acc[nt], 0, 0, 0); } } } while (0)
        f32x16 acc[4];
#pragma unroll
        for (int nt = 0; nt < 4; ++nt)
#pragma unroll
            for (int i = 0; i < 16; ++i) acc[nt][i] = 0.f;
        SC_LOAD(av0, wv0, 0); SC_LOAD(av1, wv1, 1); SC_STORE(av0, wv0, 0); __syncthreads();
        for (int tt = 0; tt < 16; tt += 2) {
            if (tt + 2 < 16) SC_LOAD(av0, wv0, tt + 2);
            SC_COMPUTE(0);
            SC_STORE(av1, wv1, 1); __syncthreads();
            if (tt + 3 < 16) SC_LOAD(av1, wv1, tt + 3);
            SC_COMPUTE(1);
            if (tt + 2 < 16) SC_STORE(av0, wv0, 0);
            __syncthreads();
        }
#undef SC_COMPUTE
#undef SC_LOAD
#undef SC_STORE
        float* prow = P + (size_t)kv * CMP_ROWS * 256 + (size_t)(CMP_ROWS_P + (b * 128 + 32 * jb) * 4 + 32 * rb + r) * 256 + 128 * nh + 4 * h;
#pragma unroll
        for (int nt = 0; nt < 4; ++nt)
#pragma unroll
            for (int g4 = 0; g4 < 4; ++g4) *(f32x4*)(prow + 32 * nt + 8 * g4) = (f32x4){acc[nt][4 * g4], acc[nt][4 * g4 + 1], acc[nt][4 * g4 + 2], acc[nt][4 * g4 + 3]};
    }
}

constexpr int W2T_STR = 136;
__device__ __forceinline__ void p6_combine(Frame& F, int part, int cu, int ncu) {
    LAS bf16* W2T = (LAS bf16*)F.lds;
    LAS float* CBL = (LAS float*)(F.lds + 2 * 64 * W2T_STR * 2);
    const float* P = WSP(float, WS_CMPP); bf16* KC = WSP(bf16, WS_KC); float* KCS = WSP(float, WS_KCS);
    for (int i = F.tid; i < 2 * 128 * 64; i += 512) { const int kv = i >> 13, k = (i >> 6) & 127, d = i & 63; W2T[(kv * 64 + d) * W2T_STR + k] = (bf16)f2bf(F.cmp_w2[i]); }
    if (F.tid < 256) CBL[F.tid] = WSP(float, WS_CBIAS)[F.tid];
    __syncthreads();
    const int lane = F.lane, ml = lane & 15, fq = lane >> 4;
    const int gw = cu * NWAVES + F.wave, NGW = ncu * NWAVES;
    constexpr int NT_P = CMP_ROWS_P / 16, NT_S = CMP_ROWS_S / 16;
    const bool prompt = part == 1; const int ntp = prompt ? NT_P : NT_S;
    for (int task = gw; task < 2 * ntp; task += NGW) {
        const int kv = task / ntp, r0 = (task % ntp) * 16;
        const int prow = (prompt ? r0 : CMP_ROWS_P + r0) + ml; const int nimask = prompt ? 255 : 127;
        const int ro = r0 + ml, i_blk = (ro >> 2) & nimask; const bool valid = i_blk < nimask;
        const float* plo = P + (size_t)kv * CMP_ROWS * 256 + (size_t)prow * 256 + 8 * fq; const float* phi = plo + 4 * 256 + 128;
        f32x4 lo[4][2], hi[4][2];
#pragma unroll
        for (int ks = 0; ks < 4; ++ks) { lo[ks][0] = *(const f32x4*)(plo + 32 * ks); lo[ks][1] = *(const f32x4*)(plo + 32 * ks + 4); hi[ks][0] = *(const f32x4*)(phi + 32 * ks); hi[ks][1] = *(const f32x4*)(phi + 32 * ks + 4); }
        bf16x8 hb[4];
#pragma unroll
        for (int ks = 0; ks < 4; ++ks) { f32x4 z[2];
#pragma unroll
            for (int e = 0; e < 2; ++e) { z[e] = lo[ks][e] + hi[ks][e] + *(const LAS f32x4*)(CBL + kv * 128 + 32 * ks + 8 * fq + 4 * e);
#pragma unroll
                for (int q = 0; q < 4; ++q) { const float zz = z[e][q]; z[e][q] = valid ? zz / (1.0f + __expf(-zz)) : 0.f; } }
            hb[ks] = cvt8(z[0], z[1]); }
#pragma unroll
        for (int db = 0; db < 4; ++db) { f32x4 acc = (f32x4){0.f, 0.f, 0.f, 0.f};
#pragma unroll
            for (int ks = 0; ks < 4; ++ks) { const bf16x8 a = *(const LAS bf16x8*)(W2T + (kv * 64 + 16 * db + ml) * W2T_STR + 32 * ks + 8 * fq); acc = __builtin_amdgcn_mfma_f32_16x16x32_bf16(a, hb[ks], acc, 0, 0, 0); }
            const int g = ro & 3, d0 = 16 * db + 4 * fq;
            if (prompt) { const int b = ro >> 10; v2u o; o.x = cvtpk(acc[0], acc[1]); o.y = cvtpk(acc[2], acc[3]); *(v2u*)(KC + ((size_t)((kv * 4 + b) * 4 + g) * 256 + i_blk) * 64 + d0) = o; }
            else { const int b = ro >> 9; *(f32x4*)(KCS + ((size_t)((kv * 128 + b) * 4 + g) * 128 + i_blk) * 64 + d0) = acc; } }
    }
}

constexpr int AT_K = 0, AT_V = 64 * KSTR, AT_BUF = 2 * 64 * KSTR  , AT_T = 2 * AT_BUF, AT_TS = 66, AT_U = AT_T + 64 * AT_TS * 4, AT_SEL = AT_U + 64 * AT_TS * 4, AT_WUNI = AT_SEL + 512, AT_END = AT_WUNI + 64;
static_assert(AT_END <= RING_BYTES, "attention LDS");

__device__ __forceinline__ v4i16_t vtr(const LAS unsigned char* p) { return __builtin_amdgcn_ds_read_tr16_b64_v4i16((LAS v4i16_t*)p); }

struct KvRegs { v4u k, v; };
__device__ __forceinline__ void load_kv(Frame& F, KvRegs& R, const bf16* ksrc, const bf16* vsrc, int pitch) {
    const int key = F.tid >> 3, ch = F.tid & 7;
    R.k = *(const v4u*)(ksrc + (size_t)key * pitch + ch * 8);
    R.v = *(const v4u*)(vsrc + (size_t)key * pitch + ch * 8);
}
__device__ __forceinline__ void store_kv(Frame& F, const KvRegs& R, int buf) {
    const int key = F.tid >> 3, ch = F.tid & 7;
    *(LAS v4u*)(F.lds + buf * AT_BUF + AT_K + key * KSTR + ch * 16) = R.k;
    *(LAS v4u*)(F.lds + buf * AT_BUF + AT_V + key * KSTR + ch * 16) = R.v;
}

constexpr float ATT_THR = 8.0f;
template <int MODE>
__device__ __forceinline__ void attn_tile(Frame& F, bool MASKED, int buf, const bf16x8 (&qf)[4], int relb, float slope2, bool rowok, float& m, float& l, bool& any, f32x16& o0, f32x16& o1,
                                          float mfin, float invl, LAS float* Tq, LAS float* Uq, int sig0) {
    const int lane = F.lane, r = lane & 31, h = lane >> 5;
    const LAS unsigned char* Kt = F.lds + buf * AT_BUF + AT_K; const LAS unsigned char* Vt = F.lds + buf * AT_BUF + AT_V;
    constexpr int PM = (MODE <= 1) ? 16 : 1;
    const float NEG = -INFINITY;
    float c0 = slope2 * (float)relb - ((MODE == 1) ? mfin : m);
    if (!rowok) c0 = NEG;
    const float k32 = slope2 * (float)(32 * PM);
    f32x16 p0, p1;
#pragma unroll
    for (int i = 0; i < 16; ++i) { p0[i] = fmaf(slope2, (float)(PM * ((i & 3) + 8 * (i >> 2))), c0); p1[i] = p0[i] + k32; }
#pragma unroll
    for (int ks = 0; ks < 4; ++ks) {
        const bf16x8 a0 = *(const LAS bf16x8*)(Kt + r * KSTR + ks * 32 + h * 16);
        const bf16x8 a1 = *(const LAS bf16x8*)(Kt + (32 + r) * KSTR + ks * 32 + h * 16);
        p0 = __builtin_amdgcn_mfma_f32_32x32x16_bf16(a0, qf[ks], p0, 0, 0, 0);
        p1 = __builtin_amdgcn_mfma_f32_32x32x16_bf16(a1, qf[ks], p1, 0, 0, 0);
    }
    if (MASKED) {
#pragma unroll
        for (int i = 0; i < 16; ++i) {
            const int kofs = PM * ((i & 3) + 8 * (i >> 2));
            const int rel0 = relb + kofs, rel1 = rel0 + PM * 32;
            bool ok0 = rel0 <= 0, ok1 = rel1 <= 0;
            if (MODE == 3) { ok0 = ok0 && rel0 > -512; ok1 = ok1 && rel1 > -512; }
            p0[i] = ok0 ? p0[i] : NEG; p1[i] = ok1 ? p1[i] : NEG;
        }
    }
    if (MODE == 1) {
#pragma unroll
        for (int i = 0; i < 16; ++i) { p0[i] = __builtin_amdgcn_exp2f(p0[i]) * invl; p1[i] = __builtin_amdgcn_exp2f(p1[i]) * invl; }
#pragma unroll
        for (int hf = 0; hf < 2; ++hf)
#pragma unroll
            for (int g4 = 0; g4 < 4; ++g4) {
                const float pa = hf ? p1[4 * g4] : p0[4 * g4], pb = hf ? p1[4 * g4 + 1] : p0[4 * g4 + 1], pc = hf ? p1[4 * g4 + 2] : p0[4 * g4 + 2], pd = hf ? p1[4 * g4 + 3] : p0[4 * g4 + 3];
                float tv = 2.f * ((pa + pb) + pc) + pd, uv = pd;
                tv += __shfl_xor(tv, 1); uv += __shfl_xor(uv, 1); tv += __shfl_xor(tv, 2); uv += __shfl_xor(uv, 2);
                const int sg = sig0 + 8 * hf + 2 * g4 + h;
                if ((lane & 3) == 0) { Tq[sg] = tv; Uq[sg + 1] = uv; }
            }
    } else {
        float mxa = fmaxf(fmaxf(p0[0], p0[1]), p1[0]), mxb = fmaxf(fmaxf(p0[2], p0[3]), p1[1]); mxa = fmaxf(fmaxf(mxa, p1[2]), p1[3]);
#pragma unroll
        for (int i = 4; i < 16; i += 4) { mxa = fmaxf(fmaxf(mxa, p0[i]), p0[i + 1]); mxb = fmaxf(fmaxf(mxb, p0[i + 2]), p0[i + 3]); mxa = fmaxf(fmaxf(mxa, p1[i]), p1[i + 1]); mxb = fmaxf(fmaxf(mxb, p1[i + 2]), p1[i + 3]); }
        float mx = fmaxf(mxa, mxb); mx = fmaxf(mx, __shfl_xor(mx, 32));
        const bool need = (mx > ATT_THR) || (!any && mx > NEG);
        if (__any(need)) {
            const float dl = need ? mx : 0.f; const float f = any ? __builtin_amdgcn_exp2f(-dl) : 1.f;
            m += dl; l *= f;
#pragma unroll
            for (int i = 0; i < 16; ++i) { p0[i] -= dl; p1[i] -= dl; }
            if (MODE >= 2) {
#pragma unroll
                for (int i = 0; i < 16; ++i) { o0[i] *= f; o1[i] *= f; } }
        }
        any = any || (mx > NEG);
        float rs0 = 0.f, rs1 = 0.f;
#pragma unroll
        for (int i = 0; i < 16; ++i) { p0[i] = __builtin_amdgcn_exp2f(p0[i]); p1[i] = __builtin_amdgcn_exp2f(p1[i]); rs0 += p0[i]; rs1 += p1[i]; }
        l += rs0 + rs1;
        if (MODE == 0) return;
    }
    const LAS unsigned char* vb = Vt + (((lane & 15) >> 2) + 4 * h) * KSTR + (16 * ((lane >> 4) & 1) + 4 * (lane & 3)) * 2;
#pragma unroll
    for (int sp = 0; sp < 4; ++sp) {
        v4u pw;
        if (sp < 2) { const int b8 = 8 * sp; pw.x = cvtpk(p0[b8], p0[b8 + 1]); pw.y = cvtpk(p0[b8 + 2], p0[b8 + 3]); pw.z = cvtpk(p0[b8 + 4], p0[b8 + 5]); pw.w = cvtpk(p0[b8 + 6], p0[b8 + 7]); }
        else { const int b8 = 8 * (sp - 2); pw.x = cvtpk(p1[b8], p1[b8 + 1]); pw.y = cvtpk(p1[b8 + 2], p1[b8 + 3]); pw.z = cvtpk(p1[b8 + 4], p1[b8 + 5]); pw.w = cvtpk(p1[b8 + 6], p1[b8 + 7]); }
        const bf16x8 pbf = __builtin_bit_cast(bf16x8, pw);
#pragma unroll
        for (int db = 0; db < 2; ++db) {
            const v4i16_t lo = vtr(vb + (16 * sp) * KSTR + 64 * db), hi = vtr(vb + (16 * sp + 8) * KSTR + 64 * db);
            const bf16x8 vf = (bf16x8){lo[0], lo[1], lo[2], lo[3], hi[0], hi[1], hi[2], hi[3]};
            if (db == 0) o0 = __builtin_amdgcn_mfma_f32_32x32x16_bf16(vf, pbf, o0, 0, 0, 0);
            else o1 = __builtin_amdgcn_mfma_f32_32x32x16_bf16(vf, pbf, o1, 0, 0, 0);
        }
    }
}

struct BgCopy {
    size_t base; int k, pend; f32x4 v0;
    __device__ __forceinline__ void init(Frame& F) { const int b = F.vcu >> 1, hb = F.vcu & 1; k = (F.G == 256) ? 0 : 64; pend = 0; base = (size_t)b * 65536 + hb * 32704; }
    __device__ __forceinline__ void step(Frame& F) {
        const f32x4* src = (const f32x4*)F.state_win + base + 128 + F.tid; f32x4* dst = (f32x4*)(F.out + OUT_WIN_S) + base + F.tid;
        if (pend) { if (k - 1 < 63 || F.tid < 448) dst[512 * (k - 1)] = v0; pend = 0; }
        if (k < 64) { if (k < 63 || F.tid < 448) v0 = src[512 * k]; k += 1; pend = 1; }
    }
    __device__ __forceinline__ void finish(Frame& F) { while (k < 64 || pend) step(F); }
};

__device__ __forceinline__ void attn_prompt_unit(Frame& F, BgCopy& BG, int b, int g, int qb) {
    const int lane = F.lane, r = lane & 31, h = lane >> 5, w = F.wave;
    const int c0 = qb * 64, cur = qb, ql = 8 * w + (r >> 2), tq = c0 + ql, hd = g * 4 + (r & 3);
    const bf16* Q = WSP(bf16, WS_Q); const bf16* KVS = WSP(bf16, WS_KVS); const bf16* KVW = WSP(bf16, WS_KVW); const bf16* KC = WSP(bf16, WS_KC); const float* GATE = WSP(float, WS_GATE);
    bf16* O = WSP(bf16, WS_DIFF);
    const size_t row = (size_t)b * SEQ + tq;
    bf16x8 qf[4];
#pragma unroll
    for (int ks = 0; ks < 4; ++ks) qf[ks] = *(const bf16x8*)(Q + row * D + hd * 64 + ks * 16 + h * 8);
    const float slope2 = exp2f(-0.5f * (float)(hd + 1)) * LOG2E;
    const float g0 = GATE[row * 48 + hd * 3 + 0], g1 = GATE[row * 48 + hd * 3 + 1], g2 = GATE[row * 48 + hd * 3 + 2];
    LAS float* T = (LAS float*)(F.lds + AT_T); LAS float* U = (LAS float*)(F.lds + AT_U);
    LAS unsigned* SELM = (LAS unsigned*)(F.lds + AT_SEL); LAS unsigned* WUNI = (LAS unsigned*)(F.lds + AT_WUNI);
    for (int i = F.tid; i < 2 * 64 * AT_TS; i += 512) T[i] = 0.f;
    f32x16 of0, of1, o0, o1;
#pragma unroll
    for (int i = 0; i < 16; ++i) { of0[i] = 0.f; of1[i] = 0.f; o0[i] = 0.f; o1[i] = 0.f; }
    const float NEG = -INFINITY;
    const int nmax = c0 / 16 + 2;
    const int ntile = (nmax >= 255 ? 254 : nmax) / 64 + 1;
    const bf16* kc = KC + (size_t)((0 * 4 + b) * 4 + g) * 256 * 64; const bf16* vc = KC + (size_t)((1 * 4 + b) * 4 + g) * 256 * 64;
    float m = 0.f, l = 0.f; bool any = false;
    KvRegs R; int cb = 0;
    load_kv(F, R, kc, vc, 64); __syncthreads(); store_kv(F, R, 0); __syncthreads();
    for (int tl = 0; tl < ntile; ++tl) {
        const bool more = tl + 1 < ntile; BG.step(F);
        if (more) load_kv(F, R, kc + (size_t)(tl + 1) * 64 * 64, vc + (size_t)(tl + 1) * 64 * 64, 64); else load_kv(F, R, kc, vc, 64);
        attn_tile<0>(F, !(1024 * tl + 1039 <= c0 + 8 * w), cb, qf, 16 * 64 * tl + 31 + 16 * 4 * h - tq, slope2, true, m, l, any, o0, o1, 0.f, 0.f, nullptr, nullptr, 0);
        store_kv(F, R, cb ^ 1); __syncthreads(); cb ^= 1;
    }
    { const float lt = l + __shfl_xor(l, 32); const float invl = lt > 0.f ? 1.0f / lt : 0.f;
      LAS float* Tq = T + ql * AT_TS; LAS float* Uq = U + ql * AT_TS;
      for (int tl = 0; tl < ntile; ++tl) {
          const bool more = tl + 1 < ntile;
          if (more) load_kv(F, R, kc + (size_t)(tl + 1) * 64 * 64, vc + (size_t)(tl + 1) * 64 * 64, 64);
          attn_tile<1>(F, !(1024 * tl + 1039 <= c0 + 8 * w), cb, qf, 16 * 64 * tl + 31 + 16 * 4 * h - tq, slope2, true, m, l, any, o0, o1, m, invl, Tq, Uq, 16 * tl);
          if (more) { store_kv(F, R, cb ^ 1); __syncthreads(); cb ^= 1; }
      }
#pragma unroll
      for (int i = 0; i < 16; ++i) { of0[i] = g0 * o0[i]; of1[i] = g0 * o1[i]; o0[i] = 0.f; o1[i] = 0.f; } }
    __syncthreads();
    unsigned long long wuni = 0ull;
    for (int qq = 8 * w; qq < 8 * w + 8; ++qq) {
        unsigned long long msk;
        if (cur <= 15) msk = (cur == 63) ? ~0ull : ((1ull << (cur + 1)) - 1ull);
        else {
            const float v = T[qq * AT_TS + lane] + U[qq * AT_TS + lane];
            T[qq * AT_TS + lane] = v;
            LDS_WAIT(); asm volatile("" ::: "memory");
            int rank = 0;
            for (int s2 = 1; s2 <= cur - 2; ++s2) { const float o = T[qq * AT_TS + s2]; rank += (o > v || (o == v && s2 < lane)) ? 1 : 0; }
            const bool sel = (lane <= cur) && (lane == 0 || lane >= cur - 1 || rank < 13);
            msk = __ballot(sel);
        }
        if (lane == 0) { SELM[2 * qq] = (unsigned)msk; SELM[2 * qq + 1] = (unsigned)(msk >> 32); }
        wuni |= msk;
    }
    wuni = ((unsigned long long)(unsigned)__builtin_amdgcn_readfirstlane((int)(unsigned)(wuni >> 32)) << 32) | (unsigned long long)(unsigned)__builtin_amdgcn_readfirstlane((int)(unsigned)wuni);
    if (lane == 0) { WUNI[2 * w] = (unsigned)wuni; WUNI[2 * w + 1] = (unsigned)(wuni >> 32); }
    __syncthreads();
    unsigned long long guni = 0ull;
#pragma unroll
    for (int i = 0; i < 8; ++i) guni |= (unsigned long long)WUNI[2 * i] | ((unsigned long long)WUNI[2 * i + 1] << 32);
    const unsigned long long mym = (unsigned long long)SELM[2 * ql] | ((unsigned long long)SELM[2 * ql + 1] << 32);
    m = 0.f; l = 0.f; any = false;
    { const bf16* ks = KVS + (size_t)b * SEQ * 512 + g * 64; const bf16* vs = ks + 256;
      unsigned long long rem = guni;
      int s = __builtin_ctzll(rem); rem &= rem - 1ull;
      load_kv(F, R, ks + (size_t)s * 64 * 512, vs + (size_t)s * 64 * 512, 512); __syncthreads(); store_kv(F, R, 0); __syncthreads(); cb = 0;
      for (;;) {
          const bool more = rem != 0ull; const int sn = more ? __builtin_ctzll(rem) : 0; rem &= rem - 1ull; BG.step(F);
          if (more) load_kv(F, R, ks + (size_t)sn * 64 * 512, vs + (size_t)sn * 64 * 512, 512);
          if ((wuni >> s) & 1ull) attn_tile<2>(F, s == cur, cb, qf, 64 * s + 4 * h - tq, slope2, ((mym >> s) & 1ull) != 0ull, m, l, any, o0, o1, 0.f, 0.f, nullptr, nullptr, 0);
          if (!more) break;
          store_kv(F, R, cb ^ 1); __syncthreads(); cb ^= 1; s = sn;
      }
      const float lt = l + __shfl_xor(l, 32); const float sc = lt > 0.f ? g1 / lt : 0.f;
#pragma unroll
      for (int i = 0; i < 16; ++i) { of0[i] += sc * o0[i]; of1[i] += sc * o1[i]; o0[i] = 0.f; o1[i] = 0.f; } }
    m = 0.f; l = 0.f; any = false;
    { const bf16* kw = KVW + (size_t)b * SEQ * 512 + g * 64; const bf16* vw = kw + 256;
      const int j0 = (c0 >= 512) ? 0 : (512 - c0) / 64;
      { const int pos0 = c0 - 512 + 64 * j0; load_kv(F, R, kw + (size_t)pos0 * 512, vw + (size_t)pos0 * 512, 512); __syncthreads(); store_kv(F, R, 0); __syncthreads(); cb = 0; }
      for (int j = j0; j < 9; ++j) {
          const int pos0 = c0 - 512 + 64 * j; const bool more = j + 1 < 9; BG.step(F);
          if (more) load_kv(F, R, kw + (size_t)(pos0 + 64) * 512, vw + (size_t)(pos0 + 64) * 512, 512);
          attn_tile<3>(F, j == 0 || j == 8, cb, qf, pos0 + 4 * h - tq, slope2, true, m, l, any, o0, o1, 0.f, 0.f, nullptr, nullptr, 0);
          if (more) { store_kv(F, R, cb ^ 1); __syncthreads(); cb ^= 1; }
      }
      const float lt = l + __shfl_xor(l, 32); const float sc = lt > 0.f ? g2 / lt : 0.f;
#pragma unroll
      for (int i = 0; i < 16; ++i) { of0[i] += sc * o0[i]; of1[i] += sc * o1[i]; } }
    bf16* orow = O + row * D + hd * 64;
#pragma unroll
    for (int g4 = 0; g4 < 4; ++g4) {
        v2u a; a.x = cvtpk(of0[4 * g4], of0[4 * g4 + 1]); a.y = cvtpk(of0[4 * g4 + 2], of0[4 * g4 + 3]);
        v2u c; c.x = cvtpk(of1[4 * g4], of1[4 * g4 + 1]); c.y = cvtpk(of1[4 * g4 + 2], of1[4 * g4 + 3]);
        *(v2u*)(orow + 8 * g4 + 4 * h) = a; *(v2u*)(orow + 32 + 8 * g4 + 4 * h) = c;
    }
    __syncthreads();
}

constexpr int SA_QS = 0, SA_SC = 1024, SA_NK = 1664, SA_IMP = SA_SC + SA_NK * 16, SA_LIST = SA_IMP + 256, SA_BLK = SA_LIST + 64, SA_RED = SA_BLK + 128, SA_END = SA_RED + 512 * 64;
constexpr int SK_CMP = 0, SK_SEL = 128, SK_WIN = 1088, SK_NSEL = 1600, SK_NWIN = 1601;
static_assert(SA_END <= RING_BYTES, "sample attention LDS");

__device__ __forceinline__ f32x4 wave_max4(f32x4 v) {
#pragma unroll
    for (int o = 1; o < 64; o <<= 1) { v[0] = fmaxf(v[0], __shfl_xor(v[0], o)); v[1] = fmaxf(v[1], __shfl_xor(v[1], o)); v[2] = fmaxf(v[2], __shfl_xor(v[2], o)); v[3] = fmaxf(v[3], __shfl_xor(v[3], o)); }
    return v;
}
__device__ __forceinline__ f32x4 wave_sum4(f32x4 v) {
#pragma unroll
    for (int o = 1; o < 64; o <<= 1) { v[0] += __shfl_xor(v[0], o); v[1] += __shfl_xor(v[1], o); v[2] += __shfl_xor(v[2], o); v[3] += __shfl_xor(v[3], o); }
    return v;
}
__device__ __forceinline__ void sa_softmax4(LAS f32x4* SC, int k0, int nk, int kx, f32x4 post, int lane) {
    f32x4 mx = (f32x4){-INFINITY, -INFINITY, -INFINITY, -INFINITY};
    for (int i = lane; i < nk; i += 64) { const f32x4 s = SC[k0 + i]; mx[0] = fmaxf(mx[0], s[0]); mx[1] = fmaxf(mx[1], s[1]); mx[2] = fmaxf(mx[2], s[2]); mx[3] = fmaxf(mx[3], s[3]); }
    if (kx >= 0) { const f32x4 s = SC[kx]; mx[0] = fmaxf(mx[0], s[0]); mx[1] = fmaxf(mx[1], s[1]); mx[2] = fmaxf(mx[2], s[2]); mx[3] = fmaxf(mx[3], s[3]); }
    mx = wave_max4(mx);
#pragma unroll
    for (int q = 0; q < 4; ++q) if (mx[q] == -INFINITY) mx[q] = 0.f;
    f32x4 sum = (f32x4){0.f, 0.f, 0.f, 0.f};
    for (int i = lane; i < nk; i += 64) { f32x4 s = SC[k0 + i];
#pragma unroll
        for (int q = 0; q < 4; ++q) s[q] = __builtin_amdgcn_exp2f(s[q] - mx[q]);
        SC[k0 + i] = s; sum += s; }
    sum = wave_sum4(sum);
    f32x4 ex = (f32x4){0.f, 0.f, 0.f, 0.f};
    if (kx >= 0) { const f32x4 s = SC[kx];
#pragma unroll
        for (int q = 0; q < 4; ++q) ex[q] = __builtin_amdgcn_exp2f(s[q] - mx[q]);
        sum += ex; }
    f32x4 sc;
#pragma unroll
    for (int q = 0; q < 4; ++q) sc[q] = sum[q] > 0.f ? post[q] / sum[q] : 0.f;
    LDS_WAIT(); asm volatile("" ::: "memory");
    for (int i = lane; i < nk; i += 64) SC[k0 + i] = SC[k0 + i] * sc;
    if (kx >= 0 && lane == 0) SC[kx] = ex * sc;
}

#define SA_LOADK(dst, kr) do { dst[0] = *(const f32x4*)(kr); dst[1] = *(const f32x4*)((kr) + 4); dst[2] = *(const f32x4*)((kr) + 32); dst[3] = *(const f32x4*)((kr) + 36); } while (0)
#define SA_SCORE(acc, kf) do { acc = __builtin_amdgcn_mfma_f32_16x16x32_bf16(af[0], cvt8(kf[0], kf[1]), (f32x4){0.f, 0.f, 0.f, 0.f}, 0, 0, 0); acc = __builtin_amdgcn_mfma_f32_16x16x32_bf16(af[1], cvt8(kf[2], kf[3]), acc, 0, 0, 0); } while (0)

__device__ __forceinline__ void attn_sample_unit(Frame& F, int b, int g) {
    const int tid = F.tid, lane = F.lane, w = F.wave; const int row = MP + b;
    const bf16* Q = WSP(bf16, WS_Q); const bf16* KVS = WSP(bf16, WS_KVS); const bf16* KVW = WSP(bf16, WS_KVW); const float* KCS = WSP(float, WS_KCS); const float* GATE = WSP(float, WS_GATE);
    bf16* O = WSP(bf16, WS_DIFF);
    LAS f32x4* SC = (LAS f32x4*)(F.lds + SA_SC); LAS float* IMP = (LAS float*)(F.lds + SA_IMP);
    LAS int* LIST = (LAS int*)(F.lds + SA_LIST); LAS int* BLK = (LAS int*)(F.lds + SA_BLK); LAS float* RED = (LAS float*)(F.lds + SA_RED);
    const float* kc = KCS + (size_t)((0 * 128 + b) * 4 + g) * 128 * 64; const float* vc = KCS + (size_t)((1 * 128 + b) * 4 + g) * 128 * 64;
    const float* sw = F.state_win + (size_t)b * 512 * 512;
    __syncthreads();
    bf16x8 af[2];
#pragma unroll
    for (int ks = 0; ks < 2; ++ks) { af[ks] = (bf16x8){0, 0, 0, 0, 0, 0, 0, 0}; if ((lane & 15) < 4) af[ks] = *(const bf16x8*)(Q + (size_t)row * D + (g * 4 + (lane & 15)) * 64 + 32 * ks + 8 * (lane >> 4)); }
    f32x4 sl2;
#pragma unroll
    for (int i = 0; i < 4; ++i) sl2[i] = exp2f(-0.5f * (float)(g * 4 + i + 1)) * LOG2E;
    f32x4 gt0, gt1, gt2;
    { const float* gp = GATE + (size_t)row * 48 + g * 12;
#pragma unroll
      for (int i = 0; i < 4; ++i) { gt0[i] = gp[i * 3 + 0]; gt1[i] = gp[i * 3 + 1]; gt2[i] = gp[i * 3 + 2]; } }
    const int kl = lane & 15, kc8 = 8 * (lane >> 4);
    { f32x4 kf[5][4];
      { const float* kr = kc + (size_t)(16 * w + kl) * 64 + kc8; SA_LOADK(kf[0], kr); }
#pragma unroll
      for (int j = 1; j < 5; ++j) { const float* kr = sw + (size_t)(16 * (w + 8 * (j - 1)) + kl) * 512 + g * 64 + kc8; SA_LOADK(kf[j], kr); }
      f32x4 acc;
      SA_SCORE(acc, kf[0]);
      if (lane < 16) { const int n = 16 * w + kl; const float rel = (float)(16 * n + 31 - PAST); f32x4 s;
#pragma unroll
          for (int i = 0; i < 4; ++i) s[i] = (n < 127) ? acc[i] + sl2[i] * rel : -INFINITY;
          SC[SK_CMP + n] = s; }
#pragma unroll
      for (int j = 1; j < 5; ++j) { SA_SCORE(acc, kf[j]);
          if (lane < 16) { const int i2 = 16 * (w + 8 * (j - 1)) + kl; const float rel = (float)(i2 - 512); f32x4 s;
#pragma unroll
              for (int i = 0; i < 4; ++i) s[i] = (i2 >= 1) ? acc[i] + sl2[i] * rel : -INFINITY;
              SC[SK_WIN + i2] = s; } }
      if (w == 7) {
          f32x4 a, c2; const float kwn = bf2f(KVW[(size_t)row * 512 + g * 64 + lane]), ksn = bf2f(KVS[(size_t)row * 512 + g * 64 + lane]);
#pragma unroll
          for (int i = 0; i < 4; ++i) { const float qv = bf2f(Q[(size_t)row * D + (g * 4 + i) * 64 + lane]); a[i] = qv * kwn; c2[i] = qv * ksn; }
          a = wave_sum4(a); c2 = wave_sum4(c2);
          if (lane == 0) { SC[SK_NWIN] = a; SC[SK_NSEL] = c2; }
      }
    }
    __syncthreads();
    if (w == 0) {
        sa_softmax4(SC, SK_CMP, 128, -1, (f32x4){1.f, 1.f, 1.f, 1.f}, lane);
        LDS_WAIT(); asm volatile("" ::: "memory");
        if (lane < 33) { float a = 0.f;
#pragma unroll
            for (int dn = -1; dn <= 3; ++dn) { const int n = 4 * lane + dn; if (n >= 0 && n < 127) { const f32x4 p = SC[SK_CMP + n]; a += ((dn == -1 || dn == 3) ? 1.f : 2.f) * ((p[0] + p[1]) + (p[2] + p[3])); } }
            IMP[lane] = a; }
        LDS_WAIT(); asm volatile("" ::: "memory");
        const float v = (lane <= 32) ? IMP[lane] : 0.f; int rank = 0;
        for (int s2 = 1; s2 <= 30; ++s2) { const float o = IMP[s2]; rank += (o > v || (o == v && s2 < lane)) ? 1 : 0; }
        const bool sel = (lane == 0) || (lane == 31) || (lane >= 1 && lane <= 30 && rank < 13);
        const unsigned long long msk = __ballot(sel);
        if (sel) { const int pos = __builtin_popcountll(msk & ((1ull << lane) - 1ull)); LIST[pos] = lane;
            const int page = F.page_table[b * 16 + (lane >> 1)]; BLK[pos] = page * 128 + (lane & 1) * 64; }
        LDS_WAIT(); asm volatile("" ::: "memory");
        for (int i = lane; i < 128; i += 64) SC[SK_CMP + i] = SC[SK_CMP + i] * gt0;
    }
    __syncthreads();
#pragma unroll
    for (int bt = 0; bt < 2; ++bt) {
        f32x4 kf[4][4];
#pragma unroll
        for (int j = 0; j < 4; ++j) { const int st = w + 8 * (4 * bt + j); if (st < 60) { const int bi = st >> 2, kk = 16 * (st & 3) + kl;
            const float* kr = F.cache + ((size_t)(BLK[bi] + kk) * 4 + 2) * 256 + g * 64 + kc8; SA_LOADK(kf[j], kr); } }
#pragma unroll
        for (int j = 0; j < 4; ++j) { const int st = w + 8 * (4 * bt + j); if (st < 60) { const int bi = st >> 2, kk = 16 * (st & 3) + kl; f32x4 acc; SA_SCORE(acc, kf[j]);
            if (lane < 16) { const float rel = (float)(64 * LIST[bi] + kk - PAST); f32x4 s;
#pragma unroll
                for (int i = 0; i < 4; ++i) s[i] = acc[i] + sl2[i] * rel;
                SC[SK_SEL + 64 * bi + kk] = s; } } }
    }
    if (w == 1) sa_softmax4(SC, SK_WIN, 512, SK_NWIN, gt2, lane);
    __syncthreads();
    if (w == 0) sa_softmax4(SC, SK_SEL, 960, SK_NSEL, gt1, lane);
    __syncthreads();
    { const int kq = lane >> 4, c4 = 4 * (lane & 15);
      f32x4 acc[4];
#pragma unroll
      for (int i = 0; i < 4; ++i) acc[i] = (f32x4){0.f, 0.f, 0.f, 0.f};
      { f32x4 vv[4];
#pragma unroll
        for (int it = 0; it < 4; ++it) vv[it] = *(const f32x4*)(vc + (size_t)(32 * it + 4 * w + kq) * 64 + c4);
#pragma unroll
        for (int it = 0; it < 4; ++it) { const f32x4 p = SC[SK_CMP + 32 * it + 4 * w + kq];
#pragma unroll
            for (int i = 0; i < 4; ++i) acc[i] += vv[it] * p[i]; } }
#pragma unroll
      for (int bt = 0; bt < 2; ++bt) { f32x4 vv[8];
#pragma unroll
        for (int j = 0; j < 8; ++j) vv[j] = *(const f32x4*)(sw + (size_t)(32 * (8 * bt + j) + 4 * w + kq) * 512 + 256 + g * 64 + c4);
#pragma unroll
        for (int j = 0; j < 8; ++j) { const f32x4 p = SC[SK_WIN + 32 * (8 * bt + j) + 4 * w + kq];
#pragma unroll
            for (int i = 0; i < 4; ++i) acc[i] += vv[j] * p[i]; } }
#pragma unroll
      for (int bt = 0; bt < 3; ++bt) { f32x4 vv[10];
#pragma unroll
        for (int j = 0; j < 10; ++j) { const int k = 32 * (10 * bt + j) + 4 * w + kq; vv[j] = *(const f32x4*)(F.cache + ((size_t)(BLK[k >> 6] + (k & 63)) * 4 + 3) * 256 + g * 64 + c4); }
#pragma unroll
        for (int j = 0; j < 10; ++j) { const f32x4 p = SC[SK_SEL + 32 * (10 * bt + j) + 4 * w + kq];
#pragma unroll
            for (int i = 0; i < 4; ++i) acc[i] += vv[j] * p[i]; } }
#pragma unroll
      for (int i = 0; i < 4; ++i) *(LAS f32x4*)(RED + tid * 16 + 4 * i) = acc[i];
    }
    __syncthreads();
    if (tid < 256) { const int hd = tid >> 6, d = tid & 63; float a = 0.f;
#pragma unroll 8
        for (int j = 0; j < 32; ++j) a += RED[((j >> 2) * 64 + (j & 3) * 16 + (d >> 2)) * 16 + hd * 4 + (d & 3)];
        { const f32x4 ps = SC[SK_NSEL], pw = SC[SK_NWIN];
          a += ps[hd] * bf2f(KVS[(size_t)row * 512 + 256 + g * 64 + d]) + pw[hd] * bf2f(KVW[(size_t)row * 512 + 256 + g * 64 + d]); }
        O[(size_t)row * D + (g * 4 + hd) * 64 + d] = (bf16)f2bf(a); }
    __syncthreads();
}

__device__ __forceinline__ void p7_attention(Frame& F) {
    BgCopy BG; BG.init(F);
    const bool sfirst = (blockIdx.x & 1) == 0;
    if (sfirst) for (int i = F.vcu; i < DB * 4; i += F.G) attn_sample_unit(F, i >> 2, i & 3);
    for (int i = F.vcu; i < 1024; i += F.G) { const int k = i >> 8, c = i & 255, bg = c >> 4, s = c & 15; const int qb = (k == 0) ? s : (k == 1) ? 31 - s : (k == 2) ? 32 + s : 63 - s;
        attn_prompt_unit(F, BG, bg >> 2, bg & 3, qb); }
    BG.finish(F);
    if (!sfirst) for (int i = F.vcu; i < DB * 4; i += F.G) attn_sample_unit(F, i >> 2, i & 3);
}

enum { SG_POOL = 0, SG_UP = 1, SG_DOWN = 2, SG_KVQG = 3, SG_WO = 4 };
constexpr int SG_RED = 0, SG_SSQ = 8 * 16 * 64 * 4;
template <int KIND>
__device__ __forceinline__ void small_gemm(Frame& F, int layer) {
    constexpr bool F32B = (KIND == SG_UP || KIND == SG_KVQG);
    constexpr int KR = (KIND == SG_POOL) ? 256 : 1024;
    constexpr int KSPLIT = (KIND == SG_DOWN) ? 4 : 1;
    constexpr int NSL = (KIND == SG_POOL) ? 32 : (KIND == SG_UP) ? 128 : (KIND == SG_KVQG) ? 82 : 32;
    constexpr int KW = KR / 8, NKS = KW / 16;
    const int lane = F.lane, w = F.wave, r = lane & 31, h = lane >> 5;
    float* X = WSP(float, WS_X);
    LAS float* RED = (LAS float*)(F.lds + SG_RED); LAS float* SSQ = (LAS float*)(F.lds + SG_SSQ);
    for (int item = F.vcu; item < NSL * 4 * KSPLIT; item += F.G) {
        const int kr = item % KSPLIT, tt = item / KSPLIT, rbk = tt & 3, ns = tt >> 2;
        const int row = MP + 32 * rbk + r, b = 32 * rbk + r;
        int n0 = ns * 32; const int kb = kr * KR + w * KW + 8 * h;
        const bf16* wrow; const bf16* b16 = nullptr; const float* b32 = nullptr;
        if (KIND == SG_POOL) { const int g = ns >> 3; n0 = (ns & 7) * 32; wrow = WSP(bf16, WS_WPOOL) + (size_t)g * 65536 + (size_t)(n0 + r) * 256 + kb; b16 = WSP(bf16, WS_DIFF) + (size_t)row * D + g * 256 + kb; n0 += g * 256; }
        else if (KIND == SG_UP) { wrow = WSP(bf16, WS_WUP) + (size_t)layer * FF * D + (size_t)(n0 + r) * D + kb; b32 = X + (size_t)row * D + kb; }
        else if (KIND == SG_DOWN) { wrow = WSP(bf16, WS_WDN) + (size_t)layer * D * FF + (size_t)(n0 + r) * FF + kb; b16 = WSP(bf16, WS_H) + (size_t)row * FF + kb; }
        else if (KIND == SG_KVQG) { wrow = WSP(bf16, WS_WKVQG) + (size_t)(n0 + r) * D + kb; b32 = X + (size_t)row * D + kb; }
        else { wrow = WSP(bf16, WS_WO) + (size_t)(n0 + r) * D + kb; b16 = WSP(bf16, WS_DIFF) + (size_t)row * D + kb; }
        bf16x8 a[NKS], bb[NKS]; f32x4 x0[NKS], x1[NKS];
#pragma unroll
        for (int j = 0; j < NKS; ++j) { a[j] = *(const bf16x8*)(wrow + 16 * j);
            if (F32B) { x0[j] = *(const f32x4*)(b32 + 16 * j); x1[j] = *(const f32x4*)(b32 + 16 * j + 4); } else bb[j] = *(const bf16x8*)(b16 + 16 * j); }
        f32x16 acc; float ssq = 0.f;
#pragma unroll
        for (int i = 0; i < 16; ++i) acc[i] = 0.f;
#pragma unroll
        for (int j = 0; j < NKS; ++j) {
            if (F32B) { ssq += (x0[j][0] * x0[j][0] + x0[j][1] * x0[j][1]) + (x0[j][2] * x0[j][2] + x0[j][3] * x0[j][3]) + (x1[j][0] * x1[j][0] + x1[j][1] * x1[j][1]) + (x1[j][2] * x1[j][2] + x1[j][3] * x1[j][3]); bb[j] = cvt8(x0[j], x1[j]); }
            acc = __builtin_amdgcn_mfma_f32_32x32x16_bf16(a[j], bb[j], acc, 0, 0, 0);
        }
        __syncthreads();
#pragma unroll
        for (int i = 0; i < 16; ++i) RED[(w * 16 + i) * 64 + lane] = acc[i];
        if (F32B) SSQ[w * 64 + lane] = ssq;
        __syncthreads();
        if (w < 4) {
            f32x4 v = (f32x4){0.f, 0.f, 0.f, 0.f};
#pragma unroll
            for (int ww = 0; ww < 8; ++ww)
#pragma unroll
                for (int e = 0; e < 4; ++e) v[e] += RED[(ww * 16 + 4 * w + e) * 64 + lane];
            float rstd = 1.f;
            if (F32B) { float q = 0.f;
#pragma unroll
                for (int ww = 0; ww < 8; ++ww) q += SSQ[ww * 64 + r] + SSQ[ww * 64 + 32 + r];
                rstd = 1.0f / sqrtf(q * (1.0f / D) + RMS_EPS); }
            const int col = n0 + 8 * w + 4 * h;
            if (KIND == SG_POOL) {
                *(f32x4*)(X + (size_t)row * D + col) = *(const f32x4*)(F.x_s + (size_t)b * D + col) + v * *(const f32x4*)(F.pool_scale + col);
            } else if (KIND == SG_UP) {
                v = v * rstd;
#pragma unroll
                for (int e = 0; e < 4; ++e) { const float t = fmaxf(v[e], 0.f); v[e] = t * t; }
                v2u o; o.x = cvtpk(v[0], v[1]); o.y = cvtpk(v[2], v[3]); *(v2u*)(WSP(bf16, WS_H) + (size_t)row * FF + col) = o;
            } else if (KIND == SG_DOWN || KIND == SG_WO) {
#pragma unroll
                for (int e = 0; e < 4; ++e) unsafeAtomicAdd(X + (size_t)row * D + col + e, v[e]);
            } else {
                v = v * rstd; v2u o; o.x = cvtpk(v[0], v[1]); o.y = cvtpk(v[2], v[3]);
                if (n0 < 1024) { *(f32x4*)(F.out + OUT_KV_S + (size_t)b * D + col) = v; if (n0 >= 512) *(v2u*)(WSP(bf16, WS_KVS) + (size_t)row * 512 + col - 512) = o; }
                else if (n0 < 1536) { *(v2u*)(WSP(bf16, WS_KVW) + (size_t)row * 512 + col - 1024) = o; *(f32x4*)(F.out + OUT_WIN_S + ((size_t)b * 512 + 511) * 512 + col - 1024) = v; }
                else if (n0 < 2560) { *(v2u*)(WSP(bf16, WS_Q) + (size_t)row * D + col - 1536) = o; }
                else if (col < 2608) { float* gp = WSP(float, WS_GATE) + (size_t)row * 48 + col - 2560;
#pragma unroll
                    for (int e = 0; e < 4; ++e) gp[e] = 1.0f / (1.0f + __expf(-(v[e] + F.b_gate[col - 2560 + e]))); }
            }
        }
    }
    VM_WAIT(); __syncthreads();
}

__device__ __forceinline__ void p11_final(Frame& F) {
    const int gw = F.vcu * NWAVES + F.wave, NGW = F.G * NWAVES, lane = F.lane; const float* X = WSP(float, WS_X);
    for (int row = gw; row < MT; row += NGW) {
        const f32x4* xr = (const f32x4*)(X + (size_t)row * D) + lane; f32x4 v[4]; float ss = 0.f;
#pragma unroll
        for (int j = 0; j < 4; ++j) { v[j] = xr[64 * j]; ss += (v[j][0] * v[j][0] + v[j][1] * v[j][1]) + (v[j][2] * v[j][2] + v[j][3] * v[j][3]); }
        const float rstd = 1.0f / sqrtf(wave_sum(ss) * (1.0f / D) + RMS_EPS);
        float* o = (row < MP) ? F.out + OUT_Y_P + (size_t)row * D : F.out + OUT_Y_S + (size_t)(row - MP) * D;
#pragma unroll
        for (int j = 0; j < 4; ++j) *((f32x4*)o + lane + 64 * j) = v[j] * rstd * *((const f32x4*)F.norm_final + lane + 64 * j);
    }
}

constexpr int NPHASE = 12;
struct Args { const void* in[21]; float* out; unsigned char* ws; int ph_lo, ph_hi; };
__global__ void __launch_bounds__(NWAVES * 64, 2) yoco_fwd(Args args) {
    extern __shared__ __attribute__((aligned(16))) unsigned char lds[];
    Frame F;
    F.lds = (LAS unsigned char*)lds;
    F.tid = threadIdx.x; F.lane = F.tid & 63; F.wave = __builtin_amdgcn_readfirstlane(F.tid >> 6);
    F.G = gridDim.x; { const int bx = blockIdx.x; F.vcu = (F.G % 8 == 0) ? (bx % 8) * (F.G / 8) + bx / 8 : bx; }
    F.x_p = (const float*)args.in[0]; F.x_s = (const float*)args.in[1]; F.state_pool = (const float*)args.in[2]; F.cache = (const float*)args.in[3]; F.state_win = (const float*)args.in[4];
    F.page_table = (const int*)args.in[5]; F.norm_mix = (const float*)args.in[6]; F.norm_mlp = (const float*)args.in[7]; F.w_up = (const float*)args.in[8]; F.w_down = (const float*)args.in[9];
    F.pool_w = (const float*)args.in[10]; F.pool_scale = (const float*)args.in[11]; F.norm_kv = (const float*)args.in[12]; F.w_kv = (const float*)args.in[13]; F.cmp_pe = (const float*)args.in[14];
    F.cmp_w1 = (const float*)args.in[15]; F.cmp_w2 = (const float*)args.in[16]; F.w_qg = (const float*)args.in[17]; F.b_gate = (const float*)args.in[18]; F.w_o = (const float*)args.in[19];
    F.norm_final = (const float*)args.in[20]; F.out = args.out; F.ws = args.ws;
    volatile LAS unsigned* MISC = (volatile LAS unsigned*)(F.lds + MISC_OFF);
    for (int u = F.tid; u < (LDS_BYTES - RING_BYTES) / 4; u += NWAVES * 64) ((LAS unsigned*)(F.lds + RING_BYTES))[u] = 0u;
    __syncthreads();
    unsigned* ctl = (unsigned*)(F.ws + WS_CTL);
#if MK_MULTI
#define GRID_BAR() do { } while (0)
#else
    XcdBarrier bar = xcd_barrier_post(ctl + CW_BAR, MISC + 8);
#define GRID_BAR() xcd_barrier(bar)
#endif
    const int lo = args.ph_lo, hi = args.ph_hi;
#define IN(k) (lo <= (k) && (k) < hi)
#define SEAM(k) do { if (IN(k) && IN((k) + 1)) GRID_BAR(); } while (0)
    using namespace pg8;
    float* X = WSP(float, WS_X); bf16* XB = WSP(bf16, WS_XB); float* RS = WSP(float, WS_RS);

    if (IN(0)) { for (int rep = 0; rep < REP(0); ++rep) { p0_prologue(F); __syncthreads(); } } SEAM(0);
    if (IN(1)) {
        for (int rep = 0; rep < REP(16); ++rep) small_gemm<SG_POOL>(F, 0);
        Gemm g{WSP(bf16_t, WS_DIFF), WSP(bf16_t, WS_WPOOL), MP, 1024, 256, 1024, 256, (size_t)512}; StaticOrder S; S.init(MP, 1024, F.G, (int)blockIdx.x);
        EpiResid E{F.x_p, F.x_s, X, XB, RS, F.pool_scale};
        gemm_phase<EpiResid, StaticOrder, true, true>(F.lds, g, S, E);
    } SEAM(1);
    if (IN(2)) {
        for (int rep = 0; rep < REP(14); ++rep) small_gemm<SG_UP>(F, 0);
        Gemm g{XB, WSP(bf16_t, WS_WUP), MP, FF, D, D, D, (size_t)0}; StaticOrder S; S.init(MP, FF, F.G, (int)blockIdx.x);
        EpiUp E{WSP(bf16_t, WS_H), RS};
        for (int rep = 0; rep < REP(2); ++rep) { gemm_phase<EpiUp, StaticOrder, true, true>(F.lds, g, S, E); __syncthreads(); }
    } SEAM(2);
    if (IN(3)) {
        small_gemm<SG_DOWN>(F, 0);
        Gemm g{WSP(bf16_t, WS_H), WSP(bf16_t, WS_WDN), MP, D, FF, FF, FF, (size_t)0}; StaticOrder S; S.init(MP, D, F.G, (int)blockIdx.x);
        EpiResid E{X, X + (size_t)MP * D, X, XB, RS, nullptr};
        gemm_phase<EpiResid, StaticOrder, true, true>(F.lds, g, S, E);
    } SEAM(3);
    if (IN(4)) {
        for (int rep = 0; rep < REP(15); ++rep) small_gemm<SG_KVQG>(F, 0);
        if ((blockIdx.x & 1) == 0) p5_sample_compress(F, ctl + CW_QUEUE, 4);
        Gemm g{XB, WSP(bf16_t, WS_WKVQG), MP, NKVQG, D, D, D, (size_t)0}; StaticOrder S; S.init(MP, NKVQG, F.G, (int)blockIdx.x);
        EpiKvqg E{RS, F.b_gate, F.out + OUT_KV_P, F.out + OUT_KV_S, F.out + OUT_WIN_P, F.out + OUT_WIN_S, WSP(bf16_t, WS_CMPA), WSP(bf16_t, WS_KVS), WSP(bf16_t, WS_KVW), WSP(bf16_t, WS_Q), WSP(float, WS_GATE)};
        gemm_phase<EpiKvqg, StaticOrder, true, true>(F.lds, g, S, E);
        __syncthreads();
        p5_sample_compress(F, ctl + CW_QUEUE, 1 << 30);
    } SEAM(4);
    if (IN(5)) {
        Gemm g{WSP(bf16_t, WS_CMPA), WSP(bf16_t, WS_W1CAT), CMP_ROWS_P, 512, D, D, D, (size_t)CMP_ROWS * D * 2}; StaticOrder S; S.init(CMP_ROWS_P, 512, F.G, (int)blockIdx.x);
        EpiCmp E{WSP(float, WS_CMPP)};
        gemm_phase<EpiCmp, StaticOrder, true, true>(F.lds, g, S, E);
        __syncthreads();
        if (F.G > 32) { if ((int)blockIdx.x >= 32) p6_combine(F, 0, (int)blockIdx.x - 32, F.G - 32); } else p6_combine(F, 0, (int)blockIdx.x, F.G);
    } SEAM(5);
    if (IN(6)) { p6_combine(F, 1, (int)blockIdx.x, F.G); } SEAM(6);
    if (IN(7)) { p7_attention(F); } SEAM(7);
    if (IN(8)) {
        small_gemm<SG_WO>(F, 0);
        Gemm g{WSP(bf16_t, WS_DIFF), WSP(bf16_t, WS_WO), MP, D, D, D, D, (size_t)0}; StaticOrder S; S.init(MP, D, F.G, (int)blockIdx.x);
        EpiResid E{X, X + (size_t)MP * D, X, XB, RS, nullptr};
        gemm_phase<EpiResid, StaticOrder, true, true>(F.lds, g, S, E);
    } SEAM(8);
    if (IN(9)) {
        small_gemm<SG_UP>(F, 1);
        Gemm g{XB, WSP(bf16_t, WS_WUP) + (size_t)FF * D, MP, FF, D, D, D, (size_t)0}; StaticOrder S; S.init(MP, FF, F.G, (int)blockIdx.x);
        EpiUp E{WSP(bf16_t, WS_H), RS};
        gemm_phase<EpiUp, StaticOrder, true, true>(F.lds, g, S, E);
    } SEAM(9);
    if (IN(10)) {
        small_gemm<SG_DOWN>(F, 1);
        Gemm g{WSP(bf16_t, WS_H), WSP(bf16_t, WS_WDN) + (size_t)D * FF, MP, D, FF, FF, FF, (size_t)0}; StaticOrder S; S.init(MP, D, F.G, (int)blockIdx.x);
        EpiResid E{X, X + (size_t)MP * D, X, XB, RS, nullptr};
        gemm_phase<EpiResid, StaticOrder, true, true>(F.lds, g, S, E);
    } SEAM(10);
    if (IN(11)) { p11_final(F); }
#undef IN
#undef SEAM
}

extern "C" void kernel_launch(void* const* d_in, const int* in_sizes, int n_in, void* d_out, int out_size, void* d_ws, size_t ws_size, hipStream_t stream) {
    static int grid = 0;
    if (grid == 0) {
        if (n_in != 21 || (size_t)out_size != OUT_TOTAL || ws_size < WS_END) { fprintf(stderr, "kernel_launch: unexpected sizes n_in %d out %d ws %zu\n", n_in, out_size, ws_size); grid = -1; return; }
        int dev = 0, cus = 0, per_cu = 0;
        if (hipGetDevice(&dev) != hipSuccess || hipDeviceGetAttribute(&cus, hipDeviceAttributeMultiprocessorCount, dev) != hipSuccess) { grid = -1; return; }
        if (hipFuncSetAttribute((const void*)yoco_fwd, hipFuncAttributeMaxDynamicSharedMemorySize, LDS_BYTES) != hipSuccess) { fprintf(stderr, "kernel_launch: hipFuncSetAttribute failed\n"); grid = -1; return; }
        if (hipOccupancyMaxActiveBlocksPerMultiprocessor(&per_cu, (const void*)yoco_fwd, NWAVES * 64, LDS_BYTES) != hipSuccess || per_cu < 1) fprintf(stderr, "kernel_launch: occupancy query says %d\n", per_cu);
        (void)hipGetLastError();
        grid = cus;
    }
    if (grid < 0) return;
    (void)hipMemsetAsync((char*)d_ws + WS_CTL, 0, CTL_ZERO_BYTES, stream);
    Args a{};
    for (int i = 0; i < 21; ++i) a.in[i] = d_in[i];
    a.out = (float*)d_out; a.ws = (unsigned char*)d_ws;
#if MK_MULTI
    for (int p = 0; p < NPHASE; ++p) { a.ph_lo = p; a.ph_hi = p + 1; hipLaunchKernelGGL(yoco_fwd, dim3(grid), dim3(NWAVES * 64), LDS_BYTES, stream, a); }
#else
    a.ph_lo = 0; a.ph_hi = NPHASE;
    hipLaunchKernelGGL(yoco_fwd, dim3(grid), dim3(NWAVES * 64), LDS_BYTES, stream, a);
#endif
    const hipError_t le = hipPeekAtLastError();
    if (le != hipSuccess) fprintf(stderr, "kernel_launch: launch failed: %s\n", hipGetErrorName(le));
}
```

```cpp
#include <hip/hip_runtime.h>
#include <hip/hip_bf16.h>
#include <cstdio>
#include <cstdint>
#include <cmath>

#ifndef MK_MULTI
#define MK_MULTI 0
#endif

constexpr int D = 1024, FF = 4096, SEQ = 4096, NB = 4, DB = 128, PAST = 2048;
constexpr int MP = NB * SEQ;
constexpr int MT = MP + DB;
constexpr int MPAD = 16640;
constexpr int NKVQG = 2816;
constexpr int CMP_ROWS_P = NB * 256 * 4;
constexpr int CMP_ROWS_S = DB * 128 * 4;
constexpr int CMP_ROWS = CMP_ROWS_P + CMP_ROWS_S;
constexpr float RMS_EPS = 1e-6f;
constexpr float LOG2E = 1.4426950408889634f;
constexpr float QSCALE = 0.125f * LOG2E;

namespace pg8 {
#define PG8_LAS __attribute__((address_space(3)))
typedef unsigned short bf16_t;
typedef short bf16x8 __attribute__((ext_vector_type(8)));
typedef float f32x4 __attribute__((ext_vector_type(4)));
typedef float f32x2 __attribute__((ext_vector_type(2)));
typedef unsigned u32x4 __attribute__((ext_vector_type(4)));
typedef unsigned u32x2 __attribute__((ext_vector_type(2)));
constexpr int BM = 256, BK = 64, HALF = 128, HTB = HALF * BK * 2, STAGE_BYTES = 8 * HTB, NXCD = 8, WGM = 8;

__host__ __device__ __forceinline__ int lds_byte(int r, int c) { const int st = (r >> 4) * 2 + (c >> 5), rr = r & 15, cc = c & 31, ob = rr * 64 + cc * 2; return st * 1024 + (ob ^ (((ob >> 9) & 1) << 5)); }
__host__ __device__ __forceinline__ void stage_rc(int b, int& R, int& C) { const int st = b / 1024, sb = b % 1024, swz = sb ^ (((sb >> 9) & 1) << 5); R = (st >> 1) * 16 + swz / 64; C = (st & 1) * 32 + (swz % 64) / 2; }
__host__ __device__ __forceinline__ int perm32(int rho) { const int n = rho >> 4, i = rho & 15; return 8 * (i >> 2) + 4 * n + (i & 3); }

struct Unit { int pm, pn; };
struct Gemm { const bf16_t* A; const bf16_t* Bt; int M, N, K, lda, ldb; size_t a_pn_off; };

struct StaticOrder {
    int nM, nN, nwg, G, c;
    __host__ __device__ void init(int M, int N, int G_, int c_) { nM = M / BM; nN = N / BM; nwg = nM * nN; G = G_; c = c_; }
    __host__ __device__ bool next(int i, Unit& u) const {
        const long L = (long)i * G + c; if (L >= nwg) return false;
        int wgid = (int)L; { const int q = nwg / NXCD, r = nwg % NXCD, xcd = wgid % NXCD, off = wgid / NXCD; wgid = (xcd < r ? xcd * (q + 1) : r * (q + 1) + (xcd - r) * q) + off; }
        const int nig = WGM * nN, gid = wgid / nig, fm = gid * WGM, gsz = (nM - fm) < WGM ? (nM - fm) : WGM;
        u.pm = fm + ((wgid % nig) % gsz); u.pn = (wgid % nig) / gsz; return true;
    }
    __device__ __forceinline__ void a_ready(const Unit&) const {}
    __device__ __forceinline__ void done(const Unit&) const {}
};

__device__ __forceinline__ unsigned cvt_pk_bf16(float lo, float hi) { unsigned r; asm volatile("v_cvt_pk_bf16_f32 %0, %1, %2" : "=v"(r) : "v"(lo), "v"(hi)); return r; }

__device__ __forceinline__ float row_rstd(const float* rs, int row) {
    const f32x4* p = (const f32x4*)(rs + (size_t)row * 16); const f32x4 a = p[0], b = p[1], c = p[2], d = p[3];
    const float s = ((a[0] + a[1]) + (a[2] + a[3])) + ((b[0] + b[1]) + (b[2] + b[3])) + ((c[0] + c[1]) + (c[2] + c[3])) + ((d[0] + d[1]) + (d[2] + d[3]));
    return 1.0f / sqrtf(s * (1.0f / 1024.0f) + RMS_EPS);
}

struct EpiResid {
    static constexpr bool PERM = false, AFTER_DRAIN = false;
    const float* base_f; bf16_t* XB; float* RS; const float* scale;
    __device__ __forceinline__ void operator()(const f32x4 (&acc)[2][2][4][2], const Unit& u, int wr, int wc, int fr, int fq) const {
        const int col0 = u.pn * BM + wc * 32 + 4 * fq;
        f32x4 sc[2][2];
#pragma unroll
        for (int bj = 0; bj < 2; ++bj)
#pragma unroll
            for (int n = 0; n < 2; ++n) sc[bj][n] = scale ? *(const f32x4*)(scale + col0 + bj * HALF + n * 16) : (f32x4){1.f, 1.f, 1.f, 1.f};
#pragma unroll
        for (int ai = 0; ai < 2; ++ai) {
#pragma unroll
            for (int m = 0; m < 4; ++m) {
                const int row = u.pm * BM + ai * HALF + wr * 64 + m * 16 + fr;
                float ss = 0.f;
#pragma unroll
                for (int bj = 0; bj < 2; ++bj)
#pragma unroll
                    for (int n = 0; n < 2; ++n) {
                        const int col = col0 + bj * HALF + n * 16;
                        f32x4 bv;
                        if (base_f) bv = *(const f32x4*)(base_f + (size_t)row * D + col);
                        else { const u32x2 q = *(const u32x2*)(XB + (size_t)row * D + col); bv = (f32x4){__builtin_bit_cast(float, q.x << 16), __builtin_bit_cast(float, q.x & 0xffff0000u), __builtin_bit_cast(float, q.y << 16), __builtin_bit_cast(float, q.y & 0xffff0000u)}; }
                        const f32x4 v = bv + acc[ai][bj][m][n] * sc[bj][n];
                        u32x2 w; w.x = cvt_pk_bf16(v[0], v[1]); w.y = cvt_pk_bf16(v[2], v[3]);
                        *(u32x2*)(XB + (size_t)row * D + col) = w;
                        ss += (v[0] * v[0] + v[1] * v[1]) + (v[2] * v[2] + v[3] * v[3]);
                    }
                ss += __shfl_xor(ss, 16); ss += __shfl_xor(ss, 32);
                if (fq == 0) RS[(size_t)row * 16 + u.pn * 4 + wc] = ss;
            }
        }
    }
};

struct EpiUp {
    static constexpr bool PERM = true, AFTER_DRAIN = false;
    bf16_t* H; const float* RS;
    __device__ __forceinline__ void operator()(const f32x4 (&acc)[2][2][4][2], const Unit& u, int wr, int wc, int fr, int fq) const {
        const int col0 = u.pn * BM + wc * 32 + 8 * fq;
#pragma unroll
        for (int ai = 0; ai < 2; ++ai) {
            if (u.pm * BM + ai * HALF >= MT) continue;
#pragma unroll
            for (int m = 0; m < 4; ++m) {
                const int row = u.pm * BM + ai * HALF + wr * 64 + m * 16 + fr;
                const float rstd = row_rstd(RS, row);
#pragma unroll
                for (int bj = 0; bj < 2; ++bj) {
                    f32x4 v0 = acc[ai][bj][m][0] * rstd, v1 = acc[ai][bj][m][1] * rstd;
#pragma unroll
                    for (int e = 0; e < 4; ++e) { const float a = fmaxf(v0[e], 0.f), b = fmaxf(v1[e], 0.f); v0[e] = a * a; v1[e] = b * b; }
                    u32x4 w; w.x = cvt_pk_bf16(v0[0], v0[1]); w.y = cvt_pk_bf16(v0[2], v0[3]); w.z = cvt_pk_bf16(v1[0], v1[1]); w.w = cvt_pk_bf16(v1[2], v1[3]);
                    *(u32x4*)(H + (size_t)row * FF + col0 + bj * HALF) = w;
                }
            }
        }
    }
};

struct EpiKvqg {
    static constexpr bool PERM = true, AFTER_DRAIN = false;
    const float* RS; const float* bgate;
    float* kv_p; float* kv_s; float* win_p; float* win_s;
    bf16_t* CMPA; bf16_t* KVS; bf16_t* KVW; bf16_t* Q; float* GATE;
    __device__ __forceinline__ void operator()(const f32x4 (&acc)[2][2][4][2], const Unit& u, int wr, int wc, int fr, int fq) const {
        const int pn = u.pn;
#pragma unroll
        for (int ai = 0; ai < 2; ++ai) {
            if (u.pm * BM + ai * HALF >= MT) continue;
#pragma unroll
            for (int m = 0; m < 4; ++m) {
                const int row = u.pm * BM + ai * HALF + wr * 64 + m * 16 + fr;
                const float rstd = row_rstd(RS, row);
                const bool prompt = row < MP; const int b = prompt ? (row >> 12) : (row - MP), t = row & (SEQ - 1);
#pragma unroll
                for (int bj = 0; bj < 2; ++bj) {
                    const int cin = bj * HALF + wc * 32 + 8 * fq;
                    const f32x4 v0 = acc[ai][bj][m][0] * rstd, v1 = acc[ai][bj][m][1] * rstd;
                    u32x4 w; w.x = cvt_pk_bf16(v0[0], v0[1]); w.y = cvt_pk_bf16(v0[2], v0[3]); w.z = cvt_pk_bf16(v1[0], v1[1]); w.w = cvt_pk_bf16(v1[2], v1[3]);
                    if (pn < 4) {
                        float* o = prompt ? kv_p + (size_t)row * D : kv_s + (size_t)b * D;
                        *(f32x4*)(o + pn * BM + cin) = v0; *(f32x4*)(o + pn * BM + cin + 4) = v1;
                        if (pn < 2) {
                            if (prompt) { const int g = cin >> 6, d = cin & 63;
                                *(u32x4*)(CMPA + (size_t)pn * CMP_ROWS * D + (size_t)(((b * 256 + (t >> 4)) * 4 + g)) * D + (t & 15) * 64 + d) = w; }
                        } else *(u32x4*)(KVS + (size_t)row * 512 + (pn - 2) * BM + cin) = w;
                    } else if (pn < 6) {
                        const int c = (pn - 4) * BM + cin;
                        *(u32x4*)(KVW + (size_t)row * 512 + c) = w;
                        if (prompt) { if (t >= SEQ - 512) { float* o = win_p + ((size_t)b * 512 + (t - (SEQ - 512))) * 512 + c; *(f32x4*)o = v0; *(f32x4*)(o + 4) = v1; } }
                        else { float* o = win_s + ((size_t)b * 512 + 511) * 512 + c; *(f32x4*)o = v0; *(f32x4*)(o + 4) = v1; }
                    } else if (pn < 10) {
                        *(u32x4*)(Q + (size_t)row * D + (pn - 6) * BM + cin) = w;
                    } else {
                        if (cin < 48) {
#pragma unroll
                            for (int e = 0; e < 4; ++e) { GATE[(size_t)row * 48 + cin + e] = 1.0f / (1.0f + __expf(-(v0[e] + bgate[cin + e]))); GATE[(size_t)row * 48 + cin + 4 + e] = 1.0f / (1.0f + __expf(-(v1[e] + bgate[cin + 4 + e]))); }
                        }
                    }
                }
            }
        }
    }
};

struct EpiCmp {
    static constexpr bool PERM = false, AFTER_DRAIN = false;
    float* P;
    __device__ __forceinline__ void operator()(const f32x4 (&acc)[2][2][4][2], const Unit& u, int wr, int wc, int fr, int fq) const {
        float* base = P + (size_t)u.pn * CMP_ROWS * 256;
#pragma unroll
        for (int ai = 0; ai < 2; ++ai)
#pragma unroll
            for (int m = 0; m < 4; ++m) {
                const int row = u.pm * BM + ai * HALF + wr * 64 + m * 16 + fr;
#pragma unroll
                for (int bj = 0; bj < 2; ++bj)
#pragma unroll
                    for (int n = 0; n < 2; ++n) *(f32x4*)(base + (size_t)row * 256 + bj * HALF + wc * 32 + n * 16 + 4 * fq) = acc[ai][bj][m][n];
            }
    }
};

template <class Epi, class Sched, bool ALIGN_EPI = false, bool SP2 = false>
__device__ __forceinline__ void gemm_phase(PG8_LAS unsigned char* lds, const Gemm g, const Sched& S, const Epi& E) {
    const int tid = threadIdx.x, wid = __builtin_amdgcn_readfirstlane(tid >> 6), lane = tid & 63, wr = wid >> 2, wc = wid & 3, fr = lane & 15, fq = lane >> 4;
    const int K = g.K, nt = K / BK;
    unsigned voffA[2], voffB[2];
#pragma unroll
    for (int i = 0; i < 2; ++i) { int R, C; stage_rc(tid * 16 + i * 8192, R, C); const int Rb = Epi::PERM ? ((R & ~31) + perm32(R & 31)) : R;
        voffA[i] = (unsigned)(R * g.lda + C) * 2u; voffB[i] = (unsigned)(Rb * g.ldb + C) * 2u; }
    const size_t kstep = (size_t)(BK * 2);
    const size_t hstepA = (size_t)HALF * g.lda * 2, hstepB = (size_t)HALF * g.ldb * 2;
    const size_t tstepA = 2 * hstepA, tstepB = 2 * hstepB;
    const unsigned ldsw = (unsigned)wid * 1024u;
    const int aoff = lds_byte(wr * 64 + fr, fq * 8), boff = lds_byte(wc * 32 + fr, fq * 8);
#define PG8_SA(b, h) (((b) * 2 + (h)) * HTB)
#define PG8_SB(b, h) ((4 + (b) * 2 + (h)) * HTB)
#define PG8_STAGE(bufoff, gbase, voff) do { _Pragma("unroll") for (int _i = 0; _i < 2; ++_i) \
        __builtin_amdgcn_global_load_lds((const unsigned*)((const char*)(gbase) + (voff)[_i]), (PG8_LAS unsigned*)(lds + (bufoff) + ldsw + _i * 8192), 16, 0, 0); } while (0)
#define PG8_LDA(dst, b, h) do { _Pragma("unroll") for (int m = 0; m < 4; ++m) _Pragma("unroll") for (int k = 0; k < 2; ++k) dst[m][k] = *(const PG8_LAS bf16x8*)(lds + PG8_SA(b, h) + aoff + m * 2048 + k * 1024); } while (0)
#define PG8_LDB(dst, b, h) do { _Pragma("unroll") for (int n = 0; n < 2; ++n) _Pragma("unroll") for (int k = 0; k < 2; ++k) dst[n][k] = *(const PG8_LAS bf16x8*)(lds + PG8_SB(b, h) + boff + n * 2048 + k * 1024); } while (0)
#define PG8_MMA(ai, bj, At, Bt) do { __builtin_amdgcn_s_setprio(1); _Pragma("unroll") for (int m = 0; m < 4; ++m) _Pragma("unroll") for (int n = 0; n < 2; ++n) _Pragma("unroll") for (int k = 0; k < 2; ++k) \
        acc[ai][bj][m][n] = __builtin_amdgcn_mfma_f32_16x16x32_bf16(Bt[n][k], At[m][k], acc[ai][bj][m][n], 0, 0, 0); __builtin_amdgcn_s_setprio(0); } while (0)
#define PG8_WAIT_V(n) asm volatile("s_waitcnt vmcnt(" #n ")" ::: "memory")
#define PG8_WAIT_L(n) asm volatile("s_waitcnt lgkmcnt(" #n ")" ::: "memory")
#define PG8_BAR __builtin_amdgcn_s_barrier()
#define PG8_SCHED __builtin_amdgcn_sched_barrier(0)
    Unit cur, nxt; int ui = 0;
    if (!S.next(0, cur)) return;
    f32x4 acc[2][2][4][2];
#pragma unroll
    for (int a = 0; a < 2; ++a)
#pragma unroll
        for (int b = 0; b < 2; ++b)
#pragma unroll
            for (int m = 0; m < 4; ++m)
#pragma unroll
                for (int n = 0; n < 2; ++n) acc[a][b][m][n] = (f32x4){0.f, 0.f, 0.f, 0.f};
    bf16x8 At[4][2], B0[2][2], B1[2][2];
    const char* cA = (const char*)g.A + (size_t)cur.pm * tstepA + (size_t)cur.pn * g.a_pn_off; const char* cB = (const char*)g.Bt + (size_t)cur.pn * tstepB;
    S.a_ready(cur);
    if constexpr (SP2) {
        PG8_STAGE(PG8_SB(0, 0), cB, voffB); PG8_STAGE(PG8_SB(0, 1), cB + hstepB, voffB); PG8_STAGE(PG8_SA(0, 0), cA, voffA); PG8_STAGE(PG8_SA(0, 1), cA + hstepA, voffA);
        if (wr == 1) PG8_BAR;
        PG8_WAIT_V(2); PG8_BAR;
        PG8_STAGE(PG8_SB(1, 0), cB + kstep, voffB); PG8_STAGE(PG8_SA(1, 0), cA + kstep, voffA); PG8_STAGE(PG8_SB(1, 1), cB + hstepB + kstep, voffB);
        PG8_WAIT_V(6); PG8_BAR;
    } else {
        PG8_STAGE(PG8_SB(0, 0), cB, voffB); PG8_STAGE(PG8_SA(0, 0), cA, voffA); PG8_STAGE(PG8_SB(0, 1), cB + hstepB, voffB); PG8_STAGE(PG8_SA(0, 1), cA + hstepA, voffA);
        if (wr == 1) PG8_BAR;
        PG8_WAIT_V(4); PG8_BAR;
        PG8_STAGE(PG8_SB(1, 0), cB + kstep, voffB); PG8_STAGE(PG8_SA(1, 0), cA + kstep, voffA); PG8_STAGE(PG8_SB(1, 1), cB + hstepB + kstep, voffB);
        PG8_WAIT_V(6); PG8_BAR;
    }
    for (;;) {
        const bool has_next = S.next(ui + 1, nxt);
        const char* nA = has_next ? (const char*)g.A + (size_t)nxt.pm * tstepA + (size_t)nxt.pn * g.a_pn_off : cA; const char* nB = has_next ? (const char*)g.Bt + (size_t)nxt.pn * tstepB : cB;
        for (int t = 0; t < nt; t += 2) {
            const bool last = (t == nt - 2);
            const char* a1 = cA + (size_t)(t + 1) * kstep;
            const char* a2 = last ? nA : cA + (size_t)(t + 2) * kstep; const char* b2 = last ? nB : cB + (size_t)(t + 2) * kstep;
            const char* a3 = a2 + kstep; const char* b3 = b2 + kstep;
            if (last && has_next) S.a_ready(nxt);
            if constexpr (SP2) {
            PG8_LDB(B0, 0, 0); PG8_LDB(B1, 0, 1); PG8_SCHED; PG8_LDA(At, 0, 0); PG8_STAGE(PG8_SA(1, 1), a1 + hstepA, voffA);
            PG8_WAIT_V(8); PG8_WAIT_L(0); PG8_BAR; PG8_MMA(0, 0, At, B0); PG8_MMA(0, 1, At, B1); PG8_BAR; PG8_SCHED;
            PG8_LDA(At, 0, 1); PG8_STAGE(PG8_SB(0, 0), b2, voffB); PG8_STAGE(PG8_SB(0, 1), b2 + hstepB, voffB); PG8_STAGE(PG8_SA(0, 0), a2, voffA);
            PG8_WAIT_V(8); PG8_WAIT_L(0); PG8_BAR; PG8_MMA(1, 0, At, B0); PG8_MMA(1, 1, At, B1); PG8_BAR; PG8_SCHED;
            PG8_LDB(B0, 1, 0); PG8_LDB(B1, 1, 1); PG8_SCHED; PG8_LDA(At, 1, 0); PG8_STAGE(PG8_SA(0, 1), a2 + hstepA, voffA);
            PG8_WAIT_V(8); PG8_WAIT_L(0); PG8_BAR; PG8_MMA(0, 0, At, B0); PG8_MMA(0, 1, At, B1); PG8_BAR; PG8_SCHED;
            PG8_LDA(At, 1, 1); PG8_STAGE(PG8_SB(1, 0), b3, voffB); PG8_STAGE(PG8_SB(1, 1), b3 + hstepB, voffB); PG8_STAGE(PG8_SA(1, 0), a3, voffA);
            PG8_WAIT_V(8); PG8_WAIT_L(0); PG8_BAR; PG8_MMA(1, 0, At, B0); PG8_MMA(1, 1, At, B1); PG8_BAR; PG8_SCHED;
            } else {
            PG8_LDB(B0, 0, 0); PG8_SCHED; PG8_LDA(At, 0, 0); PG8_STAGE(PG8_SA(1, 1), a1 + hstepA, voffA);
            PG8_WAIT_L(8); PG8_BAR; PG8_WAIT_L(0); PG8_MMA(0, 0, At, B0); PG8_BAR; PG8_SCHED;
            PG8_LDB(B1, 0, 1); PG8_STAGE(PG8_SB(0, 0), b2, voffB);
            PG8_BAR; PG8_WAIT_L(0); PG8_MMA(0, 1, At, B1); PG8_BAR;
            PG8_LDA(At, 0, 1); PG8_STAGE(PG8_SA(0, 0), a2, voffA);
            PG8_BAR; PG8_WAIT_L(0); PG8_MMA(1, 0, At, B0); PG8_BAR; PG8_SCHED;
            PG8_STAGE(PG8_SB(0, 1), b2 + hstepB, voffB);
            PG8_WAIT_V(6); PG8_BAR; PG8_MMA(1, 1, At, B1); PG8_BAR;
            PG8_LDB(B0, 1, 0); PG8_SCHED; PG8_LDA(At, 1, 0); PG8_STAGE(PG8_SA(0, 1), a2 + hstepA, voffA);
            PG8_WAIT_L(8); PG8_BAR; PG8_WAIT_L(0); PG8_MMA(0, 0, At, B0); PG8_BAR; PG8_SCHED;
            PG8_LDB(B1, 1, 1); PG8_STAGE(PG8_SB(1, 0), b3, voffB);
            PG8_BAR; PG8_WAIT_L(0); PG8_MMA(0, 1, At, B1); PG8_BAR;
            PG8_LDA(At, 1, 1); PG8_STAGE(PG8_SA(1, 0), a3, voffA);
            PG8_BAR; PG8_WAIT_L(0); PG8_MMA(1, 0, At, B0); PG8_BAR; PG8_SCHED;
            PG8_STAGE(PG8_SB(1, 1), b3 + hstepB, voffB);
            PG8_WAIT_V(6); PG8_BAR; PG8_MMA(1, 1, At, B1); PG8_BAR;
            }
        }
        if constexpr (ALIGN_EPI) { if (wr == 0) PG8_BAR; }
        if constexpr (!Epi::AFTER_DRAIN) { E(acc, cur, wr, wc, fr, fq); S.done(cur); }
        if (!has_next) break;
#pragma unroll
        for (int a = 0; a < 2; ++a)
#pragma unroll
            for (int b = 0; b < 2; ++b)
#pragma unroll
                for (int m = 0; m < 4; ++m)
#pragma unroll
                    for (int n = 0; n < 2; ++n) acc[a][b][m][n] = (f32x4){0.f, 0.f, 0.f, 0.f};
        cur = nxt; cA = nA; cB = nB; ++ui;
        if constexpr (ALIGN_EPI) { if (wr == 1) PG8_BAR; }
    }
    PG8_WAIT_V(0);
    if constexpr (!ALIGN_EPI) { if (wr == 0) PG8_BAR; }
    PG8_BAR;
    if constexpr (Epi::AFTER_DRAIN) { E.fused(acc, cur, wr, wc, fr, fq, lds, wid, lane); S.done(cur); }
#undef PG8_SA
#undef PG8_SB
#undef PG8_STAGE
#undef PG8_LDA
#undef PG8_LDB
#undef PG8_MMA
#undef PG8_WAIT_V
#undef PG8_WAIT_L
#undef PG8_BAR
#undef PG8_SCHED
}
}

#define GAS __attribute__((address_space(1)))
#define LAS __attribute__((address_space(3)))
typedef unsigned short bf16;
typedef unsigned v4u __attribute__((ext_vector_type(4)));
typedef unsigned v2u __attribute__((ext_vector_type(2)));
typedef float f32x4 __attribute__((ext_vector_type(4)));
typedef float f32x2 __attribute__((ext_vector_type(2)));
typedef float f32x16 __attribute__((ext_vector_type(16)));
typedef short bf16x8 __attribute__((ext_vector_type(8)));
typedef short v4i16_t __attribute__((ext_vector_type(4)));
typedef GAS unsigned gu32;
typedef GAS unsigned long long gu64;
#define RLX_AGENT __ATOMIC_RELAXED, __HIP_MEMORY_SCOPE_AGENT
#define LDS_WAIT() asm volatile("s_waitcnt lgkmcnt(0)" ::: "memory")
#define VM_WAIT() asm volatile("s_waitcnt vmcnt(0)" ::: "memory")
__device__ __forceinline__ unsigned f2bf(float f) { unsigned u = __builtin_bit_cast(unsigned, f); return (u + 0x7fffu + ((u >> 16) & 1u)) >> 16; }
__device__ __forceinline__ unsigned pk2(float lo, float hi) { return f2bf(lo) | (f2bf(hi) << 16); }
__device__ __forceinline__ float bf2f(unsigned short h) { return __builtin_bit_cast(float, (unsigned)h << 16); }

#define XB_TMO      128
#define XB_XCNT(j)  (256  + 64 * (j))
#define XB_XSUB(j)  (1280 + 64 * (j))
#define XB_XGEN(j)  (2304 + 64 * (j))
#define XB_TOP      3328
#define XB_TOPGEN   3392
#define XCD_BAR_WORDS 3456
#define XB_SPIN_CAP (1u << 18)

__device__ __forceinline__ unsigned xb_ld(unsigned* p)              { return __hip_atomic_load(p, __ATOMIC_RELAXED, __HIP_MEMORY_SCOPE_AGENT); }
__device__ __forceinline__ unsigned xb_add(unsigned* p, unsigned v) { return __hip_atomic_fetch_add(p, v, __ATOMIC_RELAXED, __HIP_MEMORY_SCOPE_AGENT); }
__device__ __forceinline__ unsigned xb_xcc_id() { return (unsigned)__builtin_amdgcn_s_getreg((3 << 11) | 20) & 0xFu; }
#define XB_SPIN(cond, bar) do { unsigned _sp = 0; while (cond) { __builtin_amdgcn_s_sleep(1); \
    if ((++_sp & 255u) == 0u) { if (xb_ld(&(bar)[XB_TMO])) break; if (_sp > XB_SPIN_CAP) { atomicAdd(&(bar)[XB_TMO], 1u); break; } } } } while (0)

struct XcdBarrier {
    unsigned* bar; unsigned x;
    volatile LAS unsigned* st;
};

__device__ __forceinline__ XcdBarrier xcd_barrier_post(unsigned* bar, volatile LAS unsigned* st) {
    XcdBarrier b; b.bar = bar; b.x = xb_xcc_id(); b.st = st;
    if (threadIdx.x == 0) (void)xb_add(&bar[XB_XCNT(b.x)], 1u);
    return b;
}
__device__ __forceinline__ void xcd_barrier_complete(unsigned* bar, unsigned x, unsigned& nloc, unsigned& nx) {
    const unsigned G = gridDim.x * gridDim.y * gridDim.z;
    unsigned sum, cnt, mine, sp = 0u;
    for (;;) {
        sum = 0u; cnt = 0u; mine = 0u;
#pragma unroll
        for (unsigned j = 0; j < 16; ++j) { const unsigned c = xb_ld(&bar[XB_XCNT(j)]); sum += c; cnt += (c > 0u) ? 1u : 0u; mine = (j == x) ? c : mine; }
        if (sum == G) break;
        __builtin_amdgcn_s_sleep(1);
        if ((++sp & 255u) == 0u) { if (xb_ld(&bar[XB_TMO])) break; if (sp > XB_SPIN_CAP) { atomicAdd(&bar[XB_TMO], 1u); break; } }
    }
    nloc = mine > 0u ? mine : 1u; nx = cnt > 0u ? cnt : 1u;
}

__device__ __forceinline__ void xcd_barrier(const XcdBarrier& b) {
    asm volatile("s_waitcnt vmcnt(0)" ::: "memory");
    __syncthreads();
    if (threadIdx.x == 0) {
        unsigned* bar = b.bar;
        __builtin_amdgcn_s_waitcnt(0);
        unsigned nloc = b.st[0], nx = b.st[1];
        if (nloc == 0u) { xcd_barrier_complete(bar, b.x, nloc, nx); b.st[0] = nloc; b.st[1] = nx; }
        const unsigned old = xb_add(&bar[XB_XSUB(b.x)], 1u);
        const unsigned gen = old / nloc;
        if (old + 1u == (gen + 1u) * nloc) {
            __builtin_amdgcn_fence(__ATOMIC_RELEASE, "agent");
            asm volatile("s_waitcnt vmcnt(0)" ::: "memory");
            const unsigned og = xb_add(&bar[XB_TOP], 1u);
            const unsigned tg = og / nx;
            if (og + 1u == (tg + 1u) * nx) xb_add(&bar[XB_TOPGEN], 1u);
            else XB_SPIN(xb_ld(&bar[XB_TOPGEN]) == tg, bar);
            __builtin_amdgcn_fence(__ATOMIC_ACQUIRE, "agent");
            xb_add(&bar[XB_XGEN(b.x)], 1u);
            asm volatile("s_waitcnt vmcnt(0)" ::: "memory");
        } else {
            XB_SPIN(xb_ld(&bar[XB_XGEN(b.x)]) == gen, bar);
            __builtin_amdgcn_fence(__ATOMIC_ACQUIRE, "agent");
            asm volatile("s_waitcnt vmcnt(0)" ::: "memory");
        }
    }
    __syncthreads();
}

constexpr size_t MiB = 1u << 20;
constexpr size_t WS_CTL = 0, CTL_ZERO_BYTES = 1 * MiB;
constexpr size_t WS_WUP = 2 * MiB;
constexpr size_t WS_WDN = 18 * MiB;
constexpr size_t WS_WKVQG = 34 * MiB;
constexpr size_t WS_WO = 40 * MiB;
constexpr size_t WS_WPOOL = 42 * MiB;
constexpr size_t WS_W1CAT = 43 * MiB;
constexpr size_t WS_CBIAS = 44 * MiB;
constexpr size_t WS_RS = 45 * MiB;
constexpr size_t WS_GATE = 47 * MiB;
constexpr size_t WS_X = 52 * MiB;
constexpr size_t WS_XB = 118 * MiB;
constexpr size_t WS_DIFF = 152 * MiB;
constexpr size_t WS_Q = 186 * MiB;
constexpr size_t WS_KVS = 220 * MiB;
constexpr size_t WS_KVW = 238 * MiB;
constexpr size_t WS_KC = 256 * MiB;
constexpr size_t WS_KCS = 258 * MiB;
constexpr size_t WS_H = 292 * MiB;
constexpr size_t WS_CMPA = 424 * MiB;
constexpr size_t WS_CMPP = 700 * MiB;
constexpr size_t WS_END = 840 * MiB;
constexpr int CW_BAR = 4096;

constexpr size_t OUT_Y_P = 0, OUT_Y_S = 16777216, OUT_POOL_P = 16908288, OUT_POOL_S = 16969728, OUT_KV_P = 18935808, OUT_KV_S = 35713024, OUT_WIN_P = 35844096, OUT_WIN_S = 36892672, OUT_TOTAL = 70447104;

#ifndef PROBE_DUP
#define PROBE_DUP 0
#endif
#define REP(k) (1 + ((PROBE_DUP >> (k)) & 1))
constexpr int NWAVES = 8;
constexpr int RING_BYTES = 131072, MISC_OFF = RING_BYTES + 320, LDS_BYTES = 147456;

struct Frame {
    LAS unsigned char* lds;
    int tid, lane, wave, vcu, G;
    const float *x_p, *x_s, *state_pool, *cache, *state_win; const int* page_table;
    const float *norm_mix, *norm_mlp, *w_up, *w_down, *pool_w, *pool_scale, *norm_kv, *w_kv, *cmp_pe, *cmp_w1, *cmp_w2, *w_qg, *b_gate, *w_o, *norm_final;
    float* out; unsigned char* ws;
};
#define WSP(T, off) ((T*)(F.ws + (off)))

__device__ __forceinline__ unsigned cvtpk(float lo, float hi) { typedef __bf16 bf16x2_t __attribute__((ext_vector_type(2))); f32x2 v = {lo, hi}; bf16x2_t b = __builtin_convertvector(v, bf16x2_t); return __builtin_bit_cast(unsigned, b); }
__device__ __forceinline__ bf16x8 cvt8(const f32x4 a, const f32x4 b) { v4u w; w.x = cvtpk(a[0], a[1]); w.y = cvtpk(a[2], a[3]); w.z = cvtpk(b[0], b[1]); w.w = cvtpk(b[2], b[3]); return __builtin_bit_cast(bf16x8, w); }
__device__ __forceinline__ float wave_sum(float v) {
#pragma unroll
    for (int o = 1; o < 64; o <<= 1) v += __shfl_xor(v, o);
    return v;
}
__device__ __forceinline__ float wave_max(float v) {
#pragma unroll
    for (int o = 1; o < 64; o <<= 1) v = fmaxf(v, __shfl_xor(v, o));
    return v;
}

__device__ __forceinline__ void transpose_item(const float* W, int N, bf16* WT, int ldt, int row_off, const float* kscale, float scale, LAS float* scr, int kb, int nb, int lane) {
    const int k0 = 64 * kb, n0 = 32 * nb; const int n = n0 + (lane & 31);
#pragma unroll 8
    for (int i = 0; i < 32; ++i) { const int kk = 2 * i + (lane >> 5); float v = (n < N) ? W[(size_t)(k0 + kk) * N + n] : 0.f; if (kscale) v *= kscale[k0 + kk]; scr[kk * 33 + (lane & 31)] = v * scale; }
    LDS_WAIT(); asm volatile("" ::: "memory");
    const int c = lane & 7;
#pragma unroll
    for (int j = 0; j < 4; ++j) { const int nn = (lane >> 3) + 8 * j; const LAS float* s = scr + (8 * c) * 33 + nn;
        v4u o; o.x = pk2(s[0 * 33], s[1 * 33]); o.y = pk2(s[2 * 33], s[3 * 33]); o.z = pk2(s[4 * 33], s[5 * 33]); o.w = pk2(s[6 * 33], s[7 * 33]);
        if (n0 + nn < N) *(v4u*)(WT + (size_t)(row_off + n0 + nn) * ldt + k0 + 8 * c) = o; }
    LDS_WAIT(); asm volatile("" ::: "memory");
}

__device__ __forceinline__ void p0_prologue(Frame& F) {
    LAS float* scr = (LAS float*)(F.lds + F.wave * 16384);
    const int gw = F.vcu * NWAVES + F.wave, NGW = F.G * NWAVES, lane = F.lane;
    bf16* WUP = WSP(bf16, WS_WUP); bf16* WDN = WSP(bf16, WS_WDN); bf16* WKVQG = WSP(bf16, WS_WKVQG); bf16* WO = WSP(bf16, WS_WO); bf16* WPOOL = WSP(bf16, WS_WPOOL); bf16* W1CAT = WSP(bf16, WS_W1CAT);
    constexpr int I_UP = 2048, I_DN = 2048, I_KV = 768, I_QG = 544, I_WO = 512, I_PL = 32, I_C1 = 64;
    constexpr int NITEMS = 2 * I_UP + 2 * I_DN + I_KV + I_QG + I_WO + 4 * I_PL + 4 * I_C1;
    for (int rep = 0; rep < REP(17); ++rep)
    for (int it = gw; it < NITEMS; it += NGW) {
        int r = it;
        if (r < 2 * I_UP) { const int l = r / I_UP; r %= I_UP; transpose_item(F.w_up + (size_t)l * D * FF, FF, WUP + (size_t)l * FF * D, D, 0, F.norm_mlp + l * D, 1.f, scr, r / 128, r % 128, lane); continue; } r -= 2 * I_UP;
        if (r < 2 * I_DN) { const int l = r / I_DN; r %= I_DN; transpose_item(F.w_down + (size_t)l * FF * D, D, WDN + (size_t)l * D * FF, FF, 0, nullptr, 1.f, scr, r / 32, r % 32, lane); continue; } r -= 2 * I_DN;
        if (r < I_KV) { transpose_item(F.w_kv, 1536, WKVQG, D, 0, F.norm_kv, 1.f, scr, r / 48, r % 48, lane); continue; } r -= I_KV;
        if (r < I_QG) { const int nb = r % 34; transpose_item(F.w_qg, 1072, WKVQG, D, 1536, F.norm_mix + D, nb < 32 ? QSCALE : 1.f, scr, r / 34, nb, lane); continue; } r -= I_QG;
        if (r < I_WO) { transpose_item(F.w_o, D, WO, D, 0, nullptr, 1.f, scr, r / 32, r % 32, lane); continue; } r -= I_WO;
        if (r < 4 * I_PL) { const int g = r / I_PL; r %= I_PL; transpose_item(F.pool_w + (size_t)g * 65536, 256, WPOOL + (size_t)g * 65536, 256, 0, nullptr, 1.f, scr, r / 8, r % 8, lane); continue; } r -= 4 * I_PL;
        { const int kvh = r / I_C1; r %= I_C1; const int kv = kvh >> 1, half = kvh & 1;
          transpose_item(F.cmp_w1 + (size_t)kv * 2048 * 128 + (size_t)half * 1024 * 128, 128, W1CAT + (size_t)kv * 256 * D, D, half * 128, nullptr, 1.f, scr, r / 4, r % 4, lane); }
    }
    { const int gt = F.vcu * 512 + F.tid, NT = F.G * 512; v4u* z = (v4u*)(WKVQG + (size_t)2608 * D);
      for (int i = gt; i < 208 * D / 8; i += NT) z[i] = (v4u){0u, 0u, 0u, 0u}; }
    { float* CB = WSP(float, WS_CBIAS);
      for (int it = gw; it < 256; it += NGW) { const int kv = it >> 7, n = it & 127; float s = 0.f;
          for (int k = lane; k < 2048; k += 64) s += F.cmp_pe[kv * 2048 + k] * F.cmp_w1[((size_t)kv * 2048 + k) * 128 + n];
          s = wave_sum(s); if (lane == 0) CB[it] = s; } }
    bf16* DIFF = WSP(bf16, WS_DIFF);
    for (int b = gw; b < DB; b += NGW) {
        const f32x4* xr = (const f32x4*)(F.x_s + (size_t)b * D) + lane; f32x4 v[4]; float ss = 0.f;
#pragma unroll
        for (int j = 0; j < 4; ++j) { v[j] = xr[64 * j]; ss += (v[j][0] * v[j][0] + v[j][1] * v[j][1]) + (v[j][2] * v[j][2] + v[j][3] * v[j][3]); }
        const float rstd = 1.0f / sqrtf(wave_sum(ss) * (1.0f / D) + RMS_EPS);
        const float* sp = F.state_pool + (size_t)b * 15 * D; float* ps = F.out + OUT_POOL_S + (size_t)b * 15 * D;
#pragma unroll
        for (int j = 0; j < 4; ++j) {
            const int col = 256 * j + 4 * lane; const f32x4 gg = *(const f32x4*)(F.norm_mix + col); const f32x4 u = v[j] * rstd * gg;
            f32x4 sum = u; const int w = 2 << j;
            for (int r = 0; r < w - 1; ++r) sum += *(const f32x4*)(sp + (size_t)(14 - r) * D + col);
            const f32x4 df = sum * (1.0f / (float)w) - u;
            v2u o; o.x = pk2(df[0], df[1]); o.y = pk2(df[2], df[3]); *(v2u*)(DIFF + (size_t)(MP + b) * D + col) = o;
            *(f32x4*)(ps + (size_t)14 * D + col) = u;
            for (int r = 0; r < 14; ++r) *(f32x4*)(ps + (size_t)r * D + col) = *(const f32x4*)(sp + (size_t)(r + 1) * D + col);
        }
    }
    if (F.G != 256) { const size_t gt = (size_t)F.vcu * 512 + F.tid, NT = (size_t)F.G * 512; const f32x4* src = (const f32x4*)F.state_win; f32x4* dst = (f32x4*)(F.out + OUT_WIN_S);
      for (int rep = 0; rep < REP(19); ++rep)
      for (size_t e = gt; e < (size_t)DB * 511 * 128; e += NT) { const size_t b = e / (511 * 128), rem = e - b * (511 * 128); dst[b * 65536 + rem] = src[b * 65536 + rem + 128]; } }
    __syncthreads();
    LAS float* U = (LAS float*)F.lds;
    for (int rep = 0; rep < REP(20); ++rep)
    for (int task = F.vcu; task < MP / 64; task += F.G) {
        const int b = task >> 6, t0 = (task & 63) * 64;
        const float* xb = F.x_p + (size_t)b * SEQ * D;
        f32x4 gmix[4];
#pragma unroll
        for (int j = 0; j < 4; ++j) gmix[j] = *(const f32x4*)(F.norm_mix + 256 * j + 4 * lane);
        f32x4 ra[4], rb2[4];
#define DF_LOAD(T) do { const int ta_ = (T) + 2 * F.wave, tb_ = ta_ + 1; _Pragma("unroll") for (int j = 0; j < 4; ++j) { \
            ra[j] = (ta_ >= 0) ? *((const f32x4*)(xb + (size_t)ta_ * D) + lane + 64 * j) : (f32x4){0.f, 0.f, 0.f, 0.f}; rb2[j] = (tb_ >= 0) ? *((const f32x4*)(xb + (size_t)tb_ * D) + lane + 64 * j) : (f32x4){0.f, 0.f, 0.f, 0.f}; } } while (0)
#define DF_STORE1(rr, tt_) do { float ss = 0.f; _Pragma("unroll") for (int j = 0; j < 4; ++j) ss += (rr[j][0] * rr[j][0] + rr[j][1] * rr[j][1]) + (rr[j][2] * rr[j][2] + rr[j][3] * rr[j][3]); \
            const float rstd = 1.0f / sqrtf(wave_sum(ss) * (1.0f / D) + RMS_EPS); \
            _Pragma("unroll") for (int j = 0; j < 4; ++j) { const f32x4 u = rr[j] * rstd * gmix[j]; *(LAS f32x4*)(U + ((tt_) & 31) * 1024 + 256 * j + 4 * lane) = u; \
                if ((tt_) >= SEQ - 15) *(f32x4*)(F.out + OUT_POOL_P + ((size_t)b * 15 + ((tt_) - (SEQ - 15))) * D + 256 * j + 4 * lane) = u; } } while (0)
#define DF_STORE(T) do { const int ta_ = (T) + 2 * F.wave; DF_STORE1(ra, ta_); DF_STORE1(rb2, ta_ + 1); } while (0)
        DF_LOAD(t0 - 16); DF_STORE(t0 - 16);
        DF_LOAD(t0);
        const int c = 2 * F.tid, w = 2 << (F.tid >> 7);
        f32x2 S = (f32x2){0.f, 0.f};
        for (int sub = 0; sub < 4; ++sub) {
            const int T = t0 + 16 * sub;
            DF_STORE(T);
            __syncthreads();
            if (sub < 3) DF_LOAD(T + 16);
            if (sub == 0) { for (int j = 1; j < w; ++j) S += *(const LAS f32x2*)(U + ((T - j) & 31) * 1024 + c); }
            for (int tt = 0; tt < 16; ++tt) { const int t = T + tt; const int cnt = (t + 1 < w) ? (t + 1) : w;
                const f32x2 cur = *(const LAS f32x2*)(U + (t & 31) * 1024 + c);
                S += cur; const float inv = 1.0f / (float)cnt;
                *(unsigned*)(DIFF + ((size_t)b * SEQ + t) * D + c) = pk2(S[0] * inv - cur[0], S[1] * inv - cur[1]);
                S -= *(const LAS f32x2*)(U + ((t - w + 1) & 31) * 1024 + c); }
            __syncthreads();
        }
#undef DF_LOAD
#undef DF_STORE1
#undef DF_STORE
    }
}

constexpr int KSTR = 144;
constexpr int SC_ACT = 0, SC_W = 128 * KSTR, SC_BUF = SC_W + 256 * KSTR, SC_UNIT = 2 * SC_BUF, CW_QUEUE = 8192;
static_assert(SC_UNIT + 64 <= RING_BYTES, "sample compress LDS");
__device__ __forceinline__ void p5_sample_compress(Frame& F, unsigned* qctr, int quota) {
    LAS int* UNIT = (LAS int*)(F.lds + SC_UNIT);
    const int tid = F.tid, lane = F.lane, w = F.wave, r = lane & 31, h = lane >> 5, rb = w & 3, nh = w >> 2;
    float* P = WSP(float, WS_CMPP); const bf16* W1 = WSP(bf16, WS_W1CAT);
    for (int nu = 0; nu < quota; ++nu) {
        __syncthreads();
        if (tid == 0) UNIT[0] = (int)atomicAdd(qctr, 1u);
        __syncthreads();
        const int u = UNIT[0]; if (u >= DB * 8) break;
        const int b = u >> 3, jb = (u >> 1) & 3, kv = u & 1;
        size_t aoff[4]; const bf16* wsrc = W1 + ((size_t)kv * 256 + (tid >> 3)) * D + 8 * (tid & 7);
#pragma unroll
        for (int e = 0; e < 4; ++e) { const int j = 32 * jb + (tid >> 6) + 8 * e; const int page = F.page_table[b * 16 + (j >> 3)]; aoff[e] = ((size_t)page * 128 + (j & 7) * 16) * 1024 + kv * 256 + 4 * (tid & 63); }
        f32x4 av0[4], av1[4]; v4u wv0[4], wv1[4];
#define SC_LOAD(av, wv, tt) do { _Pragma("unroll") for (int e = 0; e < 4; ++e) { av[e] = *(const f32x4*)(F.cache + aoff[e] + (size_t)(tt) * 1024); wv[e] = *(const v4u*)(wsrc + (size_t)e * 64 * D + 64 * (tt)); } } while (0)
#define SC_STORE(av, wv, bf) do { _Pragma("unroll") for (int e = 0; e < 4; ++e) { v2u o; o.x = cvtpk(av[e][0], av[e][1]); o.y = cvtpk(av[e][2], av[e][3]); \
            *(LAS v2u*)(F.lds + (bf) * SC_BUF + SC_ACT + ((((tid >> 6) + 8 * e) << 2) + ((tid & 63) >> 4)) * KSTR + 8 * (tid & 15)) = o; *(LAS v4u*)(F.lds + (bf) * SC_BUF + SC_W + ((tid >> 3) + 64 * e) * KSTR + 16 * (tid & 7)) = wv[e]; } } while (0)
#define SC_COMPUTE(bf) do { const LAS unsigned char* At = F.lds + (bf) * SC_BUF + SC_ACT + (32 * rb + r) * KSTR + h * 16; const LAS unsigned char* Wt = F.lds + (bf) * SC_BUF + SC_W + (128 * nh + r) * KSTR + h * 16; \
            _Pragma("unroll") for (int ks = 0; ks < 4; ++ks) { const bf16x8 bfr = *(const LAS bf16x8*)(At + ks * 32); \
                _Pragma("unroll") for (int nt = 0; nt < 4; ++nt) { const bf16x8 afr = *(const LAS bf16x8*)(Wt + 32 * nt * KSTR + ks * 32); acc[nt] = __builtin_amdgcn_mfma_f32_32x32x16_bf16(afr, bfr, acc[nt], 0, 0, 0); } } } while (0)
        f32x16 acc[4];
#pragma unroll
        for (int nt = 0; nt < 4; ++nt)
#pragma unroll
            for (int i = 0; i < 16; ++i) acc[nt][i] = 0.f;
        SC_LOAD(av0, wv0, 0); SC_LOAD(av1, wv1, 1); SC_STORE(av0, wv0, 0); __syncthreads();
        for (int tt = 0; tt < 16; tt += 2) {
            if (tt + 2 < 16) SC_LOAD(av0, wv0, tt + 2);
            SC_COMPUTE(0);
            SC_STORE(av1, wv1, 1); __syncthreads();
            if (tt + 3 < 16) SC_LOAD(av1, wv1, tt + 3);
            SC_COMPUTE(1);
            if (tt + 2 < 16) SC_STORE(av0, wv0, 0);
            __syncthreads();
        }
#undef SC_COMPUTE
#undef SC_LOAD
#undef SC_STORE
        float* prow = P + (size_t)kv * CMP_ROWS * 256 + (size_t)(CMP_ROWS_P + (b * 128 + 32 * jb) * 4 + 32 * rb + r) * 256 + 128 * nh + 4 * h;
#pragma unroll
        for (int nt = 0; nt < 4; ++nt)
#pragma unroll
            for (int g4 = 0; g4 < 4; ++g4) *(f32x4*)(prow + 32 * nt + 8 * g4) = (f32x4){acc[nt][4 * g4], acc[nt][4 * g4 + 1], acc[nt][4 * g4 + 2], acc[nt][4 * g4 + 3]};
    }
}

constexpr int W2T_STR = 136;
__device__ __forceinline__ void p6_combine(Frame& F, int part, int cu, int ncu) {
    LAS bf16* W2T = (LAS bf16*)F.lds;
    LAS float* CBL = (LAS float*)(F.lds + 2 * 64 * W2T_STR * 2);
    const float* P = WSP(float, WS_CMPP); bf16* KC = WSP(bf16, WS_KC); float* KCS = WSP(float, WS_KCS);
    for (int i = F.tid; i < 2 * 128 * 64; i += 512) { const int kv = i >> 13, k = (i >> 6) & 127, d = i & 63; W2T[(kv * 64 + d) * W2T_STR + k] = (bf16)f2bf(F.cmp_w2[i]); }
    if (F.tid < 256) CBL[F.tid] = WSP(float, WS_CBIAS)[F.tid];
    __syncthreads();
    const int lane = F.lane, ml = lane & 15, fq = lane >> 4;
    const int gw = cu * NWAVES + F.wave, NGW = ncu * NWAVES;
    constexpr int NT_P = CMP_ROWS_P / 16, NT_S = CMP_ROWS_S / 16;
    const bool prompt = part == 1; const int ntp = prompt ? NT_P : NT_S;
    for (int task = gw; task < 2 * ntp; task += NGW) {
        const int kv = task / ntp, r0 = (task % ntp) * 16;
        const int prow = (prompt ? r0 : CMP_ROWS_P + r0) + ml; const int nimask = prompt ? 255 : 127;
        const int ro = r0 + ml, i_blk = (ro >> 2) & nimask; const bool valid = i_blk < nimask;
        const float* plo = P + (size_t)kv * CMP_ROWS * 256 + (size_t)prow * 256 + 8 * fq; const float* phi = plo + 4 * 256 + 128;
        f32x4 lo[4][2], hi[4][2];
#pragma unroll
        for (int ks = 0; ks < 4; ++ks) { lo[ks][0] = *(const f32x4*)(plo + 32 * ks); lo[ks][1] = *(const f32x4*)(plo + 32 * ks + 4); hi[ks][0] = *(const f32x4*)(phi + 32 * ks); hi[ks][1] = *(const f32x4*)(phi + 32 * ks + 4); }
        bf16x8 hb[4];
#pragma unroll
        for (int ks = 0; ks < 4; ++ks) { f32x4 z[2];
#pragma unroll
            for (int e = 0; e < 2; ++e) { z[e] = lo[ks][e] + hi[ks][e] + *(const LAS f32x4*)(CBL + kv * 128 + 32 * ks + 8 * fq + 4 * e);
#pragma unroll
                for (int q = 0; q < 4; ++q) { const float zz = z[e][q]; z[e][q] = valid ? zz / (1.0f + __expf(-zz)) : 0.f; } }
            hb[ks] = cvt8(z[0], z[1]); }
#pragma unroll
        for (int db = 0; db < 4; ++db) { f32x4 acc = (f32x4){0.f, 0.f, 0.f, 0.f};
#pragma unroll
            for (int ks = 0; ks < 4; ++ks) { const bf16x8 a = *(const LAS bf16x8*)(W2T + (kv * 64 + 16 * db + ml) * W2T_STR + 32 * ks + 8 * fq); acc = __builtin_amdgcn_mfma_f32_16x16x32_bf16(a, hb[ks], acc, 0, 0, 0); }
            const int g = ro & 3, d0 = 16 * db + 4 * fq;
            if (prompt) { const int b = ro >> 10; v2u o; o.x = cvtpk(acc[0], acc[1]); o.y = cvtpk(acc[2], acc[3]); *(v2u*)(KC + ((size_t)((kv * 4 + b) * 4 + g) * 256 + i_blk) * 64 + d0) = o; }
            else { const int b = ro >> 9; *(f32x4*)(KCS + ((size_t)((kv * 128 + b) * 4 + g) * 128 + i_blk) * 64 + d0) = acc; } }
    }
}

constexpr int VSTR = 192;
constexpr int AT_K = 0, AT_V = 64 * KSTR, AT_BUF = 64 * KSTR + 64 * VSTR  , AT_T = 2 * AT_BUF, AT_TS = 66, AT_U = AT_T + 64 * AT_TS * 4, AT_SEL = AT_U + 64 * AT_TS * 4, AT_WUNI = AT_SEL + 512, AT_END = AT_WUNI + 64;
static_assert(AT_END <= RING_BYTES, "attention LDS");

__device__ __forceinline__ v4i16_t vtr(const LAS unsigned char* p) { return __builtin_amdgcn_ds_read_tr16_b64_v4i16((LAS v4i16_t*)p); }

struct KvRegs { v4u k, v; };
__device__ __forceinline__ void load_kv(Frame& F, KvRegs& R, const bf16* ksrc, const bf16* vsrc, int pitch) {
    const int key = F.tid >> 3, ch = F.tid & 7;
    R.k = *(const v4u*)(ksrc + (size_t)key * pitch + ch * 8);
    R.v = *(const v4u*)(vsrc + (size_t)key * pitch + ch * 8);
}
__device__ __forceinline__ void store_kv(Frame& F, const KvRegs& R, int buf) {
    const int key = F.tid >> 3, ch = F.tid & 7;
    *(LAS v4u*)(F.lds + buf * AT_BUF + AT_K + key * KSTR + ch * 16) = R.k;
    *(LAS v4u*)(F.lds + buf * AT_BUF + AT_V + key * VSTR + ch * 16) = R.v;
}

constexpr float ATT_THR = 8.0f;
template <int MODE>
__device__ __forceinline__ void attn_tile(Frame& F, bool MASKED, int buf, const bf16x8 (&qf)[4], int relb, float slope2, bool rowok, float& m, float& l, bool& any, f32x16& o0, f32x16& o1,
                                          float mfin, float invl, LAS float* Tq, LAS float* Uq, int sig0) {
    const int lane = F.lane, r = lane & 31, h = lane >> 5;
    const LAS unsigned char* Kt = F.lds + buf * AT_BUF + AT_K; const LAS unsigned char* Vt = F.lds + buf * AT_BUF + AT_V;
    constexpr int PM = (MODE <= 1) ? 16 : 1;
    const float NEG = -INFINITY;
    float c0 = slope2 * (float)relb - ((MODE == 1) ? mfin : m);
    if (!rowok) c0 = NEG;
    const float k32 = slope2 * (float)(32 * PM);
    f32x16 p0, p1;
#pragma unroll
    for (int i = 0; i < 16; ++i) { p0[i] = fmaf(slope2, (float)(PM * ((i & 3) + 8 * (i >> 2))), c0); p1[i] = p0[i] + k32; }
#pragma unroll
    for (int ks = 0; ks < 4; ++ks) {
        const bf16x8 a0 = *(const LAS bf16x8*)(Kt + r * KSTR + ks * 32 + h * 16);
        const bf16x8 a1 = *(const LAS bf16x8*)(Kt + (32 + r) * KSTR + ks * 32 + h * 16);
        p0 = __builtin_amdgcn_mfma_f32_32x32x16_bf16(a0, qf[ks], p0, 0, 0, 0);
        p1 = __builtin_amdgcn_mfma_f32_32x32x16_bf16(a1, qf[ks], p1, 0, 0, 0);
    }
    if (MASKED) {
#pragma unroll
        for (int i = 0; i < 16; ++i) {
            const int kofs = PM * ((i & 3) + 8 * (i >> 2));
            const int rel0 = relb + kofs, rel1 = rel0 + PM * 32;
            bool ok0 = rel0 <= 0, ok1 = rel1 <= 0;
            if (MODE == 3) { ok0 = ok0 && rel0 > -512; ok1 = ok1 && rel1 > -512; }
            p0[i] = ok0 ? p0[i] : NEG; p1[i] = ok1 ? p1[i] : NEG;
        }
    }
    if (MODE == 1) {
#pragma unroll
        for (int i = 0; i < 16; ++i) { p0[i] = __builtin_amdgcn_exp2f(p0[i]) * invl; p1[i] = __builtin_amdgcn_exp2f(p1[i]) * invl; }
#pragma unroll
        for (int hf = 0; hf < 2; ++hf)
#pragma unroll
            for (int g4 = 0; g4 < 4; ++g4) {
                const float pa = hf ? p1[4 * g4] : p0[4 * g4], pb = hf ? p1[4 * g4 + 1] : p0[4 * g4 + 1], pc = hf ? p1[4 * g4 + 2] : p0[4 * g4 + 2], pd = hf ? p1[4 * g4 + 3] : p0[4 * g4 + 3];
                float tv = 2.f * ((pa + pb) + pc) + pd, uv = pd;
                tv += __shfl_xor(tv, 1); uv += __shfl_xor(uv, 1); tv += __shfl_xor(tv, 2); uv += __shfl_xor(uv, 2);
                const int sg = sig0 + 8 * hf + 2 * g4 + h;
                if ((lane & 3) == 0) { Tq[sg] = tv; Uq[sg + 1] = uv; }
            }
    } else {
        float mxa = fmaxf(fmaxf(p0[0], p0[1]), p1[0]), mxb = fmaxf(fmaxf(p0[2], p0[3]), p1[1]); mxa = fmaxf(fmaxf(mxa, p1[2]), p1[3]);
#pragma unroll
        for (int i = 4; i < 16; i += 4) { mxa = fmaxf(fmaxf(mxa, p0[i]), p0[i + 1]); mxb = fmaxf(fmaxf(mxb, p0[i + 2]), p0[i + 3]); mxa = fmaxf(fmaxf(mxa, p1[i]), p1[i + 1]); mxb = fmaxf(fmaxf(mxb, p1[i + 2]), p1[i + 3]); }
        float mx = fmaxf(mxa, mxb); mx = fmaxf(mx, __shfl_xor(mx, 32));
        const bool need = (mx > ATT_THR) || (!any && mx > NEG);
        if (__any(need)) {
            const float dl = need ? mx : 0.f; const float f = any ? __builtin_amdgcn_exp2f(-dl) : 1.f;
            m += dl; l *= f;
#pragma unroll
            for (int i = 0; i < 16; ++i) { p0[i] -= dl; p1[i] -= dl; }
            if (MODE >= 2) {
#pragma unroll
                for (int i = 0; i < 16; ++i) { o0[i] *= f; o1[i] *= f; } }
        }
        any = any || (mx > NEG);
        float rs0 = 0.f, rs1 = 0.f;
#pragma unroll
        for (int i = 0; i < 16; ++i) { p0[i] = __builtin_amdgcn_exp2f(p0[i]); p1[i] = __builtin_amdgcn_exp2f(p1[i]); rs0 += p0[i]; rs1 += p1[i]; }
        l += rs0 + rs1;
        if (MODE == 0) return;
    }
    const LAS unsigned char* vb = Vt + (((lane & 15) >> 2) + 4 * h) * VSTR + (16 * ((lane >> 4) & 1) + 4 * (lane & 3)) * 2;
#pragma unroll
    for (int sp = 0; sp < 4; ++sp) {
        v4u pw;
        if (sp < 2) { const int b8 = 8 * sp; pw.x = cvtpk(p0[b8], p0[b8 + 1]); pw.y = cvtpk(p0[b8 + 2], p0[b8 + 3]); pw.z = cvtpk(p0[b8 + 4], p0[b8 + 5]); pw.w = cvtpk(p0[b8 + 6], p0[b8 + 7]); }
        else { const int b8 = 8 * (sp - 2); pw.x = cvtpk(p1[b8], p1[b8 + 1]); pw.y = cvtpk(p1[b8 + 2], p1[b8 + 3]); pw.z = cvtpk(p1[b8 + 4], p1[b8 + 5]); pw.w = cvtpk(p1[b8 + 6], p1[b8 + 7]); }
        const bf16x8 pbf = __builtin_bit_cast(bf16x8, pw);
#pragma unroll
        for (int db = 0; db < 2; ++db) {
            const v4i16_t lo = vtr(vb + (16 * sp) * VSTR + 64 * db), hi = vtr(vb + (16 * sp + 8) * VSTR + 64 * db);
            const bf16x8 vf = (bf16x8){lo[0], lo[1], lo[2], lo[3], hi[0], hi[1], hi[2], hi[3]};
            if (db == 0) o0 = __builtin_amdgcn_mfma_f32_32x32x16_bf16(vf, pbf, o0, 0, 0, 0);
            else o1 = __builtin_amdgcn_mfma_f32_32x32x16_bf16(vf, pbf, o1, 0, 0, 0);
        }
    }
}

struct BgCopy {
    size_t base; int k, pend; f32x4 v0;
    __device__ __forceinline__ void init(Frame& F) { const int b = F.vcu >> 1, hb = F.vcu & 1; k = (F.G == 256) ? 0 : 64; pend = 0; base = (size_t)b * 65536 + hb * 32704; }
    __device__ __forceinline__ void step(Frame& F) {
        const f32x4* src = (const f32x4*)F.state_win + base + 128 + F.tid; f32x4* dst = (f32x4*)(F.out + OUT_WIN_S) + base + F.tid;
        if (pend) { if (k - 1 < 63 || F.tid < 448) dst[512 * (k - 1)] = v0; pend = 0; }
        if (k < 64) { if (k < 63 || F.tid < 448) v0 = src[512 * k]; k += 1; pend = 1; }
    }
    __device__ __forceinline__ void finish(Frame& F) { while (k < 64 || pend) step(F); }
};

__device__ __forceinline__ void attn_prompt_unit(Frame& F, BgCopy& BG, int b, int g, int qb) {
    const int lane = F.lane, r = lane & 31, h = lane >> 5, w = F.wave;
    const int c0 = qb * 64, cur = qb, ql = 8 * w + (r >> 2), tq = c0 + ql, hd = g * 4 + (r & 3);
    const bf16* Q = WSP(bf16, WS_Q); const bf16* KVS = WSP(bf16, WS_KVS); const bf16* KVW = WSP(bf16, WS_KVW); const bf16* KC = WSP(bf16, WS_KC); const float* GATE = WSP(float, WS_GATE);
    bf16* O = WSP(bf16, WS_DIFF);
    const size_t row = (size_t)b * SEQ + tq;
    bf16x8 qf[4];
#pragma unroll
    for (int ks = 0; ks < 4; ++ks) qf[ks] = *(const bf16x8*)(Q + row * D + hd * 64 + ks * 16 + h * 8);
    const float slope2 = exp2f(-0.5f * (float)(hd + 1)) * LOG2E;
    const float g0 = GATE[row * 48 + hd * 3 + 0], g1 = GATE[row * 48 + hd * 3 + 1], g2 = GATE[row * 48 + hd * 3 + 2];
    LAS float* T = (LAS float*)(F.lds + AT_T); LAS float* U = (LAS float*)(F.lds + AT_U);
    LAS unsigned* SELM = (LAS unsigned*)(F.lds + AT_SEL); LAS unsigned* WUNI = (LAS unsigned*)(F.lds + AT_WUNI);
    for (int i = F.tid; i < 2 * 64 * AT_TS; i += 512) T[i] = 0.f;
    f32x16 of0, of1, o0, o1;
#pragma unroll
    for (int i = 0; i < 16; ++i) { of0[i] = 0.f; of1[i] = 0.f; o0[i] = 0.f; o1[i] = 0.f; }
    const float NEG = -INFINITY;
    const int nmax = c0 / 16 + 2;
    const int ntile = (nmax >= 255 ? 254 : nmax) / 64 + 1;
    const bf16* kc = KC + (size_t)((0 * 4 + b) * 4 + g) * 256 * 64; const bf16* vc = KC + (size_t)((1 * 4 + b) * 4 + g) * 256 * 64;
    float m = 0.f, l = 0.f; bool any = false;
    KvRegs R; int cb = 0;
    load_kv(F, R, kc, vc, 64); __syncthreads(); store_kv(F, R, 0); __syncthreads();
    for (int tl = 0; tl < ntile; ++tl) {
        const bool more = tl + 1 < ntile; BG.step(F);
        if (more) load_kv(F, R, kc + (size_t)(tl + 1) * 64 * 64, vc + (size_t)(tl + 1) * 64 * 64, 64); else load_kv(F, R, kc, vc, 64);
        attn_tile<0>(F, !(1024 * tl + 1039 <= c0 + 8 * w), cb, qf, 16 * 64 * tl + 31 + 16 * 4 * h - tq, slope2, true, m, l, any, o0, o1, 0.f, 0.f, nullptr, nullptr, 0);
        store_kv(F, R, cb ^ 1); __syncthreads(); cb ^= 1;
    }
    { const float lt = l + __shfl_xor(l, 32); const float invl = lt > 0.f ? 1.0f / lt : 0.f;
      LAS float* Tq = T + ql * AT_TS; LAS float* Uq = U + ql * AT_TS;
      for (int tl = 0; tl < ntile; ++tl) {
          const bool more = tl + 1 < ntile;
          if (more) load_kv(F, R, kc + (size_t)(tl + 1) * 64 * 64, vc + (size_t)(tl + 1) * 64 * 64, 64);
          attn_tile<1>(F, !(1024 * tl + 1039 <= c0 + 8 * w), cb, qf, 16 * 64 * tl + 31 + 16 * 4 * h - tq, slope2, true, m, l, any, o0, o1, m, invl, Tq, Uq, 16 * tl);
          if (more) { store_kv(F, R, cb ^ 1); __syncthreads(); cb ^= 1; }
      }
#pragma unroll
      for (int i = 0; i < 16; ++i) { of0[i] = g0 * o0[i]; of1[i] = g0 * o1[i]; o0[i] = 0.f; o1[i] = 0.f; } }
    __syncthreads();
    unsigned long long wuni = 0ull;
    for (int qq = 8 * w; qq < 8 * w + 8; ++qq) {
        unsigned long long msk;
        if (cur <= 15) msk = (cur == 63) ? ~0ull : ((1ull << (cur + 1)) - 1ull);
        else {
            const float v = T[qq * AT_TS + lane] + U[qq * AT_TS + lane];
            T[qq * AT_TS + lane] = v;
            LDS_WAIT(); asm volatile("" ::: "memory");
            int rank = 0;
            for (int s2 = 1; s2 <= cur - 2; ++s2) { const float o = T[qq * AT_TS + s2]; rank += (o > v || (o == v && s2 < lane)) ? 1 : 0; }
            const bool sel = (lane <= cur) && (lane == 0 || lane >= cur - 1 || rank < 13);
            msk = __ballot(sel);
        }
        if (lane == 0) { SELM[2 * qq] = (unsigned)msk; SELM[2 * qq + 1] = (unsigned)(msk >> 32); }
        wuni |= msk;
    }
    wuni = ((unsigned long long)(unsigned)__builtin_amdgcn_readfirstlane((int)(unsigned)(wuni >> 32)) << 32) | (unsigned long long)(unsigned)__builtin_amdgcn_readfirstlane((int)(unsigned)wuni);
    if (lane == 0) { WUNI[2 * w] = (unsigned)wuni; WUNI[2 * w + 1] = (unsigned)(wuni >> 32); }
    __syncthreads();
    unsigned long long guni = 0ull;
#pragma unroll
    for (int i = 0; i < 8; ++i) guni |= (unsigned long long)WUNI[2 * i] | ((unsigned long long)WUNI[2 * i + 1] << 32);
    const unsigned long long mym = (unsigned long long)SELM[2 * ql] | ((unsigned long long)SELM[2 * ql + 1] << 32);
    m = 0.f; l = 0.f; any = false;
    { const bf16* ks = KVS + (size_t)b * SEQ * 512 + g * 64; const bf16* vs = ks + 256;
      unsigned long long rem = guni;
      int s = __builtin_ctzll(rem); rem &= rem - 1ull;
      load_kv(F, R, ks + (size_t)s * 64 * 512, vs + (size_t)s * 64 * 512, 512); __syncthreads(); store_kv(F, R, 0); __syncthreads(); cb = 0;
      for (;;) {
          const bool more = rem != 0ull; const int sn = more ? __builtin_ctzll(rem) : 0; rem &= rem - 1ull; BG.step(F);
          if (more) load_kv(F, R, ks + (size_t)sn * 64 * 512, vs + (size_t)sn * 64 * 512, 512);
          if ((wuni >> s) & 1ull) attn_tile<2>(F, s == cur, cb, qf, 64 * s + 4 * h - tq, slope2, ((mym >> s) & 1ull) != 0ull, m, l, any, o0, o1, 0.f, 0.f, nullptr, nullptr, 0);
          if (!more) break;
          store_kv(F, R, cb ^ 1); __syncthreads(); cb ^= 1; s = sn;
      }
      const float lt = l + __shfl_xor(l, 32); const float sc = lt > 0.f ? g1 / lt : 0.f;
#pragma unroll
      for (int i = 0; i < 16; ++i) { of0[i] += sc * o0[i]; of1[i] += sc * o1[i]; o0[i] = 0.f; o1[i] = 0.f; } }
    m = 0.f; l = 0.f; any = false;
    { const bf16* kw = KVW + (size_t)b * SEQ * 512 + g * 64; const bf16* vw = kw + 256;
      const int j0 = (c0 >= 512) ? 0 : (512 - c0) / 64;
      { const int pos0 = c0 - 512 + 64 * j0; load_kv(F, R, kw + (size_t)pos0 * 512, vw + (size_t)pos0 * 512, 512); __syncthreads(); store_kv(F, R, 0); __syncthreads(); cb = 0; }
      for (int j = j0; j < 9; ++j) {
          const int pos0 = c0 - 512 + 64 * j; const bool more = j + 1 < 9; BG.step(F);
          if (more) load_kv(F, R, kw + (size_t)(pos0 + 64) * 512, vw + (size_t)(pos0 + 64) * 512, 512);
          attn_tile<3>(F, j == 0 || j == 8, cb, qf, pos0 + 4 * h - tq, slope2, true, m, l, any, o0, o1, 0.f, 0.f, nullptr, nullptr, 0);
          if (more) { store_kv(F, R, cb ^ 1); __syncthreads(); cb ^= 1; }
      }
      const float lt = l + __shfl_xor(l, 32); const float sc = lt > 0.f ? g2 / lt : 0.f;
#pragma unroll
      for (int i = 0; i < 16; ++i) { of0[i] += sc * o0[i]; of1[i] += sc * o1[i]; } }
    bf16* orow = O + row * D + hd * 64;
#pragma unroll
    for (int g4 = 0; g4 < 4; ++g4) {
        v2u a; a.x = cvtpk(of0[4 * g4], of0[4 * g4 + 1]); a.y = cvtpk(of0[4 * g4 + 2], of0[4 * g4 + 3]);
        v2u c; c.x = cvtpk(of1[4 * g4], of1[4 * g4 + 1]); c.y = cvtpk(of1[4 * g4 + 2], of1[4 * g4 + 3]);
        *(v2u*)(orow + 8 * g4 + 4 * h) = a; *(v2u*)(orow + 32 + 8 * g4 + 4 * h) = c;
    }
    __syncthreads();
}

constexpr int SA_QS = 0, SA_SC = 1024, SA_NK = 1664, SA_IMP = SA_SC + SA_NK * 16, SA_LIST = SA_IMP + 256, SA_BLK = SA_LIST + 64, SA_RED = SA_BLK + 128, SA_END = SA_RED + 512 * 64;
constexpr int SK_CMP = 0, SK_SEL = 128, SK_WIN = 1088, SK_NSEL = 1600, SK_NWIN = 1601;
static_assert(SA_END <= RING_BYTES, "sample attention LDS");

__device__ __forceinline__ f32x4 wave_max4(f32x4 v) {
#pragma unroll
    for (int o = 1; o < 64; o <<= 1) { v[0] = fmaxf(v[0], __shfl_xor(v[0], o)); v[1] = fmaxf(v[1], __shfl_xor(v[1], o)); v[2] = fmaxf(v[2], __shfl_xor(v[2], o)); v[3] = fmaxf(v[3], __shfl_xor(v[3], o)); }
    return v;
}
__device__ __forceinline__ f32x4 wave_sum4(f32x4 v) {
#pragma unroll
    for (int o = 1; o < 64; o <<= 1) { v[0] += __shfl_xor(v[0], o); v[1] += __shfl_xor(v[1], o); v[2] += __shfl_xor(v[2], o); v[3] += __shfl_xor(v[3], o); }
    return v;
}
__device__ __forceinline__ void sa_softmax4(LAS f32x4* SC, int k0, int nk, int kx, f32x4 post, int lane) {
    f32x4 mx = (f32x4){-INFINITY, -INFINITY, -INFINITY, -INFINITY};
    for (int i = lane; i < nk; i += 64) { const f32x4 s = SC[k0 + i]; mx[0] = fmaxf(mx[0], s[0]); mx[1] = fmaxf(mx[1], s[1]); mx[2] = fmaxf(mx[2], s[2]); mx[3] = fmaxf(mx[3], s[3]); }
    if (kx >= 0) { const f32x4 s = SC[kx]; mx[0] = fmaxf(mx[0], s[0]); mx[1] = fmaxf(mx[1], s[1]); mx[2] = fmaxf(mx[2], s[2]); mx[3] = fmaxf(mx[3], s[3]); }
    mx = wave_max4(mx);
#pragma unroll
    for (int q = 0; q < 4; ++q) if (mx[q] == -INFINITY) mx[q] = 0.f;
    f32x4 sum = (f32x4){0.f, 0.f, 0.f, 0.f};
    for (int i = lane; i < nk; i += 64) { f32x4 s = SC[k0 + i];
#pragma unroll
        for (int q = 0; q < 4; ++q) s[q] = __builtin_amdgcn_exp2f(s[q] - mx[q]);
        SC[k0 + i] = s; sum += s; }
    sum = wave_sum4(sum);
    f32x4 ex = (f32x4){0.f, 0.f, 0.f, 0.f};
    if (kx >= 0) { const f32x4 s = SC[kx];
#pragma unroll
        for (int q = 0; q < 4; ++q) ex[q] = __builtin_amdgcn_exp2f(s[q] - mx[q]);
        sum += ex; }
    f32x4 sc;
#pragma unroll
    for (int q = 0; q < 4; ++q) sc[q] = sum[q] > 0.f ? post[q] / sum[q] : 0.f;
    LDS_WAIT(); asm volatile("" ::: "memory");
    for (int i = lane; i < nk; i += 64) SC[k0 + i] = SC[k0 + i] * sc;
    if (kx >= 0 && lane == 0) SC[kx] = ex * sc;
}

#define SA_LOADK(dst, kr) do { dst[0] = *(const f32x4*)(kr); dst[1] = *(const f32x4*)((kr) + 4); dst[2] = *(const f32x4*)((kr) + 32); dst[3] = *(const f32x4*)((kr) + 36); } while (0)
#define SA_SCORE(acc, kf) do { acc = __builtin_amdgcn_mfma_f32_16x16x32_bf16(af[0], cvt8(kf[0], kf[1]), (f32x4){0.f, 0.f, 0.f, 0.f}, 0, 0, 0); acc = __builtin_amdgcn_mfma_f32_16x16x32_bf16(af[1], cvt8(kf[2], kf[3]), acc, 0, 0, 0); } while (0)

__device__ __forceinline__ void attn_sample_unit(Frame& F, int b, int g) {
    const int tid = F.tid, lane = F.lane, w = F.wave; const int row = MP + b;
    const bf16* Q = WSP(bf16, WS_Q); const bf16* KVS = WSP(bf16, WS_KVS); const bf16* KVW = WSP(bf16, WS_KVW); const float* KCS = WSP(float, WS_KCS); const float* GATE = WSP(float, WS_GATE);
    bf16* O = WSP(bf16, WS_DIFF);
    LAS f32x4* SC = (LAS f32x4*)(F.lds + SA_SC); LAS float* IMP = (LAS float*)(F.lds + SA_IMP);
    LAS int* LIST = (LAS int*)(F.lds + SA_LIST); LAS int* BLK = (LAS int*)(F.lds + SA_BLK); LAS float* RED = (LAS float*)(F.lds + SA_RED);
    const float* kc = KCS + (size_t)((0 * 128 + b) * 4 + g) * 128 * 64; const float* vc = KCS + (size_t)((1 * 128 + b) * 4 + g) * 128 * 64;
    const float* sw = F.state_win + (size_t)b * 512 * 512;
    __syncthreads();
    bf16x8 af[2];
#pragma unroll
    for (int ks = 0; ks < 2; ++ks) { af[ks] = (bf16x8){0, 0, 0, 0, 0, 0, 0, 0}; if ((lane & 15) < 4) af[ks] = *(const bf16x8*)(Q + (size_t)row * D + (g * 4 + (lane & 15)) * 64 + 32 * ks + 8 * (lane >> 4)); }
    f32x4 sl2;
#pragma unroll
    for (int i = 0; i < 4; ++i) sl2[i] = exp2f(-0.5f * (float)(g * 4 + i + 1)) * LOG2E;
    f32x4 gt0, gt1, gt2;
    { const float* gp = GATE + (size_t)row * 48 + g * 12;
#pragma unroll
      for (int i = 0; i < 4; ++i) { gt0[i] = gp[i * 3 + 0]; gt1[i] = gp[i * 3 + 1]; gt2[i] = gp[i * 3 + 2]; } }
    const int kl = lane & 15, kc8 = 8 * (lane >> 4);
    { f32x4 kf[5][4];
      { const float* kr = kc + (size_t)(16 * w + kl) * 64 + kc8; SA_LOADK(kf[0], kr); }
#pragma unroll
      for (int j = 1; j < 5; ++j) { const float* kr = sw + (size_t)(16 * (w + 8 * (j - 1)) + kl) * 512 + g * 64 + kc8; SA_LOADK(kf[j], kr); }
      f32x4 acc;
      SA_SCORE(acc, kf[0]);
      if (lane < 16) { const int n = 16 * w + kl; const float rel = (float)(16 * n + 31 - PAST); f32x4 s;
#pragma unroll
          for (int i = 0; i < 4; ++i) s[i] = (n < 127) ? acc[i] + sl2[i] * rel : -INFINITY;
          SC[SK_CMP + n] = s; }
#pragma unroll
      for (int j = 1; j < 5; ++j) { SA_SCORE(acc, kf[j]);
          if (lane < 16) { const int i2 = 16 * (w + 8 * (j - 1)) + kl; const float rel = (float)(i2 - 512); f32x4 s;
#pragma unroll
              for (int i = 0; i < 4; ++i) s[i] = (i2 >= 1) ? acc[i] + sl2[i] * rel : -INFINITY;
              SC[SK_WIN + i2] = s; } }
      if (w == 7) {
          f32x4 a, c2; const float kwn = bf2f(KVW[(size_t)row * 512 + g * 64 + lane]), ksn = bf2f(KVS[(size_t)row * 512 + g * 64 + lane]);
#pragma unroll
          for (int i = 0; i < 4; ++i) { const float qv = bf2f(Q[(size_t)row * D + (g * 4 + i) * 64 + lane]); a[i] = qv * kwn; c2[i] = qv * ksn; }
          a = wave_sum4(a); c2 = wave_sum4(c2);
          if (lane == 0) { SC[SK_NWIN] = a; SC[SK_NSEL] = c2; }
      }
    }
    __syncthreads();
    if (w == 0) {
        sa_softmax4(SC, SK_CMP, 128, -1, (f32x4){1.f, 1.f, 1.f, 1.f}, lane);
        LDS_WAIT(); asm volatile("" ::: "memory");
        if (lane < 33) { float a = 0.f;
#pragma unroll
            for (int dn = -1; dn <= 3; ++dn) { const int n = 4 * lane + dn; if (n >= 0 && n < 127) { const f32x4 p = SC[SK_CMP + n]; a += ((dn == -1 || dn == 3) ? 1.f : 2.f) * ((p[0] + p[1]) + (p[2] + p[3])); } }
            IMP[lane] = a; }
        LDS_WAIT(); asm volatile("" ::: "memory");
        const float v = (lane <= 32) ? IMP[lane] : 0.f; int rank = 0;
        for (int s2 = 1; s2 <= 30; ++s2) { const float o = IMP[s2]; rank += (o > v || (o == v && s2 < lane)) ? 1 : 0; }
        const bool sel = (lane == 0) || (lane == 31) || (lane >= 1 && lane <= 30 && rank < 13);
        const unsigned long long msk = __ballot(sel);
        if (sel) { const int pos = __builtin_popcountll(msk & ((1ull << lane) - 1ull)); LIST[pos] = lane;
            const int page = F.page_table[b * 16 + (lane >> 1)]; BLK[pos] = page * 128 + (lane & 1) * 64; }
        LDS_WAIT(); asm volatile("" ::: "memory");
        for (int i = lane; i < 128; i += 64) SC[SK_CMP + i] = SC[SK_CMP + i] * gt0;
    }
    __syncthreads();
#pragma unroll
    for (int bt = 0; bt < 2; ++bt) {
        f32x4 kf[4][4];
#pragma unroll
        for (int j = 0; j < 4; ++j) { const int st = w + 8 * (4 * bt + j); if (st < 60) { const int bi = st >> 2, kk = 16 * (st & 3) + kl;
            const float* kr = F.cache + ((size_t)(BLK[bi] + kk) * 4 + 2) * 256 + g * 64 + kc8; SA_LOADK(kf[j], kr); } }
#pragma unroll
        for (int j = 0; j < 4; ++j) { const int st = w + 8 * (4 * bt + j); if (st < 60) { const int bi = st >> 2, kk = 16 * (st & 3) + kl; f32x4 acc; SA_SCORE(acc, kf[j]);
            if (lane < 16) { const float rel = (float)(64 * LIST[bi] + kk - PAST); f32x4 s;
#pragma unroll
                for (int i = 0; i < 4; ++i) s[i] = acc[i] + sl2[i] * rel;
                SC[SK_SEL + 64 * bi + kk] = s; } } }
    }
    if (w == 1) sa_softmax4(SC, SK_WIN, 512, SK_NWIN, gt2, lane);
    __syncthreads();
    if (w == 0) sa_softmax4(SC, SK_SEL, 960, SK_NSEL, gt1, lane);
    __syncthreads();
    { const int kq = lane >> 4, c4 = 4 * (lane & 15);
      f32x4 acc[4];
#pragma unroll
      for (int i = 0; i < 4; ++i) acc[i] = (f32x4){0.f, 0.f, 0.f, 0.f};
      { f32x4 vv[4];
#pragma unroll
        for (int it = 0; it < 4; ++it) vv[it] = *(const f32x4*)(vc + (size_t)(32 * it + 4 * w + kq) * 64 + c4);
#pragma unroll
        for (int it = 0; it < 4; ++it) { const f32x4 p = SC[SK_CMP + 32 * it + 4 * w + kq];
#pragma unroll
            for (int i = 0; i < 4; ++i) acc[i] += vv[it] * p[i]; } }
#pragma unroll
      for (int bt = 0; bt < 2; ++bt) { f32x4 vv[8];
#pragma unroll
        for (int j = 0; j < 8; ++j) vv[j] = *(const f32x4*)(sw + (size_t)(32 * (8 * bt + j) + 4 * w + kq) * 512 + 256 + g * 64 + c4);
#pragma unroll
        for (int j = 0; j < 8; ++j) { const f32x4 p = SC[SK_WIN + 32 * (8 * bt + j) + 4 * w + kq];
#pragma unroll
            for (int i = 0; i < 4; ++i) acc[i] += vv[j] * p[i]; } }
#pragma unroll
      for (int bt = 0; bt < 3; ++bt) { f32x4 vv[10];
#pragma unroll
        for (int j = 0; j < 10; ++j) { const int k = 32 * (10 * bt + j) + 4 * w + kq; vv[j] = *(const f32x4*)(F.cache + ((size_t)(BLK[k >> 6] + (k & 63)) * 4 + 3) * 256 + g * 64 + c4); }
#pragma unroll
        for (int j = 0; j < 10; ++j) { const f32x4 p = SC[SK_SEL + 32 * (10 * bt + j) + 4 * w + kq];
#pragma unroll
            for (int i = 0; i < 4; ++i) acc[i] += vv[j] * p[i]; } }
#pragma unroll
      for (int i = 0; i < 4; ++i) *(LAS f32x4*)(RED + tid * 16 + 4 * i) = acc[i];
    }
    __syncthreads();
    if (tid < 256) { const int hd = tid >> 6, d = tid & 63; float a = 0.f;
#pragma unroll 8
        for (int j = 0; j < 32; ++j) a += RED[((j >> 2) * 64 + (j & 3) * 16 + (d >> 2)) * 16 + hd * 4 + (d & 3)];
        { const f32x4 ps = SC[SK_NSEL], pw = SC[SK_NWIN];
          a += ps[hd] * bf2f(KVS[(size_t)row * 512 + 256 + g * 64 + d]) + pw[hd] * bf2f(KVW[(size_t)row * 512 + 256 + g * 64 + d]); }
        O[(size_t)row * D + (g * 4 + hd) * 64 + d] = (bf16)f2bf(a); }
    __syncthreads();
}

__device__ __forceinline__ void p7_attention(Frame& F) {
    BgCopy BG; BG.init(F);
    const bool sfirst = (blockIdx.x & 1) == 0;
    if (sfirst) for (int i = F.vcu; i < DB * 4; i += F.G) attn_sample_unit(F, i >> 2, i & 3);
    for (int i = F.vcu; i < 1024; i += F.G) { const int k = i >> 8, c = i & 255, bg = c >> 4, s = c & 15; const int qb = (k == 0) ? s : (k == 1) ? 31 - s : (k == 2) ? 32 + s : 63 - s;
        attn_prompt_unit(F, BG, bg >> 2, bg & 3, qb); }
    BG.finish(F);
    if (!sfirst) for (int i = F.vcu; i < DB * 4; i += F.G) attn_sample_unit(F, i >> 2, i & 3);
}

enum { SG_POOL = 0, SG_UP = 1, SG_DOWN = 2, SG_KVQG = 3, SG_WO = 4 };
constexpr int SG_RED = 0, SG_SSQ = 8 * 16 * 64 * 4;
template <int KIND>
__device__ __forceinline__ void small_gemm(Frame& F, int layer) {
    constexpr bool F32B = (KIND == SG_UP || KIND == SG_KVQG);
    constexpr int KR = (KIND == SG_POOL) ? 256 : 1024;
    constexpr int KSPLIT = (KIND == SG_DOWN) ? 4 : 1;
    constexpr int NSL = (KIND == SG_POOL) ? 32 : (KIND == SG_UP) ? 128 : (KIND == SG_KVQG) ? 82 : 32;
    constexpr int KW = KR / 8, NKS = KW / 16;
    const int lane = F.lane, w = F.wave, r = lane & 31, h = lane >> 5;
    float* X = WSP(float, WS_X);
    LAS float* RED = (LAS float*)(F.lds + SG_RED); LAS float* SSQ = (LAS float*)(F.lds + SG_SSQ);
    for (int item = F.vcu; item < NSL * 4 * KSPLIT; item += F.G) {
        const int kr = item % KSPLIT, tt = item / KSPLIT, rbk = tt & 3, ns = tt >> 2;
        const int row = MP + 32 * rbk + r, b = 32 * rbk + r;
        int n0 = ns * 32; const int kb = kr * KR + w * KW + 8 * h;
        const bf16* wrow; const bf16* b16 = nullptr; const float* b32 = nullptr;
        if (KIND == SG_POOL) { const int g = ns >> 3; n0 = (ns & 7) * 32; wrow = WSP(bf16, WS_WPOOL) + (size_t)g * 65536 + (size_t)(n0 + r) * 256 + kb; b16 = WSP(bf16, WS_DIFF) + (size_t)row * D + g * 256 + kb; n0 += g * 256; }
        else if (KIND == SG_UP) { wrow = WSP(bf16, WS_WUP) + (size_t)layer * FF * D + (size_t)(n0 + r) * D + kb; b32 = X + (size_t)row * D + kb; }
        else if (KIND == SG_DOWN) { wrow = WSP(bf16, WS_WDN) + (size_t)layer * D * FF + (size_t)(n0 + r) * FF + kb; b16 = WSP(bf16, WS_H) + (size_t)row * FF + kb; }
        else if (KIND == SG_KVQG) { wrow = WSP(bf16, WS_WKVQG) + (size_t)(n0 + r) * D + kb; b32 = X + (size_t)row * D + kb; }
        else { wrow = WSP(bf16, WS_WO) + (size_t)(n0 + r) * D + kb; b16 = WSP(bf16, WS_DIFF) + (size_t)row * D + kb; }
        bf16x8 a[NKS], bb[NKS]; f32x4 x0[NKS], x1[NKS];
#pragma unroll
        for (int j = 0; j < NKS; ++j) { a[j] = *(const bf16x8*)(wrow + 16 * j);
            if (F32B) { x0[j] = *(const f32x4*)(b32 + 16 * j); x1[j] = *(const f32x4*)(b32 + 16 * j + 4); } else bb[j] = *(const bf16x8*)(b16 + 16 * j); }
        f32x16 acc; float ssq = 0.f;
#pragma unroll
        for (int i = 0; i < 16; ++i) acc[i] = 0.f;
#pragma unroll
        for (int j = 0; j < NKS; ++j) {
            if (F32B) { ssq += (x0[j][0] * x0[j][0] + x0[j][1] * x0[j][1]) + (x0[j][2] * x0[j][2] + x0[j][3] * x0[j][3]) + (x1[j][0] * x1[j][0] + x1[j][1] * x1[j][1]) + (x1[j][2] * x1[j][2] + x1[j][3] * x1[j][3]); bb[j] = cvt8(x0[j], x1[j]); }
            acc = __builtin_amdgcn_mfma_f32_32x32x16_bf16(a[j], bb[j], acc, 0, 0, 0);
        }
        __syncthreads();
#pragma unroll
        for (int i = 0; i < 16; ++i) RED[(w * 16 + i) * 64 + lane] = acc[i];
        if (F32B) SSQ[w * 64 + lane] = ssq;
        __syncthreads();
        if (w < 4) {
            f32x4 v = (f32x4){0.f, 0.f, 0.f, 0.f};
#pragma unroll
            for (int ww = 0; ww < 8; ++ww)
#pragma unroll
                for (int e = 0; e < 4; ++e) v[e] += RED[(ww * 16 + 4 * w + e) * 64 + lane];
            float rstd = 1.f;
            if (F32B) { float q = 0.f;
#pragma unroll
                for (int ww = 0; ww < 8; ++ww) q += SSQ[ww * 64 + r] + SSQ[ww * 64 + 32 + r];
                rstd = 1.0f / sqrtf(q * (1.0f / D) + RMS_EPS); }
            const int col = n0 + 8 * w + 4 * h;
            if (KIND == SG_POOL) {
                *(f32x4*)(X + (size_t)row * D + col) = *(const f32x4*)(F.x_s + (size_t)b * D + col) + v * *(const f32x4*)(F.pool_scale + col);
            } else if (KIND == SG_UP) {
                v = v * rstd;
#pragma unroll
                for (int e = 0; e < 4; ++e) { const float t = fmaxf(v[e], 0.f); v[e] = t * t; }
                v2u o; o.x = cvtpk(v[0], v[1]); o.y = cvtpk(v[2], v[3]); *(v2u*)(WSP(bf16, WS_H) + (size_t)row * FF + col) = o;
            } else if (KIND == SG_DOWN || KIND == SG_WO) {
#pragma unroll
                for (int e = 0; e < 4; ++e) unsafeAtomicAdd(X + (size_t)row * D + col + e, v[e]);
            } else {
                v = v * rstd; v2u o; o.x = cvtpk(v[0], v[1]); o.y = cvtpk(v[2], v[3]);
                if (n0 < 1024) { *(f32x4*)(F.out + OUT_KV_S + (size_t)b * D + col) = v; if (n0 >= 512) *(v2u*)(WSP(bf16, WS_KVS) + (size_t)row * 512 + col - 512) = o; }
                else if (n0 < 1536) { *(v2u*)(WSP(bf16, WS_KVW) + (size_t)row * 512 + col - 1024) = o; *(f32x4*)(F.out + OUT_WIN_S + ((size_t)b * 512 + 511) * 512 + col - 1024) = v; }
                else if (n0 < 2560) { *(v2u*)(WSP(bf16, WS_Q) + (size_t)row * D + col - 1536) = o; }
                else if (col < 2608) { float* gp = WSP(float, WS_GATE) + (size_t)row * 48 + col - 2560;
#pragma unroll
                    for (int e = 0; e < 4; ++e) gp[e] = 1.0f / (1.0f + __expf(-(v[e] + F.b_gate[col - 2560 + e]))); }
            }
        }
    }
    VM_WAIT(); __syncthreads();
}

__device__ __forceinline__ void p11_final(Frame& F) {
    const int gw = F.vcu * NWAVES + F.wave, NGW = F.G * NWAVES, lane = F.lane; const float* X = WSP(float, WS_X); const bf16* XB = WSP(bf16, WS_XB);
    for (int row = gw; row < MT; row += NGW) {
        f32x4 v[4]; float ss = 0.f;
        if (row < MP) { const v2u* xr = (const v2u*)(XB + (size_t)row * D) + lane;
#pragma unroll
            for (int j = 0; j < 4; ++j) { const v2u q = xr[64 * j]; v[j] = (f32x4){__builtin_bit_cast(float, q.x << 16), __builtin_bit_cast(float, q.x & 0xffff0000u), __builtin_bit_cast(float, q.y << 16), __builtin_bit_cast(float, q.y & 0xffff0000u)}; } }
        else { const f32x4* xr = (const f32x4*)(X + (size_t)row * D) + lane;
#pragma unroll
            for (int j = 0; j < 4; ++j) v[j] = xr[64 * j]; }
#pragma unroll
        for (int j = 0; j < 4; ++j) ss += (v[j][0] * v[j][0] + v[j][1] * v[j][1]) + (v[j][2] * v[j][2] + v[j][3] * v[j][3]);
        const float rstd = 1.0f / sqrtf(wave_sum(ss) * (1.0f / D) + RMS_EPS);
        float* o = (row < MP) ? F.out + OUT_Y_P + (size_t)row * D : F.out + OUT_Y_S + (size_t)(row - MP) * D;
#pragma unroll
        for (int j = 0; j < 4; ++j) *((f32x4*)o + lane + 64 * j) = v[j] * rstd * *((const f32x4*)F.norm_final + lane + 64 * j);
    }
}

constexpr int NPHASE = 12;
struct Args { const void* in[21]; float* out; unsigned char* ws; int ph_lo, ph_hi; };
__global__ void __launch_bounds__(NWAVES * 64, 2) yoco_fwd(Args args) {
    extern __shared__ __attribute__((aligned(16))) unsigned char lds[];
    Frame F;
    F.lds = (LAS unsigned char*)lds;
    F.tid = threadIdx.x; F.lane = F.tid & 63; F.wave = __builtin_amdgcn_readfirstlane(F.tid >> 6);
    F.G = gridDim.x; { const int bx = blockIdx.x; F.vcu = (F.G % 8 == 0) ? (bx % 8) * (F.G / 8) + bx / 8 : bx; }
    F.x_p = (const float*)args.in[0]; F.x_s = (const float*)args.in[1]; F.state_pool = (const float*)args.in[2]; F.cache = (const float*)args.in[3]; F.state_win = (const float*)args.in[4];
    F.page_table = (const int*)args.in[5]; F.norm_mix = (const float*)args.in[6]; F.norm_mlp = (const float*)args.in[7]; F.w_up = (const float*)args.in[8]; F.w_down = (const float*)args.in[9];
    F.pool_w = (const float*)args.in[10]; F.pool_scale = (const float*)args.in[11]; F.norm_kv = (const float*)args.in[12]; F.w_kv = (const float*)args.in[13]; F.cmp_pe = (const float*)args.in[14];
    F.cmp_w1 = (const float*)args.in[15]; F.cmp_w2 = (const float*)args.in[16]; F.w_qg = (const float*)args.in[17]; F.b_gate = (const float*)args.in[18]; F.w_o = (const float*)args.in[19];
    F.norm_final = (const float*)args.in[20]; F.out = args.out; F.ws = args.ws;
    volatile LAS unsigned* MISC = (volatile LAS unsigned*)(F.lds + MISC_OFF);
    for (int u = F.tid; u < (LDS_BYTES - RING_BYTES) / 4; u += NWAVES * 64) ((LAS unsigned*)(F.lds + RING_BYTES))[u] = 0u;
    __syncthreads();
    unsigned* ctl = (unsigned*)(F.ws + WS_CTL);
#if MK_MULTI
#define GRID_BAR() do { } while (0)
#else
    XcdBarrier bar = xcd_barrier_post(ctl + CW_BAR, MISC + 8);
#define GRID_BAR() xcd_barrier(bar)
#endif
    const int lo = args.ph_lo, hi = args.ph_hi;
#define IN(k) (lo <= (k) && (k) < hi)
#define SEAM(k) do { if (IN(k) && IN((k) + 1)) GRID_BAR(); } while (0)
    using namespace pg8;
    float* X = WSP(float, WS_X); bf16* XB = WSP(bf16, WS_XB); float* RS = WSP(float, WS_RS);

    if (IN(0)) { for (int rep = 0; rep < REP(0); ++rep) { p0_prologue(F); __syncthreads(); } } SEAM(0);
    if (IN(1)) {
        for (int rep = 0; rep < REP(16); ++rep) small_gemm<SG_POOL>(F, 0);
        Gemm g{WSP(bf16_t, WS_DIFF), WSP(bf16_t, WS_WPOOL), MP, 1024, 256, 1024, 256, (size_t)512}; StaticOrder S; S.init(MP, 1024, F.G, (int)blockIdx.x);
        EpiResid E{F.x_p, XB, RS, F.pool_scale};
        gemm_phase<EpiResid, StaticOrder, true, true>(F.lds, g, S, E);
    } SEAM(1);
    if (IN(2)) {
        for (int rep = 0; rep < REP(14); ++rep) small_gemm<SG_UP>(F, 0);
        Gemm g{XB, WSP(bf16_t, WS_WUP), MP, FF, D, D, D, (size_t)0}; StaticOrder S; S.init(MP, FF, F.G, (int)blockIdx.x);
        EpiUp E{WSP(bf16_t, WS_H), RS};
        for (int rep = 0; rep < REP(2); ++rep) { gemm_phase<EpiUp, StaticOrder, true, true>(F.lds, g, S, E); __syncthreads(); }
    } SEAM(2);
    if (IN(3)) {
        small_gemm<SG_DOWN>(F, 0);
        Gemm g{WSP(bf16_t, WS_H), WSP(bf16_t, WS_WDN), MP, D, FF, FF, FF, (size_t)0}; StaticOrder S; S.init(MP, D, F.G, (int)blockIdx.x);
        EpiResid E{nullptr, XB, RS, nullptr};
        gemm_phase<EpiResid, StaticOrder, true, true>(F.lds, g, S, E);
    } SEAM(3);
    if (IN(4)) {
        for (int rep = 0; rep < REP(15); ++rep) small_gemm<SG_KVQG>(F, 0);
        if ((blockIdx.x & 1) == 0) p5_sample_compress(F, ctl + CW_QUEUE, 4);
        Gemm g{XB, WSP(bf16_t, WS_WKVQG), MP, NKVQG, D, D, D, (size_t)0}; StaticOrder S; S.init(MP, NKVQG, F.G, (int)blockIdx.x);
        EpiKvqg E{RS, F.b_gate, F.out + OUT_KV_P, F.out + OUT_KV_S, F.out + OUT_WIN_P, F.out + OUT_WIN_S, WSP(bf16_t, WS_CMPA), WSP(bf16_t, WS_KVS), WSP(bf16_t, WS_KVW), WSP(bf16_t, WS_Q), WSP(float, WS_GATE)};
        gemm_phase<EpiKvqg, StaticOrder, true, true>(F.lds, g, S, E);
        __syncthreads();
        p5_sample_compress(F, ctl + CW_QUEUE, 1 << 30);
    } SEAM(4);
    if (IN(5)) {
        Gemm g{WSP(bf16_t, WS_CMPA), WSP(bf16_t, WS_W1CAT), CMP_ROWS_P, 512, D, D, D, (size_t)CMP_ROWS * D * 2}; StaticOrder S; S.init(CMP_ROWS_P, 512, F.G, (int)blockIdx.x);
        EpiCmp E{WSP(float, WS_CMPP)};
        gemm_phase<EpiCmp, StaticOrder, true, true>(F.lds, g, S, E);
        __syncthreads();
        if (F.G > 32) { if ((int)blockIdx.x >= 32) p6_combine(F, 0, (int)blockIdx.x - 32, F.G - 32); } else p6_combine(F, 0, (int)blockIdx.x, F.G);
    } SEAM(5);
    if (IN(6)) { p6_combine(F, 1, (int)blockIdx.x, F.G); } SEAM(6);
    if (IN(7)) { p7_attention(F); } SEAM(7);
    if (IN(8)) {
        small_gemm<SG_WO>(F, 0);
        Gemm g{WSP(bf16_t, WS_DIFF), WSP(bf16_t, WS_WO), MP, D, D, D, D, (size_t)0}; StaticOrder S; S.init(MP, D, F.G, (int)blockIdx.x);
        EpiResid E{nullptr, XB, RS, nullptr};
        gemm_phase<EpiResid, StaticOrder, true, true>(F.lds, g, S, E);
    } SEAM(8);
    if (IN(9)) {
        small_gemm<SG_UP>(F, 1);
        Gemm g{XB, WSP(bf16_t, WS_WUP) + (size_t)FF * D, MP, FF, D, D, D, (size_t)0}; StaticOrder S; S.init(MP, FF, F.G, (int)blockIdx.x);
        EpiUp E{WSP(bf16_t, WS_H), RS};
        gemm_phase<EpiUp, StaticOrder, true, true>(F.lds, g, S, E);
    } SEAM(9);
    if (IN(10)) {
        small_gemm<SG_DOWN>(F, 1);
        Gemm g{WSP(bf16_t, WS_H), WSP(bf16_t, WS_WDN) + (size_t)D * FF, MP, D, FF, FF, FF, (size_t)0}; StaticOrder S; S.init(MP, D, F.G, (int)blockIdx.x);
        EpiResid E{nullptr, XB, RS, nullptr};
        gemm_phase<EpiResid, StaticOrder, true, true>(F.lds, g, S, E);
    } SEAM(10);
    if (IN(11)) { p11_final(F); }
#undef IN
#undef SEAM
}

extern "C" void kernel_launch(void* const* d_in, const int* in_sizes, int n_in, void* d_out, int out_size, void* d_ws, size_t ws_size, hipStream_t stream) {
    static int grid = 0;
    if (grid == 0) {
        if (n_in != 21 || (size_t)out_size != OUT_TOTAL || ws_size < WS_END) { fprintf(stderr, "kernel_launch: unexpected sizes n_in %d out %d ws %zu\n", n_in, out_size, ws_size); grid = -1; return; }
        int dev = 0, cus = 0, per_cu = 0;
        if (hipGetDevice(&dev) != hipSuccess || hipDeviceGetAttribute(&cus, hipDeviceAttributeMultiprocessorCount, dev) != hipSuccess) { grid = -1; return; }
        if (hipFuncSetAttribute((const void*)yoco_fwd, hipFuncAttributeMaxDynamicSharedMemorySize, LDS_BYTES) != hipSuccess) { fprintf(stderr, "kernel_launch: hipFuncSetAttribute failed\n"); grid = -1; return; }
        if (hipOccupancyMaxActiveBlocksPerMultiprocessor(&per_cu, (const void*)yoco_fwd, NWAVES * 64, LDS_BYTES) != hipSuccess || per_cu < 1) fprintf(stderr, "kernel_launch: occupancy query says %d\n", per_cu);
        (void)hipGetLastError();
        grid = cus;
    }
    if (grid < 0) return;
    (void)hipMemsetAsync((char*)d_ws + WS_CTL, 0, CTL_ZERO_BYTES, stream);
    Args a{};
    for (int i = 0; i < 21; ++i) a.in[i] = d_in[i];
    a.out = (float*)d_out; a.ws = (unsigned char*)d_ws;
#if MK_MULTI
    for (int p = 0; p < NPHASE; ++p) { a.ph_lo = p; a.ph_hi = p + 1; hipLaunchKernelGGL(yoco_fwd, dim3(grid), dim3(NWAVES * 64), LDS_BYTES, stream, a); }
#else
    a.ph_lo = 0; a.ph_hi = NPHASE;
    hipLaunchKernelGGL(yoco_fwd, dim3(grid), dim3(NWAVES * 64), LDS_BYTES, stream, a);
#endif
    const hipError_t le = hipPeekAtLastError();
    if (le != hipSuccess) fprintf(stderr, "kernel_launch: launch failed: %s\n", hipGetErrorName(le));
}
```

```cpp
#include <hip/hip_runtime.h>
#include <hip/hip_bf16.h>
#include <cstdio>
#include <cstdint>
#include <cmath>

#ifndef MK_MULTI
#define MK_MULTI 0
#endif

constexpr int D = 1024, FF = 4096, SEQ = 4096, NB = 4, DB = 128, PAST = 2048;
constexpr int MP = NB * SEQ;
constexpr int MT = MP + DB;
constexpr int MPAD = 16640;
constexpr int NKVQG = 2816;
constexpr int CMP_ROWS_P = NB * 256 * 4;
constexpr int CMP_ROWS_S = DB * 128 * 4;
constexpr int CMP_ROWS = CMP_ROWS_P + CMP_ROWS_S;
constexpr float RMS_EPS = 1e-6f;
constexpr float LOG2E = 1.4426950408889634f;
constexpr float QSCALE = 0.125f * LOG2E;

namespace pg8 {
#define PG8_LAS __attribute__((address_space(3)))
typedef unsigned short bf16_t;
typedef short bf16x8 __attribute__((ext_vector_type(8)));
typedef float f32x4 __attribute__((ext_vector_type(4)));
typedef float f32x2 __attribute__((ext_vector_type(2)));
typedef unsigned u32x4 __attribute__((ext_vector_type(4)));
typedef unsigned u32x2 __attribute__((ext_vector_type(2)));
constexpr int BM = 256, BK = 64, HALF = 128, HTB = HALF * BK * 2, STAGE_BYTES = 8 * HTB, NXCD = 8, WGM = 8;

__host__ __device__ __forceinline__ int lds_byte(int r, int c) { const int st = (r >> 4) * 2 + (c >> 5), rr = r & 15, cc = c & 31, ob = rr * 64 + cc * 2; return st * 1024 + (ob ^ (((ob >> 9) & 1) << 5)); }
__host__ __device__ __forceinline__ void stage_rc(int b, int& R, int& C) { const int st = b / 1024, sb = b % 1024, swz = sb ^ (((sb >> 9) & 1) << 5); R = (st >> 1) * 16 + swz / 64; C = (st & 1) * 32 + (swz % 64) / 2; }
__host__ __device__ __forceinline__ int perm32(int rho) { const int n = rho >> 4, i = rho & 15; return 8 * (i >> 2) + 4 * n + (i & 3); }

struct Unit { int pm, pn; };
struct Gemm { const bf16_t* A; const bf16_t* Bt; int M, N, K, lda, ldb; size_t a_pn_off; };

struct StaticOrder {
    int nM, nN, nwg, G, c;
    __host__ __device__ void init(int M, int N, int G_, int c_) { nM = M / BM; nN = N / BM; nwg = nM * nN; G = G_; c = c_; }
    __host__ __device__ bool next(int i, Unit& u) const {
        const long L = (long)i * G + c; if (L >= nwg) return false;
        int wgid = (int)L; { const int q = nwg / NXCD, r = nwg % NXCD, xcd = wgid % NXCD, off = wgid / NXCD; wgid = (xcd < r ? xcd * (q + 1) : r * (q + 1) + (xcd - r) * q) + off; }
        const int nig = WGM * nN, gid = wgid / nig, fm = gid * WGM, gsz = (nM - fm) < WGM ? (nM - fm) : WGM;
        u.pm = fm + ((wgid % nig) % gsz); u.pn = (wgid % nig) / gsz; return true;
    }
    __device__ __forceinline__ void a_ready(const Unit&) const {}
    __device__ __forceinline__ void done(const Unit&) const {}
};

__device__ __forceinline__ unsigned cvt_pk_bf16(float lo, float hi) { unsigned r; asm volatile("v_cvt_pk_bf16_f32 %0, %1, %2" : "=v"(r) : "v"(lo), "v"(hi)); return r; }

__device__ __forceinline__ float row_rstd(const float* rs, int row) {
    const f32x4* p = (const f32x4*)(rs + (size_t)row * 16); const f32x4 a = p[0], b = p[1], c = p[2], d = p[3];
    const float s = ((a[0] + a[1]) + (a[2] + a[3])) + ((b[0] + b[1]) + (b[2] + b[3])) + ((c[0] + c[1]) + (c[2] + c[3])) + ((d[0] + d[1]) + (d[2] + d[3]));
    return 1.0f / sqrtf(s * (1.0f / 1024.0f) + RMS_EPS);
}

struct EpiResid {
    static constexpr bool PERM = false, AFTER_DRAIN = false;
    const float* base_f; bf16_t* XB; float* RS; const float* scale;
    __device__ __forceinline__ void operator()(const f32x4 (&acc)[2][2][4][2], const Unit& u, int wr, int wc, int fr, int fq) const {
        const int col0 = u.pn * BM + wc * 32 + 4 * fq;
        f32x4 sc[2][2];
#pragma unroll
        for (int bj = 0; bj < 2; ++bj)
#pragma unroll
            for (int n = 0; n < 2; ++n) sc[bj][n] = scale ? *(const f32x4*)(scale + col0 + bj * HALF + n * 16) : (f32x4){1.f, 1.f, 1.f, 1.f};
#pragma unroll
        for (int ai = 0; ai < 2; ++ai) {
#pragma unroll
            for (int m = 0; m < 4; ++m) {
                const int row = u.pm * BM + ai * HALF + wr * 64 + m * 16 + fr;
                float ss = 0.f;
#pragma unroll
                for (int bj = 0; bj < 2; ++bj)
#pragma unroll
                    for (int n = 0; n < 2; ++n) {
                        const int col = col0 + bj * HALF + n * 16;
                        f32x4 bv;
                        if (base_f) bv = *(const f32x4*)(base_f + (size_t)row * D + col);
                        else { const u32x2 q = *(const u32x2*)(XB + (size_t)row * D + col); bv = (f32x4){__builtin_bit_cast(float, q.x << 16), __builtin_bit_cast(float, q.x & 0xffff0000u), __builtin_bit_cast(float, q.y << 16), __builtin_bit_cast(float, q.y & 0xffff0000u)}; }
                        const f32x4 v = bv + acc[ai][bj][m][n] * sc[bj][n];
                        u32x2 w; w.x = cvt_pk_bf16(v[0], v[1]); w.y = cvt_pk_bf16(v[2], v[3]);
                        *(u32x2*)(XB + (size_t)row * D + col) = w;
                        ss += (v[0] * v[0] + v[1] * v[1]) + (v[2] * v[2] + v[3] * v[3]);
                    }
                ss += __shfl_xor(ss, 16); ss += __shfl_xor(ss, 32);
                if (fq == 0) RS[(size_t)row * 16 + u.pn * 4 + wc] = ss;
            }
        }
    }
};

struct EpiUp {
    static constexpr bool PERM = true, AFTER_DRAIN = false;
    bf16_t* H; const float* RS;
    __device__ __forceinline__ void operator()(const f32x4 (&acc)[2][2][4][2], const Unit& u, int wr, int wc, int fr, int fq) const {
        const int col0 = u.pn * BM + wc * 32 + 8 * fq;
#pragma unroll
        for (int ai = 0; ai < 2; ++ai) {
            if (u.pm * BM + ai * HALF >= MT) continue;
#pragma unroll
            for (int m = 0; m < 4; ++m) {
                const int row = u.pm * BM + ai * HALF + wr * 64 + m * 16 + fr;
                const float rstd = row_rstd(RS, row);
#pragma unroll
                for (int bj = 0; bj < 2; ++bj) {
                    f32x4 v0 = acc[ai][bj][m][0] * rstd, v1 = acc[ai][bj][m][1] * rstd;
#pragma unroll
                    for (int e = 0; e < 4; ++e) { const float a = fmaxf(v0[e], 0.f), b = fmaxf(v1[e], 0.f); v0[e] = a * a; v1[e] = b * b; }
                    u32x4 w; w.x = cvt_pk_bf16(v0[0], v0[1]); w.y = cvt_pk_bf16(v0[2], v0[3]); w.z = cvt_pk_bf16(v1[0], v1[1]); w.w = cvt_pk_bf16(v1[2], v1[3]);
                    *(u32x4*)(H + (size_t)row * FF + col0 + bj * HALF) = w;
                }
            }
        }
    }
};

struct EpiKvqg {
    static constexpr bool PERM = true, AFTER_DRAIN = false;
    const float* RS; const float* bgate;
    float* kv_p; float* kv_s; float* win_p; float* win_s;
    bf16_t* CMPA; bf16_t* KVS; bf16_t* KVW; bf16_t* Q; float* GATE;
    __device__ __forceinline__ void operator()(const f32x4 (&acc)[2][2][4][2], const Unit& u, int wr, int wc, int fr, int fq) const {
        const int pn = u.pn;
#pragma unroll
        for (int ai = 0; ai < 2; ++ai) {
            if (u.pm * BM + ai * HALF >= MT) continue;
#pragma unroll
            for (int m = 0; m < 4; ++m) {
                const int row = u.pm * BM + ai * HALF + wr * 64 + m * 16 + fr;
                const float rstd = row_rstd(RS, row);
                const bool prompt = row < MP; const int b = prompt ? (row >> 12) : (row - MP), t = row & (SEQ - 1);
#pragma unroll
                for (int bj = 0; bj < 2; ++bj) {
                    const int cin = bj * HALF + wc * 32 + 8 * fq;
                    const f32x4 v0 = acc[ai][bj][m][0] * rstd, v1 = acc[ai][bj][m][1] * rstd;
                    u32x4 w; w.x = cvt_pk_bf16(v0[0], v0[1]); w.y = cvt_pk_bf16(v0[2], v0[3]); w.z = cvt_pk_bf16(v1[0], v1[1]); w.w = cvt_pk_bf16(v1[2], v1[3]);
                    if (pn < 4) {
                        float* o = prompt ? kv_p + (size_t)row * D : kv_s + (size_t)b * D;
                        *(f32x4*)(o + pn * BM + cin) = v0; *(f32x4*)(o + pn * BM + cin + 4) = v1;
                        if (pn < 2) {
                            if (prompt) { const int g = cin >> 6, d = cin & 63;
                                *(u32x4*)(CMPA + (size_t)pn * CMP_ROWS * D + (size_t)(((b * 256 + (t >> 4)) * 4 + g)) * D + (t & 15) * 64 + d) = w; }
                        } else *(u32x4*)(KVS + (size_t)row * 512 + (pn - 2) * BM + cin) = w;
                    } else if (pn < 6) {
                        const int c = (pn - 4) * BM + cin;
                        *(u32x4*)(KVW + (size_t)row * 512 + c) = w;
                        if (prompt) { if (t >= SEQ - 512) { float* o = win_p + ((size_t)b * 512 + (t - (SEQ - 512))) * 512 + c; *(f32x4*)o = v0; *(f32x4*)(o + 4) = v1; } }
                        else { float* o = win_s + ((size_t)b * 512 + 511) * 512 + c; *(f32x4*)o = v0; *(f32x4*)(o + 4) = v1; }
                    } else if (pn < 10) {
                        *(u32x4*)(Q + (size_t)row * D + (pn - 6) * BM + cin) = w;
                    } else {
                        if (cin < 48) {
#pragma unroll
                            for (int e = 0; e < 4; ++e) { GATE[(size_t)row * 48 + cin + e] = 1.0f / (1.0f + __expf(-(v0[e] + bgate[cin + e]))); GATE[(size_t)row * 48 + cin + 4 + e] = 1.0f / (1.0f + __expf(-(v1[e] + bgate[cin + 4 + e]))); }
                        }
                    }
                }
            }
        }
    }
};

struct EpiCmp {
    static constexpr bool PERM = false, AFTER_DRAIN = false;
    float* P;
    __device__ __forceinline__ void operator()(const f32x4 (&acc)[2][2][4][2], const Unit& u, int wr, int wc, int fr, int fq) const {
        float* base = P + (size_t)u.pn * CMP_ROWS * 256;
#pragma unroll
        for (int ai = 0; ai < 2; ++ai)
#pragma unroll
            for (int m = 0; m < 4; ++m) {
                const int row = u.pm * BM + ai * HALF + wr * 64 + m * 16 + fr;
#pragma unroll
                for (int bj = 0; bj < 2; ++bj)
#pragma unroll
                    for (int n = 0; n < 2; ++n) *(f32x4*)(base + (size_t)row * 256 + bj * HALF + wc * 32 + n * 16 + 4 * fq) = acc[ai][bj][m][n];
            }
    }
};

template <class Epi, class Sched, bool ALIGN_EPI = false, bool SP2 = false>
__device__ __forceinline__ void gemm_phase(PG8_LAS unsigned char* lds, const Gemm g, const Sched& S, const Epi& E) {
    const int tid = threadIdx.x, wid = __builtin_amdgcn_readfirstlane(tid >> 6), lane = tid & 63, wr = wid >> 2, wc = wid & 3, fr = lane & 15, fq = lane >> 4;
    const int K = g.K, nt = K / BK;
    unsigned voffA[2], voffB[2];
#pragma unroll
    for (int i = 0; i < 2; ++i) { int R, C; stage_rc(tid * 16 + i * 8192, R, C); const int Rb = Epi::PERM ? ((R & ~31) + perm32(R & 31)) : R;
        voffA[i] = (unsigned)(R * g.lda + C) * 2u; voffB[i] = (unsigned)(Rb * g.ldb + C) * 2u; }
    const size_t kstep = (size_t)(BK * 2);
    const size_t hstepA = (size_t)HALF * g.lda * 2, hstepB = (size_t)HALF * g.ldb * 2;
    const size_t tstepA = 2 * hstepA, tstepB = 2 * hstepB;
    const unsigned ldsw = (unsigned)wid * 1024u;
    const int aoff = lds_byte(wr * 64 + fr, fq * 8), boff = lds_byte(wc * 32 + fr, fq * 8);
#define PG8_SA(b, h) (((b) * 2 + (h)) * HTB)
#define PG8_SB(b, h) ((4 + (b) * 2 + (h)) * HTB)
#define PG8_STAGE(bufoff, gbase, voff) do { _Pragma("unroll") for (int _i = 0; _i < 2; ++_i) \
        __builtin_amdgcn_global_load_lds((const unsigned*)((const char*)(gbase) + (voff)[_i]), (PG8_LAS unsigned*)(lds + (bufoff) + ldsw + _i * 8192), 16, 0, 0); } while (0)
#define PG8_LDA(dst, b, h) do { _Pragma("unroll") for (int m = 0; m < 4; ++m) _Pragma("unroll") for (int k = 0; k < 2; ++k) dst[m][k] = *(const PG8_LAS bf16x8*)(lds + PG8_SA(b, h) + aoff + m * 2048 + k * 1024); } while (0)
#define PG8_LDB(dst, b, h) do { _Pragma("unroll") for (int n = 0; n < 2; ++n) _Pragma("unroll") for (int k = 0; k < 2; ++k) dst[n][k] = *(const PG8_LAS bf16x8*)(lds + PG8_SB(b, h) + boff + n * 2048 + k * 1024); } while (0)
#define PG8_MMA(ai, bj, At, Bt) do { __builtin_amdgcn_s_setprio(1); _Pragma("unroll") for (int m = 0; m < 4; ++m) _Pragma("unroll") for (int n = 0; n < 2; ++n) _Pragma("unroll") for (int k = 0; k < 2; ++k) \
        acc[ai][bj][m][n] = __builtin_amdgcn_mfma_f32_16x16x32_bf16(Bt[n][k], At[m][k], acc[ai][bj][m][n], 0, 0, 0); __builtin_amdgcn_s_setprio(0); } while (0)
#define PG8_WAIT_V(n) asm volatile("s_waitcnt vmcnt(" #n ")" ::: "memory")
#define PG8_WAIT_L(n) asm volatile("s_waitcnt lgkmcnt(" #n ")" ::: "memory")
#define PG8_BAR __builtin_amdgcn_s_barrier()
#define PG8_SCHED __builtin_amdgcn_sched_barrier(0)
    Unit cur, nxt; int ui = 0;
    if (!S.next(0, cur)) return;
    f32x4 acc[2][2][4][2];
#pragma unroll
    for (int a = 0; a < 2; ++a)
#pragma unroll
        for (int b = 0; b < 2; ++b)
#pragma unroll
            for (int m = 0; m < 4; ++m)
#pragma unroll
                for (int n = 0; n < 2; ++n) acc[a][b][m][n] = (f32x4){0.f, 0.f, 0.f, 0.f};
    bf16x8 At[4][2], B0[2][2], B1[2][2];
    const char* cA = (const char*)g.A + (size_t)cur.pm * tstepA + (size_t)cur.pn * g.a_pn_off; const char* cB = (const char*)g.Bt + (size_t)cur.pn * tstepB;
    S.a_ready(cur);
    if constexpr (SP2) {
        PG8_STAGE(PG8_SB(0, 0), cB, voffB); PG8_STAGE(PG8_SB(0, 1), cB + hstepB, voffB); PG8_STAGE(PG8_SA(0, 0), cA, voffA); PG8_STAGE(PG8_SA(0, 1), cA + hstepA, voffA);
        if (wr == 1) PG8_BAR;
        PG8_WAIT_V(2); PG8_BAR;
        PG8_STAGE(PG8_SB(1, 0), cB + kstep, voffB); PG8_STAGE(PG8_SA(1, 0), cA + kstep, voffA); PG8_STAGE(PG8_SB(1, 1), cB + hstepB + kstep, voffB);
        PG8_WAIT_V(6); PG8_BAR;
    } else {
        PG8_STAGE(PG8_SB(0, 0), cB, voffB); PG8_STAGE(PG8_SA(0, 0), cA, voffA); PG8_STAGE(PG8_SB(0, 1), cB + hstepB, voffB); PG8_STAGE(PG8_SA(0, 1), cA + hstepA, voffA);
        if (wr == 1) PG8_BAR;
        PG8_WAIT_V(4); PG8_BAR;
        PG8_STAGE(PG8_SB(1, 0), cB + kstep, voffB); PG8_STAGE(PG8_SA(1, 0), cA + kstep, voffA); PG8_STAGE(PG8_SB(1, 1), cB + hstepB + kstep, voffB);
        PG8_WAIT_V(6); PG8_BAR;
    }
    for (;;) {
        const bool has_next = S.next(ui + 1, nxt);
        const char* nA = has_next ? (const char*)g.A + (size_t)nxt.pm * tstepA + (size_t)nxt.pn * g.a_pn_off : cA; const char* nB = has_next ? (const char*)g.Bt + (size_t)nxt.pn * tstepB : cB;
        for (int t = 0; t < nt; t += 2) {
            const bool last = (t == nt - 2);
            const char* a1 = cA + (size_t)(t + 1) * kstep;
            const char* a2 = last ? nA : cA + (size_t)(t + 2) * kstep; const char* b2 = last ? nB : cB + (size_t)(t + 2) * kstep;
            const char* a3 = a2 + kstep; const char* b3 = b2 + kstep;
            if (last && has_next) S.a_ready(nxt);
            if constexpr (SP2) {
            PG8_LDB(B0, 0, 0); PG8_LDB(B1, 0, 1); PG8_SCHED; PG8_LDA(At, 0, 0); PG8_STAGE(PG8_SA(1, 1), a1 + hstepA, voffA);
            PG8_WAIT_V(8); PG8_WAIT_L(0); PG8_BAR; PG8_MMA(0, 0, At, B0); PG8_MMA(0, 1, At, B1); PG8_BAR; PG8_SCHED;
            PG8_LDA(At, 0, 1); PG8_STAGE(PG8_SB(0, 0), b2, voffB); PG8_STAGE(PG8_SB(0, 1), b2 + hstepB, voffB); PG8_STAGE(PG8_SA(0, 0), a2, voffA);
            PG8_WAIT_V(8); PG8_WAIT_L(0); PG8_BAR; PG8_MMA(1, 0, At, B0); PG8_MMA(1, 1, At, B1); PG8_BAR; PG8_SCHED;
            PG8_LDB(B0, 1, 0); PG8_LDB(B1, 1, 1); PG8_SCHED; PG8_LDA(At, 1, 0); PG8_STAGE(PG8_SA(0, 1), a2 + hstepA, voffA);
            PG8_WAIT_V(8); PG8_WAIT_L(0); PG8_BAR; PG8_MMA(0, 0, At, B0); PG8_MMA(0, 1, At, B1); PG8_BAR; PG8_SCHED;
            PG8_LDA(At, 1, 1); PG8_STAGE(PG8_SB(1, 0), b3, voffB); PG8_STAGE(PG8_SB(1, 1), b3 + hstepB, voffB); PG8_STAGE(PG8_SA(1, 0), a3, voffA);
            PG8_WAIT_V(8); PG8_WAIT_L(0); PG8_BAR; PG8_MMA(1, 0, At, B0); PG8_MMA(1, 1, At, B1); PG8_BAR; PG8_SCHED;
            } else {
            PG8_LDB(B0, 0, 0); PG8_SCHED; PG8_LDA(At, 0, 0); PG8_STAGE(PG8_SA(1, 1), a1 + hstepA, voffA);
            PG8_WAIT_L(8); PG8_BAR; PG8_WAIT_L(0); PG8_MMA(0, 0, At, B0); PG8_BAR; PG8_SCHED;
            PG8_LDB(B1, 0, 1); PG8_STAGE(PG8_SB(0, 0), b2, voffB);
            PG8_BAR; PG8_WAIT_L(0); PG8_MMA(0, 1, At, B1); PG8_BAR;
            PG8_LDA(At, 0, 1); PG8_STAGE(PG8_SA(0, 0), a2, voffA);
            PG8_BAR; PG8_WAIT_L(0); PG8_MMA(1, 0, At, B0); PG8_BAR; PG8_SCHED;
            PG8_STAGE(PG8_SB(0, 1), b2 + hstepB, voffB);
            PG8_WAIT_V(6); PG8_BAR; PG8_MMA(1, 1, At, B1); PG8_BAR;
            PG8_LDB(B0, 1, 0); PG8_SCHED; PG8_LDA(At, 1, 0); PG8_STAGE(PG8_SA(0, 1), a2 + hstepA, voffA);
            PG8_WAIT_L(8); PG8_BAR; PG8_WAIT_L(0); PG8_MMA(0, 0, At, B0); PG8_BAR; PG8_SCHED;
            PG8_LDB(B1, 1, 1); PG8_STAGE(PG8_SB(1, 0), b3, voffB);
            PG8_BAR; PG8_WAIT_L(0); PG8_MMA(0, 1, At, B1); PG8_BAR;
            PG8_LDA(At, 1, 1); PG8_STAGE(PG8_SA(1, 0), a3, voffA);
            PG8_BAR; PG8_WAIT_L(0); PG8_MMA(1, 0, At, B0); PG8_BAR; PG8_SCHED;
            PG8_STAGE(PG8_SB(1, 1), b3 + hstepB, voffB);
            PG8_WAIT_V(6); PG8_BAR; PG8_MMA(1, 1, At, B1); PG8_BAR;
            }
        }
        if constexpr (ALIGN_EPI) { if (wr == 0) PG8_BAR; }
        if constexpr (!Epi::AFTER_DRAIN) { E(acc, cur, wr, wc, fr, fq); S.done(cur); }
        if (!has_next) break;
#pragma unroll
        for (int a = 0; a < 2; ++a)
#pragma unroll
            for (int b = 0; b < 2; ++b)
#pragma unroll
                for (int m = 0; m < 4; ++m)
#pragma unroll
                    for (int n = 0; n < 2; ++n) acc[a][b][m][n] = (f32x4){0.f, 0.f, 0.f, 0.f};
        cur = nxt; cA = nA; cB = nB; ++ui;
        if constexpr (ALIGN_EPI) { if (wr == 1) PG8_BAR; }
    }
    PG8_WAIT_V(0);
    if constexpr (!ALIGN_EPI) { if (wr == 0) PG8_BAR; }
    PG8_BAR;
    if constexpr (Epi::AFTER_DRAIN) { E.fused(acc, cur, wr, wc, fr, fq, lds, wid, lane); S.done(cur); }
#undef PG8_SA
#undef PG8_SB
#undef PG8_STAGE
#undef PG8_LDA
#undef PG8_LDB
#undef PG8_MMA
#undef PG8_WAIT_V
#undef PG8_WAIT_L
#undef PG8_BAR
#undef PG8_SCHED
}
}

#define GAS __attribute__((address_space(1)))
#define LAS __attribute__((address_space(3)))
typedef unsigned short bf16;
typedef unsigned v4u __attribute__((ext_vector_type(4)));
typedef unsigned v2u __attribute__((ext_vector_type(2)));
typedef float f32x4 __attribute__((ext_vector_type(4)));
typedef float f32x2 __attribute__((ext_vector_type(2)));
typedef float f32x16 __attribute__((ext_vector_type(16)));
typedef short bf16x8 __attribute__((ext_vector_type(8)));
typedef short v4i16_t __attribute__((ext_vector_type(4)));
typedef GAS unsigned gu32;
typedef GAS unsigned long long gu64;
#define RLX_AGENT __ATOMIC_RELAXED, __HIP_MEMORY_SCOPE_AGENT
#define LDS_WAIT() asm volatile("s_waitcnt lgkmcnt(0)" ::: "memory")
#define VM_WAIT() asm volatile("s_waitcnt vmcnt(0)" ::: "memory")
__device__ __forceinline__ unsigned f2bf(float f) { unsigned u = __builtin_bit_cast(unsigned, f); return (u + 0x7fffu + ((u >> 16) & 1u)) >> 16; }
__device__ __forceinline__ unsigned pk2(float lo, float hi) { return f2bf(lo) | (f2bf(hi) << 16); }
__device__ __forceinline__ float bf2f(unsigned short h) { return __builtin_bit_cast(float, (unsigned)h << 16); }

#define XB_TMO      128
#define XB_XCNT(j)  (256  + 64 * (j))
#define XB_XSUB(j)  (1280 + 64 * (j))
#define XB_XGEN(j)  (2304 + 64 * (j))
#define XB_TOP      3328
#define XB_TOPGEN   3392
#define XCD_BAR_WORDS 3456
#define XB_SPIN_CAP (1u << 18)

__device__ __forceinline__ unsigned xb_ld(unsigned* p)              { return __hip_atomic_load(p, __ATOMIC_RELAXED, __HIP_MEMORY_SCOPE_AGENT); }
__device__ __forceinline__ unsigned xb_add(unsigned* p, unsigned v) { return __hip_atomic_fetch_add(p, v, __ATOMIC_RELAXED, __HIP_MEMORY_SCOPE_AGENT); }
__device__ __forceinline__ unsigned xb_xcc_id() { return (unsigned)__builtin_amdgcn_s_getreg((3 << 11) | 20) & 0xFu; }
#define XB_SPIN(cond, bar) do { unsigned _sp = 0; while (cond) { __builtin_amdgcn_s_sleep(1); \
    if ((++_sp & 255u) == 0u) { if (xb_ld(&(bar)[XB_TMO])) break; if (_sp > XB_SPIN_CAP) { atomicAdd(&(bar)[XB_TMO], 1u); break; } } } } while (0)

struct XcdBarrier {
    unsigned* bar; unsigned x;
    volatile LAS unsigned* st;
};

__device__ __forceinline__ XcdBarrier xcd_barrier_post(unsigned* bar, volatile LAS unsigned* st) {
    XcdBarrier b; b.bar = bar; b.x = xb_xcc_id(); b.st = st;
    if (threadIdx.x == 0) (void)xb_add(&bar[XB_XCNT(b.x)], 1u);
    return b;
}
__device__ __forceinline__ void xcd_barrier_complete(unsigned* bar, unsigned x, unsigned& nloc, unsigned& nx) {
    const unsigned G = gridDim.x * gridDim.y * gridDim.z;
    unsigned sum, cnt, mine, sp = 0u;
    for (;;) {
        sum = 0u; cnt = 0u; mine = 0u;
#pragma unroll
        for (unsigned j = 0; j < 16; ++j) { const unsigned c = xb_ld(&bar[XB_XCNT(j)]); sum += c; cnt += (c > 0u) ? 1u : 0u; mine = (j == x) ? c : mine; }
        if (sum == G) break;
        __builtin_amdgcn_s_sleep(1);
        if ((++sp & 255u) == 0u) { if (xb_ld(&bar[XB_TMO])) break; if (sp > XB_SPIN_CAP) { atomicAdd(&bar[XB_TMO], 1u); break; } }
    }
    nloc = mine > 0u ? mine : 1u; nx = cnt > 0u ? cnt : 1u;
}

__device__ __forceinline__ void xcd_barrier(const XcdBarrier& b) {
    asm volatile("s_waitcnt vmcnt(0)" ::: "memory");
    __syncthreads();
    if (threadIdx.x == 0) {
        unsigned* bar = b.bar;
        __builtin_amdgcn_s_waitcnt(0);
        unsigned nloc = b.st[0], nx = b.st[1];
        if (nloc == 0u) { xcd_barrier_complete(bar, b.x, nloc, nx); b.st[0] = nloc; b.st[1] = nx; }
        const unsigned old = xb_add(&bar[XB_XSUB(b.x)], 1u);
        const unsigned gen = old / nloc;
        if (old + 1u == (gen + 1u) * nloc) {
            __builtin_amdgcn_fence(__ATOMIC_RELEASE, "agent");
            asm volatile("s_waitcnt vmcnt(0)" ::: "memory");
            const unsigned og = xb_add(&bar[XB_TOP], 1u);
            const unsigned tg = og / nx;
            if (og + 1u == (tg + 1u) * nx) xb_add(&bar[XB_TOPGEN], 1u);
            else XB_SPIN(xb_ld(&bar[XB_TOPGEN]) == tg, bar);
            __builtin_amdgcn_fence(__ATOMIC_ACQUIRE, "agent");
            xb_add(&bar[XB_XGEN(b.x)], 1u);
            asm volatile("s_waitcnt vmcnt(0)" ::: "memory");
        } else {
            XB_SPIN(xb_ld(&bar[XB_XGEN(b.x)]) == gen, bar);
            __builtin_amdgcn_fence(__ATOMIC_ACQUIRE, "agent");
            asm volatile("s_waitcnt vmcnt(0)" ::: "memory");
        }
    }
    __syncthreads();
}

constexpr size_t MiB = 1u << 20;
constexpr size_t WS_CTL = 0, CTL_ZERO_BYTES = 1 * MiB;
constexpr size_t WS_WUP = 2 * MiB;
constexpr size_t WS_WDN = 18 * MiB;
constexpr size_t WS_WKVQG = 34 * MiB;
constexpr size_t WS_WO = 40 * MiB;
constexpr size_t WS_WPOOL = 42 * MiB;
constexpr size_t WS_W1CAT = 43 * MiB;
constexpr size_t WS_CBIAS = 128 * 1024;
constexpr size_t WS_RS = 45 * MiB;
constexpr size_t WS_GATE = 47 * MiB;
constexpr size_t WS_X = 52 * MiB;
constexpr size_t WS_XB = 118 * MiB;
constexpr size_t WS_DIFF = 152 * MiB;
constexpr size_t WS_Q = 186 * MiB;
constexpr size_t WS_KVS = 220 * MiB;
constexpr size_t WS_KVW = 238 * MiB;
constexpr size_t WS_KC = 256 * MiB;
constexpr size_t WS_KCS = 258 * MiB;
constexpr size_t WS_H = 292 * MiB;
constexpr size_t WS_CMPA = 424 * MiB;
constexpr size_t WS_CMPP = 700 * MiB;
constexpr size_t WS_END = 840 * MiB;
constexpr int CW_BAR = 4096;

constexpr size_t OUT_Y_P = 0, OUT_Y_S = 16777216, OUT_POOL_P = 16908288, OUT_POOL_S = 16969728, OUT_KV_P = 18935808, OUT_KV_S = 35713024, OUT_WIN_P = 35844096, OUT_WIN_S = 36892672, OUT_TOTAL = 70447104;

#ifndef PROBE_DUP
#define PROBE_DUP 0
#endif
#define REP(k) (1 + ((PROBE_DUP >> (k)) & 1))
constexpr int NWAVES = 8;
constexpr int RING_BYTES = 131072, MISC_OFF = RING_BYTES + 320, LDS_BYTES = 147456;

#ifndef PROBE_SEG
#define PROBE_SEG -1
#endif
#define SEG_BEGIN(id) do { if (PROBE_SEG == (id)) F.seg_t0 = __builtin_amdgcn_s_memrealtime(); } while (0)
#define SEG_END(id) do { if (PROBE_SEG == (id)) F.seg_dt += __builtin_amdgcn_s_memrealtime() - F.seg_t0; } while (0)
struct Frame {
    unsigned long long seg_t0, seg_dt;
    LAS unsigned char* lds;
    int tid, lane, wave, vcu, G;
    const float *x_p, *x_s, *state_pool, *cache, *state_win; const int* page_table;
    const float *norm_mix, *norm_mlp, *w_up, *w_down, *pool_w, *pool_scale, *norm_kv, *w_kv, *cmp_pe, *cmp_w1, *cmp_w2, *w_qg, *b_gate, *w_o, *norm_final;
    float* out; unsigned char* ws;
};
#define WSP(T, off) ((T*)(F.ws + (off)))

__device__ __forceinline__ unsigned cvtpk(float lo, float hi) { typedef __bf16 bf16x2_t __attribute__((ext_vector_type(2))); f32x2 v = {lo, hi}; bf16x2_t b = __builtin_convertvector(v, bf16x2_t); return __builtin_bit_cast(unsigned, b); }
__device__ __forceinline__ bf16x8 cvt8(const f32x4 a, const f32x4 b) { v4u w; w.x = cvtpk(a[0], a[1]); w.y = cvtpk(a[2], a[3]); w.z = cvtpk(b[0], b[1]); w.w = cvtpk(b[2], b[3]); return __builtin_bit_cast(bf16x8, w); }
__device__ __forceinline__ float wave_sum(float v) {
#pragma unroll
    for (int o = 1; o < 64; o <<= 1) v += __shfl_xor(v, o);
    return v;
}
__device__ __forceinline__ float wave_max(float v) {
#pragma unroll
    for (int o = 1; o < 64; o <<= 1) v = fmaxf(v, __shfl_xor(v, o));
    return v;
}

struct TItem { const float* W; bf16* WT; const float* kscale; int N, ldt, row_off, kb, nb; float scale; };
__device__ __forceinline__ void ti_load(const TItem& t, float (&wv)[32], float (&ksv)[8], int lane) {
    const int k0 = 64 * t.kb, n = 32 * t.nb + (lane & 31);
#pragma unroll
    for (int i = 0; i < 32; ++i) { const int kk = 2 * i + (lane >> 5); wv[i] = (n < t.N) ? t.W[(size_t)(k0 + kk) * t.N + n] : 0.f; }
    const int c = lane & 7;
#pragma unroll
    for (int e = 0; e < 8; ++e) ksv[e] = t.kscale ? t.kscale[k0 + 8 * c + e] : 1.f;
}
__device__ __forceinline__ void ti_finish(const TItem& t, const float (&wv)[32], const float (&ksv)[8], LAS float* scr, int lane) {
    const int k0 = 64 * t.kb, n0 = 32 * t.nb;
#pragma unroll
    for (int i = 0; i < 32; ++i) { const int kk = 2 * i + (lane >> 5); scr[kk * 33 + (lane & 31)] = wv[i] * t.scale; }
    LDS_WAIT(); asm volatile("" ::: "memory");
    const int c = lane & 7;
#pragma unroll
    for (int j = 0; j < 4; ++j) { const int nn = (lane >> 3) + 8 * j; const LAS float* s = scr + (8 * c) * 33 + nn;
        v4u o; o.x = pk2(s[0 * 33] * ksv[0], s[1 * 33] * ksv[1]); o.y = pk2(s[2 * 33] * ksv[2], s[3 * 33] * ksv[3]); o.z = pk2(s[4 * 33] * ksv[4], s[5 * 33] * ksv[5]); o.w = pk2(s[6 * 33] * ksv[6], s[7 * 33] * ksv[7]);
        if (n0 + nn < t.N) *(v4u*)(t.WT + (size_t)(t.row_off + n0 + nn) * t.ldt + k0 + 8 * c) = o; }
    LDS_WAIT(); asm volatile("" ::: "memory");
}

__device__ __forceinline__ void p0_prologue(Frame& F) {
    LAS float* scr = (LAS float*)(F.lds + F.wave * 16384);
    const int gw = F.vcu * NWAVES + F.wave, NGW = F.G * NWAVES, lane = F.lane;
    bf16* WUP = WSP(bf16, WS_WUP); bf16* WDN = WSP(bf16, WS_WDN); bf16* WKVQG = WSP(bf16, WS_WKVQG); bf16* WO = WSP(bf16, WS_WO); bf16* WPOOL = WSP(bf16, WS_WPOOL); bf16* W1CAT = WSP(bf16, WS_W1CAT);
    SEG_BEGIN(40);
    constexpr int I_UP = 2048, I_DN = 2048, I_KV = 768, I_QG = 544, I_WO = 512, I_PL = 32, I_C1 = 64;
    constexpr int NITEMS = 2 * I_UP + 2 * I_DN + I_KV + I_QG + I_WO + 4 * I_PL + 4 * I_C1;
    auto decode = [&](int it) -> TItem {
        int r = it; TItem t;
        if (r < 2 * I_UP) { const int l = r / I_UP; r %= I_UP; t = TItem{F.w_up + (size_t)l * D * FF, WUP + (size_t)l * FF * D, F.norm_mlp + l * D, FF, D, 0, r / 128, r % 128, 1.f}; return t; } r -= 2 * I_UP;
        if (r < 2 * I_DN) { const int l = r / I_DN; r %= I_DN; t = TItem{F.w_down + (size_t)l * FF * D, WDN + (size_t)l * D * FF, nullptr, D, FF, 0, r / 32, r % 32, 1.f}; return t; } r -= 2 * I_DN;
        if (r < I_KV) { t = TItem{F.w_kv, WKVQG, F.norm_kv, 1536, D, 0, r / 48, r % 48, 1.f}; return t; } r -= I_KV;
        if (r < I_QG) { const int nb = r % 34; t = TItem{F.w_qg, WKVQG, F.norm_mix + D, 1072, D, 1536, r / 34, nb, nb < 32 ? QSCALE : 1.f}; return t; } r -= I_QG;
        if (r < I_WO) { t = TItem{F.w_o, WO, nullptr, D, D, 0, r / 32, r % 32, 1.f}; return t; } r -= I_WO;
        if (r < 4 * I_PL) { const int g = r / I_PL; r %= I_PL; t = TItem{F.pool_w + (size_t)g * 65536, WPOOL + (size_t)g * 65536, nullptr, 256, 256, 0, r / 8, r % 8, 1.f}; return t; } r -= 4 * I_PL;
        { const int kvh = r / I_C1; r %= I_C1; const int kv = kvh >> 1, half = kvh & 1;
          t = TItem{F.cmp_w1 + (size_t)kv * 2048 * 128 + (size_t)half * 1024 * 128, W1CAT + (size_t)kv * 256 * D, nullptr, 128, D, half * 128, r / 4, r % 4, 1.f}; return t; }
    };
    {
        int it = gw; TItem ta, tb; float wa[32], ka[8], wb[32], kb2[8];
        if (it < NITEMS) { ta = decode(it); ti_load(ta, wa, ka, lane); }
        while (it < NITEMS) {
            int i2 = it + NGW; if (i2 < NITEMS) { tb = decode(i2); ti_load(tb, wb, kb2, lane); }
            ti_finish(ta, wa, ka, scr, lane);
            it = i2; if (it >= NITEMS) break;
            i2 = it + NGW; if (i2 < NITEMS) { ta = decode(i2); ti_load(ta, wa, ka, lane); }
            ti_finish(tb, wb, kb2, scr, lane);
            it = i2;
        }
    }
    { const int gt = F.vcu * 512 + F.tid, NT = F.G * 512; v4u* z = (v4u*)(WKVQG + (size_t)2608 * D);
      for (int i = gt; i < 208 * D / 8; i += NT) z[i] = (v4u){0u, 0u, 0u, 0u}; }
    { float* CB = WSP(float, WS_CBIAS);
      for (int it = gw; it < 64; it += NGW) { const int kv = it >> 5, kc0 = (it & 31) * 64; float a0 = 0.f, a1 = 0.f;
#pragma unroll 16
          for (int k = 0; k < 64; ++k) { const float p = F.cmp_pe[kv * 2048 + kc0 + k]; const float* wr = F.cmp_w1 + ((size_t)kv * 2048 + kc0 + k) * 128; a0 += p * wr[lane]; a1 += p * wr[64 + lane]; }
          unsafeAtomicAdd(CB + kv * 128 + lane, a0); unsafeAtomicAdd(CB + kv * 128 + 64 + lane, a1); } }
    SEG_END(40); SEG_BEGIN(41);
    bf16* DIFF = WSP(bf16, WS_DIFF);
    if (F.wave == 0)
    for (int b = F.vcu; b < DB; b += F.G) {
        const f32x4* xr = (const f32x4*)(F.x_s + (size_t)b * D) + lane; f32x4 v[4]; float ss = 0.f;
#pragma unroll
        for (int j = 0; j < 4; ++j) { v[j] = xr[64 * j]; ss += (v[j][0] * v[j][0] + v[j][1] * v[j][1]) + (v[j][2] * v[j][2] + v[j][3] * v[j][3]); }
        const float rstd = 1.0f / sqrtf(wave_sum(ss) * (1.0f / D) + RMS_EPS);
        const float* sp = F.state_pool + (size_t)b * 15 * D; float* ps = F.out + OUT_POOL_S + (size_t)b * 15 * D;
#pragma unroll
        for (int j = 0; j < 4; ++j) {
            const int col = 256 * j + 4 * lane; const f32x4 gg = *(const f32x4*)(F.norm_mix + col); const f32x4 u = v[j] * rstd * gg;
            f32x4 st[15];
#pragma unroll
            for (int r = 0; r < 15; ++r) st[r] = *(const f32x4*)(sp + (size_t)r * D + col);
            f32x4 sum = u; const int w = 2 << j;
#pragma unroll
            for (int r = 0; r < 15; ++r) if (r < w - 1) sum += st[14 - r];
            const f32x4 df = sum * (1.0f / (float)w) - u;
            v2u o; o.x = pk2(df[0], df[1]); o.y = pk2(df[2], df[3]); *(v2u*)(DIFF + (size_t)(MP + b) * D + col) = o;
            *(f32x4*)(ps + (size_t)14 * D + col) = u;
#pragma unroll
            for (int r = 0; r < 14; ++r) *(f32x4*)(ps + (size_t)r * D + col) = st[r + 1];
        }
    }
    SEG_END(41);
    if (F.G != 256) { const size_t gt = (size_t)F.vcu * 512 + F.tid, NT = (size_t)F.G * 512; const f32x4* src = (const f32x4*)F.state_win; f32x4* dst = (f32x4*)(F.out + OUT_WIN_S);
      for (int rep = 0; rep < REP(19); ++rep)
      for (size_t e = gt; e < (size_t)DB * 511 * 128; e += NT) { const size_t b = e / (511 * 128), rem = e - b * (511 * 128); dst[b * 65536 + rem] = src[b * 65536 + rem + 128]; } }
    __syncthreads();
    LAS float* U = (LAS float*)F.lds;
    SEG_BEGIN(42);
    for (int rep = 0; rep < REP(20); ++rep)
    for (int task = F.vcu; task < MP / 64; task += F.G) {
        const int b = task >> 6, t0 = (task & 63) * 64;
        const float* xb = F.x_p + (size_t)b * SEQ * D;
        f32x4 gmix[4];
#pragma unroll
        for (int j = 0; j < 4; ++j) gmix[j] = *(const f32x4*)(F.norm_mix + 256 * j + 4 * lane);
        f32x4 ra[4], rb2[4];
#define DF_LOAD(T) do { const int ta_ = (T) + 2 * F.wave, tb_ = ta_ + 1; _Pragma("unroll") for (int j = 0; j < 4; ++j) { \
            ra[j] = (ta_ >= 0) ? *((const f32x4*)(xb + (size_t)ta_ * D) + lane + 64 * j) : (f32x4){0.f, 0.f, 0.f, 0.f}; rb2[j] = (tb_ >= 0) ? *((const f32x4*)(xb + (size_t)tb_ * D) + lane + 64 * j) : (f32x4){0.f, 0.f, 0.f, 0.f}; } } while (0)
#define DF_STORE1(rr, tt_) do { float ss = 0.f; _Pragma("unroll") for (int j = 0; j < 4; ++j) ss += (rr[j][0] * rr[j][0] + rr[j][1] * rr[j][1]) + (rr[j][2] * rr[j][2] + rr[j][3] * rr[j][3]); \
            const float rstd = 1.0f / sqrtf(wave_sum(ss) * (1.0f / D) + RMS_EPS); \
            _Pragma("unroll") for (int j = 0; j < 4; ++j) { const f32x4 u = rr[j] * rstd * gmix[j]; *(LAS f32x4*)(U + ((tt_) & 31) * 1024 + 256 * j + 4 * lane) = u; \
                if ((tt_) >= SEQ - 15) *(f32x4*)(F.out + OUT_POOL_P + ((size_t)b * 15 + ((tt_) - (SEQ - 15))) * D + 256 * j + 4 * lane) = u; } } while (0)
#define DF_STORE(T) do { const int ta_ = (T) + 2 * F.wave; DF_STORE1(ra, ta_); DF_STORE1(rb2, ta_ + 1); } while (0)
        DF_LOAD(t0 - 16); DF_STORE(t0 - 16);
        DF_LOAD(t0);
        const int c = 2 * F.tid, w = 2 << (F.tid >> 7);
        f32x2 S = (f32x2){0.f, 0.f};
        for (int sub = 0; sub < 4; ++sub) {
            const int T = t0 + 16 * sub;
            DF_STORE(T);
            __syncthreads();
            if (sub < 3) DF_LOAD(T + 16);
            if (sub == 0) { for (int j = 1; j < w; ++j) S += *(const LAS f32x2*)(U + ((T - j) & 31) * 1024 + c); }
            for (int tt = 0; tt < 16; ++tt) { const int t = T + tt; const int cnt = (t + 1 < w) ? (t + 1) : w;
                const f32x2 cur = *(const LAS f32x2*)(U + (t & 31) * 1024 + c);
                S += cur; const float inv = 1.0f / (float)cnt;
                *(unsigned*)(DIFF + ((size_t)b * SEQ + t) * D + c) = pk2(S[0] * inv - cur[0], S[1] * inv - cur[1]);
                S -= *(const LAS f32x2*)(U + ((t - w + 1) & 31) * 1024 + c); }
            __syncthreads();
        }
#undef DF_LOAD
#undef DF_STORE1
#undef DF_STORE
    }
    SEG_END(42);
}

constexpr int KSTR = 144;
constexpr int SC_ACT = 0, SC_W = 128 * KSTR, SC_BUF = SC_W + 256 * KSTR, SC_UNIT = 2 * SC_BUF, CW_QUEUE = 8192;
static_assert(SC_UNIT + 64 <= RING_BYTES, "sample compress LDS");
__device__ __forceinline__ void p5_sample_compress(Frame& F, unsigned* qctr, int quota) {
    LAS int* UNIT = (LAS int*)(F.lds + SC_UNIT);
    const int tid = F.tid, lane = F.lane, w = F.wave, r = lane & 31, h = lane >> 5, rb = w & 3, nh = w >> 2;
    float* P = WSP(float, WS_CMPP); const bf16* W1 = WSP(bf16, WS_W1CAT);
    for (int nu = 0; nu < quota; ++nu) {
        __syncthreads();
        if (tid == 0) UNIT[0] = (int)atomicAdd(qctr, 1u);
        __syncthreads();
        const int u = UNIT[0]; if (u >= DB * 8) break;
        const int b = u >> 3, jb = (u >> 1) & 3, kv = u & 1;
        size_t aoff[4]; const bf16* wsrc = W1 + ((size_t)kv * 256 + (tid >> 3)) * D + 8 * (tid & 7);
#pragma unroll
        for (int e = 0; e < 4; ++e) { const int j = 32 * jb + (tid >> 6) + 8 * e; const int page = F.page_table[b * 16 + (j >> 3)]; aoff[e] = ((size_t)page * 128 + (j & 7) * 16) * 1024 + kv * 256 + 4 * (tid & 63); }
        f32x4 av0[4], av1[4]; v4u wv0[4], wv1[4];
#define SC_LOAD(av, wv, tt) do { _Pragma("unroll") for (int e = 0; e < 4; ++e) { av[e] = *(const f32x4*)(F.cache + aoff[e] + (size_t)(tt) * 1024); wv[e] = *(const v4u*)(wsrc + (size_t)e * 64 * D + 64 * (tt)); } } while (0)
#define SC_STORE(av, wv, bf) do { _Pragma("unroll") for (int e = 0; e < 4; ++e) { v2u o; o.x = cvtpk(av[e][0], av[e][1]); o.y = cvtpk(av[e][2], av[e][3]); \
            *(LAS v2u*)(F.lds + (bf) * SC_BUF + SC_ACT + ((((tid >> 6) + 8 * e) << 2) + ((tid & 63) >> 4)) * KSTR + 8 * (tid & 15)) = o; *(LAS v4u*)(F.lds + (bf) * SC_BUF + SC_W + ((tid >> 3) + 64 * e) * KSTR + 16 * (tid & 7)) = wv[e]; } } while (0)
#define SC_COMPUTE(bf) do { const LAS unsigned char* At = F.lds + (bf) * SC_BUF + SC_ACT + (32 * rb + r) * KSTR + h * 16; const LAS unsigned char* Wt = F.lds + (bf) * SC_BUF + SC_W + (128 * nh + r) * KSTR + h * 16; \
            _Pragma("unroll") for (int k2 = 0; k2 < 2; ++k2) { bf16x8 bfr_[2], afr_[2][4]; \
            _Pragma("unroll") for (int ks = 0; ks < 2; ++ks) { bfr_[ks] = *(const LAS bf16x8*)(At + (2 * k2 + ks) * 32); \
                _Pragma("unroll") for (int nt = 0; nt < 4; ++nt) afr_[ks][nt] = *(const LAS bf16x8*)(Wt + 32 * nt * KSTR + (2 * k2 + ks) * 32); } \
            __builtin_amdgcn_sched_barrier(0); \
            _Pragma("unroll") for (int ks = 0; ks < 2; ++ks) \
                _Pragma("unroll") for (int nt = 0; nt < 4; ++nt) acc[nt] = __builtin_amdgcn_mfma_f32_32x32x16_bf16(afr_[ks][nt], bfr_[ks], acc[nt], 0, 0, 0); \
            __builtin_amdgcn_sched_barrier(0); } } while (0)
        f32x16 acc[4];
#pragma unroll
        for (int nt = 0; nt < 4; ++nt)
#pragma unroll
            for (int i = 0; i < 16; ++i) acc[nt][i] = 0.f;
        SC_LOAD(av0, wv0, 0); SC_LOAD(av1, wv1, 1); SC_STORE(av0, wv0, 0); __syncthreads();
        for (int tt = 0; tt < 16; tt += 2) {
            if (tt + 2 < 16) SC_LOAD(av0, wv0, tt + 2);
            __builtin_amdgcn_sched_barrier(0);
            SC_COMPUTE(0);
            __builtin_amdgcn_sched_barrier(0);
            SC_STORE(av1, wv1, 1); __syncthreads();
            if (tt + 3 < 16) SC_LOAD(av1, wv1, tt + 3);
            __builtin_amdgcn_sched_barrier(0);
            SC_COMPUTE(1);
            __builtin_amdgcn_sched_barrier(0);
            if (tt + 2 < 16) SC_STORE(av0, wv0, 0);
            __syncthreads();
        }
#undef SC_COMPUTE
#undef SC_LOAD
#undef SC_STORE
        float* prow = P + (size_t)kv * CMP_ROWS * 256 + (size_t)(CMP_ROWS_P + (b * 128 + 32 * jb) * 4 + 32 * rb + r) * 256 + 128 * nh + 4 * h;
#pragma unroll
        for (int nt = 0; nt < 4; ++nt)
#pragma unroll
            for (int g4 = 0; g4 < 4; ++g4) *(f32x4*)(prow + 32 * nt + 8 * g4) = (f32x4){acc[nt][4 * g4], acc[nt][4 * g4 + 1], acc[nt][4 * g4 + 2], acc[nt][4 * g4 + 3]};
    }
}

__device__ __forceinline__ void p5_prompt_compress(Frame& F) {
    const int tid = F.tid, lane = F.lane, w = F.wave, r = lane & 31, h = lane >> 5, rb = w & 3, nh = w >> 2;
    float* P = WSP(float, WS_CMPP); const bf16* W1 = WSP(bf16, WS_W1CAT); const bf16* CA = WSP(bf16, WS_CMPA);
    for (int u = (int)blockIdx.x; u < 2 * CMP_ROWS_P / 128; u += F.G) {
        const int kv = u & 1, rblk = u >> 1;
        const bf16* asrc = CA + (size_t)kv * CMP_ROWS * D + (size_t)(rblk * 128 + (tid >> 3)) * D + 8 * (tid & 7);
        const bf16* wsrc = W1 + ((size_t)kv * 256 + (tid >> 3)) * D + 8 * (tid & 7);
        v4u aa[2], wv[4];
#define PC_LOAD(tt) do { _Pragma("unroll") for (int e = 0; e < 2; ++e) aa[e] = *(const v4u*)(asrc + (size_t)e * 64 * D + 64 * (tt)); _Pragma("unroll") for (int e = 0; e < 4; ++e) wv[e] = *(const v4u*)(wsrc + (size_t)e * 64 * D + 64 * (tt)); } while (0)
#define PC_STORE(bf) do { _Pragma("unroll") for (int e = 0; e < 2; ++e) *(LAS v4u*)(F.lds + (bf) * SC_BUF + SC_ACT + ((tid >> 3) + 64 * e) * KSTR + 16 * (tid & 7)) = aa[e]; \
            _Pragma("unroll") for (int e = 0; e < 4; ++e) *(LAS v4u*)(F.lds + (bf) * SC_BUF + SC_W + ((tid >> 3) + 64 * e) * KSTR + 16 * (tid & 7)) = wv[e]; } while (0)
        f32x16 acc[4];
#pragma unroll
        for (int nt = 0; nt < 4; ++nt)
#pragma unroll
            for (int i = 0; i < 16; ++i) acc[nt][i] = 0.f;
        __syncthreads();
        PC_LOAD(0); PC_STORE(0); __syncthreads();
        for (int tt = 0; tt < 16; ++tt) {
            const int bf = tt & 1;
            if (tt + 1 < 16) PC_LOAD(tt + 1);
            __builtin_amdgcn_sched_barrier(0);
            const LAS unsigned char* At = F.lds + bf * SC_BUF + SC_ACT + (32 * rb + r) * KSTR + h * 16; const LAS unsigned char* Wt = F.lds + bf * SC_BUF + SC_W + (128 * nh + r) * KSTR + h * 16;
            bf16x8 bfr_[4], afr_[4][4];
#pragma unroll
            for (int ks = 0; ks < 4; ++ks) { bfr_[ks] = *(const LAS bf16x8*)(At + ks * 32);
#pragma unroll
                for (int nt = 0; nt < 4; ++nt) afr_[ks][nt] = *(const LAS bf16x8*)(Wt + 32 * nt * KSTR + ks * 32); }
            __builtin_amdgcn_sched_barrier(0);
#pragma unroll
            for (int ks = 0; ks < 4; ++ks)
#pragma unroll
                for (int nt = 0; nt < 4; ++nt) acc[nt] = __builtin_amdgcn_mfma_f32_32x32x16_bf16(afr_[ks][nt], bfr_[ks], acc[nt], 0, 0, 0);
            __builtin_amdgcn_sched_barrier(0);
            if (tt + 1 < 16) PC_STORE(bf ^ 1);
            __syncthreads();
        }
#undef PC_LOAD
#undef PC_STORE
        float* prow = P + (size_t)kv * CMP_ROWS * 256 + (size_t)(rblk * 128 + 32 * rb + r) * 256 + 128 * nh + 4 * h;
#pragma unroll
        for (int nt = 0; nt < 4; ++nt)
#pragma unroll
            for (int g4 = 0; g4 < 4; ++g4) *(f32x4*)(prow + 32 * nt + 8 * g4) = (f32x4){acc[nt][4 * g4], acc[nt][4 * g4 + 1], acc[nt][4 * g4 + 2], acc[nt][4 * g4 + 3]};
    }
}

constexpr int W2T_STR = 136;
__device__ __forceinline__ void p6_combine(Frame& F, int part, int cu, int ncu) {
    LAS bf16* W2T = (LAS bf16*)F.lds;
    LAS float* CBL = (LAS float*)(F.lds + 2 * 64 * W2T_STR * 2);
    const float* P = WSP(float, WS_CMPP); bf16* KC = WSP(bf16, WS_KC); float* KCS = WSP(float, WS_KCS);
    for (int i = F.tid; i < 2 * 128 * 64; i += 512) { const int kv = i >> 13, k = (i >> 6) & 127, d = i & 63; W2T[(kv * 64 + d) * W2T_STR + k] = (bf16)f2bf(F.cmp_w2[i]); }
    if (F.tid < 256) CBL[F.tid] = WSP(float, WS_CBIAS)[F.tid];
    __syncthreads();
    const int lane = F.lane, ml = lane & 15, fq = lane >> 4;
    const int gw = cu * NWAVES + F.wave, NGW = ncu * NWAVES;
    constexpr int NT_P = CMP_ROWS_P / 16, NT_S = CMP_ROWS_S / 16;
    const bool prompt = part == 1; const int ntp = prompt ? NT_P : NT_S;
    f32x4 loA[4][2], hiA[4][2], loB[4][2], hiB[4][2];
#define CB_LOAD(lo_, hi_, task_) do { const int kv_ = (task_) / ntp, r0_ = ((task_) % ntp) * 16; const int prow_ = (prompt ? r0_ : CMP_ROWS_P + r0_) + ml; \
        const float* plo_ = P + (size_t)kv_ * CMP_ROWS * 256 + (size_t)prow_ * 256 + 8 * fq; const float* phi_ = plo_ + 4 * 256 + 128; \
        _Pragma("unroll") for (int ks = 0; ks < 4; ++ks) { lo_[ks][0] = *(const f32x4*)(plo_ + 32 * ks); lo_[ks][1] = *(const f32x4*)(plo_ + 32 * ks + 4); hi_[ks][0] = *(const f32x4*)(phi_ + 32 * ks); hi_[ks][1] = *(const f32x4*)(phi_ + 32 * ks + 4); } } while (0)
#define CB_FINISH(lo_, hi_, task_) do { const int kv = (task_) / ntp, r0 = ((task_) % ntp) * 16; const int nimask = prompt ? 255 : 127; \
        const int ro = r0 + ml, i_blk = (ro >> 2) & nimask; const bool valid = i_blk < nimask; \
        bf16x8 hb[4]; \
        _Pragma("unroll") for (int ks = 0; ks < 4; ++ks) { f32x4 z[2]; \
            _Pragma("unroll") for (int e = 0; e < 2; ++e) { z[e] = lo_[ks][e] + hi_[ks][e] + *(const LAS f32x4*)(CBL + kv * 128 + 32 * ks + 8 * fq + 4 * e); \
                _Pragma("unroll") for (int q = 0; q < 4; ++q) { const float zz = z[e][q]; z[e][q] = valid ? zz / (1.0f + __expf(-zz)) : 0.f; } } \
            hb[ks] = cvt8(z[0], z[1]); } \
        _Pragma("unroll") for (int db = 0; db < 4; ++db) { f32x4 acc = (f32x4){0.f, 0.f, 0.f, 0.f}; \
            _Pragma("unroll") for (int ks = 0; ks < 4; ++ks) { const bf16x8 a = *(const LAS bf16x8*)(W2T + (kv * 64 + 16 * db + ml) * W2T_STR + 32 * ks + 8 * fq); acc = __builtin_amdgcn_mfma_f32_16x16x32_bf16(a, hb[ks], acc, 0, 0, 0); } \
            const int g = ro & 3, d0 = 16 * db + 4 * fq; \
            if (prompt) { const int b = ro >> 10; v2u o; o.x = cvtpk(acc[0], acc[1]); o.y = cvtpk(acc[2], acc[3]); *(v2u*)(KC + ((size_t)((kv * 4 + b) * 4 + g) * 256 + i_blk) * 64 + d0) = o; } \
            else { const int b = ro >> 9; *(f32x4*)(KCS + ((size_t)((kv * 128 + b) * 4 + g) * 128 + i_blk) * 64 + d0) = acc; } } } while (0)
    const int ntask = 2 * ntp;
    int task = gw;
    if (task < ntask) CB_LOAD(loA, hiA, task);
    while (task < ntask) {
        int t2 = task + NGW; if (t2 < ntask) CB_LOAD(loB, hiB, t2);
        CB_FINISH(loA, hiA, task);
        task = t2; if (task >= ntask) break;
        t2 = task + NGW; if (t2 < ntask) CB_LOAD(loA, hiA, t2);
        CB_FINISH(loB, hiB, task);
        task = t2;
    }
#undef CB_LOAD
#undef CB_FINISH
}

constexpr int VSTR = 192;
constexpr int AT_K = 0, AT_V = 64 * KSTR, AT_BUF = 64 * KSTR + 64 * VSTR  , AT_T = 2 * AT_BUF, AT_TS = 66, AT_U = AT_T + 64 * AT_TS * 4, AT_OF = AT_T  , AT_SEL = AT_OF + 8 * 32 * 64 * 4, AT_WUNI = AT_SEL + 512, AT_END = AT_WUNI + 64;
static_assert(AT_U + 64 * AT_TS * 4 <= AT_SEL, "attention LDS");
static_assert(AT_END <= RING_BYTES, "attention LDS");

__device__ __forceinline__ v4i16_t vtr(const LAS unsigned char* p) { return __builtin_amdgcn_ds_read_tr16_b64_v4i16((LAS v4i16_t*)p); }

struct KvRegs { v4u k, v; };
__device__ __forceinline__ void load_kv(Frame& F, KvRegs& R, const bf16* ksrc, const bf16* vsrc, int pitch) {
    const int key = F.tid >> 3, ch = F.tid & 7;
    R.k = *(const v4u*)(ksrc + (size_t)key * pitch + ch * 8);
    R.v = *(const v4u*)(vsrc + (size_t)key * pitch + ch * 8);
}
__device__ __forceinline__ void store_kv(Frame& F, const KvRegs& R, int buf) {
    const int key = F.tid >> 3, ch = F.tid & 7;
    *(LAS v4u*)(F.lds + buf * AT_BUF + AT_K + key * KSTR + ch * 16) = R.k;
    *(LAS v4u*)(F.lds + buf * AT_BUF + AT_V + key * VSTR + ch * 16) = R.v;
}

constexpr float ATT_THR = 8.0f;
template <int MODE>
__device__ __forceinline__ void attn_tile(Frame& F, bool MASKED, int buf, const bf16x8 (&qf)[4], int relb, float slope2, bool rowok, float& m, float& l, bool& any, f32x16& o0, f32x16& o1,
                                          float mfin, float invl, LAS float* Tq, LAS float* Uq, int sig0) {
    const int lane = F.lane, r = lane & 31, h = lane >> 5;
    const LAS unsigned char* Kt = F.lds + buf * AT_BUF + AT_K; const LAS unsigned char* Vt = F.lds + buf * AT_BUF + AT_V;
    constexpr int PM = (MODE <= 1) ? 16 : 1;
    const float NEG = -INFINITY;
    float c0 = slope2 * (float)relb - ((MODE == 1) ? mfin : m);
    if (!rowok) c0 = NEG;
    const float k32 = slope2 * (float)(32 * PM);
    f32x16 p0, p1;
#pragma unroll
    for (int i = 0; i < 16; ++i) { p0[i] = fmaf(slope2, (float)(PM * ((i & 3) + 8 * (i >> 2))), c0); p1[i] = p0[i] + k32; }
    bf16x8 kfr[8];
#pragma unroll
    for (int ks = 0; ks < 4; ++ks) { kfr[2 * ks] = *(const LAS bf16x8*)(Kt + r * KSTR + ks * 32 + h * 16); kfr[2 * ks + 1] = *(const LAS bf16x8*)(Kt + (32 + r) * KSTR + ks * 32 + h * 16); }
    v4i16_t vlo[4][2], vhi[4][2];
    if (MODE != 0) { const LAS unsigned char* vb = Vt + (((lane & 15) >> 2) + 4 * h) * VSTR + (16 * ((lane >> 4) & 1) + 4 * (lane & 3)) * 2;
#pragma unroll
        for (int sp = 0; sp < 4; ++sp)
#pragma unroll
            for (int db = 0; db < 2; ++db) { vlo[sp][db] = vtr(vb + (16 * sp) * VSTR + 64 * db); vhi[sp][db] = vtr(vb + (16 * sp + 8) * VSTR + 64 * db); } }
    __builtin_amdgcn_sched_barrier(0);
#pragma unroll
    for (int ks = 0; ks < 4; ++ks) {
        p0 = __builtin_amdgcn_mfma_f32_32x32x16_bf16(kfr[2 * ks], qf[ks], p0, 0, 0, 0);
        p1 = __builtin_amdgcn_mfma_f32_32x32x16_bf16(kfr[2 * ks + 1], qf[ks], p1, 0, 0, 0);
    }
    __builtin_amdgcn_sched_barrier(0);
    if (MASKED) {
#pragma unroll
        for (int i = 0; i < 16; ++i) {
            const int kofs = PM * ((i & 3) + 8 * (i >> 2));
            const int rel0 = relb + kofs, rel1 = rel0 + PM * 32;
            bool ok0 = rel0 <= 0, ok1 = rel1 <= 0;
            if (MODE == 3) { ok0 = ok0 && rel0 > -512; ok1 = ok1 && rel1 > -512; }
            p0[i] = ok0 ? p0[i] : NEG; p1[i] = ok1 ? p1[i] : NEG;
        }
    }
    if (MODE == 1) {
#pragma unroll
        for (int i = 0; i < 16; ++i) { p0[i] = __builtin_amdgcn_exp2f(p0[i]) * invl; p1[i] = __builtin_amdgcn_exp2f(p1[i]) * invl; }
#pragma unroll
        for (int hf = 0; hf < 2; ++hf)
#pragma unroll
            for (int g4 = 0; g4 < 4; ++g4) {
                const float pa = hf ? p1[4 * g4] : p0[4 * g4], pb = hf ? p1[4 * g4 + 1] : p0[4 * g4 + 1], pc = hf ? p1[4 * g4 + 2] : p0[4 * g4 + 2], pd = hf ? p1[4 * g4 + 3] : p0[4 * g4 + 3];
                float tv = 2.f * ((pa + pb) + pc) + pd, uv = pd;
                tv += __shfl_xor(tv, 1); uv += __shfl_xor(uv, 1); tv += __shfl_xor(tv, 2); uv += __shfl_xor(uv, 2);
                const int sg = sig0 + 8 * hf + 2 * g4 + h;
                if ((lane & 3) == 0) { Tq[sg] = tv; Uq[sg + 1] = uv; }
            }
    } else {
        float mxa = fmaxf(fmaxf(p0[0], p0[1]), p1[0]), mxb = fmaxf(fmaxf(p0[2], p0[3]), p1[1]); mxa = fmaxf(fmaxf(mxa, p1[2]), p1[3]);
#pragma unroll
        for (int i = 4; i < 16; i += 4) { mxa = fmaxf(fmaxf(mxa, p0[i]), p0[i + 1]); mxb = fmaxf(fmaxf(mxb, p0[i + 2]), p0[i + 3]); mxa = fmaxf(fmaxf(mxa, p1[i]), p1[i + 1]); mxb = fmaxf(fmaxf(mxb, p1[i + 2]), p1[i + 3]); }
        float mx = fmaxf(mxa, mxb); mx = fmaxf(mx, __shfl_xor(mx, 32));
        const bool need = (mx > ATT_THR) || (!any && mx > NEG);
        if (__any(need)) {
            const float dl = need ? mx : 0.f; const float f = any ? __builtin_amdgcn_exp2f(-dl) : 1.f;
            m += dl; l *= f;
#pragma unroll
            for (int i = 0; i < 16; ++i) { p0[i] -= dl; p1[i] -= dl; }
            if (MODE >= 2) {
#pragma unroll
                for (int i = 0; i < 16; ++i) { o0[i] *= f; o1[i] *= f; } }
        }
        any = any || (mx > NEG);
        float rs0 = 0.f, rs1 = 0.f;
#pragma unroll
        for (int i = 0; i < 16; ++i) { p0[i] = __builtin_amdgcn_exp2f(p0[i]); p1[i] = __builtin_amdgcn_exp2f(p1[i]); rs0 += p0[i]; rs1 += p1[i]; }
        l += rs0 + rs1;
        if (MODE == 0) return;
    }
    __builtin_amdgcn_sched_barrier(0);
#pragma unroll
    for (int sp = 0; sp < 4; ++sp) {
        v4u pw;
        if (sp < 2) { const int b8 = 8 * sp; pw.x = cvtpk(p0[b8], p0[b8 + 1]); pw.y = cvtpk(p0[b8 + 2], p0[b8 + 3]); pw.z = cvtpk(p0[b8 + 4], p0[b8 + 5]); pw.w = cvtpk(p0[b8 + 6], p0[b8 + 7]); }
        else { const int b8 = 8 * (sp - 2); pw.x = cvtpk(p1[b8], p1[b8 + 1]); pw.y = cvtpk(p1[b8 + 2], p1[b8 + 3]); pw.z = cvtpk(p1[b8 + 4], p1[b8 + 5]); pw.w = cvtpk(p1[b8 + 6], p1[b8 + 7]); }
        const bf16x8 pbf = __builtin_bit_cast(bf16x8, pw);
#pragma unroll
        for (int db = 0; db < 2; ++db) {
            const v4i16_t lo = vlo[sp][db], hi = vhi[sp][db];
            const bf16x8 vf = (bf16x8){lo[0], lo[1], lo[2], lo[3], hi[0], hi[1], hi[2], hi[3]};
            if (db == 0) o0 = __builtin_amdgcn_mfma_f32_32x32x16_bf16(vf, pbf, o0, 0, 0, 0);
            else o1 = __builtin_amdgcn_mfma_f32_32x32x16_bf16(vf, pbf, o1, 0, 0, 0);
        }
    }
}

struct BgCopy {
    size_t base; int k, pend; f32x4 v0;
    __device__ __forceinline__ void init(Frame& F) { const int b = F.vcu >> 1, hb = F.vcu & 1; k = (F.G == 256) ? 0 : 64; pend = 0; base = (size_t)b * 65536 + hb * 32704; }
    __device__ __forceinline__ void step(Frame& F) {
        const f32x4* src = (const f32x4*)F.state_win + base + 128 + F.tid; f32x4* dst = (f32x4*)(F.out + OUT_WIN_S) + base + F.tid;
        if (pend) { if (k - 1 < 63 || F.tid < 448) dst[512 * (k - 1)] = v0; pend = 0; }
        if (k < 64) { if (k < 63 || F.tid < 448) v0 = src[512 * k]; k += 1; pend = 1; }
    }
    __device__ __forceinline__ void finish(Frame& F) { while (k < 64 || pend) step(F); }
};

__device__ __forceinline__ void attn_prompt_unit(Frame& F, BgCopy& BG, int b, int g, int qb) {
    const int lane = F.lane, r = lane & 31, h = lane >> 5, w = F.wave;
    const int c0 = qb * 64, cur = qb, ql = 8 * w + (r >> 2), tq = c0 + ql, hd = g * 4 + (r & 3);
    const bf16* Q = WSP(bf16, WS_Q); const bf16* KVS = WSP(bf16, WS_KVS); const bf16* KVW = WSP(bf16, WS_KVW); const bf16* KC = WSP(bf16, WS_KC); const float* GATE = WSP(float, WS_GATE);
    bf16* O = WSP(bf16, WS_DIFF);
    const size_t row = (size_t)b * SEQ + tq;
    bf16x8 qf[4];
#pragma unroll
    for (int ks = 0; ks < 4; ++ks) qf[ks] = *(const bf16x8*)(Q + row * D + hd * 64 + ks * 16 + h * 8);
    const float slope2 = exp2f(-0.5f * (float)(hd + 1)) * LOG2E;
    const float g0 = GATE[row * 48 + hd * 3 + 0], g1 = GATE[row * 48 + hd * 3 + 1], g2 = GATE[row * 48 + hd * 3 + 2];
    LAS float* T = (LAS float*)(F.lds + AT_T); LAS float* U = (LAS float*)(F.lds + AT_U);
    LAS unsigned* SELM = (LAS unsigned*)(F.lds + AT_SEL); LAS unsigned* WUNI = (LAS unsigned*)(F.lds + AT_WUNI);
    for (int i = F.tid; i < 2 * 64 * AT_TS; i += 512) T[i] = 0.f;
    f32x16 of0, of1, o0, o1;
#pragma unroll
    for (int i = 0; i < 16; ++i) { of0[i] = 0.f; of1[i] = 0.f; o0[i] = 0.f; o1[i] = 0.f; }
    const float NEG = -INFINITY;
    const int nmax = c0 / 16 + 2;
    const int ntile = (nmax >= 255 ? 254 : nmax) / 64 + 1;
    const bf16* kc = KC + (size_t)((0 * 4 + b) * 4 + g) * 256 * 64; const bf16* vc = KC + (size_t)((1 * 4 + b) * 4 + g) * 256 * 64;
    float m = 0.f, l = 0.f; bool any = false;
    KvRegs R; int cb = 0;
    load_kv(F, R, kc, vc, 64); __syncthreads(); store_kv(F, R, 0); __syncthreads();
    for (int tl = 0; tl < ntile; ++tl) {
        const bool more = tl + 1 < ntile; BG.step(F);
        if (more) load_kv(F, R, kc + (size_t)(tl + 1) * 64 * 64, vc + (size_t)(tl + 1) * 64 * 64, 64); else load_kv(F, R, kc, vc, 64);
        attn_tile<0>(F, !(1024 * tl + 1039 <= c0 + 8 * w), cb, qf, 16 * 64 * tl + 31 + 16 * 4 * h - tq, slope2, true, m, l, any, o0, o1, 0.f, 0.f, nullptr, nullptr, 0);
        store_kv(F, R, cb ^ 1); __syncthreads(); cb ^= 1;
    }
    { const float lt = l + __shfl_xor(l, 32); const float invl = lt > 0.f ? 1.0f / lt : 0.f;
      LAS float* Tq = T + ql * AT_TS; LAS float* Uq = U + ql * AT_TS;
      for (int tl = 0; tl < ntile; ++tl) {
          const bool more = tl + 1 < ntile;
          if (more) load_kv(F, R, kc + (size_t)(tl + 1) * 64 * 64, vc + (size_t)(tl + 1) * 64 * 64, 64);
          attn_tile<1>(F, !(1024 * tl + 1039 <= c0 + 8 * w), cb, qf, 16 * 64 * tl + 31 + 16 * 4 * h - tq, slope2, true, m, l, any, o0, o1, m, invl, Tq, Uq, 16 * tl);
          if (more) { store_kv(F, R, cb ^ 1); __syncthreads(); cb ^= 1; }
      }
#pragma unroll
      for (int i = 0; i < 16; ++i) { of0[i] = g0 * o0[i]; of1[i] = g0 * o1[i]; o0[i] = 0.f; o1[i] = 0.f; } }
    __syncthreads();
    unsigned long long wuni = 0ull;
    for (int qq = 8 * w; qq < 8 * w + 8; ++qq) {
        unsigned long long msk;
        if (cur <= 15) msk = (cur == 63) ? ~0ull : ((1ull << (cur + 1)) - 1ull);
        else {
            const float v = T[qq * AT_TS + lane] + U[qq * AT_TS + lane];
            T[qq * AT_TS + lane] = v;
            LDS_WAIT(); asm volatile("" ::: "memory");
            int rank = 0;
            for (int s2 = 1; s2 <= cur - 2; ++s2) { const float o = T[qq * AT_TS + s2]; rank += (o > v || (o == v && s2 < lane)) ? 1 : 0; }
            const bool sel = (lane <= cur) && (lane == 0 || lane >= cur - 1 || rank < 13);
            msk = __ballot(sel);
        }
        if (lane == 0) { SELM[2 * qq] = (unsigned)msk; SELM[2 * qq + 1] = (unsigned)(msk >> 32); }
        wuni |= msk;
    }
    wuni = ((unsigned long long)(unsigned)__builtin_amdgcn_readfirstlane((int)(unsigned)(wuni >> 32)) << 32) | (unsigned long long)(unsigned)__builtin_amdgcn_readfirstlane((int)(unsigned)wuni);
    if (lane == 0) { WUNI[2 * w] = (unsigned)wuni; WUNI[2 * w + 1] = (unsigned)(wuni >> 32); }
    __syncthreads();
    unsigned long long guni = 0ull;
#pragma unroll
    for (int i = 0; i < 8; ++i) guni |= (unsigned long long)WUNI[2 * i] | ((unsigned long long)WUNI[2 * i + 1] << 32);
    const unsigned long long mym = (unsigned long long)SELM[2 * ql] | ((unsigned long long)SELM[2 * ql + 1] << 32);
    LAS float* OFP = (LAS float*)(F.lds + AT_OF) + w * 32 * 64 + lane;
#pragma unroll
    for (int i = 0; i < 16; ++i) { OFP[i * 64] = of0[i]; OFP[(16 + i) * 64] = of1[i]; }
    m = 0.f; l = 0.f; any = false;
    { const bf16* ks = KVS + (size_t)b * SEQ * 512 + g * 64; const bf16* vs = ks + 256;
      unsigned long long rem = guni;
      int s = __builtin_ctzll(rem); rem &= rem - 1ull;
      load_kv(F, R, ks + (size_t)s * 64 * 512, vs + (size_t)s * 64 * 512, 512); __syncthreads(); store_kv(F, R, 0); __syncthreads(); cb = 0;
      for (;;) {
          const bool more = rem != 0ull; const int sn = more ? __builtin_ctzll(rem) : 0; rem &= rem - 1ull; BG.step(F);
          if (more) load_kv(F, R, ks + (size_t)sn * 64 * 512, vs + (size_t)sn * 64 * 512, 512);
          if ((wuni >> s) & 1ull) attn_tile<2>(F, s == cur, cb, qf, 64 * s + 4 * h - tq, slope2, ((mym >> s) & 1ull) != 0ull, m, l, any, o0, o1, 0.f, 0.f, nullptr, nullptr, 0);
          if (!more) break;
          store_kv(F, R, cb ^ 1); __syncthreads(); cb ^= 1; s = sn;
      }
      const float lt = l + __shfl_xor(l, 32); const float sc = lt > 0.f ? g1 / lt : 0.f;
#pragma unroll
      for (int i = 0; i < 16; ++i) { OFP[i * 64] += sc * o0[i]; OFP[(16 + i) * 64] += sc * o1[i]; o0[i] = 0.f; o1[i] = 0.f; } }
    m = 0.f; l = 0.f; any = false;
    { const bf16* kw = KVW + (size_t)b * SEQ * 512 + g * 64; const bf16* vw = kw + 256;
      const int j0 = (c0 >= 512) ? 0 : (512 - c0) / 64;
      { const int pos0 = c0 - 512 + 64 * j0; load_kv(F, R, kw + (size_t)pos0 * 512, vw + (size_t)pos0 * 512, 512); __syncthreads(); store_kv(F, R, 0); __syncthreads(); cb = 0; }
      for (int j = j0; j < 9; ++j) {
          const int pos0 = c0 - 512 + 64 * j; const bool more = j + 1 < 9; BG.step(F);
          if (more) load_kv(F, R, kw + (size_t)(pos0 + 64) * 512, vw + (size_t)(pos0 + 64) * 512, 512);
          attn_tile<3>(F, j == 0 || j == 8, cb, qf, pos0 + 4 * h - tq, slope2, true, m, l, any, o0, o1, 0.f, 0.f, nullptr, nullptr, 0);
          if (more) { store_kv(F, R, cb ^ 1); __syncthreads(); cb ^= 1; }
      }
      const float lt = l + __shfl_xor(l, 32); const float sc = lt > 0.f ? g2 / lt : 0.f;
#pragma unroll
      for (int i = 0; i < 16; ++i) { of0[i] = OFP[i * 64] + sc * o0[i]; of1[i] = OFP[(16 + i) * 64] + sc * o1[i]; } }
    bf16* orow = O + row * D + hd * 64;
#pragma unroll
    for (int g4 = 0; g4 < 4; ++g4) {
        v2u a; a.x = cvtpk(of0[4 * g4], of0[4 * g4 + 1]); a.y = cvtpk(of0[4 * g4 + 2], of0[4 * g4 + 3]);
        v2u c; c.x = cvtpk(of1[4 * g4], of1[4 * g4 + 1]); c.y = cvtpk(of1[4 * g4 + 2], of1[4 * g4 + 3]);
        *(v2u*)(orow + 8 * g4 + 4 * h) = a; *(v2u*)(orow + 32 + 8 * g4 + 4 * h) = c;
    }
    __syncthreads();
}

constexpr int SA_QS = 0, SA_SC = 1024, SA_NK = 1664, SA_IMP = SA_SC + SA_NK * 16, SA_LIST = SA_IMP + 256, SA_BLK = SA_LIST + 64, SA_RED = SA_BLK + 128, SA_END = SA_RED + 512 * 64;
constexpr int SK_CMP = 0, SK_SEL = 128, SK_WIN = 1088, SK_NSEL = 1600, SK_NWIN = 1601;
static_assert(SA_END <= RING_BYTES, "sample attention LDS");

__device__ __forceinline__ f32x4 wave_max4(f32x4 v) {
#pragma unroll
    for (int o = 1; o < 64; o <<= 1) { v[0] = fmaxf(v[0], __shfl_xor(v[0], o)); v[1] = fmaxf(v[1], __shfl_xor(v[1], o)); v[2] = fmaxf(v[2], __shfl_xor(v[2], o)); v[3] = fmaxf(v[3], __shfl_xor(v[3], o)); }
    return v;
}
__device__ __forceinline__ f32x4 wave_sum4(f32x4 v) {
#pragma unroll
    for (int o = 1; o < 64; o <<= 1) { v[0] += __shfl_xor(v[0], o); v[1] += __shfl_xor(v[1], o); v[2] += __shfl_xor(v[2], o); v[3] += __shfl_xor(v[3], o); }
    return v;
}
__device__ __forceinline__ void sa_softmax4(LAS f32x4* SC, int k0, int nk, int kx, f32x4 post, int lane) {
    f32x4 mx = (f32x4){-INFINITY, -INFINITY, -INFINITY, -INFINITY};
    for (int i = lane; i < nk; i += 64) { const f32x4 s = SC[k0 + i]; mx[0] = fmaxf(mx[0], s[0]); mx[1] = fmaxf(mx[1], s[1]); mx[2] = fmaxf(mx[2], s[2]); mx[3] = fmaxf(mx[3], s[3]); }
    if (kx >= 0) { const f32x4 s = SC[kx]; mx[0] = fmaxf(mx[0], s[0]); mx[1] = fmaxf(mx[1], s[1]); mx[2] = fmaxf(mx[2], s[2]); mx[3] = fmaxf(mx[3], s[3]); }
    mx = wave_max4(mx);
#pragma unroll
    for (int q = 0; q < 4; ++q) if (mx[q] == -INFINITY) mx[q] = 0.f;
    f32x4 sum = (f32x4){0.f, 0.f, 0.f, 0.f};
    for (int i = lane; i < nk; i += 64) { f32x4 s = SC[k0 + i];
#pragma unroll
        for (int q = 0; q < 4; ++q) s[q] = __builtin_amdgcn_exp2f(s[q] - mx[q]);
        SC[k0 + i] = s; sum += s; }
    sum = wave_sum4(sum);
    f32x4 ex = (f32x4){0.f, 0.f, 0.f, 0.f};
    if (kx >= 0) { const f32x4 s = SC[kx];
#pragma unroll
        for (int q = 0; q < 4; ++q) ex[q] = __builtin_amdgcn_exp2f(s[q] - mx[q]);
        sum += ex; }
    f32x4 sc;
#pragma unroll
    for (int q = 0; q < 4; ++q) sc[q] = sum[q] > 0.f ? post[q] / sum[q] : 0.f;
    LDS_WAIT(); asm volatile("" ::: "memory");
    for (int i = lane; i < nk; i += 64) SC[k0 + i] = SC[k0 + i] * sc;
    if (kx >= 0 && lane == 0) SC[kx] = ex * sc;
}

#define SA_LOADK(dst, kr) do { dst[0] = *(const f32x4*)(kr); dst[1] = *(const f32x4*)((kr) + 4); dst[2] = *(const f32x4*)((kr) + 32); dst[3] = *(const f32x4*)((kr) + 36); } while (0)
#define SA_SCORE(acc, kf) do { acc = __builtin_amdgcn_mfma_f32_16x16x32_bf16(af[0], cvt8(kf[0], kf[1]), (f32x4){0.f, 0.f, 0.f, 0.f}, 0, 0, 0); acc = __builtin_amdgcn_mfma_f32_16x16x32_bf16(af[1], cvt8(kf[2], kf[3]), acc, 0, 0, 0); } while (0)

__device__ __forceinline__ void attn_sample_unit(Frame& F, int b, int g) {
    const int tid = F.tid, lane = F.lane, w = F.wave; const int row = MP + b;
    const bf16* Q = WSP(bf16, WS_Q); const bf16* KVS = WSP(bf16, WS_KVS); const bf16* KVW = WSP(bf16, WS_KVW); const float* KCS = WSP(float, WS_KCS); const float* GATE = WSP(float, WS_GATE);
    bf16* O = WSP(bf16, WS_DIFF);
    LAS f32x4* SC = (LAS f32x4*)(F.lds + SA_SC); LAS float* IMP = (LAS float*)(F.lds + SA_IMP);
    LAS int* LIST = (LAS int*)(F.lds + SA_LIST); LAS int* BLK = (LAS int*)(F.lds + SA_BLK); LAS float* RED = (LAS float*)(F.lds + SA_RED);
    const float* kc = KCS + (size_t)((0 * 128 + b) * 4 + g) * 128 * 64; const float* vc = KCS + (size_t)((1 * 128 + b) * 4 + g) * 128 * 64;
    const float* sw = F.state_win + (size_t)b * 512 * 512;
    __syncthreads();
    bf16x8 af[2];
#pragma unroll
    for (int ks = 0; ks < 2; ++ks) { af[ks] = (bf16x8){0, 0, 0, 0, 0, 0, 0, 0}; if ((lane & 15) < 4) af[ks] = *(const bf16x8*)(Q + (size_t)row * D + (g * 4 + (lane & 15)) * 64 + 32 * ks + 8 * (lane >> 4)); }
    f32x4 sl2;
#pragma unroll
    for (int i = 0; i < 4; ++i) sl2[i] = exp2f(-0.5f * (float)(g * 4 + i + 1)) * LOG2E;
    f32x4 gt0, gt1, gt2;
    { const float* gp = GATE + (size_t)row * 48 + g * 12;
#pragma unroll
      for (int i = 0; i < 4; ++i) { gt0[i] = gp[i * 3 + 0]; gt1[i] = gp[i * 3 + 1]; gt2[i] = gp[i * 3 + 2]; } }
    const int kl = lane & 15, kc8 = 8 * (lane >> 4);
    { f32x4 kf[5][4];
      { const float* kr = kc + (size_t)(16 * w + kl) * 64 + kc8; SA_LOADK(kf[0], kr); }
#pragma unroll
      for (int j = 1; j < 5; ++j) { const float* kr = sw + (size_t)(16 * (w + 8 * (j - 1)) + kl) * 512 + g * 64 + kc8; SA_LOADK(kf[j], kr); }
      f32x4 acc;
      SA_SCORE(acc, kf[0]);
      if (lane < 16) { const int n = 16 * w + kl; const float rel = (float)(16 * n + 31 - PAST); f32x4 s;
#pragma unroll
          for (int i = 0; i < 4; ++i) s[i] = (n < 127) ? acc[i] + sl2[i] * rel : -INFINITY;
          SC[SK_CMP + n] = s; }
#pragma unroll
      for (int j = 1; j < 5; ++j) { SA_SCORE(acc, kf[j]);
          if (lane < 16) { const int i2 = 16 * (w + 8 * (j - 1)) + kl; const float rel = (float)(i2 - 512); f32x4 s;
#pragma unroll
              for (int i = 0; i < 4; ++i) s[i] = (i2 >= 1) ? acc[i] + sl2[i] * rel : -INFINITY;
              SC[SK_WIN + i2] = s; } }
      if (w == 7) {
          f32x4 a, c2; const float kwn = bf2f(KVW[(size_t)row * 512 + g * 64 + lane]), ksn = bf2f(KVS[(size_t)row * 512 + g * 64 + lane]);
#pragma unroll
          for (int i = 0; i < 4; ++i) { const float qv = bf2f(Q[(size_t)row * D + (g * 4 + i) * 64 + lane]); a[i] = qv * kwn; c2[i] = qv * ksn; }
          a = wave_sum4(a); c2 = wave_sum4(c2);
          if (lane == 0) { SC[SK_NWIN] = a; SC[SK_NSEL] = c2; }
      }
    }
    __syncthreads();
    if (w == 0) {
        sa_softmax4(SC, SK_CMP, 128, -1, (f32x4){1.f, 1.f, 1.f, 1.f}, lane);
        LDS_WAIT(); asm volatile("" ::: "memory");
        if (lane < 33) { float a = 0.f;
#pragma unroll
            for (int dn = -1; dn <= 3; ++dn) { const int n = 4 * lane + dn; if (n >= 0 && n < 127) { const f32x4 p = SC[SK_CMP + n]; a += ((dn == -1 || dn == 3) ? 1.f : 2.f) * ((p[0] + p[1]) + (p[2] + p[3])); } }
            IMP[lane] = a; }
        LDS_WAIT(); asm volatile("" ::: "memory");
        const float v = (lane <= 32) ? IMP[lane] : 0.f; int rank = 0;
        for (int s2 = 1; s2 <= 30; ++s2) { const float o = IMP[s2]; rank += (o > v || (o == v && s2 < lane)) ? 1 : 0; }
        const bool sel = (lane == 0) || (lane == 31) || (lane >= 1 && lane <= 30 && rank < 13);
        const unsigned long long msk = __ballot(sel);
        if (sel) { const int pos = __builtin_popcountll(msk & ((1ull << lane) - 1ull)); LIST[pos] = lane;
            const int page = F.page_table[b * 16 + (lane >> 1)]; BLK[pos] = page * 128 + (lane & 1) * 64; }
        LDS_WAIT(); asm volatile("" ::: "memory");
        for (int i = lane; i < 128; i += 64) SC[SK_CMP + i] = SC[SK_CMP + i] * gt0;
    }
    __syncthreads();
#pragma unroll
    for (int bt = 0; bt < 2; ++bt) {
        f32x4 kf[4][4];
#pragma unroll
        for (int j = 0; j < 4; ++j) { const int st = w + 8 * (4 * bt + j); if (st < 60) { const int bi = st >> 2, kk = 16 * (st & 3) + kl;
            const float* kr = F.cache + ((size_t)(BLK[bi] + kk) * 4 + 2) * 256 + g * 64 + kc8; SA_LOADK(kf[j], kr); } }
#pragma unroll
        for (int j = 0; j < 4; ++j) { const int st = w + 8 * (4 * bt + j); if (st < 60) { const int bi = st >> 2, kk = 16 * (st & 3) + kl; f32x4 acc; SA_SCORE(acc, kf[j]);
            if (lane < 16) { const float rel = (float)(64 * LIST[bi] + kk - PAST); f32x4 s;
#pragma unroll
                for (int i = 0; i < 4; ++i) s[i] = acc[i] + sl2[i] * rel;
                SC[SK_SEL + 64 * bi + kk] = s; } } }
    }
    if (w == 1) sa_softmax4(SC, SK_WIN, 512, SK_NWIN, gt2, lane);
    __syncthreads();
    if (w == 0) sa_softmax4(SC, SK_SEL, 960, SK_NSEL, gt1, lane);
    __syncthreads();
    { const int kq = lane >> 4, c4 = 4 * (lane & 15);
      f32x4 acc[4];
#pragma unroll
      for (int i = 0; i < 4; ++i) acc[i] = (f32x4){0.f, 0.f, 0.f, 0.f};
      { f32x4 vv[4];
#pragma unroll
        for (int it = 0; it < 4; ++it) vv[it] = *(const f32x4*)(vc + (size_t)(32 * it + 4 * w + kq) * 64 + c4);
#pragma unroll
        for (int it = 0; it < 4; ++it) { const f32x4 p = SC[SK_CMP + 32 * it + 4 * w + kq];
#pragma unroll
            for (int i = 0; i < 4; ++i) acc[i] += vv[it] * p[i]; } }
#pragma unroll
      for (int bt = 0; bt < 1; ++bt) { f32x4 vv[16];
#pragma unroll
        for (int j = 0; j < 16; ++j) vv[j] = *(const f32x4*)(sw + (size_t)(32 * j + 4 * w + kq) * 512 + 256 + g * 64 + c4);
#pragma unroll
        for (int j = 0; j < 16; ++j) { const f32x4 p = SC[SK_WIN + 32 * j + 4 * w + kq];
#pragma unroll
            for (int i = 0; i < 4; ++i) acc[i] += vv[j] * p[i]; } }
#pragma unroll
      for (int bt = 0; bt < 2; ++bt) { f32x4 vv[15];
#pragma unroll
        for (int j = 0; j < 15; ++j) { const int k = 32 * (15 * bt + j) + 4 * w + kq; vv[j] = *(const f32x4*)(F.cache + ((size_t)(BLK[k >> 6] + (k & 63)) * 4 + 3) * 256 + g * 64 + c4); }
#pragma unroll
        for (int j = 0; j < 15; ++j) { const f32x4 p = SC[SK_SEL + 32 * (15 * bt + j) + 4 * w + kq];
#pragma unroll
            for (int i = 0; i < 4; ++i) acc[i] += vv[j] * p[i]; } }
#pragma unroll
      for (int i = 0; i < 4; ++i) *(LAS f32x4*)(RED + tid * 16 + 4 * i) = acc[i];
    }
    __syncthreads();
    if (tid < 256) { const int hd = tid >> 6, d = tid & 63; float a = 0.f;
#pragma unroll 8
        for (int j = 0; j < 32; ++j) a += RED[((j >> 2) * 64 + (j & 3) * 16 + (d >> 2)) * 16 + hd * 4 + (d & 3)];
        { const f32x4 ps = SC[SK_NSEL], pw = SC[SK_NWIN];
          a += ps[hd] * bf2f(KVS[(size_t)row * 512 + 256 + g * 64 + d]) + pw[hd] * bf2f(KVW[(size_t)row * 512 + 256 + g * 64 + d]); }
        O[(size_t)row * D + (g * 4 + hd) * 64 + d] = (bf16)f2bf(a); }
    __syncthreads();
}

__device__ __forceinline__ void p7_attention(Frame& F) {
    BgCopy BG; BG.init(F);
    const bool sfirst = (blockIdx.x & 1) == 0;
    SEG_BEGIN(20); if (sfirst) for (int i = F.vcu; i < DB * 4; i += F.G) attn_sample_unit(F, i >> 2, i & 3); SEG_END(20);
    SEG_BEGIN(21);
    for (int i = F.vcu; i < 1024; i += F.G) { const int k = i >> 8, c = i & 255, bg = c >> 4, s = c & 15; const int qb = (k == 0) ? s : (k == 1) ? 31 - s : (k == 2) ? 32 + s : 63 - s;
        attn_prompt_unit(F, BG, bg >> 2, bg & 3, qb); }
    BG.finish(F); SEG_END(21);
    SEG_BEGIN(20); if (!sfirst) for (int i = F.vcu; i < DB * 4; i += F.G) attn_sample_unit(F, i >> 2, i & 3); SEG_END(20);
}

enum { SG_POOL = 0, SG_UP = 1, SG_DOWN = 2, SG_KVQG = 3, SG_WO = 4 };
constexpr int SG_RED = 0, SG_SSQ = 2 * 8 * 16 * 64 * 4;
template <int KIND>
__device__ __forceinline__ void small_gemm(Frame& F, int layer) {
    constexpr bool F32B = (KIND == SG_UP || KIND == SG_KVQG);
    constexpr int KR = (KIND == SG_POOL) ? 256 : 1024;
    constexpr int KSPLIT = (KIND == SG_DOWN) ? 4 : 1;
    constexpr int NSL = (KIND == SG_POOL) ? 32 : (KIND == SG_UP) ? 128 : (KIND == SG_KVQG) ? 82 : 32;
    constexpr int KW = KR / 8, NKS = KW / 16;
    const int lane = F.lane, w = F.wave, r = lane & 31, h = lane >> 5;
    float* X = WSP(float, WS_X);
    LAS float* RED = (LAS float*)(F.lds + SG_RED); LAS float* SSQ = (LAS float*)(F.lds + SG_SSQ);
    for (int item = F.vcu; item < (NSL / 2) * 4 * KSPLIT; item += F.G) {
        const int kr = item % KSPLIT, tt = item / KSPLIT, rbk = tt & 3, np = tt >> 2;
        const int row = MP + 32 * rbk + r, b = 32 * rbk + r;
        const int kb = kr * KR + w * KW + 8 * h;
        int n0[2]; const bf16* wrow[2]; const bf16* b16 = nullptr; const float* b32 = nullptr;
#pragma unroll
        for (int t = 0; t < 2; ++t) { const int ns = 2 * np + t; n0[t] = ns * 32;
            if (KIND == SG_POOL) { const int g = ns >> 3; n0[t] = (ns & 7) * 32; wrow[t] = WSP(bf16, WS_WPOOL) + (size_t)g * 65536 + (size_t)(n0[t] + r) * 256 + kb; b16 = WSP(bf16, WS_DIFF) + (size_t)row * D + g * 256 + kb; n0[t] += g * 256; }
            else if (KIND == SG_UP) { wrow[t] = WSP(bf16, WS_WUP) + (size_t)layer * FF * D + (size_t)(n0[t] + r) * D + kb; b32 = X + (size_t)row * D + kb; }
            else if (KIND == SG_DOWN) { wrow[t] = WSP(bf16, WS_WDN) + (size_t)layer * D * FF + (size_t)(n0[t] + r) * FF + kb; b16 = WSP(bf16, WS_H) + (size_t)row * FF + kb; }
            else if (KIND == SG_KVQG) { wrow[t] = WSP(bf16, WS_WKVQG) + (size_t)(n0[t] + r) * D + kb; b32 = X + (size_t)row * D + kb; }
            else { wrow[t] = WSP(bf16, WS_WO) + (size_t)(n0[t] + r) * D + kb; b16 = WSP(bf16, WS_DIFF) + (size_t)row * D + kb; } }
        bf16x8 a0[NKS], a1[NKS], bb[NKS]; f32x4 x0[NKS], x1[NKS];
#pragma unroll
        for (int j = 0; j < NKS; ++j) { a0[j] = *(const bf16x8*)(wrow[0] + 16 * j); a1[j] = *(const bf16x8*)(wrow[1] + 16 * j);
            if (F32B) { x0[j] = *(const f32x4*)(b32 + 16 * j); x1[j] = *(const f32x4*)(b32 + 16 * j + 4); } else bb[j] = *(const bf16x8*)(b16 + 16 * j); }
        f32x16 acc0, acc1; float ssq = 0.f;
#pragma unroll
        for (int i = 0; i < 16; ++i) { acc0[i] = 0.f; acc1[i] = 0.f; }
#pragma unroll
        for (int j = 0; j < NKS; ++j) {
            if (F32B) { ssq += (x0[j][0] * x0[j][0] + x0[j][1] * x0[j][1]) + (x0[j][2] * x0[j][2] + x0[j][3] * x0[j][3]) + (x1[j][0] * x1[j][0] + x1[j][1] * x1[j][1]) + (x1[j][2] * x1[j][2] + x1[j][3] * x1[j][3]); bb[j] = cvt8(x0[j], x1[j]); }
            acc0 = __builtin_amdgcn_mfma_f32_32x32x16_bf16(a0[j], bb[j], acc0, 0, 0, 0);
            acc1 = __builtin_amdgcn_mfma_f32_32x32x16_bf16(a1[j], bb[j], acc1, 0, 0, 0);
        }
        __syncthreads();
#pragma unroll
        for (int i = 0; i < 16; ++i) { RED[(w * 16 + i) * 64 + lane] = acc0[i]; RED[((8 + w) * 16 + i) * 64 + lane] = acc1[i]; }
        if (F32B) SSQ[w * 64 + lane] = ssq;
        __syncthreads();
        {
            const int te = w >> 2, wq = w & 3;
            f32x4 v = (f32x4){0.f, 0.f, 0.f, 0.f};
#pragma unroll
            for (int ww = 0; ww < 8; ++ww)
#pragma unroll
                for (int e = 0; e < 4; ++e) v[e] += RED[((8 * te + ww) * 16 + 4 * wq + e) * 64 + lane];
            float rstd = 1.f;
            if (F32B) { float q = 0.f;
#pragma unroll
                for (int ww = 0; ww < 8; ++ww) q += SSQ[ww * 64 + r] + SSQ[ww * 64 + 32 + r];
                rstd = 1.0f / sqrtf(q * (1.0f / D) + RMS_EPS); }
            const int nb = te ? n0[1] : n0[0]; const int col = nb + 8 * wq + 4 * h;
            if (KIND == SG_POOL) {
                *(f32x4*)(X + (size_t)row * D + col) = *(const f32x4*)(F.x_s + (size_t)b * D + col) + v * *(const f32x4*)(F.pool_scale + col);
            } else if (KIND == SG_UP) {
                v = v * rstd;
#pragma unroll
                for (int e = 0; e < 4; ++e) { const float t = fmaxf(v[e], 0.f); v[e] = t * t; }
                v2u o; o.x = cvtpk(v[0], v[1]); o.y = cvtpk(v[2], v[3]); *(v2u*)(WSP(bf16, WS_H) + (size_t)row * FF + col) = o;
            } else if (KIND == SG_DOWN || KIND == SG_WO) {
#pragma unroll
                for (int e = 0; e < 4; ++e) unsafeAtomicAdd(X + (size_t)row * D + col + e, v[e]);
            } else {
                v = v * rstd; v2u o; o.x = cvtpk(v[0], v[1]); o.y = cvtpk(v[2], v[3]);
                if (nb < 1024) { *(f32x4*)(F.out + OUT_KV_S + (size_t)b * D + col) = v; if (nb >= 512) *(v2u*)(WSP(bf16, WS_KVS) + (size_t)row * 512 + col - 512) = o; }
                else if (nb < 1536) { *(v2u*)(WSP(bf16, WS_KVW) + (size_t)row * 512 + col - 1024) = o; *(f32x4*)(F.out + OUT_WIN_S + ((size_t)b * 512 + 511) * 512 + col - 1024) = v; }
                else if (nb < 2560) { *(v2u*)(WSP(bf16, WS_Q) + (size_t)row * D + col - 1536) = o; }
                else if (col < 2608) { float* gp = WSP(float, WS_GATE) + (size_t)row * 48 + col - 2560;
#pragma unroll
                    for (int e = 0; e < 4; ++e) gp[e] = 1.0f / (1.0f + __expf(-(v[e] + F.b_gate[col - 2560 + e]))); }
            }
        }
    }
    VM_WAIT(); __syncthreads();
}

__device__ __forceinline__ void p11_final(Frame& F) {
    const int gw = F.vcu * NWAVES + F.wave, NGW = F.G * NWAVES, lane = F.lane; const float* X = WSP(float, WS_X); const bf16* XB = WSP(bf16, WS_XB);
    for (int row = gw; row < MT; row += NGW) {
        f32x4 v[4]; float ss = 0.f;
        if (row < MP) { const v2u* xr = (const v2u*)(XB + (size_t)row * D) + lane;
#pragma unroll
            for (int j = 0; j < 4; ++j) { const v2u q = xr[64 * j]; v[j] = (f32x4){__builtin_bit_cast(float, q.x << 16), __builtin_bit_cast(float, q.x & 0xffff0000u), __builtin_bit_cast(float, q.y << 16), __builtin_bit_cast(float, q.y & 0xffff0000u)}; } }
        else { const f32x4* xr = (const f32x4*)(X + (size_t)row * D) + lane;
#pragma unroll
            for (int j = 0; j < 4; ++j) v[j] = xr[64 * j]; }
#pragma unroll
        for (int j = 0; j < 4; ++j) ss += (v[j][0] * v[j][0] + v[j][1] * v[j][1]) + (v[j][2] * v[j][2] + v[j][3] * v[j][3]);
        const float rstd = 1.0f / sqrtf(wave_sum(ss) * (1.0f / D) + RMS_EPS);
        float* o = (row < MP) ? F.out + OUT_Y_P + (size_t)row * D : F.out + OUT_Y_S + (size_t)(row - MP) * D;
#pragma unroll
        for (int j = 0; j < 4; ++j) *((f32x4*)o + lane + 64 * j) = v[j] * rstd * *((const f32x4*)F.norm_final + lane + 64 * j);
    }
}

constexpr int NPHASE = 12;
struct Args { const void* in[21]; float* out; unsigned char* ws; int ph_lo, ph_hi; };
__global__ void __launch_bounds__(NWAVES * 64, 2) yoco_fwd(Args args) {
    extern __shared__ __attribute__((aligned(16))) unsigned char lds[];
    Frame F;
    F.lds = (LAS unsigned char*)lds;
    F.tid = threadIdx.x; F.lane = F.tid & 63; F.wave = __builtin_amdgcn_readfirstlane(F.tid >> 6);
    F.G = gridDim.x; { const int bx = blockIdx.x; F.vcu = (F.G % 8 == 0) ? (bx % 8) * (F.G / 8) + bx / 8 : bx; }
    F.x_p = (const float*)args.in[0]; F.x_s = (const float*)args.in[1]; F.state_pool = (const float*)args.in[2]; F.cache = (const float*)args.in[3]; F.state_win = (const float*)args.in[4];
    F.page_table = (const int*)args.in[5]; F.norm_mix = (const float*)args.in[6]; F.norm_mlp = (const float*)args.in[7]; F.w_up = (const float*)args.in[8]; F.w_down = (const float*)args.in[9];
    F.pool_w = (const float*)args.in[10]; F.pool_scale = (const float*)args.in[11]; F.norm_kv = (const float*)args.in[12]; F.w_kv = (const float*)args.in[13]; F.cmp_pe = (const float*)args.in[14];
    F.cmp_w1 = (const float*)args.in[15]; F.cmp_w2 = (const float*)args.in[16]; F.w_qg = (const float*)args.in[17]; F.b_gate = (const float*)args.in[18]; F.w_o = (const float*)args.in[19];
    F.norm_final = (const float*)args.in[20]; F.out = args.out; F.ws = args.ws;
    volatile LAS unsigned* MISC = (volatile LAS unsigned*)(F.lds + MISC_OFF);
    for (int u = F.tid; u < (LDS_BYTES - RING_BYTES) / 4; u += NWAVES * 64) ((LAS unsigned*)(F.lds + RING_BYTES))[u] = 0u;
    __syncthreads();
    unsigned* ctl = (unsigned*)(F.ws + WS_CTL);
#if MK_MULTI
#define GRID_BAR() do { } while (0)
#else
    XcdBarrier bar = xcd_barrier_post(ctl + CW_BAR, MISC + 8);
#define GRID_BAR() xcd_barrier(bar)
#endif
    F.seg_t0 = 0ull; F.seg_dt = 0ull;
    const int lo = args.ph_lo, hi = args.ph_hi;
#define IN(k) (lo <= (k) && (k) < hi)
#define SEAM(k) do { SEG_BEGIN(100 + (k)); if (IN(k) && IN((k) + 1)) GRID_BAR(); SEG_END(100 + (k)); SEG_END(k); SEG_BEGIN((k) + 1); } while (0)
    using namespace pg8;
    float* X = WSP(float, WS_X); bf16* XB = WSP(bf16, WS_XB); float* RS = WSP(float, WS_RS);

    SEG_BEGIN(0);
    if (IN(0)) { for (int rep = 0; rep < REP(0); ++rep) { p0_prologue(F); __syncthreads(); } } SEAM(0);
    if (IN(1)) {
        for (int rep = 0; rep < REP(16); ++rep) small_gemm<SG_POOL>(F, 0);
        Gemm g{WSP(bf16_t, WS_DIFF), WSP(bf16_t, WS_WPOOL), MP, 1024, 256, 1024, 256, (size_t)512}; StaticOrder S; S.init(MP, 1024, F.G, (int)blockIdx.x);
        EpiResid E{F.x_p, XB, RS, F.pool_scale};
        gemm_phase<EpiResid, StaticOrder, true, true>(F.lds, g, S, E);
    } SEAM(1);
    if (IN(2)) {
        SEG_BEGIN(60); for (int rep = 0; rep < REP(14); ++rep) small_gemm<SG_UP>(F, 0); SEG_END(60); SEG_BEGIN(61);
        Gemm g{XB, WSP(bf16_t, WS_WUP), MP, FF, D, D, D, (size_t)0}; StaticOrder S; S.init(MP, FF, F.G, (int)blockIdx.x);
        EpiUp E{WSP(bf16_t, WS_H), RS};
        for (int rep = 0; rep < REP(2); ++rep) { gemm_phase<EpiUp, StaticOrder, true, true>(F.lds, g, S, E); __syncthreads(); } SEG_END(61);
    } SEAM(2);
    if (IN(3)) {
        small_gemm<SG_DOWN>(F, 0);
        Gemm g{WSP(bf16_t, WS_H), WSP(bf16_t, WS_WDN), MP, D, FF, FF, FF, (size_t)0}; StaticOrder S; S.init(MP, D, F.G, (int)blockIdx.x);
        EpiResid E{nullptr, XB, RS, nullptr};
        gemm_phase<EpiResid, StaticOrder, true, true>(F.lds, g, S, E);
    } SEAM(3);
    if (IN(4)) {
        SEG_BEGIN(30); for (int rep = 0; rep < REP(15); ++rep) small_gemm<SG_KVQG>(F, 0); SEG_END(30);
        SEG_BEGIN(31); if ((blockIdx.x & 1) == 0) p5_sample_compress(F, ctl + CW_QUEUE, 3); SEG_END(31); SEG_BEGIN(32);
        Gemm g{XB, WSP(bf16_t, WS_WKVQG), MP, NKVQG, D, D, D, (size_t)0}; StaticOrder S; S.init(MP, NKVQG, F.G, (int)blockIdx.x);
        EpiKvqg E{RS, F.b_gate, F.out + OUT_KV_P, F.out + OUT_KV_S, F.out + OUT_WIN_P, F.out + OUT_WIN_S, WSP(bf16_t, WS_CMPA), WSP(bf16_t, WS_KVS), WSP(bf16_t, WS_KVW), WSP(bf16_t, WS_Q), WSP(float, WS_GATE)};
        gemm_phase<EpiKvqg, StaticOrder, true, true>(F.lds, g, S, E);
        __syncthreads(); SEG_END(32); SEG_BEGIN(33);
        p5_sample_compress(F, ctl + CW_QUEUE, 1 << 30); SEG_END(33);
    } SEAM(4);
    if (IN(5)) {
        SEG_BEGIN(50); p5_prompt_compress(F); SEG_END(50); SEG_BEGIN(51);
        if (F.G > 64) { if ((int)blockIdx.x >= 64) p6_combine(F, 0, (int)blockIdx.x - 64, F.G - 64); } else { __syncthreads(); p6_combine(F, 0, (int)blockIdx.x, F.G); } SEG_END(51);
    } SEAM(5);
    if (IN(6)) { p6_combine(F, 1, (int)blockIdx.x, F.G); } SEAM(6);
    if (IN(7)) { p7_attention(F); } SEAM(7);
    if (IN(8)) {
        SEG_BEGIN(70); small_gemm<SG_WO>(F, 0); SEG_END(70); SEG_BEGIN(71);
        Gemm g{WSP(bf16_t, WS_DIFF), WSP(bf16_t, WS_WO), MP, D, D, D, D, (size_t)0}; StaticOrder S; S.init(MP, D, F.G, (int)blockIdx.x);
        EpiResid E{nullptr, XB, RS, nullptr};
        gemm_phase<EpiResid, StaticOrder, true, true>(F.lds, g, S, E); SEG_END(71);
    } SEAM(8);
    if (IN(9)) {
        small_gemm<SG_UP>(F, 1);
        Gemm g{XB, WSP(bf16_t, WS_WUP) + (size_t)FF * D, MP, FF, D, D, D, (size_t)0}; StaticOrder S; S.init(MP, FF, F.G, (int)blockIdx.x);
        EpiUp E{WSP(bf16_t, WS_H), RS};
        gemm_phase<EpiUp, StaticOrder, true, true>(F.lds, g, S, E);
    } SEAM(9);
    if (IN(10)) {
        small_gemm<SG_DOWN>(F, 1);
        Gemm g{WSP(bf16_t, WS_H), WSP(bf16_t, WS_WDN) + (size_t)D * FF, MP, D, FF, FF, FF, (size_t)0}; StaticOrder S; S.init(MP, D, F.G, (int)blockIdx.x);
        EpiResid E{nullptr, XB, RS, nullptr};
        gemm_phase<EpiResid, StaticOrder, true, true>(F.lds, g, S, E);
    } SEAM(10);
    if (IN(11)) { p11_final(F); }
    SEG_END(11);
    if (PROBE_SEG >= 0) { __syncthreads(); const unsigned long long t1 = __builtin_amdgcn_s_memrealtime(); while (__builtin_amdgcn_s_memrealtime() - t1 < F.seg_dt) __builtin_amdgcn_s_sleep(8); }
#undef IN
#undef SEAM
}

extern "C" void kernel_launch(void* const* d_in, const int* in_sizes, int n_in, void* d_out, int out_size, void* d_ws, size_t ws_size, hipStream_t stream) {
    static int grid = 0;
    if (grid == 0) {
        if (n_in != 21 || (size_t)out_size != OUT_TOTAL || ws_size < WS_END) { fprintf(stderr, "kernel_launch: unexpected sizes n_in %d out %d ws %zu\n", n_in, out_size, ws_size); grid = -1; return; }
        int dev = 0, cus = 0, per_cu = 0;
        if (hipGetDevice(&dev) != hipSuccess || hipDeviceGetAttribute(&cus, hipDeviceAttributeMultiprocessorCount, dev) != hipSuccess) { grid = -1; return; }
        if (hipFuncSetAttribute((const void*)yoco_fwd, hipFuncAttributeMaxDynamicSharedMemorySize, LDS_BYTES) != hipSuccess) { fprintf(stderr, "kernel_launch: hipFuncSetAttribute failed\n"); grid = -1; return; }
        if (hipOccupancyMaxActiveBlocksPerMultiprocessor(&per_cu, (const void*)yoco_fwd, NWAVES * 64, LDS_BYTES) != hipSuccess || per_cu < 1) fprintf(stderr, "kernel_launch: occupancy query says %d\n", per_cu);
        (void)hipGetLastError();
        grid = cus;
    }
    if (grid < 0) return;
    (void)hipMemsetAsync((char*)d_ws + WS_CTL, 0, CTL_ZERO_BYTES, stream);
    Args a{};
    for (int i = 0; i < 21; ++i) a.in[i] = d_in[i];
    a.out = (float*)d_out; a.ws = (unsigned char*)d_ws;
#if MK_MULTI
    for (int p = 0; p < NPHASE; ++p) { a.ph_lo = p; a.ph_hi = p + 1; hipLaunchKernelGGL(yoco_fwd, dim3(grid), dim3(NWAVES * 64), LDS_BYTES, stream, a); }
#else
    a.ph_lo = 0; a.ph_hi = NPHASE;
    hipLaunchKernelGGL(yoco_fwd, dim3(grid), dim3(NWAVES * 64), LDS_BYTES, stream, a);
#endif
    const hipError_t le = hipPeekAtLastError();
    if (le != hipSuccess) fprintf(stderr, "kernel_launch: launch failed: %s\n", hipGetErrorName(le));
}
```

```cpp
#include <hip/hip_runtime.h>
#include <hip/hip_bf16.h>
#include <cstdio>
#include <cstdint>
#include <cmath>

#ifndef MK_MULTI
#define MK_MULTI 0
#endif

constexpr int D = 1024, FF = 4096, SEQ = 4096, NB = 4, DB = 128, PAST = 2048;
constexpr int MP = NB * SEQ;
constexpr int MT = MP + DB;
constexpr int MPAD = 16640;
constexpr int NKVQG = 2816;
constexpr int CMP_ROWS_P = NB * 256 * 4;
constexpr int CMP_ROWS_S = DB * 128 * 4;
constexpr int CMP_ROWS = CMP_ROWS_P + CMP_ROWS_S;
constexpr float RMS_EPS = 1e-6f;
constexpr float LOG2E = 1.4426950408889634f;
constexpr float QSCALE = 0.125f * LOG2E;

namespace pg8 {
#define PG8_LAS __attribute__((address_space(3)))
typedef unsigned short bf16_t;
typedef short bf16x8 __attribute__((ext_vector_type(8)));
typedef float f32x4 __attribute__((ext_vector_type(4)));
typedef float f32x2 __attribute__((ext_vector_type(2)));
typedef unsigned u32x4 __attribute__((ext_vector_type(4)));
typedef unsigned u32x2 __attribute__((ext_vector_type(2)));
constexpr int BM = 256, BK = 64, HALF = 128, HTB = HALF * BK * 2, STAGE_BYTES = 8 * HTB, NXCD = 8, WGM = 8;

__host__ __device__ __forceinline__ int lds_byte(int r, int c) { const int st = (r >> 4) * 2 + (c >> 5), rr = r & 15, cc = c & 31, ob = rr * 64 + cc * 2; return st * 1024 + (ob ^ (((ob >> 9) & 1) << 5)); }
__host__ __device__ __forceinline__ void stage_rc(int b, int& R, int& C) { const int st = b / 1024, sb = b % 1024, swz = sb ^ (((sb >> 9) & 1) << 5); R = (st >> 1) * 16 + swz / 64; C = (st & 1) * 32 + (swz % 64) / 2; }
__host__ __device__ __forceinline__ int perm32(int rho) { const int n = rho >> 4, i = rho & 15; return 8 * (i >> 2) + 4 * n + (i & 3); }

struct Unit { int pm, pn; };
struct Gemm { const bf16_t* A; const bf16_t* Bt; int M, N, K, lda, ldb; size_t a_pn_off; };

struct StaticOrder {
    int nM, nN, nwg, G, c;
    __host__ __device__ void init(int M, int N, int G_, int c_) { nM = M / BM; nN = N / BM; nwg = nM * nN; G = G_; c = c_; }
    __host__ __device__ bool next(int i, Unit& u) const {
        const long L = (long)i * G + c; if (L >= nwg) return false;
        int wgid = (int)L; { const int q = nwg / NXCD, r = nwg % NXCD, xcd = wgid % NXCD, off = wgid / NXCD; wgid = (xcd < r ? xcd * (q + 1) : r * (q + 1) + (xcd - r) * q) + off; }
        const int nig = WGM * nN, gid = wgid / nig, fm = gid * WGM, gsz = (nM - fm) < WGM ? (nM - fm) : WGM;
        u.pm = fm + ((wgid % nig) % gsz); u.pn = (wgid % nig) / gsz; return true;
    }
    __device__ __forceinline__ void a_ready(const Unit&) const {}
    __device__ __forceinline__ void done(const Unit&) const {}
};

__device__ __forceinline__ unsigned cvt_pk_bf16(float lo, float hi) { unsigned r; asm volatile("v_cvt_pk_bf16_f32 %0, %1, %2" : "=v"(r) : "v"(lo), "v"(hi)); return r; }

__device__ __forceinline__ float row_rstd(const float* rs, int row) {
    const f32x4* p = (const f32x4*)(rs + (size_t)row * 16); const f32x4 a = p[0], b = p[1], c = p[2], d = p[3];
    const float s = ((a[0] + a[1]) + (a[2] + a[3])) + ((b[0] + b[1]) + (b[2] + b[3])) + ((c[0] + c[1]) + (c[2] + c[3])) + ((d[0] + d[1]) + (d[2] + d[3]));
    return 1.0f / sqrtf(s * (1.0f / 1024.0f) + RMS_EPS);
}

struct EpiResid {
    static constexpr bool PERM = false, AFTER_DRAIN = false;
    const float* base_f; bf16_t* XB; float* RS; const float* scale;
    __device__ __forceinline__ void operator()(const f32x4 (&acc)[2][2][4][2], const Unit& u, int wr, int wc, int fr, int fq) const {
        const int col0 = u.pn * BM + wc * 32 + 4 * fq;
        f32x4 sc[2][2];
#pragma unroll
        for (int bj = 0; bj < 2; ++bj)
#pragma unroll
            for (int n = 0; n < 2; ++n) sc[bj][n] = scale ? *(const f32x4*)(scale + col0 + bj * HALF + n * 16) : (f32x4){1.f, 1.f, 1.f, 1.f};
#pragma unroll
        for (int ai = 0; ai < 2; ++ai) {
#pragma unroll
            for (int m = 0; m < 4; ++m) {
                const int row = u.pm * BM + ai * HALF + wr * 64 + m * 16 + fr;
                float ss = 0.f;
#pragma unroll
                for (int bj = 0; bj < 2; ++bj)
#pragma unroll
                    for (int n = 0; n < 2; ++n) {
                        const int col = col0 + bj * HALF + n * 16;
                        f32x4 bv;
                        if (base_f) bv = *(const f32x4*)(base_f + (size_t)row * D + col);
                        else { const u32x2 q = *(const u32x2*)(XB + (size_t)row * D + col); bv = (f32x4){__builtin_bit_cast(float, q.x << 16), __builtin_bit_cast(float, q.x & 0xffff0000u), __builtin_bit_cast(float, q.y << 16), __builtin_bit_cast(float, q.y & 0xffff0000u)}; }
                        const f32x4 v = bv + acc[ai][bj][m][n] * sc[bj][n];
                        u32x2 w; w.x = cvt_pk_bf16(v[0], v[1]); w.y = cvt_pk_bf16(v[2], v[3]);
                        *(u32x2*)(XB + (size_t)row * D + col) = w;
                        ss += (v[0] * v[0] + v[1] * v[1]) + (v[2] * v[2] + v[3] * v[3]);
                    }
                ss += __shfl_xor(ss, 16); ss += __shfl_xor(ss, 32);
                if (fq == 0) RS[(size_t)row * 16 + u.pn * 4 + wc] = ss;
            }
        }
    }
};

struct EpiUp {
    static constexpr bool PERM = true, AFTER_DRAIN = false;
    bf16_t* H; const float* RS;
    __device__ __forceinline__ void operator()(const f32x4 (&acc)[2][2][4][2], const Unit& u, int wr, int wc, int fr, int fq) const {
        const int col0 = u.pn * BM + wc * 32 + 8 * fq;
#pragma unroll
        for (int ai = 0; ai < 2; ++ai) {
            if (u.pm * BM + ai * HALF >= MT) continue;
#pragma unroll
            for (int m = 0; m < 4; ++m) {
                const int row = u.pm * BM + ai * HALF + wr * 64 + m * 16 + fr;
                const float rstd = row_rstd(RS, row);
#pragma unroll
                for (int bj = 0; bj < 2; ++bj) {
                    f32x4 v0 = acc[ai][bj][m][0] * rstd, v1 = acc[ai][bj][m][1] * rstd;
#pragma unroll
                    for (int e = 0; e < 4; ++e) { const float a = fmaxf(v0[e], 0.f), b = fmaxf(v1[e], 0.f); v0[e] = a * a; v1[e] = b * b; }
                    u32x4 w; w.x = cvt_pk_bf16(v0[0], v0[1]); w.y = cvt_pk_bf16(v0[2], v0[3]); w.z = cvt_pk_bf16(v1[0], v1[1]); w.w = cvt_pk_bf16(v1[2], v1[3]);
                    *(u32x4*)(H + (size_t)row * FF + col0 + bj * HALF) = w;
                }
            }
        }
    }
};

struct EpiKvqg {
    static constexpr bool PERM = true, AFTER_DRAIN = false;
    const float* RS; const float* bgate;
    float* kv_p; float* kv_s; float* win_p; float* win_s;
    bf16_t* CMPA; bf16_t* KVS; bf16_t* KVW; bf16_t* Q; float* GATE;
    __device__ __forceinline__ void operator()(const f32x4 (&acc)[2][2][4][2], const Unit& u, int wr, int wc, int fr, int fq) const {
        const int pn = u.pn;
#pragma unroll
        for (int ai = 0; ai < 2; ++ai) {
            if (u.pm * BM + ai * HALF >= MT) continue;
#pragma unroll
            for (int m = 0; m < 4; ++m) {
                const int row = u.pm * BM + ai * HALF + wr * 64 + m * 16 + fr;
                const float rstd = row_rstd(RS, row);
                const bool prompt = row < MP; const int b = prompt ? (row >> 12) : (row - MP), t = row & (SEQ - 1);
#pragma unroll
                for (int bj = 0; bj < 2; ++bj) {
                    const int cin = bj * HALF + wc * 32 + 8 * fq;
                    const f32x4 v0 = acc[ai][bj][m][0] * rstd, v1 = acc[ai][bj][m][1] * rstd;
                    u32x4 w; w.x = cvt_pk_bf16(v0[0], v0[1]); w.y = cvt_pk_bf16(v0[2], v0[3]); w.z = cvt_pk_bf16(v1[0], v1[1]); w.w = cvt_pk_bf16(v1[2], v1[3]);
                    if (pn < 4) {
                        float* o = prompt ? kv_p + (size_t)row * D : kv_s + (size_t)b * D;
                        *(f32x4*)(o + pn * BM + cin) = v0; *(f32x4*)(o + pn * BM + cin + 4) = v1;
                        if (pn < 2) {
                            if (prompt) { const int g = cin >> 6, d = cin & 63;
                                *(u32x4*)(CMPA + (size_t)pn * CMP_ROWS * D + (size_t)(((b * 256 + (t >> 4)) * 4 + g)) * D + (t & 15) * 64 + d) = w; }
                        } else *(u32x4*)(KVS + (size_t)row * 512 + (pn - 2) * BM + cin) = w;
                    } else if (pn < 6) {
                        const int c = (pn - 4) * BM + cin;
                        *(u32x4*)(KVW + (size_t)row * 512 + c) = w;
                        if (prompt) { if (t >= SEQ - 512) { float* o = win_p + ((size_t)b * 512 + (t - (SEQ - 512))) * 512 + c; *(f32x4*)o = v0; *(f32x4*)(o + 4) = v1; } }
                        else { float* o = win_s + ((size_t)b * 512 + 511) * 512 + c; *(f32x4*)o = v0; *(f32x4*)(o + 4) = v1; }
                    } else if (pn < 10) {
                        *(u32x4*)(Q + (size_t)row * D + (pn - 6) * BM + cin) = w;
                    } else {
                        if (cin < 48) {
#pragma unroll
                            for (int e = 0; e < 4; ++e) { GATE[(size_t)row * 48 + cin + e] = 1.0f / (1.0f + __expf(-(v0[e] + bgate[cin + e]))); GATE[(size_t)row * 48 + cin + 4 + e] = 1.0f / (1.0f + __expf(-(v1[e] + bgate[cin + 4 + e]))); }
                        }
                    }
                }
            }
        }
    }
};

struct EpiCmp {
    static constexpr bool PERM = false, AFTER_DRAIN = false;
    float* P;
    __device__ __forceinline__ void operator()(const f32x4 (&acc)[2][2][4][2], const Unit& u, int wr, int wc, int fr, int fq) const {
        float* base = P + (size_t)u.pn * CMP_ROWS * 256;
#pragma unroll
        for (int ai = 0; ai < 2; ++ai)
#pragma unroll
            for (int m = 0; m < 4; ++m) {
                const int row = u.pm * BM + ai * HALF + wr * 64 + m * 16 + fr;
#pragma unroll
                for (int bj = 0; bj < 2; ++bj)
#pragma unroll
                    for (int n = 0; n < 2; ++n) *(f32x4*)(base + (size_t)row * 256 + bj * HALF + wc * 32 + n * 16 + 4 * fq) = acc[ai][bj][m][n];
            }
    }
};

template <class Epi, class Sched, bool ALIGN_EPI = false, bool SP2 = false>
__device__ __forceinline__ void gemm_phase(PG8_LAS unsigned char* lds, const Gemm g, const Sched& S, const Epi& E) {
    const int tid = threadIdx.x, wid = __builtin_amdgcn_readfirstlane(tid >> 6), lane = tid & 63, wr = wid >> 2, wc = wid & 3, fr = lane & 15, fq = lane >> 4;
    const int K = g.K, nt = K / BK;
    unsigned voffA[2], voffB[2];
#pragma unroll
    for (int i = 0; i < 2; ++i) { int R, C; stage_rc(tid * 16 + i * 8192, R, C); const int Rb = Epi::PERM ? ((R & ~31) + perm32(R & 31)) : R;
        voffA[i] = (unsigned)(R * g.lda + C) * 2u; voffB[i] = (unsigned)(Rb * g.ldb + C) * 2u; }
    const size_t kstep = (size_t)(BK * 2);
    const size_t hstepA = (size_t)HALF * g.lda * 2, hstepB = (size_t)HALF * g.ldb * 2;
    const size_t tstepA = 2 * hstepA, tstepB = 2 * hstepB;
    const unsigned ldsw = (unsigned)wid * 1024u;
    const int aoff = lds_byte(wr * 64 + fr, fq * 8), boff = lds_byte(wc * 32 + fr, fq * 8);
#define PG8_SA(b, h) (((b) * 2 + (h)) * HTB)
#define PG8_SB(b, h) ((4 + (b) * 2 + (h)) * HTB)
#define PG8_STAGE(bufoff, gbase, voff) do { _Pragma("unroll") for (int _i = 0; _i < 2; ++_i) \
        __builtin_amdgcn_global_load_lds((const unsigned*)((const char*)(gbase) + (voff)[_i]), (PG8_LAS unsigned*)(lds + (bufoff) + ldsw + _i * 8192), 16, 0, 0); } while (0)
#define PG8_LDA(dst, b, h) do { _Pragma("unroll") for (int m = 0; m < 4; ++m) _Pragma("unroll") for (int k = 0; k < 2; ++k) dst[m][k] = *(const PG8_LAS bf16x8*)(lds + PG8_SA(b, h) + aoff + m * 2048 + k * 1024); } while (0)
#define PG8_LDB(dst, b, h) do { _Pragma("unroll") for (int n = 0; n < 2; ++n) _Pragma("unroll") for (int k = 0; k < 2; ++k) dst[n][k] = *(const PG8_LAS bf16x8*)(lds + PG8_SB(b, h) + boff + n * 2048 + k * 1024); } while (0)
#define PG8_MMA(ai, bj, At, Bt) do { __builtin_amdgcn_s_setprio(1); _Pragma("unroll") for (int m = 0; m < 4; ++m) _Pragma("unroll") for (int n = 0; n < 2; ++n) _Pragma("unroll") for (int k = 0; k < 2; ++k) \
        acc[ai][bj][m][n] = __builtin_amdgcn_mfma_f32_16x16x32_bf16(Bt[n][k], At[m][k], acc[ai][bj][m][n], 0, 0, 0); __builtin_amdgcn_s_setprio(0); } while (0)
#define PG8_WAIT_V(n) asm volatile("s_waitcnt vmcnt(" #n ")" ::: "memory")
#define PG8_WAIT_L(n) asm volatile("s_waitcnt lgkmcnt(" #n ")" ::: "memory")
#define PG8_BAR __builtin_amdgcn_s_barrier()
#define PG8_SCHED __builtin_amdgcn_sched_barrier(0)
    Unit cur, nxt; int ui = 0;
    if (!S.next(0, cur)) return;
    f32x4 acc[2][2][4][2];
#pragma unroll
    for (int a = 0; a < 2; ++a)
#pragma unroll
        for (int b = 0; b < 2; ++b)
#pragma unroll
            for (int m = 0; m < 4; ++m)
#pragma unroll
                for (int n = 0; n < 2; ++n) acc[a][b][m][n] = (f32x4){0.f, 0.f, 0.f, 0.f};
    bf16x8 At[4][2], B0[2][2], B1[2][2];
    const char* cA = (const char*)g.A + (size_t)cur.pm * tstepA + (size_t)cur.pn * g.a_pn_off; const char* cB = (const char*)g.Bt + (size_t)cur.pn * tstepB;
    S.a_ready(cur);
    if constexpr (SP2) {
        PG8_STAGE(PG8_SB(0, 0), cB, voffB); PG8_STAGE(PG8_SB(0, 1), cB + hstepB, voffB); PG8_STAGE(PG8_SA(0, 0), cA, voffA); PG8_STAGE(PG8_SA(0, 1), cA + hstepA, voffA);
        if (wr == 1) PG8_BAR;
        PG8_WAIT_V(2); PG8_BAR;
        PG8_STAGE(PG8_SB(1, 0), cB + kstep, voffB); PG8_STAGE(PG8_SA(1, 0), cA + kstep, voffA); PG8_STAGE(PG8_SB(1, 1), cB + hstepB + kstep, voffB);
        PG8_WAIT_V(6); PG8_BAR;
    } else {
        PG8_STAGE(PG8_SB(0, 0), cB, voffB); PG8_STAGE(PG8_SA(0, 0), cA, voffA); PG8_STAGE(PG8_SB(0, 1), cB + hstepB, voffB); PG8_STAGE(PG8_SA(0, 1), cA + hstepA, voffA);
        if (wr == 1) PG8_BAR;
        PG8_WAIT_V(4); PG8_BAR;
        PG8_STAGE(PG8_SB(1, 0), cB + kstep, voffB); PG8_STAGE(PG8_SA(1, 0), cA + kstep, voffA); PG8_STAGE(PG8_SB(1, 1), cB + hstepB + kstep, voffB);
        PG8_WAIT_V(6); PG8_BAR;
    }
    for (;;) {
        const bool has_next = S.next(ui + 1, nxt);
        const char* nA = has_next ? (const char*)g.A + (size_t)nxt.pm * tstepA + (size_t)nxt.pn * g.a_pn_off : cA; const char* nB = has_next ? (const char*)g.Bt + (size_t)nxt.pn * tstepB : cB;
        for (int t = 0; t < nt; t += 2) {
            const bool last = (t == nt - 2);
            const char* a1 = cA + (size_t)(t + 1) * kstep;
            const char* a2 = last ? nA : cA + (size_t)(t + 2) * kstep; const char* b2 = last ? nB : cB + (size_t)(t + 2) * kstep;
            const char* a3 = a2 + kstep; const char* b3 = b2 + kstep;
            if (last && has_next) S.a_ready(nxt);
            if constexpr (SP2) {
            PG8_LDB(B0, 0, 0); PG8_LDB(B1, 0, 1); PG8_SCHED; PG8_LDA(At, 0, 0); PG8_STAGE(PG8_SA(1, 1), a1 + hstepA, voffA);
            PG8_WAIT_V(8); PG8_WAIT_L(0); PG8_BAR; PG8_MMA(0, 0, At, B0); PG8_MMA(0, 1, At, B1); PG8_BAR; PG8_SCHED;
            PG8_LDA(At, 0, 1); PG8_STAGE(PG8_SB(0, 0), b2, voffB); PG8_STAGE(PG8_SB(0, 1), b2 + hstepB, voffB); PG8_STAGE(PG8_SA(0, 0), a2, voffA);
            PG8_WAIT_V(8); PG8_WAIT_L(0); PG8_BAR; PG8_MMA(1, 0, At, B0); PG8_MMA(1, 1, At, B1); PG8_BAR; PG8_SCHED;
            PG8_LDB(B0, 1, 0); PG8_LDB(B1, 1, 1); PG8_SCHED; PG8_LDA(At, 1, 0); PG8_STAGE(PG8_SA(0, 1), a2 + hstepA, voffA);
            PG8_WAIT_V(8); PG8_WAIT_L(0); PG8_BAR; PG8_MMA(0, 0, At, B0); PG8_MMA(0, 1, At, B1); PG8_BAR; PG8_SCHED;
            PG8_LDA(At, 1, 1); PG8_STAGE(PG8_SB(1, 0), b3, voffB); PG8_STAGE(PG8_SB(1, 1), b3 + hstepB, voffB); PG8_STAGE(PG8_SA(1, 0), a3, voffA);
            PG8_WAIT_V(8); PG8_WAIT_L(0); PG8_BAR; PG8_MMA(1, 0, At, B0); PG8_MMA(1, 1, At, B1); PG8_BAR; PG8_SCHED;
            } else {
            PG8_LDB(B0, 0, 0); PG8_SCHED; PG8_LDA(At, 0, 0); PG8_STAGE(PG8_SA(1, 1), a1 + hstepA, voffA);
            PG8_WAIT_L(8); PG8_BAR; PG8_WAIT_L(0); PG8_MMA(0, 0, At, B0); PG8_BAR; PG8_SCHED;
            PG8_LDB(B1, 0, 1); PG8_STAGE(PG8_SB(0, 0), b2, voffB);
            PG8_BAR; PG8_WAIT_L(0); PG8_MMA(0, 1, At, B1); PG8_BAR;
            PG8_LDA(At, 0, 1); PG8_STAGE(PG8_SA(0, 0), a2, voffA);
            PG8_BAR; PG8_WAIT_L(0); PG8_MMA(1, 0, At, B0); PG8_BAR; PG8_SCHED;
            PG8_STAGE(PG8_SB(0, 1), b2 + hstepB, voffB);
            PG8_WAIT_V(6); PG8_BAR; PG8_MMA(1, 1, At, B1); PG8_BAR;
            PG8_LDB(B0, 1, 0); PG8_SCHED; PG8_LDA(At, 1, 0); PG8_STAGE(PG8_SA(0, 1), a2 + hstepA, voffA);
            PG8_WAIT_L(8); PG8_BAR; PG8_WAIT_L(0); PG8_MMA(0, 0, At, B0); PG8_BAR; PG8_SCHED;
            PG8_LDB(B1, 1, 1); PG8_STAGE(PG8_SB(1, 0), b3, voffB);
            PG8_BAR; PG8_WAIT_L(0); PG8_MMA(0, 1, At, B1); PG8_BAR;
            PG8_LDA(At, 1, 1); PG8_STAGE(PG8_SA(1, 0), a3, voffA);
            PG8_BAR; PG8_WAIT_L(0); PG8_MMA(1, 0, At, B0); PG8_BAR; PG8_SCHED;
            PG8_STAGE(PG8_SB(1, 1), b3 + hstepB, voffB);
            PG8_WAIT_V(6); PG8_BAR; PG8_MMA(1, 1, At, B1); PG8_BAR;
            }
        }
        if constexpr (ALIGN_EPI) { if (wr == 0) PG8_BAR; }
        if constexpr (!Epi::AFTER_DRAIN) { E(acc, cur, wr, wc, fr, fq); S.done(cur); }
        if (!has_next) break;
#pragma unroll
        for (int a = 0; a < 2; ++a)
#pragma unroll
            for (int b = 0; b < 2; ++b)
#pragma unroll
                for (int m = 0; m < 4; ++m)
#pragma unroll
                    for (int n = 0; n < 2; ++n) acc[a][b][m][n] = (f32x4){0.f, 0.f, 0.f, 0.f};
        cur = nxt; cA = nA; cB = nB; ++ui;
        if constexpr (ALIGN_EPI) { if (wr == 1) PG8_BAR; }
    }
    PG8_WAIT_V(0);
    if constexpr (!ALIGN_EPI) { if (wr == 0) PG8_BAR; }
    PG8_BAR;
    if constexpr (Epi::AFTER_DRAIN) { E.fused(acc, cur, wr, wc, fr, fq, lds, wid, lane); S.done(cur); }
#undef PG8_SA
#undef PG8_SB
#undef PG8_STAGE
#undef PG8_LDA
#undef PG8_LDB
#undef PG8_MMA
#undef PG8_WAIT_V
#undef PG8_WAIT_L
#undef PG8_BAR
#undef PG8_SCHED
}
}

#define GAS __attribute__((address_space(1)))
#define LAS __attribute__((address_space(3)))
typedef unsigned short bf16;
typedef unsigned v4u __attribute__((ext_vector_type(4)));
typedef unsigned v2u __attribute__((ext_vector_type(2)));
typedef float f32x4 __attribute__((ext_vector_type(4)));
typedef float f32x2 __attribute__((ext_vector_type(2)));
typedef float f32x16 __attribute__((ext_vector_type(16)));
typedef short bf16x8 __attribute__((ext_vector_type(8)));
typedef short v4i16_t __attribute__((ext_vector_type(4)));
typedef GAS unsigned gu32;
typedef GAS unsigned long long gu64;
#define RLX_AGENT __ATOMIC_RELAXED, __HIP_MEMORY_SCOPE_AGENT
#define LDS_WAIT() asm volatile("s_waitcnt lgkmcnt(0)" ::: "memory")
#define VM_WAIT() asm volatile("s_waitcnt vmcnt(0)" ::: "memory")
__device__ __forceinline__ unsigned f2bf(float f) { unsigned u = __builtin_bit_cast(unsigned, f); return (u + 0x7fffu + ((u >> 16) & 1u)) >> 16; }
__device__ __forceinline__ unsigned pk2(float lo, float hi) { return f2bf(lo) | (f2bf(hi) << 16); }
__device__ __forceinline__ float bf2f(unsigned short h) { return __builtin_bit_cast(float, (unsigned)h << 16); }

#define XB_TMO      128
#define XB_XCNT(j)  (256  + 64 * (j))
#define XB_XSUB(j)  (1280 + 64 * (j))
#define XB_XGEN(j)  (2304 + 64 * (j))
#define XB_TOP      3328
#define XB_TOPGEN   3392
#define XCD_BAR_WORDS 3456
#define XB_SPIN_CAP (1u << 18)

__device__ __forceinline__ unsigned xb_ld(unsigned* p)              { return __hip_atomic_load(p, __ATOMIC_RELAXED, __HIP_MEMORY_SCOPE_AGENT); }
__device__ __forceinline__ unsigned xb_add(unsigned* p, unsigned v) { return __hip_atomic_fetch_add(p, v, __ATOMIC_RELAXED, __HIP_MEMORY_SCOPE_AGENT); }
__device__ __forceinline__ unsigned xb_xcc_id() { return (unsigned)__builtin_amdgcn_s_getreg((3 << 11) | 20) & 0xFu; }
#define XB_SPIN(cond, bar) do { unsigned _sp = 0; while (cond) { __builtin_amdgcn_s_sleep(1); \
    if ((++_sp & 255u) == 0u) { if (xb_ld(&(bar)[XB_TMO])) break; if (_sp > XB_SPIN_CAP) { atomicAdd(&(bar)[XB_TMO], 1u); break; } } } } while (0)

struct XcdBarrier {
    unsigned* bar; unsigned x;
    volatile LAS unsigned* st;
};

__device__ __forceinline__ XcdBarrier xcd_barrier_post(unsigned* bar, volatile LAS unsigned* st) {
    XcdBarrier b; b.bar = bar; b.x = xb_xcc_id(); b.st = st;
    if (threadIdx.x == 0) (void)xb_add(&bar[XB_XCNT(b.x)], 1u);
    return b;
}
__device__ __forceinline__ void xcd_barrier_complete(unsigned* bar, unsigned x, unsigned& nloc, unsigned& nx) {
    const unsigned G = gridDim.x * gridDim.y * gridDim.z;
    unsigned sum, cnt, mine, sp = 0u;
    for (;;) {
        sum = 0u; cnt = 0u; mine = 0u;
#pragma unroll
        for (unsigned j = 0; j < 16; ++j) { const unsigned c = xb_ld(&bar[XB_XCNT(j)]); sum += c; cnt += (c > 0u) ? 1u : 0u; mine = (j == x) ? c : mine; }
        if (sum == G) break;
        __builtin_amdgcn_s_sleep(1);
        if ((++sp & 255u) == 0u) { if (xb_ld(&bar[XB_TMO])) break; if (sp > XB_SPIN_CAP) { atomicAdd(&bar[XB_TMO], 1u); break; } }
    }
    nloc = mine > 0u ? mine : 1u; nx = cnt > 0u ? cnt : 1u;
}

__device__ __forceinline__ void xcd_barrier(const XcdBarrier& b) {
    asm volatile("s_waitcnt vmcnt(0)" ::: "memory");
    __syncthreads();
    if (threadIdx.x == 0) {
        unsigned* bar = b.bar;
        __builtin_amdgcn_s_waitcnt(0);
        unsigned nloc = b.st[0], nx = b.st[1];
        if (nloc == 0u) { xcd_barrier_complete(bar, b.x, nloc, nx); b.st[0] = nloc; b.st[1] = nx; }
        const unsigned old = xb_add(&bar[XB_XSUB(b.x)], 1u);
        const unsigned gen = old / nloc;
        if (old + 1u == (gen + 1u) * nloc) {
            __builtin_amdgcn_fence(__ATOMIC_RELEASE, "agent");
            asm volatile("s_waitcnt vmcnt(0)" ::: "memory");
            const unsigned og = xb_add(&bar[XB_TOP], 1u);
            const unsigned tg = og / nx;
            if (og + 1u == (tg + 1u) * nx) xb_add(&bar[XB_TOPGEN], 1u);
            else XB_SPIN(xb_ld(&bar[XB_TOPGEN]) == tg, bar);
            __builtin_amdgcn_fence(__ATOMIC_ACQUIRE, "agent");
            xb_add(&bar[XB_XGEN(b.x)], 1u);
            asm volatile("s_waitcnt vmcnt(0)" ::: "memory");
        } else {
            XB_SPIN(xb_ld(&bar[XB_XGEN(b.x)]) == gen, bar);
            __builtin_amdgcn_fence(__ATOMIC_ACQUIRE, "agent");
            asm volatile("s_waitcnt vmcnt(0)" ::: "memory");
        }
    }
    __syncthreads();
}

constexpr size_t MiB = 1u << 20;
constexpr size_t WS_CTL = 0, CTL_ZERO_BYTES = 1 * MiB;
constexpr size_t WS_WUP = 2 * MiB;
constexpr size_t WS_WDN = 18 * MiB;
constexpr size_t WS_WKVQG = 34 * MiB;
constexpr size_t WS_WO = 40 * MiB;
constexpr size_t WS_WPOOL = 42 * MiB;
constexpr size_t WS_W1CAT = 43 * MiB;
constexpr size_t WS_CBIAS = 128 * 1024;
constexpr size_t WS_RS = 45 * MiB;
constexpr size_t WS_GATE = 47 * MiB;
constexpr size_t WS_X = 52 * MiB;
constexpr size_t WS_XB = 118 * MiB;
constexpr size_t WS_DIFF = 152 * MiB;
constexpr size_t WS_Q = 186 * MiB;
constexpr size_t WS_KVS = 220 * MiB;
constexpr size_t WS_KVW = 238 * MiB;
constexpr size_t WS_KC = 256 * MiB;
constexpr size_t WS_KCS = 258 * MiB;
constexpr size_t WS_H = 292 * MiB;
constexpr size_t WS_CMPA = 424 * MiB;
constexpr size_t WS_CMPP = 700 * MiB;
constexpr size_t WS_END = 840 * MiB;
constexpr int CW_BAR = 4096;

constexpr size_t OUT_Y_P = 0, OUT_Y_S = 16777216, OUT_POOL_P = 16908288, OUT_POOL_S = 16969728, OUT_KV_P = 18935808, OUT_KV_S = 35713024, OUT_WIN_P = 35844096, OUT_WIN_S = 36892672, OUT_TOTAL = 70447104;

#ifndef PROBE_DUP
#define PROBE_DUP 0
#endif
#define REP(k) (1 + ((PROBE_DUP >> (k)) & 1))
constexpr int NWAVES = 8;
constexpr int RING_BYTES = 131072, MISC_OFF = RING_BYTES + 320, LDS_BYTES = 147456;

#ifndef PROBE_SEG
#define PROBE_SEG -1
#endif
#define SEG_BEGIN(id) do { if (PROBE_SEG == (id)) F.seg_t0 = __builtin_amdgcn_s_memrealtime(); } while (0)
#define SEG_END(id) do { if (PROBE_SEG == (id)) F.seg_dt += __builtin_amdgcn_s_memrealtime() - F.seg_t0; } while (0)
struct Frame {
    unsigned long long seg_t0, seg_dt;
    LAS unsigned char* lds;
    int tid, lane, wave, vcu, G;
    const float *x_p, *x_s, *state_pool, *cache, *state_win; const int* page_table;
    const float *norm_mix, *norm_mlp, *w_up, *w_down, *pool_w, *pool_scale, *norm_kv, *w_kv, *cmp_pe, *cmp_w1, *cmp_w2, *w_qg, *b_gate, *w_o, *norm_final;
    float* out; unsigned char* ws;
};
#define WSP(T, off) ((T*)(F.ws + (off)))

__device__ __forceinline__ unsigned cvtpk(float lo, float hi) { typedef __bf16 bf16x2_t __attribute__((ext_vector_type(2))); f32x2 v = {lo, hi}; bf16x2_t b = __builtin_convertvector(v, bf16x2_t); return __builtin_bit_cast(unsigned, b); }
__device__ __forceinline__ bf16x8 cvt8(const f32x4 a, const f32x4 b) { v4u w; w.x = cvtpk(a[0], a[1]); w.y = cvtpk(a[2], a[3]); w.z = cvtpk(b[0], b[1]); w.w = cvtpk(b[2], b[3]); return __builtin_bit_cast(bf16x8, w); }
__device__ __forceinline__ float wave_sum(float v) {
#pragma unroll
    for (int o = 1; o < 64; o <<= 1) v += __shfl_xor(v, o);
    return v;
}
__device__ __forceinline__ float wave_max(float v) {
#pragma unroll
    for (int o = 1; o < 64; o <<= 1) v = fmaxf(v, __shfl_xor(v, o));
    return v;
}

struct TItem { const float* W; bf16* WT; const float* kscale; int N, ldt, row_off, kb, nb; float scale; };
constexpr int TP = 260;
__device__ __forceinline__ void ti_load(const TItem& t, f32x4 (&wv)[8], int tid) {
    const int k0 = 64 * t.kb, col = 256 * t.nb + 4 * (tid & 63);
#pragma unroll
    for (int e = 0; e < 8; ++e) wv[e] = (col < t.N) ? *(const f32x4*)(t.W + (size_t)(k0 + (tid >> 6) + 8 * e) * t.N + col) : (f32x4){0.f, 0.f, 0.f, 0.f};
}
__device__ __forceinline__ void ti_stage(const f32x4 (&wv)[8], LAS float* T, int tid) {
#pragma unroll
    for (int e = 0; e < 8; ++e) *(LAS f32x4*)(T + ((tid >> 6) + 8 * e) * TP + 4 * (tid & 63)) = wv[e];
}
__device__ __forceinline__ void ti_write(const TItem& t, const LAS float* T, int tid) {
    const int n = tid >> 1, kh = 32 * (tid & 1), k0 = 64 * t.kb;
    float ks[32];
#pragma unroll
    for (int i = 0; i < 8; ++i) { const f32x4 q = t.kscale ? *(const f32x4*)(t.kscale + k0 + kh + 4 * i) : (f32x4){1.f, 1.f, 1.f, 1.f}; ks[4 * i] = q[0] * t.scale; ks[4 * i + 1] = q[1] * t.scale; ks[4 * i + 2] = q[2] * t.scale; ks[4 * i + 3] = q[3] * t.scale; }
    const LAS float* c = T + kh * TP + n;
    if (256 * t.nb + n < t.N) {
        bf16* dst = t.WT + (size_t)(t.row_off + 256 * t.nb + n) * t.ldt + k0 + kh;
#pragma unroll
        for (int j = 0; j < 4; ++j) { v4u o;
            o.x = pk2(c[(8 * j + 0) * TP] * ks[8 * j + 0], c[(8 * j + 1) * TP] * ks[8 * j + 1]); o.y = pk2(c[(8 * j + 2) * TP] * ks[8 * j + 2], c[(8 * j + 3) * TP] * ks[8 * j + 3]);
            o.z = pk2(c[(8 * j + 4) * TP] * ks[8 * j + 4], c[(8 * j + 5) * TP] * ks[8 * j + 5]); o.w = pk2(c[(8 * j + 6) * TP] * ks[8 * j + 6], c[(8 * j + 7) * TP] * ks[8 * j + 7]);
            *(v4u*)(dst + 8 * j) = o; }
    }
}

__device__ __forceinline__ void p0_prologue(Frame& F) {
    const int gw = F.vcu * NWAVES + F.wave, NGW = F.G * NWAVES, lane = F.lane;
    bf16* WUP = WSP(bf16, WS_WUP); bf16* WDN = WSP(bf16, WS_WDN); bf16* WKVQG = WSP(bf16, WS_WKVQG); bf16* WO = WSP(bf16, WS_WO); bf16* WPOOL = WSP(bf16, WS_WPOOL); bf16* W1CAT = WSP(bf16, WS_W1CAT);
    SEG_BEGIN(40);
    constexpr int I_UP = 256, I_DN = 256, I_KV = 96, I_QG = 80, I_WO = 64, I_PL = 4, I_C1 = 16;
    constexpr int NITEMS = 2 * I_UP + 2 * I_DN + I_KV + I_QG + I_WO + 4 * I_PL + 4 * I_C1;
    auto decode = [&](int it) -> TItem {
        int r = it; TItem t;
        if (r < 2 * I_UP) { const int l = r / I_UP; r %= I_UP; t = TItem{F.w_up + (size_t)l * D * FF, WUP + (size_t)l * FF * D, F.norm_mlp + l * D, FF, D, 0, r / 16, r % 16, 1.f}; return t; } r -= 2 * I_UP;
        if (r < 2 * I_DN) { const int l = r / I_DN; r %= I_DN; t = TItem{F.w_down + (size_t)l * FF * D, WDN + (size_t)l * D * FF, nullptr, D, FF, 0, r / 4, r % 4, 1.f}; return t; } r -= 2 * I_DN;
        if (r < I_KV) { t = TItem{F.w_kv, WKVQG, F.norm_kv, 1536, D, 0, r / 6, r % 6, 1.f}; return t; } r -= I_KV;
        if (r < I_QG) { const int nb = r % 5; t = TItem{F.w_qg, WKVQG, F.norm_mix + D, 1072, D, 1536, r / 5, nb, nb < 4 ? QSCALE : 1.f}; return t; } r -= I_QG;
        if (r < I_WO) { t = TItem{F.w_o, WO, nullptr, D, D, 0, r / 4, r % 4, 1.f}; return t; } r -= I_WO;
        if (r < 4 * I_PL) { const int g = r / I_PL; r %= I_PL; t = TItem{F.pool_w + (size_t)g * 65536, WPOOL + (size_t)g * 65536, nullptr, 256, 256, 0, r, 0, 1.f}; return t; } r -= 4 * I_PL;
        { const int kvh = r / I_C1; r %= I_C1; const int kv = kvh >> 1, half = kvh & 1;
          t = TItem{F.cmp_w1 + (size_t)kv * 2048 * 128 + (size_t)half * 1024 * 128, W1CAT + (size_t)kv * 256 * D, nullptr, 128, D, half * 128, r, 0, 1.f}; return t; }
    };
    {
        LAS float* T = (LAS float*)F.lds; f32x4 wv[8];
        int it = F.vcu; TItem tc;
        if (it < NITEMS) { tc = decode(it); ti_load(tc, wv, F.tid); }
        while (it < NITEMS) {
            ti_stage(wv, T, F.tid);
            __syncthreads();
            const int i2 = it + F.G; TItem tn = tc; if (i2 < NITEMS) { tn = decode(i2); ti_load(tn, wv, F.tid); }
            ti_write(tc, T, F.tid);
            __syncthreads();
            tc = tn; it = i2;
        }
    }
    { const int gt = F.vcu * 512 + F.tid, NT = F.G * 512; v4u* z = (v4u*)(WKVQG + (size_t)2608 * D);
      for (int i = gt; i < 208 * D / 8; i += NT) z[i] = (v4u){0u, 0u, 0u, 0u}; }
    { float* CB = WSP(float, WS_CBIAS);
      const int cb0 = (NGW >= 1024) ? 512 : 0;
      for (int it = gw - cb0; it >= 0 && it < 64; it += NGW) { const int kv = it >> 5, kc0 = (it & 31) * 64; float a0 = 0.f, a1 = 0.f;
#pragma unroll 16
          for (int k = 0; k < 64; ++k) { const float p = F.cmp_pe[kv * 2048 + kc0 + k]; const float* wr = F.cmp_w1 + ((size_t)kv * 2048 + kc0 + k) * 128; a0 += p * wr[lane]; a1 += p * wr[64 + lane]; }
          unsafeAtomicAdd(CB + kv * 128 + lane, a0); unsafeAtomicAdd(CB + kv * 128 + 64 + lane, a1); } }
    SEG_END(40); SEG_BEGIN(41);
    bf16* DIFF = WSP(bf16, WS_DIFF);
    if (F.wave == 0)
    for (int b = F.G - 1 - F.vcu; b < DB; b += F.G) {
        const f32x4* xr = (const f32x4*)(F.x_s + (size_t)b * D) + lane; f32x4 v[4]; float ss = 0.f;
#pragma unroll
        for (int j = 0; j < 4; ++j) { v[j] = xr[64 * j]; ss += (v[j][0] * v[j][0] + v[j][1] * v[j][1]) + (v[j][2] * v[j][2] + v[j][3] * v[j][3]); }
        const float rstd = 1.0f / sqrtf(wave_sum(ss) * (1.0f / D) + RMS_EPS);
        const float* sp = F.state_pool + (size_t)b * 15 * D; float* ps = F.out + OUT_POOL_S + (size_t)b * 15 * D;
#pragma unroll
        for (int j = 0; j < 4; ++j) {
            const int col = 256 * j + 4 * lane; const f32x4 gg = *(const f32x4*)(F.norm_mix + col); const f32x4 u = v[j] * rstd * gg;
            f32x4 st[15];
#pragma unroll
            for (int r = 0; r < 15; ++r) st[r] = *(const f32x4*)(sp + (size_t)r * D + col);
            f32x4 sum = u; const int w = 2 << j;
#pragma unroll
            for (int r = 0; r < 15; ++r) if (r < w - 1) sum += st[14 - r];
            const f32x4 df = sum * (1.0f / (float)w) - u;
            v2u o; o.x = pk2(df[0], df[1]); o.y = pk2(df[2], df[3]); *(v2u*)(DIFF + (size_t)(MP + b) * D + col) = o;
            *(f32x4*)(ps + (size_t)14 * D + col) = u;
#pragma unroll
            for (int r = 0; r < 14; ++r) *(f32x4*)(ps + (size_t)r * D + col) = st[r + 1];
        }
    }
    SEG_END(41);
    if (F.G != 256) { const size_t gt = (size_t)F.vcu * 512 + F.tid, NT = (size_t)F.G * 512; const f32x4* src = (const f32x4*)F.state_win; f32x4* dst = (f32x4*)(F.out + OUT_WIN_S);
      for (int rep = 0; rep < REP(19); ++rep)
      for (size_t e = gt; e < (size_t)DB * 511 * 128; e += NT) { const size_t b = e / (511 * 128), rem = e - b * (511 * 128); dst[b * 65536 + rem] = src[b * 65536 + rem + 128]; } }
    __syncthreads();
    LAS float* U = (LAS float*)F.lds;
    SEG_BEGIN(42);
    for (int rep = 0; rep < REP(20); ++rep)
    for (int task = F.vcu; task < MP / 64; task += F.G) {
        const int b = task >> 6, t0 = (task & 63) * 64;
        const float* xb = F.x_p + (size_t)b * SEQ * D;
        f32x4 gmix[4];
#pragma unroll
        for (int j = 0; j < 4; ++j) gmix[j] = *(const f32x4*)(F.norm_mix + 256 * j + 4 * lane);
        f32x4 ra[4], rb2[4];
#define DF_LOAD(T) do { const int ta_ = (T) + 2 * F.wave, tb_ = ta_ + 1; _Pragma("unroll") for (int j = 0; j < 4; ++j) { \
            ra[j] = (ta_ >= 0) ? *((const f32x4*)(xb + (size_t)ta_ * D) + lane + 64 * j) : (f32x4){0.f, 0.f, 0.f, 0.f}; rb2[j] = (tb_ >= 0) ? *((const f32x4*)(xb + (size_t)tb_ * D) + lane + 64 * j) : (f32x4){0.f, 0.f, 0.f, 0.f}; } } while (0)
#define DF_STORE1(rr, tt_) do { float ss = 0.f; _Pragma("unroll") for (int j = 0; j < 4; ++j) ss += (rr[j][0] * rr[j][0] + rr[j][1] * rr[j][1]) + (rr[j][2] * rr[j][2] + rr[j][3] * rr[j][3]); \
            const float rstd = 1.0f / sqrtf(wave_sum(ss) * (1.0f / D) + RMS_EPS); \
            _Pragma("unroll") for (int j = 0; j < 4; ++j) { const f32x4 u = rr[j] * rstd * gmix[j]; *(LAS f32x4*)(U + ((tt_) & 31) * 1024 + 256 * j + 4 * lane) = u; \
                if ((tt_) >= SEQ - 15) *(f32x4*)(F.out + OUT_POOL_P + ((size_t)b * 15 + ((tt_) - (SEQ - 15))) * D + 256 * j + 4 * lane) = u; } } while (0)
#define DF_STORE(T) do { const int ta_ = (T) + 2 * F.wave; DF_STORE1(ra, ta_); DF_STORE1(rb2, ta_ + 1); } while (0)
        DF_LOAD(t0 - 16); DF_STORE(t0 - 16);
        DF_LOAD(t0);
        const int c = 2 * F.tid, w = 2 << (F.tid >> 7);
        f32x2 S = (f32x2){0.f, 0.f};
        for (int sub = 0; sub < 4; ++sub) {
            const int T = t0 + 16 * sub;
            DF_STORE(T);
            __syncthreads();
            if (sub < 3) DF_LOAD(T + 16);
            if (sub == 0) { for (int j = 1; j < w; ++j) S += *(const LAS f32x2*)(U + ((T - j) & 31) * 1024 + c); }
            for (int tt = 0; tt < 16; ++tt) { const int t = T + tt; const int cnt = (t + 1 < w) ? (t + 1) : w;
                const f32x2 cur = *(const LAS f32x2*)(U + (t & 31) * 1024 + c);
                S += cur; const float inv = 1.0f / (float)cnt;
                *(unsigned*)(DIFF + ((size_t)b * SEQ + t) * D + c) = pk2(S[0] * inv - cur[0], S[1] * inv - cur[1]);
                S -= *(const LAS f32x2*)(U + ((t - w + 1) & 31) * 1024 + c); }
            __syncthreads();
        }
#undef DF_LOAD
#undef DF_STORE1
#undef DF_STORE
    }
    SEG_END(42);
}

constexpr int KSTR = 144;
constexpr int SC_ACT = 0, SC_W = 128 * KSTR, SC_BUF = SC_W + 256 * KSTR, SC_UNIT = 2 * SC_BUF, CW_QUEUE = 8192;
static_assert(SC_UNIT + 64 <= RING_BYTES, "sample compress LDS");
__device__ __forceinline__ void p5_sample_compress(Frame& F, unsigned* qctr, int quota) {
    LAS int* UNIT = (LAS int*)(F.lds + SC_UNIT);
    const int tid = F.tid, lane = F.lane, w = F.wave, r = lane & 31, h = lane >> 5, rb = w & 3, nh = w >> 2;
    float* P = WSP(float, WS_CMPP); const bf16* W1 = WSP(bf16, WS_W1CAT);
    for (int nu = 0; nu < quota; ++nu) {
        __syncthreads();
        if (tid == 0) UNIT[0] = (int)atomicAdd(qctr, 1u);
        __syncthreads();
        const int u = UNIT[0]; if (u >= DB * 8) break;
        const int b = u >> 3, jb = (u >> 1) & 3, kv = u & 1;
        size_t aoff[4]; const bf16* wsrc = W1 + ((size_t)kv * 256 + (tid >> 3)) * D + 8 * (tid & 7);
#pragma unroll
        for (int e = 0; e < 4; ++e) { const int j = 32 * jb + (tid >> 6) + 8 * e; const int page = F.page_table[b * 16 + (j >> 3)]; aoff[e] = ((size_t)page * 128 + (j & 7) * 16) * 1024 + kv * 256 + 4 * (tid & 63); }
        f32x4 av0[4], av1[4], av2[4], av3[4]; v4u wv0[4], wv1[4];
#define SC_LOADA(av, tt) do { _Pragma("unroll") for (int e = 0; e < 4; ++e) av[e] = *(const f32x4*)(F.cache + aoff[e] + (size_t)(tt) * 1024); } while (0)
#define SC_LOADW(wv, tt) do { _Pragma("unroll") for (int e = 0; e < 4; ++e) wv[e] = *(const v4u*)(wsrc + (size_t)e * 64 * D + 64 * (tt)); } while (0)
#define SC_STORE(av, wv, bf) do { _Pragma("unroll") for (int e = 0; e < 4; ++e) { v2u o; o.x = cvtpk(av[e][0], av[e][1]); o.y = cvtpk(av[e][2], av[e][3]); \
            *(LAS v2u*)(F.lds + (bf) * SC_BUF + SC_ACT + ((((tid >> 6) + 8 * e) << 2) + ((tid & 63) >> 4)) * KSTR + 8 * (tid & 15)) = o; *(LAS v4u*)(F.lds + (bf) * SC_BUF + SC_W + ((tid >> 3) + 64 * e) * KSTR + 16 * (tid & 7)) = wv[e]; } } while (0)
#define SC_COMPUTE(bf) do { const LAS unsigned char* At = F.lds + (bf) * SC_BUF + SC_ACT + (32 * rb + r) * KSTR + h * 16; const LAS unsigned char* Wt = F.lds + (bf) * SC_BUF + SC_W + (128 * nh + r) * KSTR + h * 16; \
            _Pragma("unroll") for (int ks = 0; ks < 4; ++ks) { bf16x8 afr_[4]; const bf16x8 bfr_ = *(const LAS bf16x8*)(At + ks * 32); \
                _Pragma("unroll") for (int nt = 0; nt < 4; ++nt) afr_[nt] = *(const LAS bf16x8*)(Wt + 32 * nt * KSTR + ks * 32); \
            __builtin_amdgcn_sched_barrier(0); \
                _Pragma("unroll") for (int nt = 0; nt < 4; ++nt) acc[nt] = __builtin_amdgcn_mfma_f32_32x32x16_bf16(afr_[nt], bfr_, acc[nt], 0, 0, 0); \
            __builtin_amdgcn_sched_barrier(0); } } while (0)
        f32x16 acc[4];
#pragma unroll
        for (int nt = 0; nt < 4; ++nt)
#pragma unroll
            for (int i = 0; i < 16; ++i) acc[nt][i] = 0.f;
#define SC_STEP(tt, aCur, wCur, aNext, wNext) do { \
            if ((tt) + 4 < 16) SC_LOADA(aCur, (tt) + 4);        \
            if ((tt) + 2 < 16) SC_LOADW(wCur, (tt) + 2); \
            __builtin_amdgcn_sched_barrier(0); \
            SC_COMPUTE((tt) & 1); \
            __builtin_amdgcn_sched_barrier(0); \
            if ((tt) + 1 < 16) SC_STORE(aNext, wNext, ((tt) + 1) & 1); \
            __syncthreads(); } while (0)
        SC_LOADA(av0, 0); SC_LOADW(wv0, 0); SC_LOADA(av1, 1); SC_LOADW(wv1, 1); SC_LOADA(av2, 2); SC_LOADA(av3, 3);
        SC_STORE(av0, wv0, 0); __syncthreads();
        for (int tt = 0; tt < 16; tt += 4) {
            SC_STEP(tt,     av0, wv0, av1, wv1);
            SC_STEP(tt + 1, av1, wv1, av2, wv0);
            SC_STEP(tt + 2, av2, wv0, av3, wv1);
            SC_STEP(tt + 3, av3, wv1, av0, wv0);
        }
#undef SC_STEP
#undef SC_LOADA
#undef SC_LOADW
#define SC_LOAD 0
#undef SC_COMPUTE
#undef SC_LOAD
#undef SC_STORE
        float* prow = P + (size_t)kv * CMP_ROWS * 256 + (size_t)(CMP_ROWS_P + (b * 128 + 32 * jb) * 4 + 32 * rb + r) * 256 + 128 * nh + 4 * h;
#pragma unroll
        for (int nt = 0; nt < 4; ++nt)
#pragma unroll
            for (int g4 = 0; g4 < 4; ++g4) *(f32x4*)(prow + 32 * nt + 8 * g4) = (f32x4){acc[nt][4 * g4], acc[nt][4 * g4 + 1], acc[nt][4 * g4 + 2], acc[nt][4 * g4 + 3]};
    }
}

__device__ __forceinline__ void p5_prompt_compress(Frame& F) {
    const int tid = F.tid, lane = F.lane, w = F.wave, r = lane & 31, h = lane >> 5, rb = w & 3, nh = w >> 2;
    float* P = WSP(float, WS_CMPP); const bf16* W1 = WSP(bf16, WS_W1CAT); const bf16* CA = WSP(bf16, WS_CMPA);
    for (int u = (int)blockIdx.x; u < 2 * CMP_ROWS_P / 128; u += F.G) {
        const int kv = u & 1, rblk = u >> 1;
        const bf16* asrc = CA + (size_t)kv * CMP_ROWS * D + (size_t)(rblk * 128 + (tid >> 3)) * D + 8 * (tid & 7);
        const bf16* wsrc = W1 + ((size_t)kv * 256 + (tid >> 3)) * D + 8 * (tid & 7);
        v4u aa[2], wv[4];
#define PC_LOAD(tt) do { _Pragma("unroll") for (int e = 0; e < 2; ++e) aa[e] = *(const v4u*)(asrc + (size_t)e * 64 * D + 64 * (tt)); _Pragma("unroll") for (int e = 0; e < 4; ++e) wv[e] = *(const v4u*)(wsrc + (size_t)e * 64 * D + 64 * (tt)); } while (0)
#define PC_STORE(bf) do { _Pragma("unroll") for (int e = 0; e < 2; ++e) *(LAS v4u*)(F.lds + (bf) * SC_BUF + SC_ACT + ((tid >> 3) + 64 * e) * KSTR + 16 * (tid & 7)) = aa[e]; \
            _Pragma("unroll") for (int e = 0; e < 4; ++e) *(LAS v4u*)(F.lds + (bf) * SC_BUF + SC_W + ((tid >> 3) + 64 * e) * KSTR + 16 * (tid & 7)) = wv[e]; } while (0)
        f32x16 acc[4];
#pragma unroll
        for (int nt = 0; nt < 4; ++nt)
#pragma unroll
            for (int i = 0; i < 16; ++i) acc[nt][i] = 0.f;
        __syncthreads();
        PC_LOAD(0); PC_STORE(0); __syncthreads();
        for (int tt = 0; tt < 16; ++tt) {
            const int bf = tt & 1;
            if (tt + 1 < 16) PC_LOAD(tt + 1);
            __builtin_amdgcn_sched_barrier(0);
            const LAS unsigned char* At = F.lds + bf * SC_BUF + SC_ACT + (32 * rb + r) * KSTR + h * 16; const LAS unsigned char* Wt = F.lds + bf * SC_BUF + SC_W + (128 * nh + r) * KSTR + h * 16;
            bf16x8 bfr_[4], afr_[4][4];
#pragma unroll
            for (int ks = 0; ks < 4; ++ks) { bfr_[ks] = *(const LAS bf16x8*)(At + ks * 32);
#pragma unroll
                for (int nt = 0; nt < 4; ++nt) afr_[ks][nt] = *(const LAS bf16x8*)(Wt + 32 * nt * KSTR + ks * 32); }
            __builtin_amdgcn_sched_barrier(0);
#pragma unroll
            for (int ks = 0; ks < 4; ++ks)
#pragma unroll
                for (int nt = 0; nt < 4; ++nt) acc[nt] = __builtin_amdgcn_mfma_f32_32x32x16_bf16(afr_[ks][nt], bfr_[ks], acc[nt], 0, 0, 0);
            __builtin_amdgcn_sched_barrier(0);
            if (tt + 1 < 16) PC_STORE(bf ^ 1);
            __syncthreads();
        }
#undef PC_LOAD
#undef PC_STORE
        float* prow = P + (size_t)kv * CMP_ROWS * 256 + (size_t)(rblk * 128 + 32 * rb + r) * 256 + 128 * nh + 4 * h;
#pragma unroll
        for (int nt = 0; nt < 4; ++nt)
#pragma unroll
            for (int g4 = 0; g4 < 4; ++g4) *(f32x4*)(prow + 32 * nt + 8 * g4) = (f32x4){acc[nt][4 * g4], acc[nt][4 * g4 + 1], acc[nt][4 * g4 + 2], acc[nt][4 * g4 + 3]};
    }
}

constexpr int W2T_STR = 136;
__device__ __forceinline__ void p6_combine(Frame& F, int part, int cu, int ncu) {
    LAS bf16* W2T = (LAS bf16*)F.lds;
    LAS float* CBL = (LAS float*)(F.lds + 2 * 64 * W2T_STR * 2);
    const float* P = WSP(float, WS_CMPP); bf16* KC = WSP(bf16, WS_KC); float* KCS = WSP(float, WS_KCS);
    for (int i = F.tid; i < 2 * 128 * 64; i += 512) { const int kv = i >> 13, k = (i >> 6) & 127, d = i & 63; W2T[(kv * 64 + d) * W2T_STR + k] = (bf16)f2bf(F.cmp_w2[i]); }
    if (F.tid < 256) CBL[F.tid] = WSP(float, WS_CBIAS)[F.tid];
    __syncthreads();
    const int lane = F.lane, ml = lane & 15, fq = lane >> 4;
    const int gw = cu * NWAVES + F.wave, NGW = ncu * NWAVES;
    constexpr int NT_P = CMP_ROWS_P / 16, NT_S = CMP_ROWS_S / 16;
    const bool prompt = part == 1; const int ntp = prompt ? NT_P : NT_S;
    f32x4 loA[4][2], hiA[4][2], loB[4][2], hiB[4][2];
#define CB_LOAD(lo_, hi_, task_) do { const int kv_ = (task_) / ntp, r0_ = ((task_) % ntp) * 16; const int prow_ = (prompt ? r0_ : CMP_ROWS_P + r0_) + ml; \
        const float* plo_ = P + (size_t)kv_ * CMP_ROWS * 256 + (size_t)prow_ * 256 + 8 * fq; const float* phi_ = plo_ + 4 * 256 + 128; \
        _Pragma("unroll") for (int ks = 0; ks < 4; ++ks) { lo_[ks][0] = *(const f32x4*)(plo_ + 32 * ks); lo_[ks][1] = *(const f32x4*)(plo_ + 32 * ks + 4); hi_[ks][0] = *(const f32x4*)(phi_ + 32 * ks); hi_[ks][1] = *(const f32x4*)(phi_ + 32 * ks + 4); } } while (0)
#define CB_FINISH(lo_, hi_, task_) do { const int kv = (task_) / ntp, r0 = ((task_) % ntp) * 16; const int nimask = prompt ? 255 : 127; \
        const int ro = r0 + ml, i_blk = (ro >> 2) & nimask; const bool valid = i_blk < nimask; \
        bf16x8 hb[4]; \
        _Pragma("unroll") for (int ks = 0; ks < 4; ++ks) { f32x4 z[2]; \
            _Pragma("unroll") for (int e = 0; e < 2; ++e) { z[e] = lo_[ks][e] + hi_[ks][e] + *(const LAS f32x4*)(CBL + kv * 128 + 32 * ks + 8 * fq + 4 * e); \
                _Pragma("unroll") for (int q = 0; q < 4; ++q) { const float zz = z[e][q]; z[e][q] = valid ? zz / (1.0f + __expf(-zz)) : 0.f; } } \
            hb[ks] = cvt8(z[0], z[1]); } \
        _Pragma("unroll") for (int db = 0; db < 4; ++db) { f32x4 acc = (f32x4){0.f, 0.f, 0.f, 0.f}; \
            _Pragma("unroll") for (int ks = 0; ks < 4; ++ks) { const bf16x8 a = *(const LAS bf16x8*)(W2T + (kv * 64 + 16 * db + ml) * W2T_STR + 32 * ks + 8 * fq); acc = __builtin_amdgcn_mfma_f32_16x16x32_bf16(a, hb[ks], acc, 0, 0, 0); } \
            const int g = ro & 3, d0 = 16 * db + 4 * fq; \
            if (prompt) { const int b = ro >> 10; v2u o; o.x = cvtpk(acc[0], acc[1]); o.y = cvtpk(acc[2], acc[3]); *(v2u*)(KC + ((size_t)((kv * 4 + b) * 4 + g) * 256 + i_blk) * 64 + d0) = o; } \
            else { const int b = ro >> 9; *(f32x4*)(KCS + ((size_t)((kv * 128 + b) * 4 + g) * 128 + i_blk) * 64 + d0) = acc; } } } while (0)
    const int ntask = 2 * ntp;
    int task = gw;
    if (task < ntask) CB_LOAD(loA, hiA, task);
    while (task < ntask) {
        int t2 = task + NGW; if (t2 < ntask) CB_LOAD(loB, hiB, t2);
        CB_FINISH(loA, hiA, task);
        task = t2; if (task >= ntask) break;
        t2 = task + NGW; if (t2 < ntask) CB_LOAD(loA, hiA, t2);
        CB_FINISH(loB, hiB, task);
        task = t2;
    }
#undef CB_LOAD
#undef CB_FINISH
}

constexpr int VSTR = 192;
constexpr int AT_K = 0, AT_V = 64 * KSTR, AT_BUF = 64 * KSTR + 64 * VSTR  , AT_T = 2 * AT_BUF, AT_TS = 66, AT_U = AT_T + 64 * AT_TS * 4, AT_OF = AT_T  , AT_SEL = AT_OF + 8 * 32 * 64 * 4, AT_WUNI = AT_SEL + 512, AT_END = AT_WUNI + 64;
static_assert(AT_U + 64 * AT_TS * 4 <= AT_SEL, "attention LDS");
static_assert(AT_END <= RING_BYTES, "attention LDS");

__device__ __forceinline__ v4i16_t vtr(const LAS unsigned char* p) { return __builtin_amdgcn_ds_read_tr16_b64_v4i16((LAS v4i16_t*)p); }

struct KvRegs { v4u k, v; };
__device__ __forceinline__ void load_kv(Frame& F, KvRegs& R, const bf16* ksrc, const bf16* vsrc, int pitch) {
    const int key = F.tid >> 3, ch = F.tid & 7;
    R.k = *(const v4u*)(ksrc + (size_t)key * pitch + ch * 8);
    R.v = *(const v4u*)(vsrc + (size_t)key * pitch + ch * 8);
}
__device__ __forceinline__ void store_kv(Frame& F, const KvRegs& R, int buf) {
    const int key = F.tid >> 3, ch = F.tid & 7;
    *(LAS v4u*)(F.lds + buf * AT_BUF + AT_K + key * KSTR + ch * 16) = R.k;
    *(LAS v4u*)(F.lds + buf * AT_BUF + AT_V + key * VSTR + ch * 16) = R.v;
}

constexpr float ATT_THR = 8.0f;
struct AugState { unsigned q0, q1, mw2, mw3, kj0, kj1, hsel; };
__device__ __forceinline__ unsigned bf16_hi_bits(float f) { return f2bf(f); }
__device__ __forceinline__ void aug_set_m(AugState& A, float m) {
    const float a = -m; const unsigned h1 = f2bf(a); const float r1 = a - bf2f((unsigned short)h1); const unsigned h2 = f2bf(r1); const float r2 = r1 - bf2f((unsigned short)h2); const unsigned h3 = f2bf(r2);
    A.mw2 = h1 << 16; A.mw3 = h2 | (h3 << 16);
}
template <int MODE>
__device__ __forceinline__ void attn_tile(Frame& F, bool MASKED, int buf, const bf16x8 (&qf)[4], AugState& A, int blk, int relb, float slope2, bool rowok, float& m, float& l, bool& any, f32x16& o0, f32x16& o1,
                                          float mfin, float invl, LAS float* Tq, LAS float* Uq, int sig0) {
    const int lane = F.lane, r = lane & 31, h = lane >> 5;
    const LAS unsigned char* Kt = F.lds + buf * AT_BUF + AT_K; const LAS unsigned char* Vt = F.lds + buf * AT_BUF + AT_V;
    constexpr int PM = (MODE <= 1) ? 16 : 1;
    const float NEG = -INFINITY;
    float c0 = slope2 * (float)relb - ((MODE == 1) ? mfin : m);
    if (!rowok) c0 = NEG;
    const float k32 = slope2 * (float)(32 * PM);
    f32x16 p0, p1;
    if (MODE <= 1) {
#pragma unroll
        for (int i = 0; i < 16; ++i) { p0[i] = fmaf(slope2, (float)(PM * ((i & 3) + 8 * (i >> 2))), c0); p1[i] = p0[i] + k32; }
    }
    bf16x8 kfr[8];
#pragma unroll
    for (int ks = 0; ks < 4; ++ks) { kfr[2 * ks] = *(const LAS bf16x8*)(Kt + r * KSTR + ks * 32 + h * 16); kfr[2 * ks + 1] = *(const LAS bf16x8*)(Kt + (32 + r) * KSTR + ks * 32 + h * 16); }
    v4i16_t vlo[4][2], vhi[4][2];
    if (MODE != 0) { const LAS unsigned char* vb = Vt + (((lane & 15) >> 2) + 4 * h) * VSTR + (16 * ((lane >> 4) & 1) + 4 * (lane & 3)) * 2;
#pragma unroll
        for (int sp = 0; sp < 4; ++sp)
#pragma unroll
            for (int db = 0; db < 2; ++db) { vlo[sp][db] = vtr(vb + (16 * sp) * VSTR + 64 * db); vhi[sp][db] = vtr(vb + (16 * sp + 8) * VSTR + 64 * db); } }
    __builtin_amdgcn_sched_barrier(0);
    if (MODE >= 2) {
        const unsigned bw = (__float_as_uint((float)blk) >> 16) * 0x10001u & A.hsel;
        const v4u ka0 = (v4u){bw, A.kj0, 0x3f803f80u & A.hsel, 0x3f803f80u & A.hsel}, ka1 = (v4u){bw, A.kj1, 0x3f803f80u & A.hsel, 0x3f803f80u & A.hsel};
        const v4u qa = (v4u){A.q0, A.q1, (rowok ? 0u : 0xc6eau) | A.mw2, A.mw3};
        const f32x16 z = {0.f, 0.f, 0.f, 0.f, 0.f, 0.f, 0.f, 0.f, 0.f, 0.f, 0.f, 0.f, 0.f, 0.f, 0.f, 0.f};
        p0 = __builtin_amdgcn_mfma_f32_32x32x16_bf16(__builtin_bit_cast(bf16x8, ka0), __builtin_bit_cast(bf16x8, qa), z, 0, 0, 0);
        p1 = __builtin_amdgcn_mfma_f32_32x32x16_bf16(__builtin_bit_cast(bf16x8, ka1), __builtin_bit_cast(bf16x8, qa), z, 0, 0, 0);
    }
#pragma unroll
    for (int ks = 0; ks < 4; ++ks) {
        p0 = __builtin_amdgcn_mfma_f32_32x32x16_bf16(kfr[2 * ks], qf[ks], p0, 0, 0, 0);
        p1 = __builtin_amdgcn_mfma_f32_32x32x16_bf16(kfr[2 * ks + 1], qf[ks], p1, 0, 0, 0);
    }
    __builtin_amdgcn_sched_barrier(0);
    if (MASKED) {
#pragma unroll
        for (int i = 0; i < 16; ++i) {
            const int kofs = PM * ((i & 3) + 8 * (i >> 2));
            const int rel0 = relb + kofs, rel1 = rel0 + PM * 32;
            bool ok0 = rel0 <= 0, ok1 = rel1 <= 0;
            if (MODE == 3) { ok0 = ok0 && rel0 > -512; ok1 = ok1 && rel1 > -512; }
            p0[i] = ok0 ? p0[i] : NEG; p1[i] = ok1 ? p1[i] : NEG;
        }
    }
    if (MODE == 1) {
#pragma unroll
        for (int i = 0; i < 16; ++i) { p0[i] = __builtin_amdgcn_exp2f(p0[i]) * invl; p1[i] = __builtin_amdgcn_exp2f(p1[i]) * invl; }
#pragma unroll
        for (int hf = 0; hf < 2; ++hf)
#pragma unroll
            for (int g4 = 0; g4 < 4; ++g4) {
                const float pa = hf ? p1[4 * g4] : p0[4 * g4], pb = hf ? p1[4 * g4 + 1] : p0[4 * g4 + 1], pc = hf ? p1[4 * g4 + 2] : p0[4 * g4 + 2], pd = hf ? p1[4 * g4 + 3] : p0[4 * g4 + 3];
                float tv = 2.f * ((pa + pb) + pc) + pd, uv = pd;
                tv += __shfl_xor(tv, 1); uv += __shfl_xor(uv, 1); tv += __shfl_xor(tv, 2); uv += __shfl_xor(uv, 2);
                const int sg = sig0 + 8 * hf + 2 * g4 + h;
                if ((lane & 3) == 0) { Tq[sg] = tv; Uq[sg + 1] = uv; }
            }
    } else {
        float mxa = fmaxf(fmaxf(p0[0], p0[1]), p1[0]), mxb = fmaxf(fmaxf(p0[2], p0[3]), p1[1]); mxa = fmaxf(fmaxf(mxa, p1[2]), p1[3]);
#pragma unroll
        for (int i = 4; i < 16; i += 4) { mxa = fmaxf(fmaxf(mxa, p0[i]), p0[i + 1]); mxb = fmaxf(fmaxf(mxb, p0[i + 2]), p0[i + 3]); mxa = fmaxf(fmaxf(mxa, p1[i]), p1[i + 1]); mxb = fmaxf(fmaxf(mxb, p1[i + 2]), p1[i + 3]); }
        float mx = fmaxf(mxa, mxb); mx = fmaxf(mx, __shfl_xor(mx, 32));
        const float VLD = (MODE >= 2) ? -1.0e4f : NEG;
        const bool need = (mx > ATT_THR) || (!any && mx > VLD);
        if (__any(need)) {
            const float dl = need ? mx : 0.f; const float f = any ? __builtin_amdgcn_exp2f(-dl) : 1.f;
            m += dl; l *= f;
            if (MODE >= 2) aug_set_m(A, m);
#pragma unroll
            for (int i = 0; i < 16; ++i) { p0[i] -= dl; p1[i] -= dl; }
            if (MODE >= 2) {
#pragma unroll
                for (int i = 0; i < 16; ++i) { o0[i] *= f; o1[i] *= f; } }
        }
        any = any || (mx > VLD);
        float rs0 = 0.f, rs1 = 0.f;
#pragma unroll
        for (int i = 0; i < 16; ++i) { p0[i] = __builtin_amdgcn_exp2f(p0[i]); p1[i] = __builtin_amdgcn_exp2f(p1[i]); rs0 += p0[i]; rs1 += p1[i]; }
        l += rs0 + rs1;
        if (MODE == 0) return;
    }
    __builtin_amdgcn_sched_barrier(0);
#pragma unroll
    for (int sp = 0; sp < 4; ++sp) {
        v4u pw;
        if (sp < 2) { const int b8 = 8 * sp; pw.x = cvtpk(p0[b8], p0[b8 + 1]); pw.y = cvtpk(p0[b8 + 2], p0[b8 + 3]); pw.z = cvtpk(p0[b8 + 4], p0[b8 + 5]); pw.w = cvtpk(p0[b8 + 6], p0[b8 + 7]); }
        else { const int b8 = 8 * (sp - 2); pw.x = cvtpk(p1[b8], p1[b8 + 1]); pw.y = cvtpk(p1[b8 + 2], p1[b8 + 3]); pw.z = cvtpk(p1[b8 + 4], p1[b8 + 5]); pw.w = cvtpk(p1[b8 + 6], p1[b8 + 7]); }
        const bf16x8 pbf = __builtin_bit_cast(bf16x8, pw);
#pragma unroll
        for (int db = 0; db < 2; ++db) {
            const v4i16_t lo = vlo[sp][db], hi = vhi[sp][db];
            const bf16x8 vf = (bf16x8){lo[0], lo[1], lo[2], lo[3], hi[0], hi[1], hi[2], hi[3]};
            if (db == 0) o0 = __builtin_amdgcn_mfma_f32_32x32x16_bf16(vf, pbf, o0, 0, 0, 0);
            else o1 = __builtin_amdgcn_mfma_f32_32x32x16_bf16(vf, pbf, o1, 0, 0, 0);
        }
    }
}

struct BgCopy {
    size_t base; int k, pend; f32x4 v0;
    __device__ __forceinline__ void init(Frame& F) { const int b = F.vcu >> 1, hb = F.vcu & 1; k = (F.G == 256) ? 0 : 64; pend = 0; base = (size_t)b * 65536 + hb * 32704; }
    __device__ __forceinline__ void step(Frame& F) {
        const f32x4* src = (const f32x4*)F.state_win + base + 128 + F.tid; f32x4* dst = (f32x4*)(F.out + OUT_WIN_S) + base + F.tid;
        if (pend) { if (k - 1 < 63 || F.tid < 448) dst[512 * (k - 1)] = v0; pend = 0; }
        if (k < 64) { if (k < 63 || F.tid < 448) v0 = src[512 * k]; k += 1; pend = 1; }
    }
    __device__ __forceinline__ void finish(Frame& F) { while (k < 64 || pend) step(F); }
};

__device__ __forceinline__ void attn_prompt_unit(Frame& F, BgCopy& BG, int b, int g, int qb) {
    const int lane = F.lane, r = lane & 31, h = lane >> 5, w = F.wave;
    const int c0 = qb * 64, cur = qb, ql = 8 * w + (r >> 2), tq = c0 + ql, hd = g * 4 + (r & 3);
    const bf16* Q = WSP(bf16, WS_Q); const bf16* KVS = WSP(bf16, WS_KVS); const bf16* KVW = WSP(bf16, WS_KVW); const bf16* KC = WSP(bf16, WS_KC); const float* GATE = WSP(float, WS_GATE);
    bf16* O = WSP(bf16, WS_DIFF);
    const size_t row = (size_t)b * SEQ + tq;
    bf16x8 qf[4];
#pragma unroll
    for (int ks = 0; ks < 4; ++ks) qf[ks] = *(const bf16x8*)(Q + row * D + hd * 64 + ks * 16 + h * 8);
    const float slope2 = exp2f(-0.5f * (float)(hd + 1)) * LOG2E;
    AugState AG;
    { const unsigned sh = f2bf(slope2); const float shf = bf2f((unsigned short)sh); const unsigned sl = f2bf(slope2 - shf); const float slf = bf2f((unsigned short)sl);
      const unsigned hs = h ? 0u : 0xffffffffu; AG.hsel = hs;
      AG.q0 = (f2bf(64.f * shf) | (f2bf(64.f * slf) << 16)) & hs; AG.q1 = (sh | (sl << 16)) & hs; AG.mw2 = 0u; AG.mw3 = 0u;
      const unsigned j0 = __float_as_uint((float)r) >> 16, j1 = __float_as_uint((float)(32 + r)) >> 16; AG.kj0 = (j0 * 0x10001u) & hs; AG.kj1 = (j1 * 0x10001u) & hs; }
    const float g0 = GATE[row * 48 + hd * 3 + 0], g1 = GATE[row * 48 + hd * 3 + 1], g2 = GATE[row * 48 + hd * 3 + 2];
    LAS float* T = (LAS float*)(F.lds + AT_T); LAS float* U = (LAS float*)(F.lds + AT_U);
    LAS unsigned* SELM = (LAS unsigned*)(F.lds + AT_SEL); LAS unsigned* WUNI = (LAS unsigned*)(F.lds + AT_WUNI);
    for (int i = F.tid; i < 2 * 64 * AT_TS; i += 512) T[i] = 0.f;
    f32x16 of0, of1, o0, o1;
#pragma unroll
    for (int i = 0; i < 16; ++i) { of0[i] = 0.f; of1[i] = 0.f; o0[i] = 0.f; o1[i] = 0.f; }
    const float NEG = -INFINITY;
    const int nmax = c0 / 16 + 2;
    const int ntile = (nmax >= 255 ? 254 : nmax) / 64 + 1;
    const bf16* kc = KC + (size_t)((0 * 4 + b) * 4 + g) * 256 * 64; const bf16* vc = KC + (size_t)((1 * 4 + b) * 4 + g) * 256 * 64;
    float m = 0.f, l = 0.f; bool any = false;
    KvRegs R; int cb = 0;
    load_kv(F, R, kc, vc, 64); __syncthreads(); store_kv(F, R, 0); __syncthreads();
    for (int tl = 0; tl < ntile; ++tl) {
        const bool more = tl + 1 < ntile; BG.step(F);
        if (more) load_kv(F, R, kc + (size_t)(tl + 1) * 64 * 64, vc + (size_t)(tl + 1) * 64 * 64, 64); else load_kv(F, R, kc, vc, 64);
        attn_tile<0>(F, !(1024 * tl + 1039 <= c0 + 8 * w), cb, qf, AG, 0, 16 * 64 * tl + 31 + 16 * 4 * h - tq, slope2, true, m, l, any, o0, o1, 0.f, 0.f, nullptr, nullptr, 0);
        store_kv(F, R, cb ^ 1); __syncthreads(); cb ^= 1;
    }
    { const float lt = l + __shfl_xor(l, 32); const float invl = lt > 0.f ? 1.0f / lt : 0.f;
      LAS float* Tq = T + ql * AT_TS; LAS float* Uq = U + ql * AT_TS;
      for (int tl = 0; tl < ntile; ++tl) {
          const bool more = tl + 1 < ntile;
          if (more) load_kv(F, R, kc + (size_t)(tl + 1) * 64 * 64, vc + (size_t)(tl + 1) * 64 * 64, 64);
          attn_tile<1>(F, !(1024 * tl + 1039 <= c0 + 8 * w), cb, qf, AG, 0, 16 * 64 * tl + 31 + 16 * 4 * h - tq, slope2, true, m, l, any, o0, o1, m, invl, Tq, Uq, 16 * tl);
          if (more) { store_kv(F, R, cb ^ 1); __syncthreads(); cb ^= 1; }
      }
#pragma unroll
      for (int i = 0; i < 16; ++i) { of0[i] = g0 * o0[i]; of1[i] = g0 * o1[i]; o0[i] = 0.f; o1[i] = 0.f; } }
    __syncthreads();
    unsigned long long wuni = 0ull;
    for (int qq = 8 * w; qq < 8 * w + 8; ++qq) {
        unsigned long long msk;
        if (cur <= 15) msk = (cur == 63) ? ~0ull : ((1ull << (cur + 1)) - 1ull);
        else {
            const float v = T[qq * AT_TS + lane] + U[qq * AT_TS + lane];
            T[qq * AT_TS + lane] = v;
            LDS_WAIT(); asm volatile("" ::: "memory");
            int rank = 0;
            for (int s2 = 1; s2 <= cur - 2; ++s2) { const float o = T[qq * AT_TS + s2]; rank += (o > v || (o == v && s2 < lane)) ? 1 : 0; }
            const bool sel = (lane <= cur) && (lane == 0 || lane >= cur - 1 || rank < 13);
            msk = __ballot(sel);
        }
        if (lane == 0) { SELM[2 * qq] = (unsigned)msk; SELM[2 * qq + 1] = (unsigned)(msk >> 32); }
        wuni |= msk;
    }
    wuni = ((unsigned long long)(unsigned)__builtin_amdgcn_readfirstlane((int)(unsigned)(wuni >> 32)) << 32) | (unsigned long long)(unsigned)__builtin_amdgcn_readfirstlane((int)(unsigned)wuni);
    if (lane == 0) { WUNI[2 * w] = (unsigned)wuni; WUNI[2 * w + 1] = (unsigned)(wuni >> 32); }
    __syncthreads();
    unsigned long long guni = 0ull;
#pragma unroll
    for (int i = 0; i < 8; ++i) guni |= (unsigned long long)WUNI[2 * i] | ((unsigned long long)WUNI[2 * i + 1] << 32);
    const unsigned long long mym = (unsigned long long)SELM[2 * ql] | ((unsigned long long)SELM[2 * ql + 1] << 32);
    LAS float* OFP = (LAS float*)(F.lds + AT_OF) + w * 32 * 64 + lane;
#pragma unroll
    for (int i = 0; i < 16; ++i) { OFP[i * 64] = of0[i]; OFP[(16 + i) * 64] = of1[i]; }
    m = 0.f; l = 0.f; any = false; AG.mw2 = 0u; AG.mw3 = 0u;
    { const bf16* ks = KVS + (size_t)b * SEQ * 512 + g * 64; const bf16* vs = ks + 256;
      unsigned long long rem = guni;
      int s = __builtin_ctzll(rem); rem &= rem - 1ull;
      load_kv(F, R, ks + (size_t)s * 64 * 512, vs + (size_t)s * 64 * 512, 512); __syncthreads(); store_kv(F, R, 0); __syncthreads(); cb = 0;
      for (;;) {
          const bool more = rem != 0ull; const int sn = more ? __builtin_ctzll(rem) : 0; rem &= rem - 1ull; BG.step(F);
          if (more) load_kv(F, R, ks + (size_t)sn * 64 * 512, vs + (size_t)sn * 64 * 512, 512);
          if ((wuni >> s) & 1ull) attn_tile<2>(F, s == cur, cb, qf, AG, s - cur, 64 * s + 4 * h - tq, slope2, ((mym >> s) & 1ull) != 0ull, m, l, any, o0, o1, 0.f, 0.f, nullptr, nullptr, 0);
          if (!more) break;
          store_kv(F, R, cb ^ 1); __syncthreads(); cb ^= 1; s = sn;
      }
      const float lt = l + __shfl_xor(l, 32); const float sc = lt > 0.f ? g1 / lt : 0.f;
#pragma unroll
      for (int i = 0; i < 16; ++i) { OFP[i * 64] += sc * o0[i]; OFP[(16 + i) * 64] += sc * o1[i]; o0[i] = 0.f; o1[i] = 0.f; } }
    m = 0.f; l = 0.f; any = false; AG.mw2 = 0u; AG.mw3 = 0u;
    { const bf16* kw = KVW + (size_t)b * SEQ * 512 + g * 64; const bf16* vw = kw + 256;
      const int j0 = (c0 >= 512) ? 0 : (512 - c0) / 64;
      { const int pos0 = c0 - 512 + 64 * j0; load_kv(F, R, kw + (size_t)pos0 * 512, vw + (size_t)pos0 * 512, 512); __syncthreads(); store_kv(F, R, 0); __syncthreads(); cb = 0; }
      for (int j = j0; j < 9; ++j) {
          const int pos0 = c0 - 512 + 64 * j; const bool more = j + 1 < 9; BG.step(F);
          if (more) load_kv(F, R, kw + (size_t)(pos0 + 64) * 512, vw + (size_t)(pos0 + 64) * 512, 512);
          attn_tile<3>(F, j == 0 || j == 8, cb, qf, AG, j - 8, pos0 + 4 * h - tq, slope2, true, m, l, any, o0, o1, 0.f, 0.f, nullptr, nullptr, 0);
          if (more) { store_kv(F, R, cb ^ 1); __syncthreads(); cb ^= 1; }
      }
      const float lt = l + __shfl_xor(l, 32); const float sc = lt > 0.f ? g2 / lt : 0.f;
#pragma unroll
      for (int i = 0; i < 16; ++i) { of0[i] = OFP[i * 64] + sc * o0[i]; of1[i] = OFP[(16 + i) * 64] + sc * o1[i]; } }
    bf16* orow = O + row * D + hd * 64;
#pragma unroll
    for (int g4 = 0; g4 < 4; ++g4) {
        v2u a; a.x = cvtpk(of0[4 * g4], of0[4 * g4 + 1]); a.y = cvtpk(of0[4 * g4 + 2], of0[4 * g4 + 3]);
        v2u c; c.x = cvtpk(of1[4 * g4], of1[4 * g4 + 1]); c.y = cvtpk(of1[4 * g4 + 2], of1[4 * g4 + 3]);
        *(v2u*)(orow + 8 * g4 + 4 * h) = a; *(v2u*)(orow + 32 + 8 * g4 + 4 * h) = c;
    }
    __syncthreads();
}

constexpr int SA_QS = 0, SA_SC = 1024, SA_NK = 1664, SA_IMP = SA_SC + SA_NK * 16, SA_LIST = SA_IMP + 256, SA_BLK = SA_LIST + 64, SA_RED = SA_BLK + 128, SA_END = SA_RED + 512 * 64;
constexpr int SK_CMP = 0, SK_SEL = 128, SK_WIN = 1088, SK_NSEL = 1600, SK_NWIN = 1601;
static_assert(SA_END <= RING_BYTES, "sample attention LDS");

__device__ __forceinline__ f32x4 wave_max4(f32x4 v) {
#pragma unroll
    for (int o = 1; o < 64; o <<= 1) { v[0] = fmaxf(v[0], __shfl_xor(v[0], o)); v[1] = fmaxf(v[1], __shfl_xor(v[1], o)); v[2] = fmaxf(v[2], __shfl_xor(v[2], o)); v[3] = fmaxf(v[3], __shfl_xor(v[3], o)); }
    return v;
}
__device__ __forceinline__ f32x4 wave_sum4(f32x4 v) {
#pragma unroll
    for (int o = 1; o < 64; o <<= 1) { v[0] += __shfl_xor(v[0], o); v[1] += __shfl_xor(v[1], o); v[2] += __shfl_xor(v[2], o); v[3] += __shfl_xor(v[3], o); }
    return v;
}
__device__ __forceinline__ void sa_softmax4(LAS f32x4* SC, int k0, int nk, int kx, f32x4 post, int lane) {
    f32x4 mx = (f32x4){-INFINITY, -INFINITY, -INFINITY, -INFINITY};
    for (int i = lane; i < nk; i += 64) { const f32x4 s = SC[k0 + i]; mx[0] = fmaxf(mx[0], s[0]); mx[1] = fmaxf(mx[1], s[1]); mx[2] = fmaxf(mx[2], s[2]); mx[3] = fmaxf(mx[3], s[3]); }
    if (kx >= 0) { const f32x4 s = SC[kx]; mx[0] = fmaxf(mx[0], s[0]); mx[1] = fmaxf(mx[1], s[1]); mx[2] = fmaxf(mx[2], s[2]); mx[3] = fmaxf(mx[3], s[3]); }
    mx = wave_max4(mx);
#pragma unroll
    for (int q = 0; q < 4; ++q) if (mx[q] == -INFINITY) mx[q] = 0.f;
    f32x4 sum = (f32x4){0.f, 0.f, 0.f, 0.f};
    for (int i = lane; i < nk; i += 64) { f32x4 s = SC[k0 + i];
#pragma unroll
        for (int q = 0; q < 4; ++q) s[q] = __builtin_amdgcn_exp2f(s[q] - mx[q]);
        SC[k0 + i] = s; sum += s; }
    sum = wave_sum4(sum);
    f32x4 ex = (f32x4){0.f, 0.f, 0.f, 0.f};
    if (kx >= 0) { const f32x4 s = SC[kx];
#pragma unroll
        for (int q = 0; q < 4; ++q) ex[q] = __builtin_amdgcn_exp2f(s[q] - mx[q]);
        sum += ex; }
    f32x4 sc;
#pragma unroll
    for (int q = 0; q < 4; ++q) sc[q] = sum[q] > 0.f ? post[q] / sum[q] : 0.f;
    LDS_WAIT(); asm volatile("" ::: "memory");
    for (int i = lane; i < nk; i += 64) SC[k0 + i] = SC[k0 + i] * sc;
    if (kx >= 0 && lane == 0) SC[kx] = ex * sc;
}

#define SA_LOADK(dst, kr) do { dst[0] = *(const f32x4*)(kr); dst[1] = *(const f32x4*)((kr) + 4); dst[2] = *(const f32x4*)((kr) + 32); dst[3] = *(const f32x4*)((kr) + 36); } while (0)
#define SA_SCORE(acc, kf) do { acc = __builtin_amdgcn_mfma_f32_16x16x32_bf16(af[0], cvt8(kf[0], kf[1]), (f32x4){0.f, 0.f, 0.f, 0.f}, 0, 0, 0); acc = __builtin_amdgcn_mfma_f32_16x16x32_bf16(af[1], cvt8(kf[2], kf[3]), acc, 0, 0, 0); } while (0)

__device__ __forceinline__ void attn_sample_unit(Frame& F, int b, int g) {
    const int tid = F.tid, lane = F.lane, w = F.wave; const int row = MP + b;
    const bf16* Q = WSP(bf16, WS_Q); const bf16* KVS = WSP(bf16, WS_KVS); const bf16* KVW = WSP(bf16, WS_KVW); const float* KCS = WSP(float, WS_KCS); const float* GATE = WSP(float, WS_GATE);
    bf16* O = WSP(bf16, WS_DIFF);
    LAS f32x4* SC = (LAS f32x4*)(F.lds + SA_SC); LAS float* IMP = (LAS float*)(F.lds + SA_IMP);
    LAS int* LIST = (LAS int*)(F.lds + SA_LIST); LAS int* BLK = (LAS int*)(F.lds + SA_BLK); LAS float* RED = (LAS float*)(F.lds + SA_RED);
    const float* kc = KCS + (size_t)((0 * 128 + b) * 4 + g) * 128 * 64; const float* vc = KCS + (size_t)((1 * 128 + b) * 4 + g) * 128 * 64;
    const float* sw = F.state_win + (size_t)b * 512 * 512;
    __syncthreads();
    bf16x8 af[2];
#pragma unroll
    for (int ks = 0; ks < 2; ++ks) { af[ks] = (bf16x8){0, 0, 0, 0, 0, 0, 0, 0}; if ((lane & 15) < 4) af[ks] = *(const bf16x8*)(Q + (size_t)row * D + (g * 4 + (lane & 15)) * 64 + 32 * ks + 8 * (lane >> 4)); }
    f32x4 sl2;
#pragma unroll
    for (int i = 0; i < 4; ++i) sl2[i] = exp2f(-0.5f * (float)(g * 4 + i + 1)) * LOG2E;
    f32x4 gt0, gt1, gt2;
    { const float* gp = GATE + (size_t)row * 48 + g * 12;
#pragma unroll
      for (int i = 0; i < 4; ++i) { gt0[i] = gp[i * 3 + 0]; gt1[i] = gp[i * 3 + 1]; gt2[i] = gp[i * 3 + 2]; } }
    const int kl = lane & 15, kc8 = 8 * (lane >> 4);
    { f32x4 kf[5][4];
      { const float* kr = kc + (size_t)(16 * w + kl) * 64 + kc8; SA_LOADK(kf[0], kr); }
#pragma unroll
      for (int j = 1; j < 5; ++j) { const float* kr = sw + (size_t)(16 * (w + 8 * (j - 1)) + kl) * 512 + g * 64 + kc8; SA_LOADK(kf[j], kr); }
      f32x4 acc;
      SA_SCORE(acc, kf[0]);
      if (lane < 16) { const int n = 16 * w + kl; const float rel = (float)(16 * n + 31 - PAST); f32x4 s;
#pragma unroll
          for (int i = 0; i < 4; ++i) s[i] = (n < 127) ? acc[i] + sl2[i] * rel : -INFINITY;
          SC[SK_CMP + n] = s; }
#pragma unroll
      for (int j = 1; j < 5; ++j) { SA_SCORE(acc, kf[j]);
          if (lane < 16) { const int i2 = 16 * (w + 8 * (j - 1)) + kl; const float rel = (float)(i2 - 512); f32x4 s;
#pragma unroll
              for (int i = 0; i < 4; ++i) s[i] = (i2 >= 1) ? acc[i] + sl2[i] * rel : -INFINITY;
              SC[SK_WIN + i2] = s; } }
      if (w == 7) {
          f32x4 a, c2; const float kwn = bf2f(KVW[(size_t)row * 512 + g * 64 + lane]), ksn = bf2f(KVS[(size_t)row * 512 + g * 64 + lane]);
#pragma unroll
          for (int i = 0; i < 4; ++i) { const float qv = bf2f(Q[(size_t)row * D + (g * 4 + i) * 64 + lane]); a[i] = qv * kwn; c2[i] = qv * ksn; }
          a = wave_sum4(a); c2 = wave_sum4(c2);
          if (lane == 0) { SC[SK_NWIN] = a; SC[SK_NSEL] = c2; }
      }
    }
    __syncthreads();
    if (w == 0) {
        sa_softmax4(SC, SK_CMP, 128, -1, (f32x4){1.f, 1.f, 1.f, 1.f}, lane);
        LDS_WAIT(); asm volatile("" ::: "memory");
        if (lane < 33) { float a = 0.f;
#pragma unroll
            for (int dn = -1; dn <= 3; ++dn) { const int n = 4 * lane + dn; if (n >= 0 && n < 127) { const f32x4 p = SC[SK_CMP + n]; a += ((dn == -1 || dn == 3) ? 1.f : 2.f) * ((p[0] + p[1]) + (p[2] + p[3])); } }
            IMP[lane] = a; }
        LDS_WAIT(); asm volatile("" ::: "memory");
        const float v = (lane <= 32) ? IMP[lane] : 0.f; int rank = 0;
        for (int s2 = 1; s2 <= 30; ++s2) { const float o = IMP[s2]; rank += (o > v || (o == v && s2 < lane)) ? 1 : 0; }
        const bool sel = (lane == 0) || (lane == 31) || (lane >= 1 && lane <= 30 && rank < 13);
        const unsigned long long msk = __ballot(sel);
        if (sel) { const int pos = __builtin_popcountll(msk & ((1ull << lane) - 1ull)); LIST[pos] = lane;
            const int page = F.page_table[b * 16 + (lane >> 1)]; BLK[pos] = page * 128 + (lane & 1) * 64; }
        LDS_WAIT(); asm volatile("" ::: "memory");
        for (int i = lane; i < 128; i += 64) SC[SK_CMP + i] = SC[SK_CMP + i] * gt0;
    }
    __syncthreads();
#pragma unroll
    for (int bt = 0; bt < 2; ++bt) {
        f32x4 kf[4][4];
#pragma unroll
        for (int j = 0; j < 4; ++j) { const int st = w + 8 * (4 * bt + j); if (st < 60) { const int bi = st >> 2, kk = 16 * (st & 3) + kl;
            const float* kr = F.cache + ((size_t)(BLK[bi] + kk) * 4 + 2) * 256 + g * 64 + kc8; SA_LOADK(kf[j], kr); } }
#pragma unroll
        for (int j = 0; j < 4; ++j) { const int st = w + 8 * (4 * bt + j); if (st < 60) { const int bi = st >> 2, kk = 16 * (st & 3) + kl; f32x4 acc; SA_SCORE(acc, kf[j]);
            if (lane < 16) { const float rel = (float)(64 * LIST[bi] + kk - PAST); f32x4 s;
#pragma unroll
                for (int i = 0; i < 4; ++i) s[i] = acc[i] + sl2[i] * rel;
                SC[SK_SEL + 64 * bi + kk] = s; } } }
    }
    if (w == 1) sa_softmax4(SC, SK_WIN, 512, SK_NWIN, gt2, lane);
    __syncthreads();
    if (w == 0) sa_softmax4(SC, SK_SEL, 960, SK_NSEL, gt1, lane);
    __syncthreads();
    { const int kq = lane >> 4, c4 = 4 * (lane & 15);
      f32x4 acc[4];
#pragma unroll
      for (int i = 0; i < 4; ++i) acc[i] = (f32x4){0.f, 0.f, 0.f, 0.f};
      { f32x4 vv[4];
#pragma unroll
        for (int it = 0; it < 4; ++it) vv[it] = *(const f32x4*)(vc + (size_t)(32 * it + 4 * w + kq) * 64 + c4);
#pragma unroll
        for (int it = 0; it < 4; ++it) { const f32x4 p = SC[SK_CMP + 32 * it + 4 * w + kq];
#pragma unroll
            for (int i = 0; i < 4; ++i) acc[i] += vv[it] * p[i]; } }
#pragma unroll
      for (int bt = 0; bt < 1; ++bt) { f32x4 vv[16];
#pragma unroll
        for (int j = 0; j < 16; ++j) vv[j] = *(const f32x4*)(sw + (size_t)(32 * j + 4 * w + kq) * 512 + 256 + g * 64 + c4);
#pragma unroll
        for (int j = 0; j < 16; ++j) { const f32x4 p = SC[SK_WIN + 32 * j + 4 * w + kq];
#pragma unroll
            for (int i = 0; i < 4; ++i) acc[i] += vv[j] * p[i]; } }
#pragma unroll
      for (int bt = 0; bt < 2; ++bt) { f32x4 vv[15];
#pragma unroll
        for (int j = 0; j < 15; ++j) { const int k = 32 * (15 * bt + j) + 4 * w + kq; vv[j] = *(const f32x4*)(F.cache + ((size_t)(BLK[k >> 6] + (k & 63)) * 4 + 3) * 256 + g * 64 + c4); }
#pragma unroll
        for (int j = 0; j < 15; ++j) { const f32x4 p = SC[SK_SEL + 32 * (15 * bt + j) + 4 * w + kq];
#pragma unroll
            for (int i = 0; i < 4; ++i) acc[i] += vv[j] * p[i]; } }
#pragma unroll
      for (int i = 0; i < 4; ++i) *(LAS f32x4*)(RED + tid * 16 + 4 * i) = acc[i];
    }
    __syncthreads();
    if (tid < 256) { const int hd = tid >> 6, d = tid & 63; float a = 0.f;
#pragma unroll 8
        for (int j = 0; j < 32; ++j) a += RED[((j >> 2) * 64 + (j & 3) * 16 + (d >> 2)) * 16 + hd * 4 + (d & 3)];
        { const f32x4 ps = SC[SK_NSEL], pw = SC[SK_NWIN];
          a += ps[hd] * bf2f(KVS[(size_t)row * 512 + 256 + g * 64 + d]) + pw[hd] * bf2f(KVW[(size_t)row * 512 + 256 + g * 64 + d]); }
        O[(size_t)row * D + (g * 4 + hd) * 64 + d] = (bf16)f2bf(a); }
    __syncthreads();
}

__device__ __forceinline__ void p7_attention(Frame& F) {
    BgCopy BG; BG.init(F);
    const bool sfirst = (blockIdx.x & 1) == 0;
    SEG_BEGIN(20); if (sfirst) for (int i = F.vcu; i < DB * 4; i += F.G) attn_sample_unit(F, i >> 2, i & 3); SEG_END(20);
    SEG_BEGIN(21);
    for (int i = F.vcu; i < 1024; i += F.G) { const int k = i >> 8, c = i & 255, bg = c >> 4, s = c & 15; const int qb = (k == 0) ? s : (k == 1) ? 31 - s : (k == 2) ? 32 + s : 63 - s;
        attn_prompt_unit(F, BG, bg >> 2, bg & 3, qb); }
    BG.finish(F); SEG_END(21);
    SEG_BEGIN(20); if (!sfirst) for (int i = F.vcu; i < DB * 4; i += F.G) attn_sample_unit(F, i >> 2, i & 3); SEG_END(20);
}

enum { SG_POOL = 0, SG_UP = 1, SG_DOWN = 2, SG_KVQG = 3, SG_WO = 4 };
constexpr int SG_RED = 0, SG_SSQ = 2 * 8 * 16 * 64 * 4;
template <int KIND>
__device__ __forceinline__ void small_gemm(Frame& F, int layer) {
    constexpr bool F32B = (KIND == SG_UP || KIND == SG_KVQG);
    constexpr int KR = (KIND == SG_POOL) ? 256 : 1024;
    constexpr int KSPLIT = (KIND == SG_DOWN) ? 4 : 1;
    constexpr int NSL = (KIND == SG_POOL) ? 32 : (KIND == SG_UP) ? 128 : (KIND == SG_KVQG) ? 82 : 32;
    constexpr int KW = KR / 8, NKS = KW / 16;
    const int lane = F.lane, w = F.wave, r = lane & 31, h = lane >> 5;
    float* X = WSP(float, WS_X);
    LAS float* RED = (LAS float*)(F.lds + SG_RED); LAS float* SSQ = (LAS float*)(F.lds + SG_SSQ);
    for (int item = F.vcu; item < (NSL / 2) * 4 * KSPLIT; item += F.G) {
        const int kr = item % KSPLIT, tt = item / KSPLIT, rbk = tt & 3, np = tt >> 2;
        const int row = MP + 32 * rbk + r, b = 32 * rbk + r;
        const int kb = kr * KR + w * KW + 8 * h;
        int n0[2]; const bf16* wrow[2]; const bf16* b16 = nullptr; const float* b32 = nullptr;
#pragma unroll
        for (int t = 0; t < 2; ++t) { const int ns = 2 * np + t; n0[t] = ns * 32;
            if (KIND == SG_POOL) { const int g = ns >> 3; n0[t] = (ns & 7) * 32; wrow[t] = WSP(bf16, WS_WPOOL) + (size_t)g * 65536 + (size_t)(n0[t] + r) * 256 + kb; b16 = WSP(bf16, WS_DIFF) + (size_t)row * D + g * 256 + kb; n0[t] += g * 256; }
            else if (KIND == SG_UP) { wrow[t] = WSP(bf16, WS_WUP) + (size_t)layer * FF * D + (size_t)(n0[t] + r) * D + kb; b32 = X + (size_t)row * D + kb; }
            else if (KIND == SG_DOWN) { wrow[t] = WSP(bf16, WS_WDN) + (size_t)layer * D * FF + (size_t)(n0[t] + r) * FF + kb; b16 = WSP(bf16, WS_H) + (size_t)row * FF + kb; }
            else if (KIND == SG_KVQG) { wrow[t] = WSP(bf16, WS_WKVQG) + (size_t)(n0[t] + r) * D + kb; b32 = X + (size_t)row * D + kb; }
            else { wrow[t] = WSP(bf16, WS_WO) + (size_t)(n0[t] + r) * D + kb; b16 = WSP(bf16, WS_DIFF) + (size_t)row * D + kb; } }
        bf16x8 a0[NKS], a1[NKS], bb[NKS]; f32x4 x0[NKS], x1[NKS];
#pragma unroll
        for (int j = 0; j < NKS; ++j) { a0[j] = *(const bf16x8*)(wrow[0] + 16 * j); a1[j] = *(const bf16x8*)(wrow[1] + 16 * j);
            if (F32B) { x0[j] = *(const f32x4*)(b32 + 16 * j); x1[j] = *(const f32x4*)(b32 + 16 * j + 4); } else bb[j] = *(const bf16x8*)(b16 + 16 * j); }
        f32x16 acc0, acc1; float ssq = 0.f;
#pragma unroll
        for (int i = 0; i < 16; ++i) { acc0[i] = 0.f; acc1[i] = 0.f; }
#pragma unroll
        for (int j = 0; j < NKS; ++j) {
            if (F32B) { ssq += (x0[j][0] * x0[j][0] + x0[j][1] * x0[j][1]) + (x0[j][2] * x0[j][2] + x0[j][3] * x0[j][3]) + (x1[j][0] * x1[j][0] + x1[j][1] * x1[j][1]) + (x1[j][2] * x1[j][2] + x1[j][3] * x1[j][3]); bb[j] = cvt8(x0[j], x1[j]); }
            acc0 = __builtin_amdgcn_mfma_f32_32x32x16_bf16(a0[j], bb[j], acc0, 0, 0, 0);
            acc1 = __builtin_amdgcn_mfma_f32_32x32x16_bf16(a1[j], bb[j], acc1, 0, 0, 0);
        }
        __syncthreads();
#pragma unroll
        for (int i = 0; i < 16; ++i) { RED[(w * 16 + i) * 64 + lane] = acc0[i]; RED[((8 + w) * 16 + i) * 64 + lane] = acc1[i]; }
        if (F32B) SSQ[w * 64 + lane] = ssq;
        __syncthreads();
        {
            const int te = w >> 2, wq = w & 3;
            f32x4 v = (f32x4){0.f, 0.f, 0.f, 0.f};
#pragma unroll
            for (int ww = 0; ww < 8; ++ww)
#pragma unroll
                for (int e = 0; e < 4; ++e) v[e] += RED[((8 * te + ww) * 16 + 4 * wq + e) * 64 + lane];
            float rstd = 1.f;
            if (F32B) { float q = 0.f;
#pragma unroll
                for (int ww = 0; ww < 8; ++ww) q += SSQ[ww * 64 + r] + SSQ[ww * 64 + 32 + r];
                rstd = 1.0f / sqrtf(q * (1.0f / D) + RMS_EPS); }
            const int nb = te ? n0[1] : n0[0]; const int col = nb + 8 * wq + 4 * h;
            if (KIND == SG_POOL) {
                *(f32x4*)(X + (size_t)row * D + col) = *(const f32x4*)(F.x_s + (size_t)b * D + col) + v * *(const f32x4*)(F.pool_scale + col);
            } else if (KIND == SG_UP) {
                v = v * rstd;
#pragma unroll
                for (int e = 0; e < 4; ++e) { const float t = fmaxf(v[e], 0.f); v[e] = t * t; }
                v2u o; o.x = cvtpk(v[0], v[1]); o.y = cvtpk(v[2], v[3]); *(v2u*)(WSP(bf16, WS_H) + (size_t)row * FF + col) = o;
            } else if (KIND == SG_DOWN || KIND == SG_WO) {
#pragma unroll
                for (int e = 0; e < 4; ++e) unsafeAtomicAdd(X + (size_t)row * D + col + e, v[e]);
            } else {
                v = v * rstd; v2u o; o.x = cvtpk(v[0], v[1]); o.y = cvtpk(v[2], v[3]);
                if (nb < 1024) { *(f32x4*)(F.out + OUT_KV_S + (size_t)b * D + col) = v; if (nb >= 512) *(v2u*)(WSP(bf16, WS_KVS) + (size_t)row * 512 + col - 512) = o; }
                else if (nb < 1536) { *(v2u*)(WSP(bf16, WS_KVW) + (size_t)row * 512 + col - 1024) = o; *(f32x4*)(F.out + OUT_WIN_S + ((size_t)b * 512 + 511) * 512 + col - 1024) = v; }
                else if (nb < 2560) { *(v2u*)(WSP(bf16, WS_Q) + (size_t)row * D + col - 1536) = o; }
                else if (col < 2608) { float* gp = WSP(float, WS_GATE) + (size_t)row * 48 + col - 2560;
#pragma unroll
                    for (int e = 0; e < 4; ++e) gp[e] = 1.0f / (1.0f + __expf(-(v[e] + F.b_gate[col - 2560 + e]))); }
            }
        }
    }
    VM_WAIT(); __syncthreads();
}

__device__ __forceinline__ void p11_final(Frame& F) {
    const int gw = F.vcu * NWAVES + F.wave, NGW = F.G * NWAVES, lane = F.lane; const float* X = WSP(float, WS_X); const bf16* XB = WSP(bf16, WS_XB);
    for (int row = gw; row < MT; row += NGW) {
        f32x4 v[4]; float ss = 0.f;
        if (row < MP) { const v2u* xr = (const v2u*)(XB + (size_t)row * D) + lane;
#pragma unroll
            for (int j = 0; j < 4; ++j) { const v2u q = xr[64 * j]; v[j] = (f32x4){__builtin_bit_cast(float, q.x << 16), __builtin_bit_cast(float, q.x & 0xffff0000u), __builtin_bit_cast(float, q.y << 16), __builtin_bit_cast(float, q.y & 0xffff0000u)}; } }
        else { const f32x4* xr = (const f32x4*)(X + (size_t)row * D) + lane;
#pragma unroll
            for (int j = 0; j < 4; ++j) v[j] = xr[64 * j]; }
#pragma unroll
        for (int j = 0; j < 4; ++j) ss += (v[j][0] * v[j][0] + v[j][1] * v[j][1]) + (v[j][2] * v[j][2] + v[j][3] * v[j][3]);
        const float rstd = 1.0f / sqrtf(wave_sum(ss) * (1.0f / D) + RMS_EPS);
        float* o = (row < MP) ? F.out + OUT_Y_P + (size_t)row * D : F.out + OUT_Y_S + (size_t)(row - MP) * D;
#pragma unroll
        for (int j = 0; j < 4; ++j) *((f32x4*)o + lane + 64 * j) = v[j] * rstd * *((const f32x4*)F.norm_final + lane + 64 * j);
    }
}

constexpr int NPHASE = 12;
struct Args { const void* in[21]; float* out; unsigned char* ws; int ph_lo, ph_hi; };
__global__ void __launch_bounds__(NWAVES * 64, 2) yoco_fwd(Args args) {
    extern __shared__ __attribute__((aligned(16))) unsigned char lds[];
    Frame F;
    F.lds = (LAS unsigned char*)lds;
    F.tid = threadIdx.x; F.lane = F.tid & 63; F.wave = __builtin_amdgcn_readfirstlane(F.tid >> 6);
    F.G = gridDim.x; { const int bx = blockIdx.x; F.vcu = (F.G % 8 == 0) ? (bx % 8) * (F.G / 8) + bx / 8 : bx; }
    F.x_p = (const float*)args.in[0]; F.x_s = (const float*)args.in[1]; F.state_pool = (const float*)args.in[2]; F.cache = (const float*)args.in[3]; F.state_win = (const float*)args.in[4];
    F.page_table = (const int*)args.in[5]; F.norm_mix = (const float*)args.in[6]; F.norm_mlp = (const float*)args.in[7]; F.w_up = (const float*)args.in[8]; F.w_down = (const float*)args.in[9];
    F.pool_w = (const float*)args.in[10]; F.pool_scale = (const float*)args.in[11]; F.norm_kv = (const float*)args.in[12]; F.w_kv = (const float*)args.in[13]; F.cmp_pe = (const float*)args.in[14];
    F.cmp_w1 = (const float*)args.in[15]; F.cmp_w2 = (const float*)args.in[16]; F.w_qg = (const float*)args.in[17]; F.b_gate = (const float*)args.in[18]; F.w_o = (const float*)args.in[19];
    F.norm_final = (const float*)args.in[20]; F.out = args.out; F.ws = args.ws;
    volatile LAS unsigned* MISC = (volatile LAS unsigned*)(F.lds + MISC_OFF);
    for (int u = F.tid; u < (LDS_BYTES - RING_BYTES) / 4; u += NWAVES * 64) ((LAS unsigned*)(F.lds + RING_BYTES))[u] = 0u;
    __syncthreads();
    unsigned* ctl = (unsigned*)(F.ws + WS_CTL);
#if MK_MULTI
#define GRID_BAR() do { } while (0)
#else
    XcdBarrier bar = xcd_barrier_post(ctl + CW_BAR, MISC + 8);
#define GRID_BAR() xcd_barrier(bar)
#endif
    F.seg_t0 = 0ull; F.seg_dt = 0ull;
    const int lo = args.ph_lo, hi = args.ph_hi;
#define IN(k) (lo <= (k) && (k) < hi)
#define SEAM(k) do { SEG_BEGIN(100 + (k)); if (IN(k) && IN((k) + 1)) GRID_BAR(); SEG_END(100 + (k)); SEG_END(k); SEG_BEGIN((k) + 1); } while (0)
    using namespace pg8;
    float* X = WSP(float, WS_X); bf16* XB = WSP(bf16, WS_XB); float* RS = WSP(float, WS_RS);

    SEG_BEGIN(0);
    if (IN(0)) { for (int rep = 0; rep < REP(0); ++rep) { p0_prologue(F); __syncthreads(); } } SEAM(0);
    if (IN(1)) {
        for (int rep = 0; rep < REP(16); ++rep) small_gemm<SG_POOL>(F, 0);
        Gemm g{WSP(bf16_t, WS_DIFF), WSP(bf16_t, WS_WPOOL), MP, 1024, 256, 1024, 256, (size_t)512}; StaticOrder S; S.init(MP, 1024, F.G, (int)blockIdx.x);
        EpiResid E{F.x_p, XB, RS, F.pool_scale};
        gemm_phase<EpiResid, StaticOrder, true, true>(F.lds, g, S, E);
    } SEAM(1);
    if (IN(2)) {
        SEG_BEGIN(60); for (int rep = 0; rep < REP(14); ++rep) small_gemm<SG_UP>(F, 0); SEG_END(60); SEG_BEGIN(61);
        Gemm g{XB, WSP(bf16_t, WS_WUP), MP, FF, D, D, D, (size_t)0}; StaticOrder S; S.init(MP, FF, F.G, (int)blockIdx.x);
        EpiUp E{WSP(bf16_t, WS_H), RS};
        for (int rep = 0; rep < REP(2); ++rep) { gemm_phase<EpiUp, StaticOrder, true, true>(F.lds, g, S, E); __syncthreads(); } SEG_END(61);
    } SEAM(2);
    if (IN(3)) {
        small_gemm<SG_DOWN>(F, 0);
        Gemm g{WSP(bf16_t, WS_H), WSP(bf16_t, WS_WDN), MP, D, FF, FF, FF, (size_t)0}; StaticOrder S; S.init(MP, D, F.G, (int)blockIdx.x);
        EpiResid E{nullptr, XB, RS, nullptr};
        gemm_phase<EpiResid, StaticOrder, true, true>(F.lds, g, S, E);
    } SEAM(3);
    if (IN(4)) {
        SEG_BEGIN(30); for (int rep = 0; rep < REP(15); ++rep) small_gemm<SG_KVQG>(F, 0); SEG_END(30);
        SEG_BEGIN(31); if ((blockIdx.x & 1) == 0) p5_sample_compress(F, ctl + CW_QUEUE, 3); SEG_END(31); SEG_BEGIN(32);
        Gemm g{XB, WSP(bf16_t, WS_WKVQG), MP, NKVQG, D, D, D, (size_t)0}; StaticOrder S; S.init(MP, NKVQG, F.G, (int)blockIdx.x);
        EpiKvqg E{RS, F.b_gate, F.out + OUT_KV_P, F.out + OUT_KV_S, F.out + OUT_WIN_P, F.out + OUT_WIN_S, WSP(bf16_t, WS_CMPA), WSP(bf16_t, WS_KVS), WSP(bf16_t, WS_KVW), WSP(bf16_t, WS_Q), WSP(float, WS_GATE)};
        gemm_phase<EpiKvqg, StaticOrder, true, true>(F.lds, g, S, E);
        __syncthreads(); SEG_END(32); SEG_BEGIN(33);
        p5_sample_compress(F, ctl + CW_QUEUE, 1 << 30); SEG_END(33);
    } SEAM(4);
    if (IN(5)) {
        SEG_BEGIN(50); p5_prompt_compress(F); SEG_END(50); SEG_BEGIN(51);
        if (F.G > 64) { if ((int)blockIdx.x >= 64) p6_combine(F, 0, (int)blockIdx.x - 64, F.G - 64); } else { __syncthreads(); p6_combine(F, 0, (int)blockIdx.x, F.G); } SEG_END(51);
    } SEAM(5);
    if (IN(6)) { p6_combine(F, 1, (int)blockIdx.x, F.G); } SEAM(6);
    if (IN(7)) { p7_attention(F); } SEAM(7);
    if (IN(8)) {
        SEG_BEGIN(70); small_gemm<SG_WO>(F, 0); SEG_END(70); SEG_BEGIN(71);
        Gemm g{WSP(bf16_t, WS_DIFF), WSP(bf16_t, WS_WO), MP, D, D, D, D, (size_t)0}; StaticOrder S; S.init(MP, D, F.G, (int)blockIdx.x);
        EpiResid E{nullptr, XB, RS, nullptr};
        gemm_phase<EpiResid, StaticOrder, true, true>(F.lds, g, S, E); SEG_END(71);
    } SEAM(8);
    if (IN(9)) {
        small_gemm<SG_UP>(F, 1);
        Gemm g{XB, WSP(bf16_t, WS_WUP) + (size_t)FF * D, MP, FF, D, D, D, (size_t)0}; StaticOrder S; S.init(MP, FF, F.G, (int)blockIdx.x);
        EpiUp E{WSP(bf16_t, WS_H), RS};
        gemm_phase<EpiUp, StaticOrder, true, true>(F.lds, g, S, E);
    } SEAM(9);
    if (IN(10)) {
        small_gemm<SG_DOWN>(F, 1);
        Gemm g{WSP(bf16_t, WS_H), WSP(bf16_t, WS_WDN) + (size_t)D * FF, MP, D, FF, FF, FF, (size_t)0}; StaticOrder S; S.init(MP, D, F.G, (int)blockIdx.x);
        EpiResid E{nullptr, XB, RS, nullptr};
        gemm_phase<EpiResid, StaticOrder, true, true>(F.lds, g, S, E);
    } SEAM(10);
    if (IN(11)) { p11_final(F); }
    SEG_END(11);
    if (PROBE_SEG >= 0) { __syncthreads(); const unsigned long long t1 = __builtin_amdgcn_s_memrealtime(); while (__builtin_amdgcn_s_memrealtime() - t1 < F.seg_dt) __builtin_amdgcn_s_sleep(8); }
#undef IN
#undef SEAM
}

extern "C" void kernel_launch(void* const* d_in, const int* in_sizes, int n_in, void* d_out, int out_size, void* d_ws, size_t ws_size, hipStream_t stream) {
    static int grid = 0;
    if (grid == 0) {
        if (n_in != 21 || (size_t)out_size != OUT_TOTAL || ws_size < WS_END) { fprintf(stderr, "kernel_launch: unexpected sizes n_in %d out %d ws %zu\n", n_in, out_size, ws_size); grid = -1; return; }
        int dev = 0, cus = 0, per_cu = 0;
        if (hipGetDevice(&dev) != hipSuccess || hipDeviceGetAttribute(&cus, hipDeviceAttributeMultiprocessorCount, dev) != hipSuccess) { grid = -1; return; }
        if (hipFuncSetAttribute((const void*)yoco_fwd, hipFuncAttributeMaxDynamicSharedMemorySize, LDS_BYTES) != hipSuccess) { fprintf(stderr, "kernel_launch: hipFuncSetAttribute failed\n"); grid = -1; return; }
        if (hipOccupancyMaxActiveBlocksPerMultiprocessor(&per_cu, (const void*)yoco_fwd, NWAVES * 64, LDS_BYTES) != hipSuccess || per_cu < 1) fprintf(stderr, "kernel_launch: occupancy query says %d\n", per_cu);
        (void)hipGetLastError();
        grid = cus;
    }
    if (grid < 0) return;
    (void)hipMemsetAsync((char*)d_ws + WS_CTL, 0, CTL_ZERO_BYTES, stream);
    Args a{};
    for (int i = 0; i < 21; ++i) a.in[i] = d_in[i];
    a.out = (float*)d_out; a.ws = (unsigned char*)d_ws;
#if MK_MULTI
    for (int p = 0; p < NPHASE; ++p) { a.ph_lo = p; a.ph_hi = p + 1; hipLaunchKernelGGL(yoco_fwd, dim3(grid), dim3(NWAVES * 64), LDS_BYTES, stream, a); }
#else
    a.ph_lo = 0; a.ph_hi = NPHASE;
    hipLaunchKernelGGL(yoco_fwd, dim3(grid), dim3(NWAVES * 64), LDS_BYTES, stream, a);
#endif
    const hipError_t le = hipPeekAtLastError();
    if (le != hipSuccess) fprintf(stderr, "kernel_launch: launch failed: %s\n", hipGetErrorName(le));
}
```

```cpp
#include <hip/hip_runtime.h>
#include <hip/hip_bf16.h>
#include <cstdio>
#include <cstdint>
#include <cmath>

#ifndef MK_MULTI
#define MK_MULTI 0
#endif

constexpr int D = 1024, FF = 4096, SEQ = 4096, NB = 4, DB = 128, PAST = 2048;
constexpr int MP = NB * SEQ;
constexpr int MT = MP + DB;
constexpr int MPAD = 16640;
constexpr int NKVQG = 2816;
constexpr int CMP_ROWS_P = NB * 256 * 4;
constexpr int CMP_ROWS_S = DB * 128 * 4;
constexpr int CMP_ROWS = CMP_ROWS_P + CMP_ROWS_S;
constexpr float RMS_EPS = 1e-6f;
constexpr float LOG2E = 1.4426950408889634f;
constexpr float QSCALE = 0.125f * LOG2E;

namespace pg8 {
#define PG8_LAS __attribute__((address_space(3)))
typedef unsigned short bf16_t;
typedef short bf16x8 __attribute__((ext_vector_type(8)));
typedef float f32x4 __attribute__((ext_vector_type(4)));
typedef float f32x2 __attribute__((ext_vector_type(2)));
typedef unsigned u32x4 __attribute__((ext_vector_type(4)));
typedef unsigned u32x2 __attribute__((ext_vector_type(2)));
constexpr int BM = 256, BK = 64, HALF = 128, HTB = HALF * BK * 2, STAGE_BYTES = 8 * HTB, NXCD = 8, WGM = 8;

__host__ __device__ __forceinline__ int lds_byte(int r, int c) { const int st = (r >> 4) * 2 + (c >> 5), rr = r & 15, cc = c & 31, ob = rr * 64 + cc * 2; return st * 1024 + (ob ^ (((ob >> 9) & 1) << 5)); }
__host__ __device__ __forceinline__ void stage_rc(int b, int& R, int& C) { const int st = b / 1024, sb = b % 1024, swz = sb ^ (((sb >> 9) & 1) << 5); R = (st >> 1) * 16 + swz / 64; C = (st & 1) * 32 + (swz % 64) / 2; }
__host__ __device__ __forceinline__ int perm32(int rho) { const int n = rho >> 4, i = rho & 15; return 8 * (i >> 2) + 4 * n + (i & 3); }

struct Unit { int pm, pn; };
struct Gemm { const bf16_t* A; const bf16_t* Bt; int M, N, K, lda, ldb; size_t a_pn_off; };

struct StaticOrder {
    int nM, nN, nwg, G, c;
    __host__ __device__ void init(int M, int N, int G_, int c_) { nM = M / BM; nN = N / BM; nwg = nM * nN; G = G_; c = c_; }
    __host__ __device__ bool next(int i, Unit& u) const {
        const long L = (long)i * G + c; if (L >= nwg) return false;
        int wgid = (int)L; { const int q = nwg / NXCD, r = nwg % NXCD, xcd = wgid % NXCD, off = wgid / NXCD; wgid = (xcd < r ? xcd * (q + 1) : r * (q + 1) + (xcd - r) * q) + off; }
        const int nig = WGM * nN, gid = wgid / nig, fm = gid * WGM, gsz = (nM - fm) < WGM ? (nM - fm) : WGM;
        u.pm = fm + ((wgid % nig) % gsz); u.pn = (wgid % nig) / gsz; return true;
    }
    __device__ __forceinline__ void a_ready(const Unit&) const {}
    __device__ __forceinline__ void done(const Unit&) const {}
};

__device__ __forceinline__ unsigned cvt_pk_bf16(float lo, float hi) { unsigned r; asm volatile("v_cvt_pk_bf16_f32 %0, %1, %2" : "=v"(r) : "v"(lo), "v"(hi)); return r; }

__device__ __forceinline__ float row_rstd(const float* rs, int row) {
    const f32x4* p = (const f32x4*)(rs + (size_t)row * 16); const f32x4 a = p[0], b = p[1], c = p[2], d = p[3];
    const float s = ((a[0] + a[1]) + (a[2] + a[3])) + ((b[0] + b[1]) + (b[2] + b[3])) + ((c[0] + c[1]) + (c[2] + c[3])) + ((d[0] + d[1]) + (d[2] + d[3]));
    return 1.0f / sqrtf(s * (1.0f / 1024.0f) + RMS_EPS);
}

struct EpiResid {
    static constexpr bool PERM = false, AFTER_DRAIN = false;
    const float* base_f; bf16_t* XB; float* RS; const float* scale;
    __device__ __forceinline__ void operator()(const f32x4 (&acc)[2][2][4][2], const Unit& u, int wr, int wc, int fr, int fq) const {
        const int col0 = u.pn * BM + wc * 32 + 4 * fq;
        f32x4 sc[2][2];
#pragma unroll
        for (int bj = 0; bj < 2; ++bj)
#pragma unroll
            for (int n = 0; n < 2; ++n) sc[bj][n] = scale ? *(const f32x4*)(scale + col0 + bj * HALF + n * 16) : (f32x4){1.f, 1.f, 1.f, 1.f};
#pragma unroll
        for (int ai = 0; ai < 2; ++ai) {
#pragma unroll
            for (int m = 0; m < 4; ++m) {
                const int row = u.pm * BM + ai * HALF + wr * 64 + m * 16 + fr;
                float ss = 0.f;
#pragma unroll
                for (int bj = 0; bj < 2; ++bj)
#pragma unroll
                    for (int n = 0; n < 2; ++n) {
                        const int col = col0 + bj * HALF + n * 16;
                        f32x4 bv;
                        if (base_f) bv = *(const f32x4*)(base_f + (size_t)row * D + col);
                        else { const u32x2 q = *(const u32x2*)(XB + (size_t)row * D + col); bv = (f32x4){__builtin_bit_cast(float, q.x << 16), __builtin_bit_cast(float, q.x & 0xffff0000u), __builtin_bit_cast(float, q.y << 16), __builtin_bit_cast(float, q.y & 0xffff0000u)}; }
                        const f32x4 v = bv + acc[ai][bj][m][n] * sc[bj][n];
                        u32x2 w; w.x = cvt_pk_bf16(v[0], v[1]); w.y = cvt_pk_bf16(v[2], v[3]);
                        *(u32x2*)(XB + (size_t)row * D + col) = w;
                        ss += (v[0] * v[0] + v[1] * v[1]) + (v[2] * v[2] + v[3] * v[3]);
                    }
                ss += __shfl_xor(ss, 16); ss += __shfl_xor(ss, 32);
                if (fq == 0) RS[(size_t)row * 16 + u.pn * 4 + wc] = ss;
            }
        }
    }
};

struct EpiUp {
    static constexpr bool PERM = true, AFTER_DRAIN = false;
    bf16_t* H; const float* RS;
    __device__ __forceinline__ void operator()(const f32x4 (&acc)[2][2][4][2], const Unit& u, int wr, int wc, int fr, int fq) const {
        const int col0 = u.pn * BM + wc * 32 + 8 * fq;
#pragma unroll
        for (int ai = 0; ai < 2; ++ai) {
            if (u.pm * BM + ai * HALF >= MT) continue;
#pragma unroll
            for (int m = 0; m < 4; ++m) {
                const int row = u.pm * BM + ai * HALF + wr * 64 + m * 16 + fr;
                const float rstd = row_rstd(RS, row);
#pragma unroll
                for (int bj = 0; bj < 2; ++bj) {
                    f32x4 v0 = acc[ai][bj][m][0] * rstd, v1 = acc[ai][bj][m][1] * rstd;
#pragma unroll
                    for (int e = 0; e < 4; ++e) { const float a = fmaxf(v0[e], 0.f), b = fmaxf(v1[e], 0.f); v0[e] = a * a; v1[e] = b * b; }
                    u32x4 w; w.x = cvt_pk_bf16(v0[0], v0[1]); w.y = cvt_pk_bf16(v0[2], v0[3]); w.z = cvt_pk_bf16(v1[0], v1[1]); w.w = cvt_pk_bf16(v1[2], v1[3]);
                    *(u32x4*)(H + (size_t)row * FF + col0 + bj * HALF) = w;
                }
            }
        }
    }
};

struct EpiKvqg {
    static constexpr bool PERM = true, AFTER_DRAIN = false;
    const float* RS; const float* bgate;
    float* kv_p; float* kv_s; float* win_p; float* win_s;
    bf16_t* CMPA; bf16_t* KVS; bf16_t* KVW; bf16_t* Q; float* GATE;
    __device__ __forceinline__ void operator()(const f32x4 (&acc)[2][2][4][2], const Unit& u, int wr, int wc, int fr, int fq) const {
        const int pn = u.pn;
#pragma unroll
        for (int ai = 0; ai < 2; ++ai) {
            if (u.pm * BM + ai * HALF >= MT) continue;
#pragma unroll
            for (int m = 0; m < 4; ++m) {
                const int row = u.pm * BM + ai * HALF + wr * 64 + m * 16 + fr;
                const float rstd = row_rstd(RS, row);
                const bool prompt = row < MP; const int b = prompt ? (row >> 12) : (row - MP), t = row & (SEQ - 1);
#pragma unroll
                for (int bj = 0; bj < 2; ++bj) {
                    const int cin = bj * HALF + wc * 32 + 8 * fq;
                    const f32x4 v0 = acc[ai][bj][m][0] * rstd, v1 = acc[ai][bj][m][1] * rstd;
                    u32x4 w; w.x = cvt_pk_bf16(v0[0], v0[1]); w.y = cvt_pk_bf16(v0[2], v0[3]); w.z = cvt_pk_bf16(v1[0], v1[1]); w.w = cvt_pk_bf16(v1[2], v1[3]);
                    if (pn < 4) {
                        float* o = prompt ? kv_p + (size_t)row * D : kv_s + (size_t)b * D;
                        *(f32x4*)(o + pn * BM + cin) = v0; *(f32x4*)(o + pn * BM + cin + 4) = v1;
                        if (pn < 2) {
                            if (prompt) { const int g = cin >> 6, d = cin & 63;
                                *(u32x4*)(CMPA + (size_t)pn * CMP_ROWS * D + (size_t)(((b * 256 + (t >> 4)) * 4 + g)) * D + (t & 15) * 64 + d) = w; }
                        } else *(u32x4*)(KVS + (size_t)row * 512 + (pn - 2) * BM + cin) = w;
                    } else if (pn < 6) {
                        const int c = (pn - 4) * BM + cin;
                        *(u32x4*)(KVW + (size_t)row * 512 + c) = w;
                        if (prompt) { if (t >= SEQ - 512) { float* o = win_p + ((size_t)b * 512 + (t - (SEQ - 512))) * 512 + c; *(f32x4*)o = v0; *(f32x4*)(o + 4) = v1; } }
                        else { float* o = win_s + ((size_t)b * 512 + 511) * 512 + c; *(f32x4*)o = v0; *(f32x4*)(o + 4) = v1; }
                    } else if (pn < 10) {
                        *(u32x4*)(Q + (size_t)row * D + (pn - 6) * BM + cin) = w;
                    } else {
                        if (cin < 48) {
#pragma unroll
                            for (int e = 0; e < 4; ++e) { GATE[(size_t)row * 48 + cin + e] = 1.0f / (1.0f + __expf(-(v0[e] + bgate[cin + e]))); GATE[(size_t)row * 48 + cin + 4 + e] = 1.0f / (1.0f + __expf(-(v1[e] + bgate[cin + 4 + e]))); }
                        }
                    }
                }
            }
        }
    }
};

struct EpiCmp {
    static constexpr bool PERM = false, AFTER_DRAIN = false;
    float* P;
    __device__ __forceinline__ void operator()(const f32x4 (&acc)[2][2][4][2], const Unit& u, int wr, int wc, int fr, int fq) const {
        float* base = P + (size_t)u.pn * CMP_ROWS * 256;
#pragma unroll
        for (int ai = 0; ai < 2; ++ai)
#pragma unroll
            for (int m = 0; m < 4; ++m) {
                const int row = u.pm * BM + ai * HALF + wr * 64 + m * 16 + fr;
#pragma unroll
                for (int bj = 0; bj < 2; ++bj)
#pragma unroll
                    for (int n = 0; n < 2; ++n) *(f32x4*)(base + (size_t)row * 256 + bj * HALF + wc * 32 + n * 16 + 4 * fq) = acc[ai][bj][m][n];
            }
    }
};

template <class Epi, class Sched, bool ALIGN_EPI = false, bool SP2 = false>
__device__ __forceinline__ void gemm_phase(PG8_LAS unsigned char* lds, const Gemm g, const Sched& S, const Epi& E) {
    const int tid = threadIdx.x, wid = __builtin_amdgcn_readfirstlane(tid >> 6), lane = tid & 63, wr = wid >> 2, wc = wid & 3, fr = lane & 15, fq = lane >> 4;
    const int K = g.K, nt = K / BK;
    unsigned voffA[2], voffB[2];
#pragma unroll
    for (int i = 0; i < 2; ++i) { int R, C; stage_rc(tid * 16 + i * 8192, R, C); const int Rb = Epi::PERM ? ((R & ~31) + perm32(R & 31)) : R;
        voffA[i] = (unsigned)(R * g.lda + C) * 2u; voffB[i] = (unsigned)(Rb * g.ldb + C) * 2u; }
    const size_t kstep = (size_t)(BK * 2);
    const size_t hstepA = (size_t)HALF * g.lda * 2, hstepB = (size_t)HALF * g.ldb * 2;
    const size_t tstepA = 2 * hstepA, tstepB = 2 * hstepB;
    const unsigned ldsw = (unsigned)wid * 1024u;
    const int aoff = lds_byte(wr * 64 + fr, fq * 8), boff = lds_byte(wc * 32 + fr, fq * 8);
#define PG8_SA(b, h) (((b) * 2 + (h)) * HTB)
#define PG8_SB(b, h) ((4 + (b) * 2 + (h)) * HTB)
#define PG8_STAGE(bufoff, gbase, voff) do { _Pragma("unroll") for (int _i = 0; _i < 2; ++_i) \
        __builtin_amdgcn_global_load_lds((const unsigned*)((const char*)(gbase) + (voff)[_i]), (PG8_LAS unsigned*)(lds + (bufoff) + ldsw + _i * 8192), 16, 0, 0); } while (0)
#define PG8_LDA(dst, b, h) do { _Pragma("unroll") for (int m = 0; m < 4; ++m) _Pragma("unroll") for (int k = 0; k < 2; ++k) dst[m][k] = *(const PG8_LAS bf16x8*)(lds + PG8_SA(b, h) + aoff + m * 2048 + k * 1024); } while (0)
#define PG8_LDB(dst, b, h) do { _Pragma("unroll") for (int n = 0; n < 2; ++n) _Pragma("unroll") for (int k = 0; k < 2; ++k) dst[n][k] = *(const PG8_LAS bf16x8*)(lds + PG8_SB(b, h) + boff + n * 2048 + k * 1024); } while (0)
#define PG8_MMA(ai, bj, At, Bt) do { __builtin_amdgcn_s_setprio(1); _Pragma("unroll") for (int m = 0; m < 4; ++m) _Pragma("unroll") for (int n = 0; n < 2; ++n) _Pragma("unroll") for (int k = 0; k < 2; ++k) \
        acc[ai][bj][m][n] = __builtin_amdgcn_mfma_f32_16x16x32_bf16(Bt[n][k], At[m][k], acc[ai][bj][m][n], 0, 0, 0); __builtin_amdgcn_s_setprio(0); } while (0)
#define PG8_WAIT_V(n) asm volatile("s_waitcnt vmcnt(" #n ")" ::: "memory")
#define PG8_WAIT_L(n) asm volatile("s_waitcnt lgkmcnt(" #n ")" ::: "memory")
#define PG8_BAR __builtin_amdgcn_s_barrier()
#define PG8_SCHED __builtin_amdgcn_sched_barrier(0)
    Unit cur, nxt; int ui = 0;
    if (!S.next(0, cur)) return;
    f32x4 acc[2][2][4][2];
#pragma unroll
    for (int a = 0; a < 2; ++a)
#pragma unroll
        for (int b = 0; b < 2; ++b)
#pragma unroll
            for (int m = 0; m < 4; ++m)
#pragma unroll
                for (int n = 0; n < 2; ++n) acc[a][b][m][n] = (f32x4){0.f, 0.f, 0.f, 0.f};
    bf16x8 At[4][2], B0[2][2], B1[2][2];
    const char* cA = (const char*)g.A + (size_t)cur.pm * tstepA + (size_t)cur.pn * g.a_pn_off; const char* cB = (const char*)g.Bt + (size_t)cur.pn * tstepB;
    S.a_ready(cur);
    if constexpr (SP2) {
        PG8_STAGE(PG8_SB(0, 0), cB, voffB); PG8_STAGE(PG8_SB(0, 1), cB + hstepB, voffB); PG8_STAGE(PG8_SA(0, 0), cA, voffA); PG8_STAGE(PG8_SA(0, 1), cA + hstepA, voffA);
        if (wr == 1) PG8_BAR;
        PG8_WAIT_V(2); PG8_BAR;
        PG8_STAGE(PG8_SB(1, 0), cB + kstep, voffB); PG8_STAGE(PG8_SA(1, 0), cA + kstep, voffA); PG8_STAGE(PG8_SB(1, 1), cB + hstepB + kstep, voffB);
        PG8_WAIT_V(6); PG8_BAR;
    } else {
        PG8_STAGE(PG8_SB(0, 0), cB, voffB); PG8_STAGE(PG8_SA(0, 0), cA, voffA); PG8_STAGE(PG8_SB(0, 1), cB + hstepB, voffB); PG8_STAGE(PG8_SA(0, 1), cA + hstepA, voffA);
        if (wr == 1) PG8_BAR;
        PG8_WAIT_V(4); PG8_BAR;
        PG8_STAGE(PG8_SB(1, 0), cB + kstep, voffB); PG8_STAGE(PG8_SA(1, 0), cA + kstep, voffA); PG8_STAGE(PG8_SB(1, 1), cB + hstepB + kstep, voffB);
        PG8_WAIT_V(6); PG8_BAR;
    }
    for (;;) {
        const bool has_next = S.next(ui + 1, nxt);
        const char* nA = has_next ? (const char*)g.A + (size_t)nxt.pm * tstepA + (size_t)nxt.pn * g.a_pn_off : cA; const char* nB = has_next ? (const char*)g.Bt + (size_t)nxt.pn * tstepB : cB;
        for (int t = 0; t < nt; t += 2) {
            const bool last = (t == nt - 2);
            const char* a1 = cA + (size_t)(t + 1) * kstep;
            const char* a2 = last ? nA : cA + (size_t)(t + 2) * kstep; const char* b2 = last ? nB : cB + (size_t)(t + 2) * kstep;
            const char* a3 = a2 + kstep; const char* b3 = b2 + kstep;
            if (last && has_next) S.a_ready(nxt);
            if constexpr (SP2) {
            PG8_LDB(B0, 0, 0); PG8_LDB(B1, 0, 1); PG8_SCHED; PG8_LDA(At, 0, 0); PG8_STAGE(PG8_SA(1, 1), a1 + hstepA, voffA);
            PG8_WAIT_V(8); PG8_WAIT_L(0); PG8_BAR; PG8_MMA(0, 0, At, B0); PG8_MMA(0, 1, At, B1); PG8_BAR; PG8_SCHED;
            PG8_LDA(At, 0, 1); PG8_STAGE(PG8_SB(0, 0), b2, voffB); PG8_STAGE(PG8_SB(0, 1), b2 + hstepB, voffB); PG8_STAGE(PG8_SA(0, 0), a2, voffA);
            PG8_WAIT_V(8); PG8_WAIT_L(0); PG8_BAR; PG8_MMA(1, 0, At, B0); PG8_MMA(1, 1, At, B1); PG8_BAR; PG8_SCHED;
            PG8_LDB(B0, 1, 0); PG8_LDB(B1, 1, 1); PG8_SCHED; PG8_LDA(At, 1, 0); PG8_STAGE(PG8_SA(0, 1), a2 + hstepA, voffA);
            PG8_WAIT_V(8); PG8_WAIT_L(0); PG8_BAR; PG8_MMA(0, 0, At, B0); PG8_MMA(0, 1, At, B1); PG8_BAR; PG8_SCHED;
            PG8_LDA(At, 1, 1); PG8_STAGE(PG8_SB(1, 0), b3, voffB); PG8_STAGE(PG8_SB(1, 1), b3 + hstepB, voffB); PG8_STAGE(PG8_SA(1, 0), a3, voffA);
            PG8_WAIT_V(8); PG8_WAIT_L(0); PG8_BAR; PG8_MMA(1, 0, At, B0); PG8_MMA(1, 1, At, B1); PG8_BAR; PG8_SCHED;
            } else {
            PG8_LDB(B0, 0, 0); PG8_SCHED; PG8_LDA(At, 0, 0); PG8_STAGE(PG8_SA(1, 1), a1 + hstepA, voffA);
            PG8_WAIT_L(8); PG8_BAR; PG8_WAIT_L(0); PG8_MMA(0, 0, At, B0); PG8_BAR; PG8_SCHED;
            PG8_LDB(B1, 0, 1); PG8_STAGE(PG8_SB(0, 0), b2, voffB);
            PG8_BAR; PG8_WAIT_L(0); PG8_MMA(0, 1, At, B1); PG8_BAR;
            PG8_LDA(At, 0, 1); PG8_STAGE(PG8_SA(0, 0), a2, voffA);
            PG8_BAR; PG8_WAIT_L(0); PG8_MMA(1, 0, At, B0); PG8_BAR; PG8_SCHED;
            PG8_STAGE(PG8_SB(0, 1), b2 + hstepB, voffB);
            PG8_WAIT_V(6); PG8_BAR; PG8_MMA(1, 1, At, B1); PG8_BAR;
            PG8_LDB(B0, 1, 0); PG8_SCHED; PG8_LDA(At, 1, 0); PG8_STAGE(PG8_SA(0, 1), a2 + hstepA, voffA);
            PG8_WAIT_L(8); PG8_BAR; PG8_WAIT_L(0); PG8_MMA(0, 0, At, B0); PG8_BAR; PG8_SCHED;
            PG8_LDB(B1, 1, 1); PG8_STAGE(PG8_SB(1, 0), b3, voffB);
            PG8_BAR; PG8_WAIT_L(0); PG8_MMA(0, 1, At, B1); PG8_BAR;
            PG8_LDA(At, 1, 1); PG8_STAGE(PG8_SA(1, 0), a3, voffA);
            PG8_BAR; PG8_WAIT_L(0); PG8_MMA(1, 0, At, B0); PG8_BAR; PG8_SCHED;
            PG8_STAGE(PG8_SB(1, 1), b3 + hstepB, voffB);
            PG8_WAIT_V(6); PG8_BAR; PG8_MMA(1, 1, At, B1); PG8_BAR;
            }
        }
        if constexpr (ALIGN_EPI) { if (wr == 0) PG8_BAR; }
        if constexpr (!Epi::AFTER_DRAIN) { E(acc, cur, wr, wc, fr, fq); S.done(cur); }
        if (!has_next) break;
#pragma unroll
        for (int a = 0; a < 2; ++a)
#pragma unroll
            for (int b = 0; b < 2; ++b)
#pragma unroll
                for (int m = 0; m < 4; ++m)
#pragma unroll
                    for (int n = 0; n < 2; ++n) acc[a][b][m][n] = (f32x4){0.f, 0.f, 0.f, 0.f};
        cur = nxt; cA = nA; cB = nB; ++ui;
        if constexpr (ALIGN_EPI) { if (wr == 1) PG8_BAR; }
    }
    PG8_WAIT_V(0);
    if constexpr (!ALIGN_EPI) { if (wr == 0) PG8_BAR; }
    PG8_BAR;
    if constexpr (Epi::AFTER_DRAIN) { E.fused(acc, cur, wr, wc, fr, fq, lds, wid, lane); S.done(cur); }
#undef PG8_SA
#undef PG8_SB
#undef PG8_STAGE
#undef PG8_LDA
#undef PG8_LDB
#undef PG8_MMA
#undef PG8_WAIT_V
#undef PG8_WAIT_L
#undef PG8_BAR
#undef PG8_SCHED
}
}

#define GAS __attribute__((address_space(1)))
#define LAS __attribute__((address_space(3)))
typedef unsigned short bf16;
typedef unsigned v4u __attribute__((ext_vector_type(4)));
typedef unsigned v2u __attribute__((ext_vector_type(2)));
typedef float f32x4 __attribute__((ext_vector_type(4)));
typedef float f32x2 __attribute__((ext_vector_type(2)));
typedef float f32x16 __attribute__((ext_vector_type(16)));
typedef short bf16x8 __attribute__((ext_vector_type(8)));
typedef short v4i16_t __attribute__((ext_vector_type(4)));
typedef GAS unsigned gu32;
typedef GAS unsigned long long gu64;
#define RLX_AGENT __ATOMIC_RELAXED, __HIP_MEMORY_SCOPE_AGENT
#define LDS_WAIT() asm volatile("s_waitcnt lgkmcnt(0)" ::: "memory")
#define VM_WAIT() asm volatile("s_waitcnt vmcnt(0)" ::: "memory")
__device__ __forceinline__ unsigned f2bf(float f) { unsigned u = __builtin_bit_cast(unsigned, f); return (u + 0x7fffu + ((u >> 16) & 1u)) >> 16; }
__device__ __forceinline__ unsigned pk2(float lo, float hi) { return f2bf(lo) | (f2bf(hi) << 16); }
__device__ __forceinline__ float bf2f(unsigned short h) { return __builtin_bit_cast(float, (unsigned)h << 16); }

#define XB_TMO      128
#define XB_XCNT(j)  (256  + 64 * (j))
#define XB_XSUB(j)  (1280 + 64 * (j))
#define XB_XGEN(j)  (2304 + 64 * (j))
#define XB_TOP      3328
#define XB_TOPGEN   3392
#define XCD_BAR_WORDS 3456
#define XB_SPIN_CAP (1u << 18)

__device__ __forceinline__ unsigned xb_ld(unsigned* p)              { return __hip_atomic_load(p, __ATOMIC_RELAXED, __HIP_MEMORY_SCOPE_AGENT); }
__device__ __forceinline__ unsigned xb_add(unsigned* p, unsigned v) { return __hip_atomic_fetch_add(p, v, __ATOMIC_RELAXED, __HIP_MEMORY_SCOPE_AGENT); }
__device__ __forceinline__ unsigned xb_xcc_id() { return (unsigned)__builtin_amdgcn_s_getreg((3 << 11) | 20) & 0xFu; }
#define XB_SPIN(cond, bar) do { unsigned _sp = 0; while (cond) { __builtin_amdgcn_s_sleep(1); \
    if ((++_sp & 255u) == 0u) { if (xb_ld(&(bar)[XB_TMO])) break; if (_sp > XB_SPIN_CAP) { atomicAdd(&(bar)[XB_TMO], 1u); break; } } } } while (0)

struct XcdBarrier {
    unsigned* bar; unsigned x;
    volatile LAS unsigned* st;
};

__device__ __forceinline__ XcdBarrier xcd_barrier_post(unsigned* bar, volatile LAS unsigned* st) {
    XcdBarrier b; b.bar = bar; b.x = xb_xcc_id(); b.st = st;
    if (threadIdx.x == 0) (void)xb_add(&bar[XB_XCNT(b.x)], 1u);
    return b;
}
__device__ __forceinline__ void xcd_barrier_complete(unsigned* bar, unsigned x, unsigned& nloc, unsigned& nx) {
    const unsigned G = gridDim.x * gridDim.y * gridDim.z;
    unsigned sum, cnt, mine, sp = 0u;
    for (;;) {
        sum = 0u; cnt = 0u; mine = 0u;
#pragma unroll
        for (unsigned j = 0; j < 16; ++j) { const unsigned c = xb_ld(&bar[XB_XCNT(j)]); sum += c; cnt += (c > 0u) ? 1u : 0u; mine = (j == x) ? c : mine; }
        if (sum == G) break;
        __builtin_amdgcn_s_sleep(1);
        if ((++sp & 255u) == 0u) { if (xb_ld(&bar[XB_TMO])) break; if (sp > XB_SPIN_CAP) { atomicAdd(&bar[XB_TMO], 1u); break; } }
    }
    nloc = mine > 0u ? mine : 1u; nx = cnt > 0u ? cnt : 1u;
}

__device__ __forceinline__ void xcd_barrier(const XcdBarrier& b) {
    asm volatile("s_waitcnt vmcnt(0)" ::: "memory");
    __syncthreads();
    if (threadIdx.x == 0) {
        unsigned* bar = b.bar;
        __builtin_amdgcn_s_waitcnt(0);
        unsigned nloc = b.st[0], nx = b.st[1];
        if (nloc == 0u) { xcd_barrier_complete(bar, b.x, nloc, nx); b.st[0] = nloc; b.st[1] = nx; }
        const unsigned old = xb_add(&bar[XB_XSUB(b.x)], 1u);
        const unsigned gen = old / nloc;
        if (old + 1u == (gen + 1u) * nloc) {
            __builtin_amdgcn_fence(__ATOMIC_RELEASE, "agent");
            asm volatile("s_waitcnt vmcnt(0)" ::: "memory");
            const unsigned og = xb_add(&bar[XB_TOP], 1u);
            const unsigned tg = og / nx;
            if (og + 1u == (tg + 1u) * nx) xb_add(&bar[XB_TOPGEN], 1u);
            else XB_SPIN(xb_ld(&bar[XB_TOPGEN]) == tg, bar);
            __builtin_amdgcn_fence(__ATOMIC_ACQUIRE, "agent");
            xb_add(&bar[XB_XGEN(b.x)], 1u);
            asm volatile("s_waitcnt vmcnt(0)" ::: "memory");
        } else {
            XB_SPIN(xb_ld(&bar[XB_XGEN(b.x)]) == gen, bar);
            __builtin_amdgcn_fence(__ATOMIC_ACQUIRE, "agent");
            asm volatile("s_waitcnt vmcnt(0)" ::: "memory");
        }
    }
    __syncthreads();
}

constexpr size_t MiB = 1u << 20;
constexpr size_t WS_CTL = 0, CTL_ZERO_BYTES = 1 * MiB;
constexpr size_t WS_WUP = 2 * MiB;
constexpr size_t WS_WDN = 18 * MiB;
constexpr size_t WS_WKVQG = 34 * MiB;
constexpr size_t WS_WO = 40 * MiB;
constexpr size_t WS_WPOOL = 42 * MiB;
constexpr size_t WS_W1CAT = 43 * MiB;
constexpr size_t WS_CBIAS = 128 * 1024;
constexpr size_t WS_RS = 45 * MiB;
constexpr size_t WS_GATE = 47 * MiB;
constexpr size_t WS_X = 52 * MiB;
constexpr size_t WS_XB = 118 * MiB;
constexpr size_t WS_DIFF = 152 * MiB;
constexpr size_t WS_Q = 186 * MiB;
constexpr size_t WS_KVS = 220 * MiB;
constexpr size_t WS_KVW = 238 * MiB;
constexpr size_t WS_KC = 256 * MiB;
constexpr size_t WS_KCS = 258 * MiB;
constexpr size_t WS_H = 292 * MiB;
constexpr size_t WS_CMPA = 424 * MiB;
constexpr size_t WS_CMPP = 700 * MiB;
constexpr size_t WS_END = 840 * MiB;
constexpr int CW_BAR = 4096;

constexpr size_t OUT_Y_P = 0, OUT_Y_S = 16777216, OUT_POOL_P = 16908288, OUT_POOL_S = 16969728, OUT_KV_P = 18935808, OUT_KV_S = 35713024, OUT_WIN_P = 35844096, OUT_WIN_S = 36892672, OUT_TOTAL = 70447104;

#ifndef PROBE_DUP
#define PROBE_DUP 0
#endif
#define REP(k) (1 + ((PROBE_DUP >> (k)) & 1))
constexpr int NWAVES = 8;
constexpr int RING_BYTES = 131072, MISC_OFF = RING_BYTES + 320, LDS_BYTES = 147456;

#ifndef PROBE_SEG
#define PROBE_SEG -1
#endif
#define SEG_BEGIN(id) do { if (PROBE_SEG == (id)) F.seg_t0 = __builtin_amdgcn_s_memrealtime(); } while (0)
#define SEG_END(id) do { if (PROBE_SEG == (id)) F.seg_dt += __builtin_amdgcn_s_memrealtime() - F.seg_t0; } while (0)
struct Frame {
    unsigned long long seg_t0, seg_dt;
    LAS unsigned char* lds;
    int tid, lane, wave, vcu, G;
    const float *x_p, *x_s, *state_pool, *cache, *state_win; const int* page_table;
    const float *norm_mix, *norm_mlp, *w_up, *w_down, *pool_w, *pool_scale, *norm_kv, *w_kv, *cmp_pe, *cmp_w1, *cmp_w2, *w_qg, *b_gate, *w_o, *norm_final;
    float* out; unsigned char* ws;
};
#define WSP(T, off) ((T*)(F.ws + (off)))

__device__ __forceinline__ unsigned cvtpk(float lo, float hi) { typedef __bf16 bf16x2_t __attribute__((ext_vector_type(2))); f32x2 v = {lo, hi}; bf16x2_t b = __builtin_convertvector(v, bf16x2_t); return __builtin_bit_cast(unsigned, b); }
__device__ __forceinline__ bf16x8 cvt8(const f32x4 a, const f32x4 b) { v4u w; w.x = cvtpk(a[0], a[1]); w.y = cvtpk(a[2], a[3]); w.z = cvtpk(b[0], b[1]); w.w = cvtpk(b[2], b[3]); return __builtin_bit_cast(bf16x8, w); }
__device__ __forceinline__ float wave_sum(float v) {
#pragma unroll
    for (int o = 1; o < 64; o <<= 1) v += __shfl_xor(v, o);
    return v;
}
__device__ __forceinline__ float wave_max(float v) {
#pragma unroll
    for (int o = 1; o < 64; o <<= 1) v = fmaxf(v, __shfl_xor(v, o));
    return v;
}

struct TItem { const float* W; bf16* WT; const float* kscale; int N, ldt, row_off, kb, nb; float scale; };
constexpr int TP = 260;
__device__ __forceinline__ void ti_load(const TItem& t, f32x4 (&wv)[8], int tid) {
    const int k0 = 64 * t.kb, col = 256 * t.nb + 4 * (tid & 63);
#pragma unroll
    for (int e = 0; e < 8; ++e) wv[e] = (col < t.N) ? *(const f32x4*)(t.W + (size_t)(k0 + (tid >> 6) + 8 * e) * t.N + col) : (f32x4){0.f, 0.f, 0.f, 0.f};
}
__device__ __forceinline__ void ti_stage(const f32x4 (&wv)[8], LAS float* T, int tid) {
#pragma unroll
    for (int e = 0; e < 8; ++e) *(LAS f32x4*)(T + ((tid >> 6) + 8 * e) * TP + 4 * (tid & 63)) = wv[e];
}
__device__ __forceinline__ void ti_write(const TItem& t, const LAS float* T, int tid) {
    const int n = tid >> 1, kh = 32 * (tid & 1), k0 = 64 * t.kb;
    float ks[32];
#pragma unroll
    for (int i = 0; i < 8; ++i) { const f32x4 q = t.kscale ? *(const f32x4*)(t.kscale + k0 + kh + 4 * i) : (f32x4){1.f, 1.f, 1.f, 1.f}; ks[4 * i] = q[0] * t.scale; ks[4 * i + 1] = q[1] * t.scale; ks[4 * i + 2] = q[2] * t.scale; ks[4 * i + 3] = q[3] * t.scale; }
    const LAS float* c = T + kh * TP + n;
    if (256 * t.nb + n < t.N) {
        bf16* dst = t.WT + (size_t)(t.row_off + 256 * t.nb + n) * t.ldt + k0 + kh;
#pragma unroll
        for (int j = 0; j < 4; ++j) { v4u o;
            o.x = pk2(c[(8 * j + 0) * TP] * ks[8 * j + 0], c[(8 * j + 1) * TP] * ks[8 * j + 1]); o.y = pk2(c[(8 * j + 2) * TP] * ks[8 * j + 2], c[(8 * j + 3) * TP] * ks[8 * j + 3]);
            o.z = pk2(c[(8 * j + 4) * TP] * ks[8 * j + 4], c[(8 * j + 5) * TP] * ks[8 * j + 5]); o.w = pk2(c[(8 * j + 6) * TP] * ks[8 * j + 6], c[(8 * j + 7) * TP] * ks[8 * j + 7]);
            *(v4u*)(dst + 8 * j) = o; }
    }
}

__device__ __forceinline__ void p0_prologue(Frame& F) {
    const int gw = F.vcu * NWAVES + F.wave, NGW = F.G * NWAVES, lane = F.lane;
    bf16* WUP = WSP(bf16, WS_WUP); bf16* WDN = WSP(bf16, WS_WDN); bf16* WKVQG = WSP(bf16, WS_WKVQG); bf16* WO = WSP(bf16, WS_WO); bf16* WPOOL = WSP(bf16, WS_WPOOL); bf16* W1CAT = WSP(bf16, WS_W1CAT);
    SEG_BEGIN(40);
    constexpr int I_UP = 256, I_DN = 256, I_KV = 96, I_QG = 80, I_WO = 64, I_PL = 4, I_C1 = 16;
    constexpr int NITEMS = 2 * I_UP + 2 * I_DN + I_KV + I_QG + I_WO + 4 * I_PL + 4 * I_C1;
    auto decode = [&](int it) -> TItem {
        int r = it; TItem t;
        if (r < 2 * I_UP) { const int l = r / I_UP; r %= I_UP; t = TItem{F.w_up + (size_t)l * D * FF, WUP + (size_t)l * FF * D, F.norm_mlp + l * D, FF, D, 0, r / 16, r % 16, 1.f}; return t; } r -= 2 * I_UP;
        if (r < 2 * I_DN) { const int l = r / I_DN; r %= I_DN; t = TItem{F.w_down + (size_t)l * FF * D, WDN + (size_t)l * D * FF, nullptr, D, FF, 0, r / 4, r % 4, 1.f}; return t; } r -= 2 * I_DN;
        if (r < I_KV) { t = TItem{F.w_kv, WKVQG, F.norm_kv, 1536, D, 0, r / 6, r % 6, 1.f}; return t; } r -= I_KV;
        if (r < I_QG) { const int nb = r % 5; t = TItem{F.w_qg, WKVQG, F.norm_mix + D, 1072, D, 1536, r / 5, nb, nb < 4 ? QSCALE : 1.f}; return t; } r -= I_QG;
        if (r < I_WO) { t = TItem{F.w_o, WO, nullptr, D, D, 0, r / 4, r % 4, 1.f}; return t; } r -= I_WO;
        if (r < 4 * I_PL) { const int g = r / I_PL; r %= I_PL; t = TItem{F.pool_w + (size_t)g * 65536, WPOOL + (size_t)g * 65536, nullptr, 256, 256, 0, r, 0, 1.f}; return t; } r -= 4 * I_PL;
        { const int kvh = r / I_C1; r %= I_C1; const int kv = kvh >> 1, half = kvh & 1;
          t = TItem{F.cmp_w1 + (size_t)kv * 2048 * 128 + (size_t)half * 1024 * 128, W1CAT + (size_t)kv * 256 * D, nullptr, 128, D, half * 128, r, 0, 1.f}; return t; }
    };
    {
        LAS float* T = (LAS float*)F.lds; f32x4 wv[8];
        int it = F.vcu; TItem tc;
        if (it < NITEMS) { tc = decode(it); ti_load(tc, wv, F.tid); }
        while (it < NITEMS) {
            ti_stage(wv, T, F.tid);
            __syncthreads();
            const int i2 = it + F.G; TItem tn = tc; if (i2 < NITEMS) { tn = decode(i2); ti_load(tn, wv, F.tid); }
            ti_write(tc, T, F.tid);
            __syncthreads();
            tc = tn; it = i2;
        }
    }
    { const int gt = F.vcu * 512 + F.tid, NT = F.G * 512; v4u* z = (v4u*)(WKVQG + (size_t)2608 * D);
      for (int i = gt; i < 208 * D / 8; i += NT) z[i] = (v4u){0u, 0u, 0u, 0u}; }
    { float* CB = WSP(float, WS_CBIAS);
      const int cb0 = (NGW >= 1024) ? 512 : 0;
      for (int it = gw - cb0; it >= 0 && it < 64; it += NGW) { const int kv = it >> 5, kc0 = (it & 31) * 64; float a0 = 0.f, a1 = 0.f;
#pragma unroll 16
          for (int k = 0; k < 64; ++k) { const float p = F.cmp_pe[kv * 2048 + kc0 + k]; const float* wr = F.cmp_w1 + ((size_t)kv * 2048 + kc0 + k) * 128; a0 += p * wr[lane]; a1 += p * wr[64 + lane]; }
          unsafeAtomicAdd(CB + kv * 128 + lane, a0); unsafeAtomicAdd(CB + kv * 128 + 64 + lane, a1); } }
    SEG_END(40); SEG_BEGIN(41);
    bf16* DIFF = WSP(bf16, WS_DIFF);
    if (F.wave == 0)
    for (int b = F.G - 1 - F.vcu; b < DB; b += F.G) {
        const f32x4* xr = (const f32x4*)(F.x_s + (size_t)b * D) + lane; f32x4 v[4]; float ss = 0.f;
#pragma unroll
        for (int j = 0; j < 4; ++j) { v[j] = xr[64 * j]; ss += (v[j][0] * v[j][0] + v[j][1] * v[j][1]) + (v[j][2] * v[j][2] + v[j][3] * v[j][3]); }
        const float rstd = 1.0f / sqrtf(wave_sum(ss) * (1.0f / D) + RMS_EPS);
        const float* sp = F.state_pool + (size_t)b * 15 * D; float* ps = F.out + OUT_POOL_S + (size_t)b * 15 * D;
#pragma unroll
        for (int j = 0; j < 4; ++j) {
            const int col = 256 * j + 4 * lane; const f32x4 gg = *(const f32x4*)(F.norm_mix + col); const f32x4 u = v[j] * rstd * gg;
            f32x4 st[15];
#pragma unroll
            for (int r = 0; r < 15; ++r) st[r] = *(const f32x4*)(sp + (size_t)r * D + col);
            f32x4 sum = u; const int w = 2 << j;
#pragma unroll
            for (int r = 0; r < 15; ++r) if (r < w - 1) sum += st[14 - r];
            const f32x4 df = sum * (1.0f / (float)w) - u;
            v2u o; o.x = pk2(df[0], df[1]); o.y = pk2(df[2], df[3]); *(v2u*)(DIFF + (size_t)(MP + b) * D + col) = o;
            *(f32x4*)(ps + (size_t)14 * D + col) = u;
#pragma unroll
            for (int r = 0; r < 14; ++r) *(f32x4*)(ps + (size_t)r * D + col) = st[r + 1];
        }
    }
    SEG_END(41);
    if (F.G != 256) { const size_t gt = (size_t)F.vcu * 512 + F.tid, NT = (size_t)F.G * 512; const f32x4* src = (const f32x4*)F.state_win; f32x4* dst = (f32x4*)(F.out + OUT_WIN_S);
      for (int rep = 0; rep < REP(19); ++rep)
      for (size_t e = gt; e < (size_t)DB * 511 * 128; e += NT) { const size_t b = e / (511 * 128), rem = e - b * (511 * 128); dst[b * 65536 + rem] = src[b * 65536 + rem + 128]; } }
    __syncthreads();
    LAS float* U = (LAS float*)F.lds;
    SEG_BEGIN(42);
    for (int rep = 0; rep < REP(20); ++rep)
    for (int task = F.vcu; task < MP / 64; task += F.G) {
        const int b = task >> 6, t0 = (task & 63) * 64;
        const float* xb = F.x_p + (size_t)b * SEQ * D;
        f32x4 gmix[4];
#pragma unroll
        for (int j = 0; j < 4; ++j) gmix[j] = *(const f32x4*)(F.norm_mix + 256 * j + 4 * lane);
        f32x4 ra[4], rb2[4];
#define DF_LOAD(T) do { const int ta_ = (T) + 2 * F.wave, tb_ = ta_ + 1; _Pragma("unroll") for (int j = 0; j < 4; ++j) { \
            ra[j] = (ta_ >= 0) ? *((const f32x4*)(xb + (size_t)ta_ * D) + lane + 64 * j) : (f32x4){0.f, 0.f, 0.f, 0.f}; rb2[j] = (tb_ >= 0) ? *((const f32x4*)(xb + (size_t)tb_ * D) + lane + 64 * j) : (f32x4){0.f, 0.f, 0.f, 0.f}; } } while (0)
#define DF_STORE1(rr, tt_) do { float ss = 0.f; _Pragma("unroll") for (int j = 0; j < 4; ++j) ss += (rr[j][0] * rr[j][0] + rr[j][1] * rr[j][1]) + (rr[j][2] * rr[j][2] + rr[j][3] * rr[j][3]); \
            const float rstd = 1.0f / sqrtf(wave_sum(ss) * (1.0f / D) + RMS_EPS); \
            _Pragma("unroll") for (int j = 0; j < 4; ++j) { const f32x4 u = rr[j] * rstd * gmix[j]; *(LAS f32x4*)(U + ((tt_) & 31) * 1024 + 256 * j + 4 * lane) = u; \
                if ((tt_) >= SEQ - 15) *(f32x4*)(F.out + OUT_POOL_P + ((size_t)b * 15 + ((tt_) - (SEQ - 15))) * D + 256 * j + 4 * lane) = u; } } while (0)
#define DF_STORE(T) do { const int ta_ = (T) + 2 * F.wave; DF_STORE1(ra, ta_); DF_STORE1(rb2, ta_ + 1); } while (0)
        DF_LOAD(t0 - 16); DF_STORE(t0 - 16);
        DF_LOAD(t0);
        const int c = 2 * F.tid, w = 2 << (F.tid >> 7);
        f32x2 S = (f32x2){0.f, 0.f};
        for (int sub = 0; sub < 4; ++sub) {
            const int T = t0 + 16 * sub;
            DF_STORE(T);
            __syncthreads();
            if (sub < 3) DF_LOAD(T + 16);
            if (sub == 0) { for (int j = 1; j < w; ++j) S += *(const LAS f32x2*)(U + ((T - j) & 31) * 1024 + c); }
            for (int tt = 0; tt < 16; ++tt) { const int t = T + tt; const int cnt = (t + 1 < w) ? (t + 1) : w;
                const f32x2 cur = *(const LAS f32x2*)(U + (t & 31) * 1024 + c);
                S += cur; const float inv = 1.0f / (float)cnt;
                *(unsigned*)(DIFF + ((size_t)b * SEQ + t) * D + c) = pk2(S[0] * inv - cur[0], S[1] * inv - cur[1]);
                S -= *(const LAS f32x2*)(U + ((t - w + 1) & 31) * 1024 + c); }
            __syncthreads();
        }
#undef DF_LOAD
#undef DF_STORE1
#undef DF_STORE
    }
    SEG_END(42);
}

constexpr int KSTR = 144;
constexpr int SC_ACT = 0, SC_W = 128 * KSTR, SC_BUF = SC_W + 256 * KSTR, SC_UNIT = 2 * SC_BUF, CW_QUEUE = 8192;
static_assert(SC_UNIT + 64 <= RING_BYTES, "sample compress LDS");
__device__ __forceinline__ void p5_sample_compress(Frame& F, unsigned* qctr, int quota) {
    LAS int* UNIT = (LAS int*)(F.lds + SC_UNIT);
    const int tid = F.tid, lane = F.lane, w = F.wave, r = lane & 31, h = lane >> 5, rb = w & 3, nh = w >> 2;
    float* P = WSP(float, WS_CMPP); const bf16* W1 = WSP(bf16, WS_W1CAT);
    for (int nu = 0; nu < quota; ++nu) {
        __syncthreads();
        if (tid == 0) UNIT[0] = (int)atomicAdd(qctr, 1u);
        __syncthreads();
        const int u = UNIT[0]; if (u >= DB * 8) break;
        const int b = u >> 3, jb = (u >> 1) & 3, kv = u & 1;
        size_t aoff[4]; const bf16* wsrc = W1 + ((size_t)kv * 256 + (tid >> 3)) * D + 8 * (tid & 7);
#pragma unroll
        for (int e = 0; e < 4; ++e) { const int j = 32 * jb + (tid >> 6) + 8 * e; const int page = F.page_table[b * 16 + (j >> 3)]; aoff[e] = ((size_t)page * 128 + (j & 7) * 16) * 1024 + kv * 256 + 4 * (tid & 63); }
        f32x4 av0[4], av1[4], av2[4], av3[4]; v4u wv0[4], wv1[4];
#define SC_LOADA(av, tt) do { _Pragma("unroll") for (int e = 0; e < 4; ++e) av[e] = *(const f32x4*)(F.cache + aoff[e] + (size_t)(tt) * 1024); } while (0)
#define SC_LOADW(wv, tt) do { _Pragma("unroll") for (int e = 0; e < 4; ++e) wv[e] = *(const v4u*)(wsrc + (size_t)e * 64 * D + 64 * (tt)); } while (0)
#define SC_STORE(av, wv, bf) do { _Pragma("unroll") for (int e = 0; e < 4; ++e) { v2u o; o.x = cvtpk(av[e][0], av[e][1]); o.y = cvtpk(av[e][2], av[e][3]); \
            *(LAS v2u*)(F.lds + (bf) * SC_BUF + SC_ACT + ((((tid >> 6) + 8 * e) << 2) + ((tid & 63) >> 4)) * KSTR + 8 * (tid & 15)) = o; *(LAS v4u*)(F.lds + (bf) * SC_BUF + SC_W + ((tid >> 3) + 64 * e) * KSTR + 16 * (tid & 7)) = wv[e]; } } while (0)
#define SC_COMPUTE(bf) do { const LAS unsigned char* At = F.lds + (bf) * SC_BUF + SC_ACT + (32 * rb + r) * KSTR + h * 16; const LAS unsigned char* Wt = F.lds + (bf) * SC_BUF + SC_W + (128 * nh + r) * KSTR + h * 16; \
            _Pragma("unroll") for (int ks = 0; ks < 4; ++ks) { bf16x8 afr_[4]; const bf16x8 bfr_ = *(const LAS bf16x8*)(At + ks * 32); \
                _Pragma("unroll") for (int nt = 0; nt < 4; ++nt) afr_[nt] = *(const LAS bf16x8*)(Wt + 32 * nt * KSTR + ks * 32); \
            __builtin_amdgcn_sched_barrier(0); \
                _Pragma("unroll") for (int nt = 0; nt < 4; ++nt) acc[nt] = __builtin_amdgcn_mfma_f32_32x32x16_bf16(afr_[nt], bfr_, acc[nt], 0, 0, 0); \
            __builtin_amdgcn_sched_barrier(0); } } while (0)
        f32x16 acc[4];
#pragma unroll
        for (int nt = 0; nt < 4; ++nt)
#pragma unroll
            for (int i = 0; i < 16; ++i) acc[nt][i] = 0.f;
#define SC_STEP(tt, aCur, wCur, aNext, wNext) do { \
            if ((tt) + 4 < 16) SC_LOADA(aCur, (tt) + 4);        \
            if ((tt) + 2 < 16) SC_LOADW(wCur, (tt) + 2); \
            __builtin_amdgcn_sched_barrier(0); \
            SC_COMPUTE((tt) & 1); \
            __builtin_amdgcn_sched_barrier(0); \
            if ((tt) + 1 < 16) SC_STORE(aNext, wNext, ((tt) + 1) & 1); \
            __syncthreads(); } while (0)
        SC_LOADA(av0, 0); SC_LOADW(wv0, 0); SC_LOADA(av1, 1); SC_LOADW(wv1, 1); SC_LOADA(av2, 2); SC_LOADA(av3, 3);
        SC_STORE(av0, wv0, 0); __syncthreads();
        for (int tt = 0; tt < 16; tt += 4) {
            SC_STEP(tt,     av0, wv0, av1, wv1);
            SC_STEP(tt + 1, av1, wv1, av2, wv0);
            SC_STEP(tt + 2, av2, wv0, av3, wv1);
            SC_STEP(tt + 3, av3, wv1, av0, wv0);
        }
#undef SC_STEP
#undef SC_LOADA
#undef SC_LOADW
#define SC_LOAD 0
#undef SC_COMPUTE
#undef SC_LOAD
#undef SC_STORE
        float* prow = P + (size_t)kv * CMP_ROWS * 256 + (size_t)(CMP_ROWS_P + (b * 128 + 32 * jb) * 4 + 32 * rb + r) * 256 + 128 * nh + 4 * h;
#pragma unroll
        for (int nt = 0; nt < 4; ++nt)
#pragma unroll
            for (int g4 = 0; g4 < 4; ++g4) *(f32x4*)(prow + 32 * nt + 8 * g4) = (f32x4){acc[nt][4 * g4], acc[nt][4 * g4 + 1], acc[nt][4 * g4 + 2], acc[nt][4 * g4 + 3]};
    }
}

__device__ __forceinline__ void p5_prompt_compress(Frame& F) {
    const int tid = F.tid, lane = F.lane, w = F.wave, r = lane & 31, h = lane >> 5, rb = w & 3, nh = w >> 2;
    float* P = WSP(float, WS_CMPP); const bf16* W1 = WSP(bf16, WS_W1CAT); const bf16* CA = WSP(bf16, WS_CMPA);
    for (int u = (int)blockIdx.x; u < 2 * CMP_ROWS_P / 128; u += F.G) {
        const int kv = u & 1, rblk = u >> 1;
        const bf16* asrc = CA + (size_t)kv * CMP_ROWS * D + (size_t)(rblk * 128 + (tid >> 3)) * D + 8 * (tid & 7);
        const bf16* wsrc = W1 + ((size_t)kv * 256 + (tid >> 3)) * D + 8 * (tid & 7);
        v4u aa[2], wv[4];
#define PC_LOAD(tt) do { _Pragma("unroll") for (int e = 0; e < 2; ++e) aa[e] = *(const v4u*)(asrc + (size_t)e * 64 * D + 64 * (tt)); _Pragma("unroll") for (int e = 0; e < 4; ++e) wv[e] = *(const v4u*)(wsrc + (size_t)e * 64 * D + 64 * (tt)); } while (0)
#define PC_STORE(bf) do { _Pragma("unroll") for (int e = 0; e < 2; ++e) *(LAS v4u*)(F.lds + (bf) * SC_BUF + SC_ACT + ((tid >> 3) + 64 * e) * KSTR + 16 * (tid & 7)) = aa[e]; \
            _Pragma("unroll") for (int e = 0; e < 4; ++e) *(LAS v4u*)(F.lds + (bf) * SC_BUF + SC_W + ((tid >> 3) + 64 * e) * KSTR + 16 * (tid & 7)) = wv[e]; } while (0)
        f32x16 acc[4];
#pragma unroll
        for (int nt = 0; nt < 4; ++nt)
#pragma unroll
            for (int i = 0; i < 16; ++i) acc[nt][i] = 0.f;
        __syncthreads();
        PC_LOAD(0); PC_STORE(0); __syncthreads();
        for (int tt = 0; tt < 16; ++tt) {
            const int bf = tt & 1;
            if (tt + 1 < 16) PC_LOAD(tt + 1);
            __builtin_amdgcn_sched_barrier(0);
            const LAS unsigned char* At = F.lds + bf * SC_BUF + SC_ACT + (32 * rb + r) * KSTR + h * 16; const LAS unsigned char* Wt = F.lds + bf * SC_BUF + SC_W + (128 * nh + r) * KSTR + h * 16;
            bf16x8 bfr_[4], afr_[4][4];
#pragma unroll
            for (int ks = 0; ks < 4; ++ks) { bfr_[ks] = *(const LAS bf16x8*)(At + ks * 32);
#pragma unroll
                for (int nt = 0; nt < 4; ++nt) afr_[ks][nt] = *(const LAS bf16x8*)(Wt + 32 * nt * KSTR + ks * 32); }
            __builtin_amdgcn_sched_barrier(0);
#pragma unroll
            for (int ks = 0; ks < 4; ++ks)
#pragma unroll
                for (int nt = 0; nt < 4; ++nt) acc[nt] = __builtin_amdgcn_mfma_f32_32x32x16_bf16(afr_[ks][nt], bfr_[ks], acc[nt], 0, 0, 0);
            __builtin_amdgcn_sched_barrier(0);
            if (tt + 1 < 16) PC_STORE(bf ^ 1);
            __syncthreads();
        }
#undef PC_LOAD
#undef PC_STORE
        float* prow = P + (size_t)kv * CMP_ROWS * 256 + (size_t)(rblk * 128 + 32 * rb + r) * 256 + 128 * nh + 4 * h;
#pragma unroll
        for (int nt = 0; nt < 4; ++nt)
#pragma unroll
            for (int g4 = 0; g4 < 4; ++g4) *(f32x4*)(prow + 32 * nt + 8 * g4) = (f32x4){acc[nt][4 * g4], acc[nt][4 * g4 + 1], acc[nt][4 * g4 + 2], acc[nt][4 * g4 + 3]};
    }
}

constexpr int W2T_STR = 136;
__device__ __forceinline__ void p6_combine(Frame& F, int part, int cu, int ncu) {
    LAS bf16* W2T = (LAS bf16*)F.lds;
    LAS float* CBL = (LAS float*)(F.lds + 2 * 64 * W2T_STR * 2);
    const float* P = WSP(float, WS_CMPP); bf16* KC = WSP(bf16, WS_KC); float* KCS = WSP(float, WS_KCS);
    for (int i = F.tid; i < 2 * 128 * 64; i += 512) { const int kv = i >> 13, k = (i >> 6) & 127, d = i & 63; W2T[(kv * 64 + d) * W2T_STR + k] = (bf16)f2bf(F.cmp_w2[i]); }
    if (F.tid < 256) CBL[F.tid] = WSP(float, WS_CBIAS)[F.tid];
    __syncthreads();
    const int lane = F.lane, ml = lane & 15, fq = lane >> 4;
    const int gw = cu * NWAVES + F.wave, NGW = ncu * NWAVES;
    constexpr int NT_P = CMP_ROWS_P / 16, NT_S = CMP_ROWS_S / 16;
    const bool prompt = part == 1; const int ntp = prompt ? NT_P : NT_S;
    f32x4 loA[4][2], hiA[4][2], loB[4][2], hiB[4][2];
#define CB_LOAD(lo_, hi_, task_) do { const int kv_ = (task_) / ntp, r0_ = ((task_) % ntp) * 16; const int prow_ = (prompt ? r0_ : CMP_ROWS_P + r0_) + ml; \
        const float* plo_ = P + (size_t)kv_ * CMP_ROWS * 256 + (size_t)prow_ * 256 + 8 * fq; const float* phi_ = plo_ + 4 * 256 + 128; \
        _Pragma("unroll") for (int ks = 0; ks < 4; ++ks) { lo_[ks][0] = *(const f32x4*)(plo_ + 32 * ks); lo_[ks][1] = *(const f32x4*)(plo_ + 32 * ks + 4); hi_[ks][0] = *(const f32x4*)(phi_ + 32 * ks); hi_[ks][1] = *(const f32x4*)(phi_ + 32 * ks + 4); } } while (0)
#define CB_FINISH(lo_, hi_, task_) do { const int kv = (task_) / ntp, r0 = ((task_) % ntp) * 16; const int nimask = prompt ? 255 : 127; \
        const int ro = r0 + ml, i_blk = (ro >> 2) & nimask; const bool valid = i_blk < nimask; \
        bf16x8 hb[4]; \
        _Pragma("unroll") for (int ks = 0; ks < 4; ++ks) { f32x4 z[2]; \
            _Pragma("unroll") for (int e = 0; e < 2; ++e) { z[e] = lo_[ks][e] + hi_[ks][e] + *(const LAS f32x4*)(CBL + kv * 128 + 32 * ks + 8 * fq + 4 * e); \
                _Pragma("unroll") for (int q = 0; q < 4; ++q) { const float zz = z[e][q]; z[e][q] = valid ? zz / (1.0f + __expf(-zz)) : 0.f; } } \
            hb[ks] = cvt8(z[0], z[1]); } \
        _Pragma("unroll") for (int db = 0; db < 4; ++db) { f32x4 acc = (f32x4){0.f, 0.f, 0.f, 0.f}; \
            _Pragma("unroll") for (int ks = 0; ks < 4; ++ks) { const bf16x8 a = *(const LAS bf16x8*)(W2T + (kv * 64 + 16 * db + ml) * W2T_STR + 32 * ks + 8 * fq); acc = __builtin_amdgcn_mfma_f32_16x16x32_bf16(a, hb[ks], acc, 0, 0, 0); } \
            const int g = ro & 3, d0 = 16 * db + 4 * fq; \
            if (prompt) { const int b = ro >> 10; v2u o; o.x = cvtpk(acc[0], acc[1]); o.y = cvtpk(acc[2], acc[3]); *(v2u*)(KC + ((size_t)((kv * 4 + b) * 4 + g) * 256 + i_blk) * 64 + d0) = o; } \
            else { const int b = ro >> 9; *(f32x4*)(KCS + ((size_t)((kv * 128 + b) * 4 + g) * 128 + i_blk) * 64 + d0) = acc; } } } while (0)
    const int ntask = 2 * ntp;
    int task = gw;
    if (task < ntask) CB_LOAD(loA, hiA, task);
    while (task < ntask) {
        int t2 = task + NGW; if (t2 < ntask) CB_LOAD(loB, hiB, t2);
        CB_FINISH(loA, hiA, task);
        task = t2; if (task >= ntask) break;
        t2 = task + NGW; if (t2 < ntask) CB_LOAD(loA, hiA, t2);
        CB_FINISH(loB, hiB, task);
        task = t2;
    }
#undef CB_LOAD
#undef CB_FINISH
}

constexpr int VSTR = 192;
constexpr int AT_K = 0, AT_V = 64 * KSTR, AT_BUF = 64 * KSTR + 64 * VSTR  , AT_CK = 0, AT_CV = 4 * 64 * KSTR  , AT_T = AT_CV + 4 * 64 * VSTR, AT_TS = 66, AT_U = AT_T + 64 * AT_TS * 4,
    AT_SEL = AT_U + 64 * AT_TS * 4, AT_WUNI = AT_SEL + 512, AT_END = AT_WUNI + 64, AT_OF = 2 * AT_BUF  ;
static_assert(AT_OF + 8 * 32 * 64 * 4 <= AT_SEL, "attention LDS");
static_assert(AT_END <= RING_BYTES, "attention LDS");

__device__ __forceinline__ v4i16_t vtr(const LAS unsigned char* p) { return __builtin_amdgcn_ds_read_tr16_b64_v4i16((LAS v4i16_t*)p); }

struct KvRegs { v4u k, v; };
__device__ __forceinline__ void load_kv(Frame& F, KvRegs& R, const bf16* ksrc, const bf16* vsrc, int pitch) {
    const int key = F.tid >> 3, ch = F.tid & 7;
    R.k = *(const v4u*)(ksrc + (size_t)key * pitch + ch * 8);
    R.v = *(const v4u*)(vsrc + (size_t)key * pitch + ch * 8);
}
__device__ __forceinline__ void store_kv(Frame& F, const KvRegs& R, int buf) {
    const int key = F.tid >> 3, ch = F.tid & 7;
    *(LAS v4u*)(F.lds + buf * AT_BUF + AT_K + key * KSTR + ch * 16) = R.k;
    *(LAS v4u*)(F.lds + buf * AT_BUF + AT_V + key * VSTR + ch * 16) = R.v;
}

constexpr float ATT_THR = 8.0f;
__device__ __forceinline__ float quad_xor1(float x) { return __builtin_bit_cast(float, __builtin_amdgcn_update_dpp(0, __builtin_bit_cast(int, x), 0xB1, 0xF, 0xF, true)); }
__device__ __forceinline__ float quad_xor2(float x) { return __builtin_bit_cast(float, __builtin_amdgcn_update_dpp(0, __builtin_bit_cast(int, x), 0x4E, 0xF, 0xF, true)); }
__device__ __forceinline__ float half_max(float x) { auto rr = __builtin_amdgcn_permlane32_swap(__float_as_uint(x), __float_as_uint(x), false, false); return fmaxf(__uint_as_float(rr[0]), __uint_as_float(rr[1])); }
struct AugState { unsigned q0, q1, mw2, mw3, kj0, kj1, hsel; };
__device__ __forceinline__ unsigned bf16_hi_bits(float f) { return f2bf(f); }
__device__ __forceinline__ void aug_set_m(AugState& A, float m) {
    const float a = -m; const unsigned h1 = f2bf(a); const float r1 = a - bf2f((unsigned short)h1); const unsigned h2 = f2bf(r1); const float r2 = r1 - bf2f((unsigned short)h2); const unsigned h3 = f2bf(r2);
    A.mw2 = h1 << 16; A.mw3 = h2 | (h3 << 16);
}
template <int MODE>
__device__ __forceinline__ void attn_tile(Frame& F, bool MASKED, int kofs_b, int vofs_b, const bf16x8 (&qf)[4], AugState& A, int blk, int relb, float slope2, bool rowok, float& m, float& l, bool& any, f32x16& o0, f32x16& o1,
                                          float mfin, float invl, LAS float* Tq, LAS float* Uq, int sig0) {
    const int lane = F.lane, r = lane & 31, h = lane >> 5;
    const LAS unsigned char* Kt = F.lds + kofs_b; const LAS unsigned char* Vt = F.lds + vofs_b;
    constexpr int PM = (MODE <= 1) ? 16 : 1;
    const float NEG = -INFINITY;
    float c0 = slope2 * (float)relb - ((MODE == 1) ? mfin : m);
    if (!rowok) c0 = NEG;
    const float k32 = slope2 * (float)(32 * PM);
    f32x16 p0, p1;
    if (MODE <= 1) {
#pragma unroll
        for (int i = 0; i < 16; ++i) { p0[i] = fmaf(slope2, (float)(PM * ((i & 3) + 8 * (i >> 2))), c0); p1[i] = p0[i] + k32; }
    }
    bf16x8 kfr[8];
#pragma unroll
    for (int ks = 0; ks < 4; ++ks) { kfr[2 * ks] = *(const LAS bf16x8*)(Kt + r * KSTR + ks * 32 + h * 16); kfr[2 * ks + 1] = *(const LAS bf16x8*)(Kt + (32 + r) * KSTR + ks * 32 + h * 16); }
    v4i16_t vlo[4][2], vhi[4][2];
    if (MODE != 0) { const LAS unsigned char* vb = Vt + (((lane & 15) >> 2) + 4 * h) * VSTR + (16 * ((lane >> 4) & 1) + 4 * (lane & 3)) * 2;
#pragma unroll
        for (int sp = 0; sp < 4; ++sp)
#pragma unroll
            for (int db = 0; db < 2; ++db) { vlo[sp][db] = vtr(vb + (16 * sp) * VSTR + 64 * db); vhi[sp][db] = vtr(vb + (16 * sp + 8) * VSTR + 64 * db); } }
    __builtin_amdgcn_sched_barrier(0);
    if (MODE >= 2) {
        const unsigned bw = (__float_as_uint((float)blk) >> 16) * 0x10001u & A.hsel;
        const v4u ka0 = (v4u){bw, A.kj0, 0x3f803f80u & A.hsel, 0x3f803f80u & A.hsel}, ka1 = (v4u){bw, A.kj1, 0x3f803f80u & A.hsel, 0x3f803f80u & A.hsel};
        const v4u qa = (v4u){A.q0, A.q1, (rowok ? 0u : 0xc6eau) | A.mw2, A.mw3};
        const f32x16 z = {0.f, 0.f, 0.f, 0.f, 0.f, 0.f, 0.f, 0.f, 0.f, 0.f, 0.f, 0.f, 0.f, 0.f, 0.f, 0.f};
        p0 = __builtin_amdgcn_mfma_f32_32x32x16_bf16(__builtin_bit_cast(bf16x8, ka0), __builtin_bit_cast(bf16x8, qa), z, 0, 0, 0);
        p1 = __builtin_amdgcn_mfma_f32_32x32x16_bf16(__builtin_bit_cast(bf16x8, ka1), __builtin_bit_cast(bf16x8, qa), z, 0, 0, 0);
    }
#pragma unroll
    for (int ks = 0; ks < 4; ++ks) {
        p0 = __builtin_amdgcn_mfma_f32_32x32x16_bf16(kfr[2 * ks], qf[ks], p0, 0, 0, 0);
        p1 = __builtin_amdgcn_mfma_f32_32x32x16_bf16(kfr[2 * ks + 1], qf[ks], p1, 0, 0, 0);
    }
    __builtin_amdgcn_sched_barrier(0);
    if (MASKED) {
#pragma unroll
        for (int i = 0; i < 16; ++i) {
            const int kofs = PM * ((i & 3) + 8 * (i >> 2));
            const int rel0 = relb + kofs, rel1 = rel0 + PM * 32;
            bool ok0 = rel0 <= 0, ok1 = rel1 <= 0;
            if (MODE == 3) { ok0 = ok0 && rel0 > -512; ok1 = ok1 && rel1 > -512; }
            p0[i] = ok0 ? p0[i] : NEG; p1[i] = ok1 ? p1[i] : NEG;
        }
    }
    if (MODE == 1) {
#pragma unroll
        for (int i = 0; i < 16; ++i) { p0[i] = __builtin_amdgcn_exp2f(p0[i]) * invl; p1[i] = __builtin_amdgcn_exp2f(p1[i]) * invl; }
#pragma unroll
        for (int hf = 0; hf < 2; ++hf)
#pragma unroll
            for (int g4 = 0; g4 < 4; ++g4) {
                const float pa = hf ? p1[4 * g4] : p0[4 * g4], pb = hf ? p1[4 * g4 + 1] : p0[4 * g4 + 1], pc = hf ? p1[4 * g4 + 2] : p0[4 * g4 + 2], pd = hf ? p1[4 * g4 + 3] : p0[4 * g4 + 3];
                float tv = 2.f * ((pa + pb) + pc) + pd, uv = pd;
                tv += quad_xor1(tv); uv += quad_xor1(uv); tv += quad_xor2(tv); uv += quad_xor2(uv);
                const int sg = sig0 + 8 * hf + 2 * g4 + h;
                if ((lane & 3) == 0) { Tq[sg] = tv; Uq[sg + 1] = uv; }
            }
    } else {
        float mxa = fmaxf(fmaxf(p0[0], p0[1]), p1[0]), mxb = fmaxf(fmaxf(p0[2], p0[3]), p1[1]); mxa = fmaxf(fmaxf(mxa, p1[2]), p1[3]);
#pragma unroll
        for (int i = 4; i < 16; i += 4) { mxa = fmaxf(fmaxf(mxa, p0[i]), p0[i + 1]); mxb = fmaxf(fmaxf(mxb, p0[i + 2]), p0[i + 3]); mxa = fmaxf(fmaxf(mxa, p1[i]), p1[i + 1]); mxb = fmaxf(fmaxf(mxb, p1[i + 2]), p1[i + 3]); }
        float mx = half_max(fmaxf(mxa, mxb));
        const float VLD = (MODE >= 2) ? -1.0e4f : NEG;
        const bool need = (mx > ATT_THR) || (!any && mx > VLD);
        if (__any(need)) {
            const float dl = need ? mx : 0.f; const float f = any ? __builtin_amdgcn_exp2f(-dl) : 1.f;
            m += dl; l *= f;
            if (MODE >= 2) aug_set_m(A, m);
#pragma unroll
            for (int i = 0; i < 16; ++i) { p0[i] -= dl; p1[i] -= dl; }
            if (MODE >= 2) {
#pragma unroll
                for (int i = 0; i < 16; ++i) { o0[i] *= f; o1[i] *= f; } }
        }
        any = any || (mx > VLD);
        float rs0 = 0.f, rs1 = 0.f;
#pragma unroll
        for (int i = 0; i < 16; ++i) { p0[i] = __builtin_amdgcn_exp2f(p0[i]); p1[i] = __builtin_amdgcn_exp2f(p1[i]); rs0 += p0[i]; rs1 += p1[i]; }
        l += rs0 + rs1;
        if (MODE == 0) return;
    }
    __builtin_amdgcn_sched_barrier(0);
#pragma unroll
    for (int sp = 0; sp < 4; ++sp) {
        v4u pw;
        if (sp < 2) { const int b8 = 8 * sp; pw.x = cvtpk(p0[b8], p0[b8 + 1]); pw.y = cvtpk(p0[b8 + 2], p0[b8 + 3]); pw.z = cvtpk(p0[b8 + 4], p0[b8 + 5]); pw.w = cvtpk(p0[b8 + 6], p0[b8 + 7]); }
        else { const int b8 = 8 * (sp - 2); pw.x = cvtpk(p1[b8], p1[b8 + 1]); pw.y = cvtpk(p1[b8 + 2], p1[b8 + 3]); pw.z = cvtpk(p1[b8 + 4], p1[b8 + 5]); pw.w = cvtpk(p1[b8 + 6], p1[b8 + 7]); }
        const bf16x8 pbf = __builtin_bit_cast(bf16x8, pw);
#pragma unroll
        for (int db = 0; db < 2; ++db) {
            const v4i16_t lo = vlo[sp][db], hi = vhi[sp][db];
            const bf16x8 vf = (bf16x8){lo[0], lo[1], lo[2], lo[3], hi[0], hi[1], hi[2], hi[3]};
            if (db == 0) o0 = __builtin_amdgcn_mfma_f32_32x32x16_bf16(vf, pbf, o0, 0, 0, 0);
            else o1 = __builtin_amdgcn_mfma_f32_32x32x16_bf16(vf, pbf, o1, 0, 0, 0);
        }
    }
}

struct BgCopy {
    size_t base; int k, pend; f32x4 v0;
    __device__ __forceinline__ void init(Frame& F) { const int b = F.vcu >> 1, hb = F.vcu & 1; k = (F.G == 256) ? 0 : 64; pend = 0; base = (size_t)b * 65536 + hb * 32704; }
    __device__ __forceinline__ void step(Frame& F) {
        const f32x4* src = (const f32x4*)F.state_win + base + 128 + F.tid; f32x4* dst = (f32x4*)(F.out + OUT_WIN_S) + base + F.tid;
        if (pend) { if (k - 1 < 63 || F.tid < 448) dst[512 * (k - 1)] = v0; pend = 0; }
        if (k < 64) { if (k < 63 || F.tid < 448) v0 = src[512 * k]; k += 1; pend = 1; }
    }
    __device__ __forceinline__ void finish(Frame& F) { while (k < 64 || pend) step(F); }
};

__device__ __forceinline__ void attn_prompt_unit(Frame& F, BgCopy& BG, int b, int g, int qb) {
    const int lane = F.lane, r = lane & 31, h = lane >> 5, w = F.wave;
    const int c0 = qb * 64, cur = qb, ql = 8 * w + (r >> 2), tq = c0 + ql, hd = g * 4 + (r & 3);
    const bf16* Q = WSP(bf16, WS_Q); const bf16* KVS = WSP(bf16, WS_KVS); const bf16* KVW = WSP(bf16, WS_KVW); const bf16* KC = WSP(bf16, WS_KC); const float* GATE = WSP(float, WS_GATE);
    bf16* O = WSP(bf16, WS_DIFF);
    const size_t row = (size_t)b * SEQ + tq;
    bf16x8 qf[4];
#pragma unroll
    for (int ks = 0; ks < 4; ++ks) qf[ks] = *(const bf16x8*)(Q + row * D + hd * 64 + ks * 16 + h * 8);
    const float slope2 = exp2f(-0.5f * (float)(hd + 1)) * LOG2E;
    AugState AG;
    { const unsigned sh = f2bf(slope2); const float shf = bf2f((unsigned short)sh); const unsigned sl = f2bf(slope2 - shf); const float slf = bf2f((unsigned short)sl);
      const unsigned hs = h ? 0u : 0xffffffffu; AG.hsel = hs;
      AG.q0 = (f2bf(64.f * shf) | (f2bf(64.f * slf) << 16)) & hs; AG.q1 = (sh | (sl << 16)) & hs; AG.mw2 = 0u; AG.mw3 = 0u;
      const unsigned j0 = __float_as_uint((float)r) >> 16, j1 = __float_as_uint((float)(32 + r)) >> 16; AG.kj0 = (j0 * 0x10001u) & hs; AG.kj1 = (j1 * 0x10001u) & hs; }
    const float g0 = GATE[row * 48 + hd * 3 + 0], g1 = GATE[row * 48 + hd * 3 + 1], g2 = GATE[row * 48 + hd * 3 + 2];
    LAS float* T = (LAS float*)(F.lds + AT_T); LAS float* U = (LAS float*)(F.lds + AT_U);
    LAS unsigned* SELM = (LAS unsigned*)(F.lds + AT_SEL); LAS unsigned* WUNI = (LAS unsigned*)(F.lds + AT_WUNI);
    for (int i = F.tid; i < 2 * 64 * AT_TS; i += 512) T[i] = 0.f;
    f32x16 of0, of1, o0, o1;
#pragma unroll
    for (int i = 0; i < 16; ++i) { of0[i] = 0.f; of1[i] = 0.f; o0[i] = 0.f; o1[i] = 0.f; }
    const float NEG = -INFINITY;
    const int nmax = c0 / 16 + 2;
    const int ntile = (nmax >= 255 ? 254 : nmax) / 64 + 1;
    const bf16* kc = KC + (size_t)((0 * 4 + b) * 4 + g) * 256 * 64; const bf16* vc = KC + (size_t)((1 * 4 + b) * 4 + g) * 256 * 64;
    SEG_BEGIN(23);
    float m = 0.f, l = 0.f; bool any = false;
    KvRegs R; int cb = 0;
    {
        KvRegs Rc[4]; const int key = F.tid >> 3, ch = F.tid & 7;
#pragma unroll
        for (int tl = 0; tl < 4; ++tl) if (tl < ntile) load_kv(F, Rc[tl], kc + (size_t)tl * 64 * 64, vc + (size_t)tl * 64 * 64, 64);
        BG.step(F);
#pragma unroll
        for (int tl = 0; tl < 4; ++tl) if (tl < ntile) { *(LAS v4u*)(F.lds + AT_CK + tl * 64 * KSTR + key * KSTR + ch * 16) = Rc[tl].k; *(LAS v4u*)(F.lds + AT_CV + tl * 64 * VSTR + key * VSTR + ch * 16) = Rc[tl].v; }
        __syncthreads();
    }
    for (int tl = 0; tl < ntile; ++tl)
        attn_tile<0>(F, !(1024 * tl + 1039 <= c0 + 8 * w), AT_CK + tl * 64 * KSTR, AT_CV + tl * 64 * VSTR, qf, AG, 0, 16 * 64 * tl + 31 + 16 * 4 * h - tq, slope2, true, m, l, any, o0, o1, 0.f, 0.f, nullptr, nullptr, 0);
    { const float lt = l + __shfl_xor(l, 32); const float invl = lt > 0.f ? 1.0f / lt : 0.f;
      LAS float* Tq = T + ql * AT_TS; LAS float* Uq = U + ql * AT_TS;
      for (int tl = 0; tl < ntile; ++tl)
          attn_tile<1>(F, !(1024 * tl + 1039 <= c0 + 8 * w), AT_CK + tl * 64 * KSTR, AT_CV + tl * 64 * VSTR, qf, AG, 0, 16 * 64 * tl + 31 + 16 * 4 * h - tq, slope2, true, m, l, any, o0, o1, m, invl, Tq, Uq, 16 * tl);
#pragma unroll
      for (int i = 0; i < 16; ++i) { of0[i] = g0 * o0[i]; of1[i] = g0 * o1[i]; o0[i] = 0.f; o1[i] = 0.f; } }
    __syncthreads(); SEG_END(23);
    SEG_BEGIN(22);
    unsigned long long wuni = 0ull;
    if (cur <= 15) {
        const unsigned long long msk = (1ull << (cur + 1)) - 1ull;
        if (lane < 8) { SELM[2 * (8 * w + lane)] = (unsigned)msk; SELM[2 * (8 * w + lane) + 1] = (unsigned)(msk >> 32); }
        wuni = msk;
    } else {
#pragma unroll
        for (int q4 = 0; q4 < 4; ++q4) {
            const int qb4 = 8 * w + 2 * q4; float v[2]; int rank[2];
#pragma unroll
            for (int e = 0; e < 2; ++e) { v[e] = T[(qb4 + e) * AT_TS + lane] + U[(qb4 + e) * AT_TS + lane]; rank[e] = 0; }
#pragma unroll
            for (int e = 0; e < 2; ++e) T[(qb4 + e) * AT_TS + lane] = v[e];
            LDS_WAIT(); asm volatile("" ::: "memory");
            for (int s2 = 1; s2 <= cur - 2; ++s2) {
                float o[2];
#pragma unroll
                for (int e = 0; e < 2; ++e) o[e] = T[(qb4 + e) * AT_TS + s2];
                const bool before = s2 < lane;
#pragma unroll
                for (int e = 0; e < 2; ++e) rank[e] += (o[e] > v[e] || (o[e] == v[e] && before)) ? 1 : 0;
            }
#pragma unroll
            for (int e = 0; e < 2; ++e) {
                const bool sel = (lane <= cur) && (lane == 0 || lane >= cur - 1 || rank[e] < 13);
                const unsigned long long msk = __ballot(sel);
                if (lane == 0) { SELM[2 * (qb4 + e)] = (unsigned)msk; SELM[2 * (qb4 + e) + 1] = (unsigned)(msk >> 32); }
                wuni |= msk;
            }
        }
    }
    wuni = ((unsigned long long)(unsigned)__builtin_amdgcn_readfirstlane((int)(unsigned)(wuni >> 32)) << 32) | (unsigned long long)(unsigned)__builtin_amdgcn_readfirstlane((int)(unsigned)wuni);
    if (lane == 0) { WUNI[2 * w] = (unsigned)wuni; WUNI[2 * w + 1] = (unsigned)(wuni >> 32); }
    SEG_END(22);
    __syncthreads();
    unsigned long long guni = 0ull;
#pragma unroll
    for (int i = 0; i < 8; ++i) guni |= (unsigned long long)WUNI[2 * i] | ((unsigned long long)WUNI[2 * i + 1] << 32);
    const unsigned long long mym = (unsigned long long)SELM[2 * ql] | ((unsigned long long)SELM[2 * ql + 1] << 32);
    LAS float* OFP = (LAS float*)(F.lds + AT_OF) + w * 32 * 64 + lane;
#pragma unroll
    for (int i = 0; i < 16; ++i) { OFP[i * 64] = of0[i]; OFP[(16 + i) * 64] = of1[i]; }
    m = 0.f; l = 0.f; any = false; AG.mw2 = 0u; AG.mw3 = 0u;
    { const bf16* ks = KVS + (size_t)b * SEQ * 512 + g * 64; const bf16* vs = ks + 256;
      unsigned long long rem = guni;
      int s = __builtin_ctzll(rem); rem &= rem - 1ull;
      load_kv(F, R, ks + (size_t)s * 64 * 512, vs + (size_t)s * 64 * 512, 512); __syncthreads(); store_kv(F, R, 0); __syncthreads(); cb = 0;
      for (;;) {
          const bool more = rem != 0ull; const int sn = more ? __builtin_ctzll(rem) : 0; rem &= rem - 1ull; BG.step(F);
          if (more) load_kv(F, R, ks + (size_t)sn * 64 * 512, vs + (size_t)sn * 64 * 512, 512);
          if ((wuni >> s) & 1ull) attn_tile<2>(F, s == cur, cb * AT_BUF + AT_K, cb * AT_BUF + AT_V, qf, AG, s - cur, 64 * s + 4 * h - tq, slope2, ((mym >> s) & 1ull) != 0ull, m, l, any, o0, o1, 0.f, 0.f, nullptr, nullptr, 0);
          if (!more) break;
          store_kv(F, R, cb ^ 1); __syncthreads(); cb ^= 1; s = sn;
      }
      const float lt = l + __shfl_xor(l, 32); const float sc = lt > 0.f ? g1 / lt : 0.f;
#pragma unroll
      for (int i = 0; i < 16; ++i) { OFP[i * 64] += sc * o0[i]; OFP[(16 + i) * 64] += sc * o1[i]; o0[i] = 0.f; o1[i] = 0.f; } }
    m = 0.f; l = 0.f; any = false; AG.mw2 = 0u; AG.mw3 = 0u;
    { const bf16* kw = KVW + (size_t)b * SEQ * 512 + g * 64; const bf16* vw = kw + 256;
      const int j0 = (c0 >= 512) ? 0 : (512 - c0) / 64;
      { const int pos0 = c0 - 512 + 64 * j0; load_kv(F, R, kw + (size_t)pos0 * 512, vw + (size_t)pos0 * 512, 512); __syncthreads(); store_kv(F, R, 0); __syncthreads(); cb = 0; }
      for (int j = j0; j < 9; ++j) {
          const int pos0 = c0 - 512 + 64 * j; const bool more = j + 1 < 9; BG.step(F);
          if (more) load_kv(F, R, kw + (size_t)(pos0 + 64) * 512, vw + (size_t)(pos0 + 64) * 512, 512);
          attn_tile<3>(F, j == 0 || j == 8, cb * AT_BUF + AT_K, cb * AT_BUF + AT_V, qf, AG, j - 8, pos0 + 4 * h - tq, slope2, true, m, l, any, o0, o1, 0.f, 0.f, nullptr, nullptr, 0);
          if (more) { store_kv(F, R, cb ^ 1); __syncthreads(); cb ^= 1; }
      }
      const float lt = l + __shfl_xor(l, 32); const float sc = lt > 0.f ? g2 / lt : 0.f;
#pragma unroll
      for (int i = 0; i < 16; ++i) { of0[i] = OFP[i * 64] + sc * o0[i]; of1[i] = OFP[(16 + i) * 64] + sc * o1[i]; } }
    bf16* orow = O + row * D + hd * 64;
#pragma unroll
    for (int g4 = 0; g4 < 4; ++g4) {
        v2u a; a.x = cvtpk(of0[4 * g4], of0[4 * g4 + 1]); a.y = cvtpk(of0[4 * g4 + 2], of0[4 * g4 + 3]);
        v2u c; c.x = cvtpk(of1[4 * g4], of1[4 * g4 + 1]); c.y = cvtpk(of1[4 * g4 + 2], of1[4 * g4 + 3]);
        *(v2u*)(orow + 8 * g4 + 4 * h) = a; *(v2u*)(orow + 32 + 8 * g4 + 4 * h) = c;
    }
    __syncthreads();
}

constexpr int SA_QS = 0, SA_SC = 1024, SA_NK = 1664, SA_IMP = SA_SC + SA_NK * 16, SA_LIST = SA_IMP + 256, SA_BLK = SA_LIST + 64, SA_RED = SA_BLK + 128, SA_END = SA_RED + 512 * 64;
constexpr int SK_CMP = 0, SK_SEL = 128, SK_WIN = 1088, SK_NSEL = 1600, SK_NWIN = 1601;
static_assert(SA_END <= RING_BYTES, "sample attention LDS");

__device__ __forceinline__ f32x4 wave_max4(f32x4 v) {
#pragma unroll
    for (int o = 1; o < 64; o <<= 1) { v[0] = fmaxf(v[0], __shfl_xor(v[0], o)); v[1] = fmaxf(v[1], __shfl_xor(v[1], o)); v[2] = fmaxf(v[2], __shfl_xor(v[2], o)); v[3] = fmaxf(v[3], __shfl_xor(v[3], o)); }
    return v;
}
__device__ __forceinline__ f32x4 wave_sum4(f32x4 v) {
#pragma unroll
    for (int o = 1; o < 64; o <<= 1) { v[0] += __shfl_xor(v[0], o); v[1] += __shfl_xor(v[1], o); v[2] += __shfl_xor(v[2], o); v[3] += __shfl_xor(v[3], o); }
    return v;
}
__device__ __forceinline__ void sa_softmax4(LAS f32x4* SC, int k0, int nk, int kx, f32x4 post, int lane) {
    f32x4 mx = (f32x4){-INFINITY, -INFINITY, -INFINITY, -INFINITY};
    for (int i = lane; i < nk; i += 64) { const f32x4 s = SC[k0 + i]; mx[0] = fmaxf(mx[0], s[0]); mx[1] = fmaxf(mx[1], s[1]); mx[2] = fmaxf(mx[2], s[2]); mx[3] = fmaxf(mx[3], s[3]); }
    if (kx >= 0) { const f32x4 s = SC[kx]; mx[0] = fmaxf(mx[0], s[0]); mx[1] = fmaxf(mx[1], s[1]); mx[2] = fmaxf(mx[2], s[2]); mx[3] = fmaxf(mx[3], s[3]); }
    mx = wave_max4(mx);
#pragma unroll
    for (int q = 0; q < 4; ++q) if (mx[q] == -INFINITY) mx[q] = 0.f;
    f32x4 sum = (f32x4){0.f, 0.f, 0.f, 0.f};
    for (int i = lane; i < nk; i += 64) { f32x4 s = SC[k0 + i];
#pragma unroll
        for (int q = 0; q < 4; ++q) s[q] = __builtin_amdgcn_exp2f(s[q] - mx[q]);
        SC[k0 + i] = s; sum += s; }
    sum = wave_sum4(sum);
    f32x4 ex = (f32x4){0.f, 0.f, 0.f, 0.f};
    if (kx >= 0) { const f32x4 s = SC[kx];
#pragma unroll
        for (int q = 0; q < 4; ++q) ex[q] = __builtin_amdgcn_exp2f(s[q] - mx[q]);
        sum += ex; }
    f32x4 sc;
#pragma unroll
    for (int q = 0; q < 4; ++q) sc[q] = sum[q] > 0.f ? post[q] / sum[q] : 0.f;
    LDS_WAIT(); asm volatile("" ::: "memory");
    for (int i = lane; i < nk; i += 64) SC[k0 + i] = SC[k0 + i] * sc;
    if (kx >= 0 && lane == 0) SC[kx] = ex * sc;
}

#define SA_LOADK(dst, kr) do { dst[0] = *(const f32x4*)(kr); dst[1] = *(const f32x4*)((kr) + 4); dst[2] = *(const f32x4*)((kr) + 32); dst[3] = *(const f32x4*)((kr) + 36); } while (0)
#define SA_SCORE(acc, kf) do { acc = __builtin_amdgcn_mfma_f32_16x16x32_bf16(af[0], cvt8(kf[0], kf[1]), (f32x4){0.f, 0.f, 0.f, 0.f}, 0, 0, 0); acc = __builtin_amdgcn_mfma_f32_16x16x32_bf16(af[1], cvt8(kf[2], kf[3]), acc, 0, 0, 0); } while (0)

__device__ __forceinline__ void attn_sample_unit(Frame& F, int b, int g) {
    const int tid = F.tid, lane = F.lane, w = F.wave; const int row = MP + b;
    const bf16* Q = WSP(bf16, WS_Q); const bf16* KVS = WSP(bf16, WS_KVS); const bf16* KVW = WSP(bf16, WS_KVW); const float* KCS = WSP(float, WS_KCS); const float* GATE = WSP(float, WS_GATE);
    bf16* O = WSP(bf16, WS_DIFF);
    LAS f32x4* SC = (LAS f32x4*)(F.lds + SA_SC); LAS float* IMP = (LAS float*)(F.lds + SA_IMP);
    LAS int* LIST = (LAS int*)(F.lds + SA_LIST); LAS int* BLK = (LAS int*)(F.lds + SA_BLK); LAS float* RED = (LAS float*)(F.lds + SA_RED);
    const float* kc = KCS + (size_t)((0 * 128 + b) * 4 + g) * 128 * 64; const float* vc = KCS + (size_t)((1 * 128 + b) * 4 + g) * 128 * 64;
    const float* sw = F.state_win + (size_t)b * 512 * 512;
    __syncthreads();
    bf16x8 af[2];
#pragma unroll
    for (int ks = 0; ks < 2; ++ks) { af[ks] = (bf16x8){0, 0, 0, 0, 0, 0, 0, 0}; if ((lane & 15) < 4) af[ks] = *(const bf16x8*)(Q + (size_t)row * D + (g * 4 + (lane & 15)) * 64 + 32 * ks + 8 * (lane >> 4)); }
    f32x4 sl2;
#pragma unroll
    for (int i = 0; i < 4; ++i) sl2[i] = exp2f(-0.5f * (float)(g * 4 + i + 1)) * LOG2E;
    f32x4 gt0, gt1, gt2;
    { const float* gp = GATE + (size_t)row * 48 + g * 12;
#pragma unroll
      for (int i = 0; i < 4; ++i) { gt0[i] = gp[i * 3 + 0]; gt1[i] = gp[i * 3 + 1]; gt2[i] = gp[i * 3 + 2]; } }
    const int kl = lane & 15, kc8 = 8 * (lane >> 4);
    { f32x4 kf[5][4];
      { const float* kr = kc + (size_t)(16 * w + kl) * 64 + kc8; SA_LOADK(kf[0], kr); }
#pragma unroll
      for (int j = 1; j < 5; ++j) { const float* kr = sw + (size_t)(16 * (w + 8 * (j - 1)) + kl) * 512 + g * 64 + kc8; SA_LOADK(kf[j], kr); }
      f32x4 acc;
      SA_SCORE(acc, kf[0]);
      if (lane < 16) { const int n = 16 * w + kl; const float rel = (float)(16 * n + 31 - PAST); f32x4 s;
#pragma unroll
          for (int i = 0; i < 4; ++i) s[i] = (n < 127) ? acc[i] + sl2[i] * rel : -INFINITY;
          SC[SK_CMP + n] = s; }
#pragma unroll
      for (int j = 1; j < 5; ++j) { SA_SCORE(acc, kf[j]);
          if (lane < 16) { const int i2 = 16 * (w + 8 * (j - 1)) + kl; const float rel = (float)(i2 - 512); f32x4 s;
#pragma unroll
              for (int i = 0; i < 4; ++i) s[i] = (i2 >= 1) ? acc[i] + sl2[i] * rel : -INFINITY;
              SC[SK_WIN + i2] = s; } }
      if (w == 7) {
          f32x4 a, c2; const float kwn = bf2f(KVW[(size_t)row * 512 + g * 64 + lane]), ksn = bf2f(KVS[(size_t)row * 512 + g * 64 + lane]);
#pragma unroll
          for (int i = 0; i < 4; ++i) { const float qv = bf2f(Q[(size_t)row * D + (g * 4 + i) * 64 + lane]); a[i] = qv * kwn; c2[i] = qv * ksn; }
          a = wave_sum4(a); c2 = wave_sum4(c2);
          if (lane == 0) { SC[SK_NWIN] = a; SC[SK_NSEL] = c2; }
      }
    }
    __syncthreads();
    if (w == 0) {
        sa_softmax4(SC, SK_CMP, 128, -1, (f32x4){1.f, 1.f, 1.f, 1.f}, lane);
        LDS_WAIT(); asm volatile("" ::: "memory");
        if (lane < 33) { float a = 0.f;
#pragma unroll
            for (int dn = -1; dn <= 3; ++dn) { const int n = 4 * lane + dn; if (n >= 0 && n < 127) { const f32x4 p = SC[SK_CMP + n]; a += ((dn == -1 || dn == 3) ? 1.f : 2.f) * ((p[0] + p[1]) + (p[2] + p[3])); } }
            IMP[lane] = a; }
        LDS_WAIT(); asm volatile("" ::: "memory");
        const float v = (lane <= 32) ? IMP[lane] : 0.f; int rank = 0;
        for (int s2 = 1; s2 <= 30; ++s2) { const float o = IMP[s2]; rank += (o > v || (o == v && s2 < lane)) ? 1 : 0; }
        const bool sel = (lane == 0) || (lane == 31) || (lane >= 1 && lane <= 30 && rank < 13);
        const unsigned long long msk = __ballot(sel);
        if (sel) { const int pos = __builtin_popcountll(msk & ((1ull << lane) - 1ull)); LIST[pos] = lane;
            const int page = F.page_table[b * 16 + (lane >> 1)]; BLK[pos] = page * 128 + (lane & 1) * 64; }
        LDS_WAIT(); asm volatile("" ::: "memory");
        for (int i = lane; i < 128; i += 64) SC[SK_CMP + i] = SC[SK_CMP + i] * gt0;
    }
    __syncthreads();
#pragma unroll
    for (int bt = 0; bt < 2; ++bt) {
        f32x4 kf[4][4];
#pragma unroll
        for (int j = 0; j < 4; ++j) { const int st = w + 8 * (4 * bt + j); if (st < 60) { const int bi = st >> 2, kk = 16 * (st & 3) + kl;
            const float* kr = F.cache + ((size_t)(BLK[bi] + kk) * 4 + 2) * 256 + g * 64 + kc8; SA_LOADK(kf[j], kr); } }
#pragma unroll
        for (int j = 0; j < 4; ++j) { const int st = w + 8 * (4 * bt + j); if (st < 60) { const int bi = st >> 2, kk = 16 * (st & 3) + kl; f32x4 acc; SA_SCORE(acc, kf[j]);
            if (lane < 16) { const float rel = (float)(64 * LIST[bi] + kk - PAST); f32x4 s;
#pragma unroll
                for (int i = 0; i < 4; ++i) s[i] = acc[i] + sl2[i] * rel;
                SC[SK_SEL + 64 * bi + kk] = s; } } }
    }
    if (w == 1) sa_softmax4(SC, SK_WIN, 512, SK_NWIN, gt2, lane);
    __syncthreads();
    if (w == 0) sa_softmax4(SC, SK_SEL, 960, SK_NSEL, gt1, lane);
    __syncthreads();
    { const int kq = lane >> 4, c4 = 4 * (lane & 15);
      f32x4 acc[4];
#pragma unroll
      for (int i = 0; i < 4; ++i) acc[i] = (f32x4){0.f, 0.f, 0.f, 0.f};
      { f32x4 vv[4];
#pragma unroll
        for (int it = 0; it < 4; ++it) vv[it] = *(const f32x4*)(vc + (size_t)(32 * it + 4 * w + kq) * 64 + c4);
#pragma unroll
        for (int it = 0; it < 4; ++it) { const f32x4 p = SC[SK_CMP + 32 * it + 4 * w + kq];
#pragma unroll
            for (int i = 0; i < 4; ++i) acc[i] += vv[it] * p[i]; } }
#pragma unroll
      for (int bt = 0; bt < 1; ++bt) { f32x4 vv[16];
#pragma unroll
        for (int j = 0; j < 16; ++j) vv[j] = *(const f32x4*)(sw + (size_t)(32 * j + 4 * w + kq) * 512 + 256 + g * 64 + c4);
#pragma unroll
        for (int j = 0; j < 16; ++j) { const f32x4 p = SC[SK_WIN + 32 * j + 4 * w + kq];
#pragma unroll
            for (int i = 0; i < 4; ++i) acc[i] += vv[j] * p[i]; } }
#pragma unroll
      for (int bt = 0; bt < 2; ++bt) { f32x4 vv[15];
#pragma unroll
        for (int j = 0; j < 15; ++j) { const int k = 32 * (15 * bt + j) + 4 * w + kq; vv[j] = *(const f32x4*)(F.cache + ((size_t)(BLK[k >> 6] + (k & 63)) * 4 + 3) * 256 + g * 64 + c4); }
#pragma unroll
        for (int j = 0; j < 15; ++j) { const f32x4 p = SC[SK_SEL + 32 * (15 * bt + j) + 4 * w + kq];
#pragma unroll
            for (int i = 0; i < 4; ++i) acc[i] += vv[j] * p[i]; } }
#pragma unroll
      for (int i = 0; i < 4; ++i) *(LAS f32x4*)(RED + tid * 16 + 4 * i) = acc[i];
    }
    __syncthreads();
    if (tid < 256) { const int hd = tid >> 6, d = tid & 63; float a = 0.f;
#pragma unroll 8
        for (int j = 0; j < 32; ++j) a += RED[((j >> 2) * 64 + (j & 3) * 16 + (d >> 2)) * 16 + hd * 4 + (d & 3)];
        { const f32x4 ps = SC[SK_NSEL], pw = SC[SK_NWIN];
          a += ps[hd] * bf2f(KVS[(size_t)row * 512 + 256 + g * 64 + d]) + pw[hd] * bf2f(KVW[(size_t)row * 512 + 256 + g * 64 + d]); }
        O[(size_t)row * D + (g * 4 + hd) * 64 + d] = (bf16)f2bf(a); }
    __syncthreads();
}

__device__ __forceinline__ void p7_attention(Frame& F) {
    BgCopy BG; BG.init(F);
    const bool sfirst = (blockIdx.x & 1) == 0;
    SEG_BEGIN(20); if (sfirst) for (int i = F.vcu; i < DB * 4; i += F.G) attn_sample_unit(F, i >> 2, i & 3); SEG_END(20);
    SEG_BEGIN(21);
    for (int i = F.vcu; i < 1024; i += F.G) { const int k = i >> 8, c = i & 255, bg = c >> 4, s = c & 15; const int qb = (k == 0) ? s : (k == 1) ? 31 - s : (k == 2) ? 32 + s : 63 - s;
        attn_prompt_unit(F, BG, bg >> 2, bg & 3, qb); }
    BG.finish(F); SEG_END(21);
    SEG_BEGIN(20); if (!sfirst) for (int i = F.vcu; i < DB * 4; i += F.G) attn_sample_unit(F, i >> 2, i & 3); SEG_END(20);
}

enum { SG_POOL = 0, SG_UP = 1, SG_DOWN = 2, SG_KVQG = 3, SG_WO = 4 };
constexpr int SG_RED = 0, SG_SSQ = 2 * 8 * 16 * 64 * 4;
template <int KIND>
__device__ __forceinline__ void small_gemm(Frame& F, int layer) {
    constexpr bool F32B = (KIND == SG_UP || KIND == SG_KVQG);
    constexpr int KR = (KIND == SG_POOL) ? 256 : 1024;
    constexpr int KSPLIT = (KIND == SG_DOWN) ? 4 : 1;
    constexpr int NSL = (KIND == SG_POOL) ? 32 : (KIND == SG_UP) ? 128 : (KIND == SG_KVQG) ? 82 : 32;
    constexpr int KW = KR / 8, NKS = KW / 16;
    const int lane = F.lane, w = F.wave, r = lane & 31, h = lane >> 5;
    float* X = WSP(float, WS_X);
    LAS float* RED = (LAS float*)(F.lds + SG_RED); LAS float* SSQ = (LAS float*)(F.lds + SG_SSQ);
    for (int item = F.vcu; item < (NSL / 2) * 4 * KSPLIT; item += F.G) {
        const int kr = item % KSPLIT, tt = item / KSPLIT, rbk = tt & 3, np = tt >> 2;
        const int row = MP + 32 * rbk + r, b = 32 * rbk + r;
        const int kb = kr * KR + w * KW + 8 * h;
        int n0[2]; const bf16* wrow[2]; const bf16* b16 = nullptr; const float* b32 = nullptr;
#pragma unroll
        for (int t = 0; t < 2; ++t) { const int ns = 2 * np + t; n0[t] = ns * 32;
            if (KIND == SG_POOL) { const int g = ns >> 3; n0[t] = (ns & 7) * 32; wrow[t] = WSP(bf16, WS_WPOOL) + (size_t)g * 65536 + (size_t)(n0[t] + r) * 256 + kb; b16 = WSP(bf16, WS_DIFF) + (size_t)row * D + g * 256 + kb; n0[t] += g * 256; }
            else if (KIND == SG_UP) { wrow[t] = WSP(bf16, WS_WUP) + (size_t)layer * FF * D + (size_t)(n0[t] + r) * D + kb; b32 = X + (size_t)row * D + kb; }
            else if (KIND == SG_DOWN) { wrow[t] = WSP(bf16, WS_WDN) + (size_t)layer * D * FF + (size_t)(n0[t] + r) * FF + kb; b16 = WSP(bf16, WS_H) + (size_t)row * FF + kb; }
            else if (KIND == SG_KVQG) { wrow[t] = WSP(bf16, WS_WKVQG) + (size_t)(n0[t] + r) * D + kb; b32 = X + (size_t)row * D + kb; }
            else { wrow[t] = WSP(bf16, WS_WO) + (size_t)(n0[t] + r) * D + kb; b16 = WSP(bf16, WS_DIFF) + (size_t)row * D + kb; } }
        bf16x8 a0[NKS], a1[NKS], bb[NKS]; f32x4 x0[NKS], x1[NKS];
#pragma unroll
        for (int j = 0; j < NKS; ++j) { a0[j] = *(const bf16x8*)(wrow[0] + 16 * j); a1[j] = *(const bf16x8*)(wrow[1] + 16 * j);
            if (F32B) { x0[j] = *(const f32x4*)(b32 + 16 * j); x1[j] = *(const f32x4*)(b32 + 16 * j + 4); } else bb[j] = *(const bf16x8*)(b16 + 16 * j); }
        f32x16 acc0, acc1; float ssq = 0.f;
#pragma unroll
        for (int i = 0; i < 16; ++i) { acc0[i] = 0.f; acc1[i] = 0.f; }
#pragma unroll
        for (int j = 0; j < NKS; ++j) {
            if (F32B) { ssq += (x0[j][0] * x0[j][0] + x0[j][1] * x0[j][1]) + (x0[j][2] * x0[j][2] + x0[j][3] * x0[j][3]) + (x1[j][0] * x1[j][0] + x1[j][1] * x1[j][1]) + (x1[j][2] * x1[j][2] + x1[j][3] * x1[j][3]); bb[j] = cvt8(x0[j], x1[j]); }
            acc0 = __builtin_amdgcn_mfma_f32_32x32x16_bf16(a0[j], bb[j], acc0, 0, 0, 0);
            acc1 = __builtin_amdgcn_mfma_f32_32x32x16_bf16(a1[j], bb[j], acc1, 0, 0, 0);
        }
        __syncthreads();
#pragma unroll
        for (int i = 0; i < 16; ++i) { RED[(w * 16 + i) * 64 + lane] = acc0[i]; RED[((8 + w) * 16 + i) * 64 + lane] = acc1[i]; }
        if (F32B) SSQ[w * 64 + lane] = ssq;
        __syncthreads();
        {
            const int te = w >> 2, wq = w & 3;
            f32x4 v = (f32x4){0.f, 0.f, 0.f, 0.f};
#pragma unroll
            for (int ww = 0; ww < 8; ++ww)
#pragma unroll
                for (int e = 0; e < 4; ++e) v[e] += RED[((8 * te + ww) * 16 + 4 * wq + e) * 64 + lane];
            float rstd = 1.f;
            if (F32B) { float q = 0.f;
#pragma unroll
                for (int ww = 0; ww < 8; ++ww) q += SSQ[ww * 64 + r] + SSQ[ww * 64 + 32 + r];
                rstd = 1.0f / sqrtf(q * (1.0f / D) + RMS_EPS); }
            const int nb = te ? n0[1] : n0[0]; const int col = nb + 8 * wq + 4 * h;
            if (KIND == SG_POOL) {
                *(f32x4*)(X + (size_t)row * D + col) = *(const f32x4*)(F.x_s + (size_t)b * D + col) + v * *(const f32x4*)(F.pool_scale + col);
            } else if (KIND == SG_UP) {
                v = v * rstd;
#pragma unroll
                for (int e = 0; e < 4; ++e) { const float t = fmaxf(v[e], 0.f); v[e] = t * t; }
                v2u o; o.x = cvtpk(v[0], v[1]); o.y = cvtpk(v[2], v[3]); *(v2u*)(WSP(bf16, WS_H) + (size_t)row * FF + col) = o;
            } else if (KIND == SG_DOWN || KIND == SG_WO) {
#pragma unroll
                for (int e = 0; e < 4; ++e) unsafeAtomicAdd(X + (size_t)row * D + col + e, v[e]);
            } else {
                v = v * rstd; v2u o; o.x = cvtpk(v[0], v[1]); o.y = cvtpk(v[2], v[3]);
                if (nb < 1024) { *(f32x4*)(F.out + OUT_KV_S + (size_t)b * D + col) = v; if (nb >= 512) *(v2u*)(WSP(bf16, WS_KVS) + (size_t)row * 512 + col - 512) = o; }
                else if (nb < 1536) { *(v2u*)(WSP(bf16, WS_KVW) + (size_t)row * 512 + col - 1024) = o; *(f32x4*)(F.out + OUT_WIN_S + ((size_t)b * 512 + 511) * 512 + col - 1024) = v; }
                else if (nb < 2560) { *(v2u*)(WSP(bf16, WS_Q) + (size_t)row * D + col - 1536) = o; }
                else if (col < 2608) { float* gp = WSP(float, WS_GATE) + (size_t)row * 48 + col - 2560;
#pragma unroll
                    for (int e = 0; e < 4; ++e) gp[e] = 1.0f / (1.0f + __expf(-(v[e] + F.b_gate[col - 2560 + e]))); }
            }
        }
    }
    VM_WAIT(); __syncthreads();
}

__device__ __forceinline__ void p11_final(Frame& F) {
    const int gw = F.vcu * NWAVES + F.wave, NGW = F.G * NWAVES, lane = F.lane; const float* X = WSP(float, WS_X); const bf16* XB = WSP(bf16, WS_XB);
    for (int row = gw; row < MT; row += NGW) {
        f32x4 v[4]; float ss = 0.f;
        if (row < MP) { const v2u* xr = (const v2u*)(XB + (size_t)row * D) + lane;
#pragma unroll
            for (int j = 0; j < 4; ++j) { const v2u q = xr[64 * j]; v[j] = (f32x4){__builtin_bit_cast(float, q.x << 16), __builtin_bit_cast(float, q.x & 0xffff0000u), __builtin_bit_cast(float, q.y << 16), __builtin_bit_cast(float, q.y & 0xffff0000u)}; } }
        else { const f32x4* xr = (const f32x4*)(X + (size_t)row * D) + lane;
#pragma unroll
            for (int j = 0; j < 4; ++j) v[j] = xr[64 * j]; }
#pragma unroll
        for (int j = 0; j < 4; ++j) ss += (v[j][0] * v[j][0] + v[j][1] * v[j][1]) + (v[j][2] * v[j][2] + v[j][3] * v[j][3]);
        const float rstd = 1.0f / sqrtf(wave_sum(ss) * (1.0f / D) + RMS_EPS);
        float* o = (row < MP) ? F.out + OUT_Y_P + (size_t)row * D : F.out + OUT_Y_S + (size_t)(row - MP) * D;
#pragma unroll
        for (int j = 0; j < 4; ++j) *((f32x4*)o + lane + 64 * j) = v[j] * rstd * *((const f32x4*)F.norm_final + lane + 64 * j);
    }
}

constexpr int NPHASE = 12;
struct Args { const void* in[21]; float* out; unsigned char* ws; int ph_lo, ph_hi; };
__global__ void __launch_bounds__(NWAVES * 64, 2) yoco_fwd(Args args) {
    extern __shared__ __attribute__((aligned(16))) unsigned char lds[];
    Frame F;
    F.lds = (LAS unsigned char*)lds;
    F.tid = threadIdx.x; F.lane = F.tid & 63; F.wave = __builtin_amdgcn_readfirstlane(F.tid >> 6);
    F.G = gridDim.x; { const int bx = blockIdx.x; F.vcu = (F.G % 8 == 0) ? (bx % 8) * (F.G / 8) + bx / 8 : bx; }
    F.x_p = (const float*)args.in[0]; F.x_s = (const float*)args.in[1]; F.state_pool = (const float*)args.in[2]; F.cache = (const float*)args.in[3]; F.state_win = (const float*)args.in[4];
    F.page_table = (const int*)args.in[5]; F.norm_mix = (const float*)args.in[6]; F.norm_mlp = (const float*)args.in[7]; F.w_up = (const float*)args.in[8]; F.w_down = (const float*)args.in[9];
    F.pool_w = (const float*)args.in[10]; F.pool_scale = (const float*)args.in[11]; F.norm_kv = (const float*)args.in[12]; F.w_kv = (const float*)args.in[13]; F.cmp_pe = (const float*)args.in[14];
    F.cmp_w1 = (const float*)args.in[15]; F.cmp_w2 = (const float*)args.in[16]; F.w_qg = (const float*)args.in[17]; F.b_gate = (const float*)args.in[18]; F.w_o = (const float*)args.in[19];
    F.norm_final = (const float*)args.in[20]; F.out = args.out; F.ws = args.ws;
    volatile LAS unsigned* MISC = (volatile LAS unsigned*)(F.lds + MISC_OFF);
    for (int u = F.tid; u < (LDS_BYTES - RING_BYTES) / 4; u += NWAVES * 64) ((LAS unsigned*)(F.lds + RING_BYTES))[u] = 0u;
    __syncthreads();
    unsigned* ctl = (unsigned*)(F.ws + WS_CTL);
#if MK_MULTI
#define GRID_BAR() do { } while (0)
#else
    XcdBarrier bar = xcd_barrier_post(ctl + CW_BAR, MISC + 8);
#define GRID_BAR() xcd_barrier(bar)
#endif
    F.seg_t0 = 0ull; F.seg_dt = 0ull;
    const int lo = args.ph_lo, hi = args.ph_hi;
#define IN(k) (lo <= (k) && (k) < hi)
#define SEAM(k) do { SEG_BEGIN(100 + (k)); if (IN(k) && IN((k) + 1)) GRID_BAR(); SEG_END(100 + (k)); SEG_END(k); SEG_BEGIN((k) + 1); } while (0)
    using namespace pg8;
    float* X = WSP(float, WS_X); bf16* XB = WSP(bf16, WS_XB); float* RS = WSP(float, WS_RS);

    SEG_BEGIN(0);
    if (IN(0)) { for (int rep = 0; rep < REP(0); ++rep) { p0_prologue(F); __syncthreads(); } } SEAM(0);
    if (IN(1)) {
        for (int rep = 0; rep < REP(16); ++rep) small_gemm<SG_POOL>(F, 0);
        Gemm g{WSP(bf16_t, WS_DIFF), WSP(bf16_t, WS_WPOOL), MP, 1024, 256, 1024, 256, (size_t)512}; StaticOrder S; S.init(MP, 1024, F.G, (int)blockIdx.x);
        EpiResid E{F.x_p, XB, RS, F.pool_scale};
        gemm_phase<EpiResid, StaticOrder, true, true>(F.lds, g, S, E);
    } SEAM(1);
    if (IN(2)) {
        SEG_BEGIN(60); for (int rep = 0; rep < REP(14); ++rep) small_gemm<SG_UP>(F, 0); SEG_END(60); SEG_BEGIN(61);
        Gemm g{XB, WSP(bf16_t, WS_WUP), MP, FF, D, D, D, (size_t)0}; StaticOrder S; S.init(MP, FF, F.G, (int)blockIdx.x);
        EpiUp E{WSP(bf16_t, WS_H), RS};
        for (int rep = 0; rep < REP(2); ++rep) { gemm_phase<EpiUp, StaticOrder, true, true>(F.lds, g, S, E); __syncthreads(); } SEG_END(61);
    } SEAM(2);
    if (IN(3)) {
        small_gemm<SG_DOWN>(F, 0);
        Gemm g{WSP(bf16_t, WS_H), WSP(bf16_t, WS_WDN), MP, D, FF, FF, FF, (size_t)0}; StaticOrder S; S.init(MP, D, F.G, (int)blockIdx.x);
        EpiResid E{nullptr, XB, RS, nullptr};
        gemm_phase<EpiResid, StaticOrder, true, true>(F.lds, g, S, E);
    } SEAM(3);
    if (IN(4)) {
        SEG_BEGIN(30); for (int rep = 0; rep < REP(15); ++rep) small_gemm<SG_KVQG>(F, 0); SEG_END(30);
        SEG_BEGIN(31); if ((blockIdx.x & 1) == 0) p5_sample_compress(F, ctl + CW_QUEUE, 3); SEG_END(31); SEG_BEGIN(32);
        Gemm g{XB, WSP(bf16_t, WS_WKVQG), MP, NKVQG, D, D, D, (size_t)0}; StaticOrder S; S.init(MP, NKVQG, F.G, (int)blockIdx.x);
        EpiKvqg E{RS, F.b_gate, F.out + OUT_KV_P, F.out + OUT_KV_S, F.out + OUT_WIN_P, F.out + OUT_WIN_S, WSP(bf16_t, WS_CMPA), WSP(bf16_t, WS_KVS), WSP(bf16_t, WS_KVW), WSP(bf16_t, WS_Q), WSP(float, WS_GATE)};
        gemm_phase<EpiKvqg, StaticOrder, true, true>(F.lds, g, S, E);
        __syncthreads(); SEG_END(32); SEG_BEGIN(33);
        p5_sample_compress(F, ctl + CW_QUEUE, 1 << 30); SEG_END(33);
    } SEAM(4);
    if (IN(5)) {
        SEG_BEGIN(50); p5_prompt_compress(F); SEG_END(50); SEG_BEGIN(51);
        if (F.G > 64) { if ((int)blockIdx.x >= 64) p6_combine(F, 0, (int)blockIdx.x - 64, F.G - 64); } else { __syncthreads(); p6_combine(F, 0, (int)blockIdx.x, F.G); } SEG_END(51);
    } SEAM(5);
    if (IN(6)) { p6_combine(F, 1, (int)blockIdx.x, F.G); } SEAM(6);
    if (IN(7)) { p7_attention(F); } SEAM(7);
    if (IN(8)) {
        SEG_BEGIN(70); small_gemm<SG_WO>(F, 0); SEG_END(70); SEG_BEGIN(71);
        Gemm g{WSP(bf16_t, WS_DIFF), WSP(bf16_t, WS_WO), MP, D, D, D, D, (size_t)0}; StaticOrder S; S.init(MP, D, F.G, (int)blockIdx.x);
        EpiResid E{nullptr, XB, RS, nullptr};
        gemm_phase<EpiResid, StaticOrder, true, true>(F.lds, g, S, E); SEG_END(71);
    } SEAM(8);
    if (IN(9)) {
        small_gemm<SG_UP>(F, 1);
        Gemm g{XB, WSP(bf16_t, WS_WUP) + (size_t)FF * D, MP, FF, D, D, D, (size_t)0}; StaticOrder S; S.init(MP, FF, F.G, (int)blockIdx.x);
        EpiUp E{WSP(bf16_t, WS_H), RS};
        gemm_phase<EpiUp, StaticOrder, true, true>(F.lds, g, S, E);
    } SEAM(9);
    if (IN(10)) {
        small_gemm<SG_DOWN>(F, 1);
        Gemm g{WSP(bf16_t, WS_H), WSP(bf16_t, WS_WDN) + (size_t)D * FF, MP, D, FF, FF, FF, (size_t)0}; StaticOrder S; S.init(MP, D, F.G, (int)blockIdx.x);
        EpiResid E{nullptr, XB, RS, nullptr};
        gemm_phase<EpiResid, StaticOrder, true, true>(F.lds, g, S, E);
    } SEAM(10);
    if (IN(11)) { p11_final(F); }
    SEG_END(11);
    if (PROBE_SEG >= 0) { __syncthreads(); const unsigned long long t1 = __builtin_amdgcn_s_memrealtime(); while (__builtin_amdgcn_s_memrealtime() - t1 < F.seg_dt) __builtin_amdgcn_s_sleep(8); }
#undef IN
#undef SEAM
}

extern "C" void kernel_launch(void* const* d_in, const int* in_sizes, int n_in, void* d_out, int out_size, void* d_ws, size_t ws_size, hipStream_t stream) {
    static int grid = 0;
    if (grid == 0) {
        if (n_in != 21 || (size_t)out_size != OUT_TOTAL || ws_size < WS_END) { fprintf(stderr, "kernel_launch: unexpected sizes n_in %d out %d ws %zu\n", n_in, out_size, ws_size); grid = -1; return; }
        int dev = 0, cus = 0, per_cu = 0;
        if (hipGetDevice(&dev) != hipSuccess || hipDeviceGetAttribute(&cus, hipDeviceAttributeMultiprocessorCount, dev) != hipSuccess) { grid = -1; return; }
        if (hipFuncSetAttribute((const void*)yoco_fwd, hipFuncAttributeMaxDynamicSharedMemorySize, LDS_BYTES) != hipSuccess) { fprintf(stderr, "kernel_launch: hipFuncSetAttribute failed\n"); grid = -1; return; }
        if (hipOccupancyMaxActiveBlocksPerMultiprocessor(&per_cu, (const void*)yoco_fwd, NWAVES * 64, LDS_BYTES) != hipSuccess || per_cu < 1) fprintf(stderr, "kernel_launch: occupancy query says %d\n", per_cu);
        (void)hipGetLastError();
        grid = cus;
    }
    if (grid < 0) return;
    (void)hipMemsetAsync((char*)d_ws + WS_CTL, 0, CTL_ZERO_BYTES, stream);
    Args a{};
    for (int i = 0; i < 21; ++i) a.in[i] = d_in[i];
    a.out = (float*)d_out; a.ws = (unsigned char*)d_ws;
#if MK_MULTI
    for (int p = 0; p < NPHASE; ++p) { a.ph_lo = p; a.ph_hi = p + 1; hipLaunchKernelGGL(yoco_fwd, dim3(grid), dim3(NWAVES * 64), LDS_BYTES, stream, a); }
#else
    a.ph_lo = 0; a.ph_hi = NPHASE;
    hipLaunchKernelGGL(yoco_fwd, dim3(grid), dim3(NWAVES * 64), LDS_BYTES, stream, a);
#endif
    const hipError_t le = hipPeekAtLastError();
    if (le != hipSuccess) fprintf(stderr, "kernel_launch: launch failed: %s\n", hipGetErrorName(le));
}
```

```cpp
#include <hip/hip_runtime.h>
#include <hip/hip_bf16.h>
#include <cstdio>
#include <cstdint>
#include <cmath>

#ifndef MK_MULTI
#define MK_MULTI 0
#endif

constexpr int D = 1024, FF = 4096, SEQ = 4096, NB = 4, DB = 128, PAST = 2048;
constexpr int MP = NB * SEQ;
constexpr int MT = MP + DB;
constexpr int MPAD = 16640;
constexpr int NKVQG = 2816;
constexpr int CMP_ROWS_P = NB * 256 * 4;
constexpr int CMP_ROWS_S = DB * 128 * 4;
constexpr int CMP_ROWS = CMP_ROWS_P + CMP_ROWS_S;
constexpr float RMS_EPS = 1e-6f;
constexpr float LOG2E = 1.4426950408889634f;
constexpr float QSCALE = 0.125f * LOG2E;

namespace pg8 {
#define PG8_LAS __attribute__((address_space(3)))
typedef unsigned short bf16_t;
typedef short bf16x8 __attribute__((ext_vector_type(8)));
typedef float f32x4 __attribute__((ext_vector_type(4)));
typedef float f32x2 __attribute__((ext_vector_type(2)));
typedef unsigned u32x4 __attribute__((ext_vector_type(4)));
typedef unsigned u32x2 __attribute__((ext_vector_type(2)));
constexpr int BM = 256, BK = 64, HALF = 128, HTB = HALF * BK * 2, STAGE_BYTES = 8 * HTB, NXCD = 8, WGM = 8;

__host__ __device__ __forceinline__ int lds_byte(int r, int c) { const int st = (r >> 4) * 2 + (c >> 5), rr = r & 15, cc = c & 31, ob = rr * 64 + cc * 2; return st * 1024 + (ob ^ (((ob >> 9) & 1) << 5)); }
__host__ __device__ __forceinline__ void stage_rc(int b, int& R, int& C) { const int st = b / 1024, sb = b % 1024, swz = sb ^ (((sb >> 9) & 1) << 5); R = (st >> 1) * 16 + swz / 64; C = (st & 1) * 32 + (swz % 64) / 2; }
__host__ __device__ __forceinline__ int perm32(int rho) { const int n = rho >> 4, i = rho & 15; return 8 * (i >> 2) + 4 * n + (i & 3); }

struct Unit { int pm, pn; };
struct Gemm { const bf16_t* A; const bf16_t* Bt; int M, N, K, lda, ldb; size_t a_pn_off; };

struct StaticOrder {
    int nM, nN, nwg, G, c;
    __host__ __device__ void init(int M, int N, int G_, int c_) { nM = M / BM; nN = N / BM; nwg = nM * nN; G = G_; c = c_; }
    __host__ __device__ bool next(int i, Unit& u) const {
        const long L = (long)i * G + c; if (L >= nwg) return false;
        int wgid = (int)L; { const int q = nwg / NXCD, r = nwg % NXCD, xcd = wgid % NXCD, off = wgid / NXCD; wgid = (xcd < r ? xcd * (q + 1) : r * (q + 1) + (xcd - r) * q) + off; }
        const int nig = WGM * nN, gid = wgid / nig, fm = gid * WGM, gsz = (nM - fm) < WGM ? (nM - fm) : WGM;
        u.pm = fm + ((wgid % nig) % gsz); u.pn = (wgid % nig) / gsz; return true;
    }
    __device__ __forceinline__ void a_ready(const Unit&) const {}
    __device__ __forceinline__ void done(const Unit&) const {}
};

__device__ __forceinline__ unsigned cvt_pk_bf16(float lo, float hi) { unsigned r; asm volatile("v_cvt_pk_bf16_f32 %0, %1, %2" : "=v"(r) : "v"(lo), "v"(hi)); return r; }

__device__ __forceinline__ float row_rstd(const float* rs, int row) {
    const f32x4* p = (const f32x4*)(rs + (size_t)row * 16); const f32x4 a = p[0], b = p[1], c = p[2], d = p[3];
    const float s = ((a[0] + a[1]) + (a[2] + a[3])) + ((b[0] + b[1]) + (b[2] + b[3])) + ((c[0] + c[1]) + (c[2] + c[3])) + ((d[0] + d[1]) + (d[2] + d[3]));
    return 1.0f / sqrtf(s * (1.0f / 1024.0f) + RMS_EPS);
}

struct EpiResid {
    static constexpr bool PERM = false, AFTER_DRAIN = false;
    const float* base_f; bf16_t* XB; float* RS; const float* scale;
    __device__ __forceinline__ void operator()(const f32x4 (&acc)[2][2][4][2], const Unit& u, int wr, int wc, int fr, int fq) const {
        const int col0 = u.pn * BM + wc * 32 + 4 * fq;
        f32x4 sc[2][2];
#pragma unroll
        for (int bj = 0; bj < 2; ++bj)
#pragma unroll
            for (int n = 0; n < 2; ++n) sc[bj][n] = scale ? *(const f32x4*)(scale + col0 + bj * HALF + n * 16) : (f32x4){1.f, 1.f, 1.f, 1.f};
#pragma unroll
        for (int ai = 0; ai < 2; ++ai) {
#pragma unroll
            for (int m = 0; m < 4; ++m) {
                const int row = u.pm * BM + ai * HALF + wr * 64 + m * 16 + fr;
                float ss = 0.f;
#pragma unroll
                for (int bj = 0; bj < 2; ++bj)
#pragma unroll
                    for (int n = 0; n < 2; ++n) {
                        const int col = col0 + bj * HALF + n * 16;
                        f32x4 bv;
                        if (base_f) bv = *(const f32x4*)(base_f + (size_t)row * D + col);
                        else { const u32x2 q = *(const u32x2*)(XB + (size_t)row * D + col); bv = (f32x4){__builtin_bit_cast(float, q.x << 16), __builtin_bit_cast(float, q.x & 0xffff0000u), __builtin_bit_cast(float, q.y << 16), __builtin_bit_cast(float, q.y & 0xffff0000u)}; }
                        const f32x4 v = bv + acc[ai][bj][m][n] * sc[bj][n];
                        u32x2 w; w.x = cvt_pk_bf16(v[0], v[1]); w.y = cvt_pk_bf16(v[2], v[3]);
                        *(u32x2*)(XB + (size_t)row * D + col) = w;
                        ss += (v[0] * v[0] + v[1] * v[1]) + (v[2] * v[2] + v[3] * v[3]);
                    }
                ss += __shfl_xor(ss, 16); ss += __shfl_xor(ss, 32);
                if (fq == 0) RS[(size_t)row * 16 + u.pn * 4 + wc] = ss;
            }
        }
    }
};

struct EpiUp {
    static constexpr bool PERM = true, AFTER_DRAIN = false;
    bf16_t* H; const float* RS;
    __device__ __forceinline__ void operator()(const f32x4 (&acc)[2][2][4][2], const Unit& u, int wr, int wc, int fr, int fq) const {
        const int col0 = u.pn * BM + wc * 32 + 8 * fq;
#pragma unroll
        for (int ai = 0; ai < 2; ++ai) {
            if (u.pm * BM + ai * HALF >= MT) continue;
#pragma unroll
            for (int m = 0; m < 4; ++m) {
                const int row = u.pm * BM + ai * HALF + wr * 64 + m * 16 + fr;
                const float rstd = row_rstd(RS, row);
#pragma unroll
                for (int bj = 0; bj < 2; ++bj) {
                    f32x4 v0 = acc[ai][bj][m][0] * rstd, v1 = acc[ai][bj][m][1] * rstd;
#pragma unroll
                    for (int e = 0; e < 4; ++e) { const float a = fmaxf(v0[e], 0.f), b = fmaxf(v1[e], 0.f); v0[e] = a * a; v1[e] = b * b; }
                    u32x4 w; w.x = cvt_pk_bf16(v0[0], v0[1]); w.y = cvt_pk_bf16(v0[2], v0[3]); w.z = cvt_pk_bf16(v1[0], v1[1]); w.w = cvt_pk_bf16(v1[2], v1[3]);
                    *(u32x4*)(H + (size_t)row * FF + col0 + bj * HALF) = w;
                }
            }
        }
    }
};

struct EpiKvqg {
    static constexpr bool PERM = true, AFTER_DRAIN = false;
    const float* RS; const float* bgate;
    float* kv_p; float* kv_s; float* win_p; float* win_s;
    bf16_t* CMPA; bf16_t* KVS; bf16_t* KVW; bf16_t* Q; float* GATE;
    __device__ __forceinline__ void operator()(const f32x4 (&acc)[2][2][4][2], const Unit& u, int wr, int wc, int fr, int fq) const {
        const int pn = u.pn;
#pragma unroll
        for (int ai = 0; ai < 2; ++ai) {
            if (u.pm * BM + ai * HALF >= MT) continue;
#pragma unroll
            for (int m = 0; m < 4; ++m) {
                const int row = u.pm * BM + ai * HALF + wr * 64 + m * 16 + fr;
                const float rstd = row_rstd(RS, row);
                const bool prompt = row < MP; const int b = prompt ? (row >> 12) : (row - MP), t = row & (SEQ - 1);
#pragma unroll
                for (int bj = 0; bj < 2; ++bj) {
                    const int cin = bj * HALF + wc * 32 + 8 * fq;
                    const f32x4 v0 = acc[ai][bj][m][0] * rstd, v1 = acc[ai][bj][m][1] * rstd;
                    u32x4 w; w.x = cvt_pk_bf16(v0[0], v0[1]); w.y = cvt_pk_bf16(v0[2], v0[3]); w.z = cvt_pk_bf16(v1[0], v1[1]); w.w = cvt_pk_bf16(v1[2], v1[3]);
                    if (pn < 4) {
                        float* o = prompt ? kv_p + (size_t)row * D : kv_s + (size_t)b * D;
                        *(f32x4*)(o + pn * BM + cin) = v0; *(f32x4*)(o + pn * BM + cin + 4) = v1;
                        if (pn < 2) {
                            if (prompt) { const int g = cin >> 6, d = cin & 63;
                                *(u32x4*)(CMPA + (size_t)pn * CMP_ROWS * D + (size_t)(((b * 256 + (t >> 4)) * 4 + g)) * D + (t & 15) * 64 + d) = w; }
                        } else *(u32x4*)(KVS + (size_t)row * 512 + (pn - 2) * BM + cin) = w;
                    } else if (pn < 6) {
                        const int c = (pn - 4) * BM + cin;
                        *(u32x4*)(KVW + (size_t)row * 512 + c) = w;
                        if (prompt) { if (t >= SEQ - 512) { float* o = win_p + ((size_t)b * 512 + (t - (SEQ - 512))) * 512 + c; *(f32x4*)o = v0; *(f32x4*)(o + 4) = v1; } }
                        else { float* o = win_s + ((size_t)b * 512 + 511) * 512 + c; *(f32x4*)o = v0; *(f32x4*)(o + 4) = v1; }
                    } else if (pn < 10) {
                        *(u32x4*)(Q + (size_t)row * D + (pn - 6) * BM + cin) = w;
                    } else {
                        if (cin < 48) {
#pragma unroll
                            for (int e = 0; e < 4; ++e) { GATE[(size_t)row * 48 + cin + e] = 1.0f / (1.0f + __expf(-(v0[e] + bgate[cin + e]))); GATE[(size_t)row * 48 + cin + 4 + e] = 1.0f / (1.0f + __expf(-(v1[e] + bgate[cin + 4 + e]))); }
                        }
                    }
                }
            }
        }
    }
};

struct EpiCmp {
    static constexpr bool PERM = false, AFTER_DRAIN = false;
    float* P;
    __device__ __forceinline__ void operator()(const f32x4 (&acc)[2][2][4][2], const Unit& u, int wr, int wc, int fr, int fq) const {
        float* base = P + (size_t)u.pn * CMP_ROWS * 256;
#pragma unroll
        for (int ai = 0; ai < 2; ++ai)
#pragma unroll
            for (int m = 0; m < 4; ++m) {
                const int row = u.pm * BM + ai * HALF + wr * 64 + m * 16 + fr;
#pragma unroll
                for (int bj = 0; bj < 2; ++bj)
#pragma unroll
                    for (int n = 0; n < 2; ++n) *(f32x4*)(base + (size_t)row * 256 + bj * HALF + wc * 32 + n * 16 + 4 * fq) = acc[ai][bj][m][n];
            }
    }
};

template <class Epi, class Sched, bool ALIGN_EPI = false, bool SP2 = false>
__device__ __forceinline__ void gemm_phase(PG8_LAS unsigned char* lds, const Gemm g, const Sched& S, const Epi& E) {
    const int tid = threadIdx.x, wid = __builtin_amdgcn_readfirstlane(tid >> 6), lane = tid & 63, wr = wid >> 2, wc = wid & 3, fr = lane & 15, fq = lane >> 4;
    const int K = g.K, nt = K / BK;
    unsigned voffA[2], voffB[2];
#pragma unroll
    for (int i = 0; i < 2; ++i) { int R, C; stage_rc(tid * 16 + i * 8192, R, C); const int Rb = Epi::PERM ? ((R & ~31) + perm32(R & 31)) : R;
        voffA[i] = (unsigned)(R * g.lda + C) * 2u; voffB[i] = (unsigned)(Rb * g.ldb + C) * 2u; }
    const size_t kstep = (size_t)(BK * 2);
    const size_t hstepA = (size_t)HALF * g.lda * 2, hstepB = (size_t)HALF * g.ldb * 2;
    const size_t tstepA = 2 * hstepA, tstepB = 2 * hstepB;
    const unsigned ldsw = (unsigned)wid * 1024u;
    const int aoff = lds_byte(wr * 64 + fr, fq * 8), boff = lds_byte(wc * 32 + fr, fq * 8);
#define PG8_SA(b, h) (((b) * 2 + (h)) * HTB)
#define PG8_SB(b, h) ((4 + (b) * 2 + (h)) * HTB)
#define PG8_STAGE(bufoff, gbase, voff) do { _Pragma("unroll") for (int _i = 0; _i < 2; ++_i) \
        __builtin_amdgcn_global_load_lds((const unsigned*)((const char*)(gbase) + (voff)[_i]), (PG8_LAS unsigned*)(lds + (bufoff) + ldsw + _i * 8192), 16, 0, 0); } while (0)
#define PG8_LDA(dst, b, h) do { _Pragma("unroll") for (int m = 0; m < 4; ++m) _Pragma("unroll") for (int k = 0; k < 2; ++k) dst[m][k] = *(const PG8_LAS bf16x8*)(lds + PG8_SA(b, h) + aoff + m * 2048 + k * 1024); } while (0)
#define PG8_LDB(dst, b, h) do { _Pragma("unroll") for (int n = 0; n < 2; ++n) _Pragma("unroll") for (int k = 0; k < 2; ++k) dst[n][k] = *(const PG8_LAS bf16x8*)(lds + PG8_SB(b, h) + boff + n * 2048 + k * 1024); } while (0)
#define PG8_MMA(ai, bj, At, Bt) do { __builtin_amdgcn_s_setprio(1); _Pragma("unroll") for (int m = 0; m < 4; ++m) _Pragma("unroll") for (int n = 0; n < 2; ++n) _Pragma("unroll") for (int k = 0; k < 2; ++k) \
        acc[ai][bj][m][n] = __builtin_amdgcn_mfma_f32_16x16x32_bf16(Bt[n][k], At[m][k], acc[ai][bj][m][n], 0, 0, 0); __builtin_amdgcn_s_setprio(0); } while (0)
#define PG8_WAIT_V(n) asm volatile("s_waitcnt vmcnt(" #n ")" ::: "memory")
#define PG8_WAIT_L(n) asm volatile("s_waitcnt lgkmcnt(" #n ")" ::: "memory")
#define PG8_BAR __builtin_amdgcn_s_barrier()
#define PG8_SCHED __builtin_amdgcn_sched_barrier(0)
    Unit cur, nxt; int ui = 0;
    if (!S.next(0, cur)) return;
    f32x4 acc[2][2][4][2];
#pragma unroll
    for (int a = 0; a < 2; ++a)
#pragma unroll
        for (int b = 0; b < 2; ++b)
#pragma unroll
            for (int m = 0; m < 4; ++m)
#pragma unroll
                for (int n = 0; n < 2; ++n) acc[a][b][m][n] = (f32x4){0.f, 0.f, 0.f, 0.f};
    bf16x8 At[4][2], B0[2][2], B1[2][2];
    const char* cA = (const char*)g.A + (size_t)cur.pm * tstepA + (size_t)cur.pn * g.a_pn_off; const char* cB = (const char*)g.Bt + (size_t)cur.pn * tstepB;
    S.a_ready(cur);
    if constexpr (SP2) {
        PG8_STAGE(PG8_SB(0, 0), cB, voffB); PG8_STAGE(PG8_SB(0, 1), cB + hstepB, voffB); PG8_STAGE(PG8_SA(0, 0), cA, voffA); PG8_STAGE(PG8_SA(0, 1), cA + hstepA, voffA);
        if (wr == 1) PG8_BAR;
        PG8_WAIT_V(2); PG8_BAR;
        PG8_STAGE(PG8_SB(1, 0), cB + kstep, voffB); PG8_STAGE(PG8_SA(1, 0), cA + kstep, voffA); PG8_STAGE(PG8_SB(1, 1), cB + hstepB + kstep, voffB);
        PG8_WAIT_V(6); PG8_BAR;
    } else {
        PG8_STAGE(PG8_SB(0, 0), cB, voffB); PG8_STAGE(PG8_SA(0, 0), cA, voffA); PG8_STAGE(PG8_SB(0, 1), cB + hstepB, voffB); PG8_STAGE(PG8_SA(0, 1), cA + hstepA, voffA);
        if (wr == 1) PG8_BAR;
        PG8_WAIT_V(4); PG8_BAR;
        PG8_STAGE(PG8_SB(1, 0), cB + kstep, voffB); PG8_STAGE(PG8_SA(1, 0), cA + kstep, voffA); PG8_STAGE(PG8_SB(1, 1), cB + hstepB + kstep, voffB);
        PG8_WAIT_V(6); PG8_BAR;
    }
    for (;;) {
        const bool has_next = S.next(ui + 1, nxt);
        const char* nA = has_next ? (const char*)g.A + (size_t)nxt.pm * tstepA + (size_t)nxt.pn * g.a_pn_off : cA; const char* nB = has_next ? (const char*)g.Bt + (size_t)nxt.pn * tstepB : cB;
        for (int t = 0; t < nt; t += 2) {
            const bool last = (t == nt - 2);
            const char* a1 = cA + (size_t)(t + 1) * kstep;
            const char* a2 = last ? nA : cA + (size_t)(t + 2) * kstep; const char* b2 = last ? nB : cB + (size_t)(t + 2) * kstep;
            const char* a3 = a2 + kstep; const char* b3 = b2 + kstep;
            if (last && has_next) S.a_ready(nxt);
            if constexpr (SP2) {
            PG8_LDB(B0, 0, 0); PG8_LDB(B1, 0, 1); PG8_SCHED; PG8_LDA(At, 0, 0); PG8_STAGE(PG8_SA(1, 1), a1 + hstepA, voffA);
            PG8_WAIT_V(8); PG8_WAIT_L(0); PG8_BAR; PG8_MMA(0, 0, At, B0); PG8_MMA(0, 1, At, B1); PG8_BAR; PG8_SCHED;
            PG8_LDA(At, 0, 1); PG8_STAGE(PG8_SB(0, 0), b2, voffB); PG8_STAGE(PG8_SB(0, 1), b2 + hstepB, voffB); PG8_STAGE(PG8_SA(0, 0), a2, voffA);
            PG8_WAIT_V(8); PG8_WAIT_L(0); PG8_BAR; PG8_MMA(1, 0, At, B0); PG8_MMA(1, 1, At, B1); PG8_BAR; PG8_SCHED;
            PG8_LDB(B0, 1, 0); PG8_LDB(B1, 1, 1); PG8_SCHED; PG8_LDA(At, 1, 0); PG8_STAGE(PG8_SA(0, 1), a2 + hstepA, voffA);
            PG8_WAIT_V(8); PG8_WAIT_L(0); PG8_BAR; PG8_MMA(0, 0, At, B0); PG8_MMA(0, 1, At, B1); PG8_BAR; PG8_SCHED;
            PG8_LDA(At, 1, 1); PG8_STAGE(PG8_SB(1, 0), b3, voffB); PG8_STAGE(PG8_SB(1, 1), b3 + hstepB, voffB); PG8_STAGE(PG8_SA(1, 0), a3, voffA);
            PG8_WAIT_V(8); PG8_WAIT_L(0); PG8_BAR; PG8_MMA(1, 0, At, B0); PG8_MMA(1, 1, At, B1); PG8_BAR; PG8_SCHED;
            } else {
            PG8_LDB(B0, 0, 0); PG8_SCHED; PG8_LDA(At, 0, 0); PG8_STAGE(PG8_SA(1, 1), a1 + hstepA, voffA);
            PG8_WAIT_L(8); PG8_BAR; PG8_WAIT_L(0); PG8_MMA(0, 0, At, B0); PG8_BAR; PG8_SCHED;
            PG8_LDB(B1, 0, 1); PG8_STAGE(PG8_SB(0, 0), b2, voffB);
            PG8_BAR; PG8_WAIT_L(0); PG8_MMA(0, 1, At, B1); PG8_BAR;
            PG8_LDA(At, 0, 1); PG8_STAGE(PG8_SA(0, 0), a2, voffA);
            PG8_BAR; PG8_WAIT_L(0); PG8_MMA(1, 0, At, B0); PG8_BAR; PG8_SCHED;
            PG8_STAGE(PG8_SB(0, 1), b2 + hstepB, voffB);
            PG8_WAIT_V(6); PG8_BAR; PG8_MMA(1, 1, At, B1); PG8_BAR;
            PG8_LDB(B0, 1, 0); PG8_SCHED; PG8_LDA(At, 1, 0); PG8_STAGE(PG8_SA(0, 1), a2 + hstepA, voffA);
            PG8_WAIT_L(8); PG8_BAR; PG8_WAIT_L(0); PG8_MMA(0, 0, At, B0); PG8_BAR; PG8_SCHED;
            PG8_LDB(B1, 1, 1); PG8_STAGE(PG8_SB(1, 0), b3, voffB);
            PG8_BAR; PG8_WAIT_L(0); PG8_MMA(0, 1, At, B1); PG8_BAR;
            PG8_LDA(At, 1, 1); PG8_STAGE(PG8_SA(1, 0), a3, voffA);
            PG8_BAR; PG8_WAIT_L(0); PG8_MMA(1, 0, At, B0); PG8_BAR; PG8_SCHED;
            PG8_STAGE(PG8_SB(1, 1), b3 + hstepB, voffB);
            PG8_WAIT_V(6); PG8_BAR; PG8_MMA(1, 1, At, B1); PG8_BAR;
            }
        }
        if constexpr (ALIGN_EPI) { if (wr == 0) PG8_BAR; }
        if constexpr (!Epi::AFTER_DRAIN) { E(acc, cur, wr, wc, fr, fq); S.done(cur); }
        if (!has_next) break;
#pragma unroll
        for (int a = 0; a < 2; ++a)
#pragma unroll
            for (int b = 0; b < 2; ++b)
#pragma unroll
                for (int m = 0; m < 4; ++m)
#pragma unroll
                    for (int n = 0; n < 2; ++n) acc[a][b][m][n] = (f32x4){0.f, 0.f, 0.f, 0.f};
        cur = nxt; cA = nA; cB = nB; ++ui;
        if constexpr (ALIGN_EPI) { if (wr == 1) PG8_BAR; }
    }
    PG8_WAIT_V(0);
    if constexpr (!ALIGN_EPI) { if (wr == 0) PG8_BAR; }
    PG8_BAR;
    if constexpr (Epi::AFTER_DRAIN) { E.fused(acc, cur, wr, wc, fr, fq, lds, wid, lane); S.done(cur); }
#undef PG8_SA
#undef PG8_SB
#undef PG8_STAGE
#undef PG8_LDA
#undef PG8_LDB
#undef PG8_MMA
#undef PG8_WAIT_V
#undef PG8_WAIT_L
#undef PG8_BAR
#undef PG8_SCHED
}
}

#define GAS __attribute__((address_space(1)))
#define LAS __attribute__((address_space(3)))
typedef unsigned short bf16;
typedef unsigned v4u __attribute__((ext_vector_type(4)));
typedef unsigned v2u __attribute__((ext_vector_type(2)));
typedef float f32x4 __attribute__((ext_vector_type(4)));
typedef float f32x2 __attribute__((ext_vector_type(2)));
typedef float f32x16 __attribute__((ext_vector_type(16)));
typedef short bf16x8 __attribute__((ext_vector_type(8)));
typedef short v4i16_t __attribute__((ext_vector_type(4)));
typedef GAS unsigned gu32;
typedef GAS unsigned long long gu64;
#define RLX_AGENT __ATOMIC_RELAXED, __HIP_MEMORY_SCOPE_AGENT
#define LDS_WAIT() asm volatile("s_waitcnt lgkmcnt(0)" ::: "memory")
#define VM_WAIT() asm volatile("s_waitcnt vmcnt(0)" ::: "memory")
__device__ __forceinline__ unsigned f2bf(float f) { unsigned u = __builtin_bit_cast(unsigned, f); return (u + 0x7fffu + ((u >> 16) & 1u)) >> 16; }
__device__ __forceinline__ unsigned pk2(float lo, float hi) { return f2bf(lo) | (f2bf(hi) << 16); }
__device__ __forceinline__ float bf2f(unsigned short h) { return __builtin_bit_cast(float, (unsigned)h << 16); }

#define XB_TMO      128
#define XB_XCNT(j)  (256  + 64 * (j))
#define XB_XSUB(j)  (1280 + 64 * (j))
#define XB_XGEN(j)  (2304 + 64 * (j))
#define XB_TOP      3328
#define XB_TOPGEN   3392
#define XCD_BAR_WORDS 3456
#define XB_SPIN_CAP (1u << 18)

__device__ __forceinline__ unsigned xb_ld(unsigned* p)              { return __hip_atomic_load(p, __ATOMIC_RELAXED, __HIP_MEMORY_SCOPE_AGENT); }
__device__ __forceinline__ unsigned xb_add(unsigned* p, unsigned v) { return __hip_atomic_fetch_add(p, v, __ATOMIC_RELAXED, __HIP_MEMORY_SCOPE_AGENT); }
__device__ __forceinline__ unsigned xb_xcc_id() { return (unsigned)__builtin_amdgcn_s_getreg((3 << 11) | 20) & 0xFu; }
#define XB_SPIN(cond, bar) do { unsigned _sp = 0; while (cond) { __builtin_amdgcn_s_sleep(1); \
    if ((++_sp & 255u) == 0u) { if (xb_ld(&(bar)[XB_TMO])) break; if (_sp > XB_SPIN_CAP) { atomicAdd(&(bar)[XB_TMO], 1u); break; } } } } while (0)

struct XcdBarrier {
    unsigned* bar; unsigned x;
    volatile LAS unsigned* st;
};

__device__ __forceinline__ XcdBarrier xcd_barrier_post(unsigned* bar, volatile LAS unsigned* st) {
    XcdBarrier b; b.bar = bar; b.x = xb_xcc_id(); b.st = st;
    if (threadIdx.x == 0) (void)xb_add(&bar[XB_XCNT(b.x)], 1u);
    return b;
}
__device__ __forceinline__ void xcd_barrier_complete(unsigned* bar, unsigned x, unsigned& nloc, unsigned& nx) {
    const unsigned G = gridDim.x * gridDim.y * gridDim.z;
    unsigned sum, cnt, mine, sp = 0u;
    for (;;) {
        sum = 0u; cnt = 0u; mine = 0u;
#pragma unroll
        for (unsigned j = 0; j < 16; ++j) { const unsigned c = xb_ld(&bar[XB_XCNT(j)]); sum += c; cnt += (c > 0u) ? 1u : 0u; mine = (j == x) ? c : mine; }
        if (sum == G) break;
        __builtin_amdgcn_s_sleep(1);
        if ((++sp & 255u) == 0u) { if (xb_ld(&bar[XB_TMO])) break; if (sp > XB_SPIN_CAP) { atomicAdd(&bar[XB_TMO], 1u); break; } }
    }
    nloc = mine > 0u ? mine : 1u; nx = cnt > 0u ? cnt : 1u;
}

__device__ __forceinline__ void xcd_barrier(const XcdBarrier& b) {
    asm volatile("s_waitcnt vmcnt(0)" ::: "memory");
    __syncthreads();
    if (threadIdx.x == 0) {
        unsigned* bar = b.bar;
        __builtin_amdgcn_s_waitcnt(0);
        unsigned nloc = b.st[0], nx = b.st[1];
        if (nloc == 0u) { xcd_barrier_complete(bar, b.x, nloc, nx); b.st[0] = nloc; b.st[1] = nx; }
        const unsigned old = xb_add(&bar[XB_XSUB(b.x)], 1u);
        const unsigned gen = old / nloc;
        if (old + 1u == (gen + 1u) * nloc) {
            __builtin_amdgcn_fence(__ATOMIC_RELEASE, "agent");
            asm volatile("s_waitcnt vmcnt(0)" ::: "memory");
            const unsigned og = xb_add(&bar[XB_TOP], 1u);
            const unsigned tg = og / nx;
            if (og + 1u == (tg + 1u) * nx) xb_add(&bar[XB_TOPGEN], 1u);
            else XB_SPIN(xb_ld(&bar[XB_TOPGEN]) == tg, bar);
            __builtin_amdgcn_fence(__ATOMIC_ACQUIRE, "agent");
            xb_add(&bar[XB_XGEN(b.x)], 1u);
            asm volatile("s_waitcnt vmcnt(0)" ::: "memory");
        } else {
            XB_SPIN(xb_ld(&bar[XB_XGEN(b.x)]) == gen, bar);
            __builtin_amdgcn_fence(__ATOMIC_ACQUIRE, "agent");
            asm volatile("s_waitcnt vmcnt(0)" ::: "memory");
        }
    }
    __syncthreads();
}

constexpr size_t MiB = 1u << 20;
constexpr size_t WS_CTL = 0, CTL_ZERO_BYTES = 1 * MiB;
constexpr size_t WS_WUP = 2 * MiB;
constexpr size_t WS_WDN = 18 * MiB;
constexpr size_t WS_WKVQG = 34 * MiB;
constexpr size_t WS_WO = 40 * MiB;
constexpr size_t WS_WPOOL = 42 * MiB;
constexpr size_t WS_W1CAT = 43 * MiB;
constexpr size_t WS_CBIAS = 44 * MiB;
constexpr size_t WS_RS = 45 * MiB;
constexpr size_t WS_GATE = 47 * MiB;
constexpr size_t WS_X = 52 * MiB;
constexpr size_t WS_XB = 118 * MiB;
constexpr size_t WS_DIFF = 152 * MiB;
constexpr size_t WS_Q = 186 * MiB;
constexpr size_t WS_KVS = 220 * MiB;
constexpr size_t WS_KVW = 238 * MiB;
constexpr size_t WS_KC = 256 * MiB;
constexpr size_t WS_KCS = 258 * MiB;
constexpr size_t WS_H = 292 * MiB;
constexpr size_t WS_CMPA = 424 * MiB;
constexpr size_t WS_CMPP = 700 * MiB;
constexpr size_t WS_END = 840 * MiB;
constexpr int CW_BAR = 4096;

constexpr size_t OUT_Y_P = 0, OUT_Y_S = 16777216, OUT_POOL_P = 16908288, OUT_POOL_S = 16969728, OUT_KV_P = 18935808, OUT_KV_S = 35713024, OUT_WIN_P = 35844096, OUT_WIN_S = 36892672, OUT_TOTAL = 70447104;

#ifndef PROBE_DUP
#define PROBE_DUP 0
#endif
#define REP(k) (1 + ((PROBE_DUP >> (k)) & 1))
constexpr int NWAVES = 8;
constexpr int RING_BYTES = 131072, MISC_OFF = RING_BYTES + 320, LDS_BYTES = 147456;

#ifndef PROBE_SEG
#define PROBE_SEG -1
#endif
#define SEG_BEGIN(id) do { if (PROBE_SEG == (id)) F.seg_t0 = __builtin_amdgcn_s_memrealtime(); } while (0)
#define SEG_END(id) do { if (PROBE_SEG == (id)) F.seg_dt += __builtin_amdgcn_s_memrealtime() - F.seg_t0; } while (0)
struct Frame {
    unsigned long long seg_t0, seg_dt;
    LAS unsigned char* lds;
    int tid, lane, wave, vcu, G;
    const float *x_p, *x_s, *state_pool, *cache, *state_win; const int* page_table;
    const float *norm_mix, *norm_mlp, *w_up, *w_down, *pool_w, *pool_scale, *norm_kv, *w_kv, *cmp_pe, *cmp_w1, *cmp_w2, *w_qg, *b_gate, *w_o, *norm_final;
    float* out; unsigned char* ws;
};
#define WSP(T, off) ((T*)(F.ws + (off)))

__device__ __forceinline__ unsigned cvtpk(float lo, float hi) { typedef __bf16 bf16x2_t __attribute__((ext_vector_type(2))); f32x2 v = {lo, hi}; bf16x2_t b = __builtin_convertvector(v, bf16x2_t); return __builtin_bit_cast(unsigned, b); }
__device__ __forceinline__ bf16x8 cvt8(const f32x4 a, const f32x4 b) { v4u w; w.x = cvtpk(a[0], a[1]); w.y = cvtpk(a[2], a[3]); w.z = cvtpk(b[0], b[1]); w.w = cvtpk(b[2], b[3]); return __builtin_bit_cast(bf16x8, w); }
__device__ __forceinline__ float wave_sum(float v) {
#pragma unroll
    for (int o = 1; o < 64; o <<= 1) v += __shfl_xor(v, o);
    return v;
}
__device__ __forceinline__ float wave_max(float v) {
#pragma unroll
    for (int o = 1; o < 64; o <<= 1) v = fmaxf(v, __shfl_xor(v, o));
    return v;
}

struct TItem { const float* W; bf16* WT; const float* kscale; int N, ldt, row_off, kb, nb; float scale; };
constexpr int TP = 260;
__device__ __forceinline__ void ti_load(const TItem& t, f32x4 (&wv)[8], int tid) {
    const int k0 = 64 * t.kb, col = 256 * t.nb + 4 * (tid & 63);
#pragma unroll
    for (int e = 0; e < 8; ++e) wv[e] = (col < t.N) ? *(const f32x4*)(t.W + (size_t)(k0 + (tid >> 6) + 8 * e) * t.N + col) : (f32x4){0.f, 0.f, 0.f, 0.f};
}
__device__ __forceinline__ void ti_stage(const f32x4 (&wv)[8], LAS float* T, int tid) {
#pragma unroll
    for (int e = 0; e < 8; ++e) *(LAS f32x4*)(T + ((tid >> 6) + 8 * e) * TP + 4 * (tid & 63)) = wv[e];
}
__device__ __forceinline__ void ti_write(const TItem& t, const LAS float* T, int tid) {
    const int n = tid >> 1, kh = 32 * (tid & 1), k0 = 64 * t.kb;
    float ks[32];
#pragma unroll
    for (int i = 0; i < 8; ++i) { const f32x4 q = t.kscale ? *(const f32x4*)(t.kscale + k0 + kh + 4 * i) : (f32x4){1.f, 1.f, 1.f, 1.f}; ks[4 * i] = q[0] * t.scale; ks[4 * i + 1] = q[1] * t.scale; ks[4 * i + 2] = q[2] * t.scale; ks[4 * i + 3] = q[3] * t.scale; }
    const LAS float* c = T + kh * TP + n;
    if (256 * t.nb + n < t.N) {
        bf16* dst = t.WT + (size_t)(t.row_off + 256 * t.nb + n) * t.ldt + k0 + kh;
#pragma unroll
        for (int j = 0; j < 4; ++j) { v4u o;
            o.x = pk2(c[(8 * j + 0) * TP] * ks[8 * j + 0], c[(8 * j + 1) * TP] * ks[8 * j + 1]); o.y = pk2(c[(8 * j + 2) * TP] * ks[8 * j + 2], c[(8 * j + 3) * TP] * ks[8 * j + 3]);
            o.z = pk2(c[(8 * j + 4) * TP] * ks[8 * j + 4], c[(8 * j + 5) * TP] * ks[8 * j + 5]); o.w = pk2(c[(8 * j + 6) * TP] * ks[8 * j + 6], c[(8 * j + 7) * TP] * ks[8 * j + 7]);
            *(v4u*)(dst + 8 * j) = o; }
    }
}

__device__ __forceinline__ void p0_prologue(Frame& F) {
    const int gw = F.vcu * NWAVES + F.wave, NGW = F.G * NWAVES, lane = F.lane;
    bf16* WUP = WSP(bf16, WS_WUP); bf16* WDN = WSP(bf16, WS_WDN); bf16* WKVQG = WSP(bf16, WS_WKVQG); bf16* WO = WSP(bf16, WS_WO); bf16* WPOOL = WSP(bf16, WS_WPOOL); bf16* W1CAT = WSP(bf16, WS_W1CAT);
    SEG_BEGIN(40);
    constexpr int I_UP = 256, I_DN = 256, I_KV = 96, I_QG = 80, I_WO = 64, I_PL = 4, I_C1 = 16;
    constexpr int NITEMS = 2 * I_UP + 2 * I_DN + I_KV + I_QG + I_WO + 4 * I_PL + 4 * I_C1;
    auto decode = [&](int it) -> TItem {
        int r = it; TItem t;
        if (r < 2 * I_UP) { const int l = r / I_UP; r %= I_UP; t = TItem{F.w_up + (size_t)l * D * FF, WUP + (size_t)l * FF * D, F.norm_mlp + l * D, FF, D, 0, r / 16, r % 16, 1.f}; return t; } r -= 2 * I_UP;
        if (r < 2 * I_DN) { const int l = r / I_DN; r %= I_DN; t = TItem{F.w_down + (size_t)l * FF * D, WDN + (size_t)l * D * FF, nullptr, D, FF, 0, r / 4, r % 4, 1.f}; return t; } r -= 2 * I_DN;
        if (r < I_KV) { t = TItem{F.w_kv, WKVQG, F.norm_kv, 1536, D, 0, r / 6, r % 6, 1.f}; return t; } r -= I_KV;
        if (r < I_QG) { const int nb = r % 5; t = TItem{F.w_qg, WKVQG, F.norm_mix + D, 1072, D, 1536, r / 5, nb, nb < 4 ? QSCALE : 1.f}; return t; } r -= I_QG;
        if (r < I_WO) { t = TItem{F.w_o, WO, nullptr, D, D, 0, r / 4, r % 4, 1.f}; return t; } r -= I_WO;
        if (r < 4 * I_PL) { const int g = r / I_PL; r %= I_PL; t = TItem{F.pool_w + (size_t)g * 65536, WPOOL + (size_t)g * 65536, nullptr, 256, 256, 0, r, 0, 1.f}; return t; } r -= 4 * I_PL;
        { const int kvh = r / I_C1; r %= I_C1; const int kv = kvh >> 1, half = kvh & 1;
          t = TItem{F.cmp_w1 + (size_t)kv * 2048 * 128 + (size_t)half * 1024 * 128, W1CAT + (size_t)kv * 256 * D, nullptr, 128, D, half * 128, r, 0, 1.f}; return t; }
    };
    {
        LAS float* T = (LAS float*)F.lds; f32x4 wv[8];
        int it = F.vcu; TItem tc;
        if (it < NITEMS) { tc = decode(it); ti_load(tc, wv, F.tid); }
        while (it < NITEMS) {
            ti_stage(wv, T, F.tid);
            __syncthreads();
            const int i2 = it + F.G; TItem tn = tc; if (i2 < NITEMS) { tn = decode(i2); ti_load(tn, wv, F.tid); }
            ti_write(tc, T, F.tid);
            __syncthreads();
            tc = tn; it = i2;
        }
    }
    { const int gt = F.vcu * 512 + F.tid, NT = F.G * 512; v4u* z = (v4u*)(WKVQG + (size_t)2608 * D);
      for (int i = gt; i < 208 * D / 8; i += NT) z[i] = (v4u){0u, 0u, 0u, 0u}; }
    { float* CB = WSP(float, WS_CBIAS);
      const int cb0 = (NGW >= 1024) ? 512 : 0;
      for (int it = gw - cb0; it >= 0 && it < 64; it += NGW) { const int kv = it >> 5, kc0 = (it & 31) * 64; float a0 = 0.f, a1 = 0.f;
#pragma unroll 16
          for (int k = 0; k < 64; ++k) { const float p = F.cmp_pe[kv * 2048 + kc0 + k]; const float* wr = F.cmp_w1 + ((size_t)kv * 2048 + kc0 + k) * 128; a0 += p * wr[lane]; a1 += p * wr[64 + lane]; }
          CB[(size_t)it * 128 + lane] = a0; CB[(size_t)it * 128 + 64 + lane] = a1; } }
    SEG_END(40); SEG_BEGIN(41);
    bf16* DIFF = WSP(bf16, WS_DIFF);
    if (F.wave == 0)
    for (int b = F.G - 1 - F.vcu; b < DB; b += F.G) {
        const f32x4* xr = (const f32x4*)(F.x_s + (size_t)b * D) + lane; f32x4 v[4]; float ss = 0.f;
#pragma unroll
        for (int j = 0; j < 4; ++j) { v[j] = xr[64 * j]; ss += (v[j][0] * v[j][0] + v[j][1] * v[j][1]) + (v[j][2] * v[j][2] + v[j][3] * v[j][3]); }
        const float rstd = 1.0f / sqrtf(wave_sum(ss) * (1.0f / D) + RMS_EPS);
        const float* sp = F.state_pool + (size_t)b * 15 * D; float* ps = F.out + OUT_POOL_S + (size_t)b * 15 * D;
#pragma unroll
        for (int j = 0; j < 4; ++j) {
            const int col = 256 * j + 4 * lane; const f32x4 gg = *(const f32x4*)(F.norm_mix + col); const f32x4 u = v[j] * rstd * gg;
            f32x4 st[15];
#pragma unroll
            for (int r = 0; r < 15; ++r) st[r] = *(const f32x4*)(sp + (size_t)r * D + col);
            f32x4 sum = u; const int w = 2 << j;
#pragma unroll
            for (int r = 0; r < 15; ++r) if (r < w - 1) sum += st[14 - r];
            const f32x4 df = sum * (1.0f / (float)w) - u;
            v2u o; o.x = pk2(df[0], df[1]); o.y = pk2(df[2], df[3]); *(v2u*)(DIFF + (size_t)(MP + b) * D + col) = o;
            *(f32x4*)(ps + (size_t)14 * D + col) = u;
#pragma unroll
            for (int r = 0; r < 14; ++r) *(f32x4*)(ps + (size_t)r * D + col) = st[r + 1];
        }
    }
    SEG_END(41);
    if (F.G != 256) { const size_t gt = (size_t)F.vcu * 512 + F.tid, NT = (size_t)F.G * 512; const f32x4* src = (const f32x4*)F.state_win; f32x4* dst = (f32x4*)(F.out + OUT_WIN_S);
      for (int rep = 0; rep < REP(19); ++rep)
      for (size_t e = gt; e < (size_t)DB * 511 * 128; e += NT) { const size_t b = e / (511 * 128), rem = e - b * (511 * 128); dst[b * 65536 + rem] = src[b * 65536 + rem + 128]; } }
    __syncthreads();
    LAS float* U = (LAS float*)F.lds;
    SEG_BEGIN(42);
    for (int rep = 0; rep < REP(20); ++rep)
    for (int task = F.vcu; task < MP / 64; task += F.G) {
        const int b = task >> 6, t0 = (task & 63) * 64;
        const float* xb = F.x_p + (size_t)b * SEQ * D;
        f32x4 gmix[4];
#pragma unroll
        for (int j = 0; j < 4; ++j) gmix[j] = *(const f32x4*)(F.norm_mix + 256 * j + 4 * lane);
        f32x4 ra[4], rb2[4];
#define DF_LOAD(T) do { const int ta_ = (T) + 2 * F.wave, tb_ = ta_ + 1; _Pragma("unroll") for (int j = 0; j < 4; ++j) { \
            ra[j] = (ta_ >= 0) ? *((const f32x4*)(xb + (size_t)ta_ * D) + lane + 64 * j) : (f32x4){0.f, 0.f, 0.f, 0.f}; rb2[j] = (tb_ >= 0) ? *((const f32x4*)(xb + (size_t)tb_ * D) + lane + 64 * j) : (f32x4){0.f, 0.f, 0.f, 0.f}; } } while (0)
#define DF_STORE1(rr, tt_) do { float ss = 0.f; _Pragma("unroll") for (int j = 0; j < 4; ++j) ss += (rr[j][0] * rr[j][0] + rr[j][1] * rr[j][1]) + (rr[j][2] * rr[j][2] + rr[j][3] * rr[j][3]); \
            const float rstd = 1.0f / sqrtf(wave_sum(ss) * (1.0f / D) + RMS_EPS); \
            _Pragma("unroll") for (int j = 0; j < 4; ++j) { const f32x4 u = rr[j] * rstd * gmix[j]; *(LAS f32x4*)(U + ((tt_) & 31) * 1024 + 256 * j + 4 * lane) = u; \
                if ((tt_) >= SEQ - 15) *(f32x4*)(F.out + OUT_POOL_P + ((size_t)b * 15 + ((tt_) - (SEQ - 15))) * D + 256 * j + 4 * lane) = u; } } while (0)
#define DF_STORE(T) do { const int ta_ = (T) + 2 * F.wave; DF_STORE1(ra, ta_); DF_STORE1(rb2, ta_ + 1); } while (0)
        DF_LOAD(t0 - 16); DF_STORE(t0 - 16);
        DF_LOAD(t0);
        const int c = 2 * F.tid, w = 2 << (F.tid >> 7);
        f32x2 S = (f32x2){0.f, 0.f};
        for (int sub = 0; sub < 4; ++sub) {
            const int T = t0 + 16 * sub;
            DF_STORE(T);
            __syncthreads();
            if (sub < 3) DF_LOAD(T + 16);
            if (sub == 0) { for (int j = 1; j < w; ++j) S += *(const LAS f32x2*)(U + ((T - j) & 31) * 1024 + c); }
            for (int tt = 0; tt < 16; ++tt) { const int t = T + tt; const int cnt = (t + 1 < w) ? (t + 1) : w;
                const f32x2 cur = *(const LAS f32x2*)(U + (t & 31) * 1024 + c);
                S += cur; const float inv = 1.0f / (float)cnt;
                *(unsigned*)(DIFF + ((size_t)b * SEQ + t) * D + c) = pk2(S[0] * inv - cur[0], S[1] * inv - cur[1]);
                S -= *(const LAS f32x2*)(U + ((t - w + 1) & 31) * 1024 + c); }
            __syncthreads();
        }
#undef DF_LOAD
#undef DF_STORE1
#undef DF_STORE
    }
    SEG_END(42);
}

constexpr int KSTR = 144;
constexpr int SC_ACT = 0, SC_W = 128 * KSTR, SC_BUF = SC_W + 256 * KSTR, SC_UNIT = 2 * SC_BUF, CW_QUEUE = 8192;
static_assert(SC_UNIT + 64 <= RING_BYTES, "sample compress LDS");
__device__ __forceinline__ void p5_sample_compress(Frame& F, unsigned* qctr, int quota) {
    LAS int* UNIT = (LAS int*)(F.lds + SC_UNIT);
    const int tid = F.tid, lane = F.lane, w = F.wave, r = lane & 31, h = lane >> 5, rb = w & 3, nh = w >> 2;
    float* P = WSP(float, WS_CMPP); const bf16* W1 = WSP(bf16, WS_W1CAT);
    for (int nu = 0; nu < quota; ++nu) {
        __syncthreads();
        if (tid == 0) UNIT[0] = (int)atomicAdd(qctr, 1u);
        __syncthreads();
        const int u = UNIT[0]; if (u >= DB * 8) break;
        const int b = u >> 3, jb = (u >> 1) & 3, kv = u & 1;
        size_t aoff[4]; const bf16* wsrc = W1 + ((size_t)kv * 256 + (tid >> 3)) * D + 8 * (tid & 7);
#pragma unroll
        for (int e = 0; e < 4; ++e) { const int j = 32 * jb + (tid >> 6) + 8 * e; const int page = F.page_table[b * 16 + (j >> 3)]; aoff[e] = ((size_t)page * 128 + (j & 7) * 16) * 1024 + kv * 256 + 4 * (tid & 63); }
        f32x4 av0[4], av1[4], av2[4], av3[4]; v4u wv0[4], wv1[4];
#define SC_LOADA(av, tt) do { _Pragma("unroll") for (int e = 0; e < 4; ++e) av[e] = *(const f32x4*)(F.cache + aoff[e] + (size_t)(tt) * 1024); } while (0)
#define SC_LOADW(wv, tt) do { _Pragma("unroll") for (int e = 0; e < 4; ++e) wv[e] = *(const v4u*)(wsrc + (size_t)e * 64 * D + 64 * (tt)); } while (0)
#define SC_STORE(av, wv, bf) do { _Pragma("unroll") for (int e = 0; e < 4; ++e) { v2u o; o.x = cvtpk(av[e][0], av[e][1]); o.y = cvtpk(av[e][2], av[e][3]); \
            *(LAS v2u*)(F.lds + (bf) * SC_BUF + SC_ACT + ((((tid >> 6) + 8 * e) << 2) + ((tid & 63) >> 4)) * KSTR + 8 * (tid & 15)) = o; *(LAS v4u*)(F.lds + (bf) * SC_BUF + SC_W + ((tid >> 3) + 64 * e) * KSTR + 16 * (tid & 7)) = wv[e]; } } while (0)
#define SC_COMPUTE(bf) do { const LAS unsigned char* At = F.lds + (bf) * SC_BUF + SC_ACT + (64 * (w & 1) + r) * KSTR + h * 16; const LAS unsigned char* Wt = F.lds + (bf) * SC_BUF + SC_W + (64 * (w >> 1) + r) * KSTR + h * 16; \
            _Pragma("unroll") for (int ks = 0; ks < 4; ++ks) { \
                const bf16x8 b0_ = *(const LAS bf16x8*)(At + ks * 32), b1_ = *(const LAS bf16x8*)(At + 32 * KSTR + ks * 32), a0_ = *(const LAS bf16x8*)(Wt + ks * 32), a1_ = *(const LAS bf16x8*)(Wt + 32 * KSTR + ks * 32); \
            __builtin_amdgcn_sched_barrier(0); \
                acc[0] = __builtin_amdgcn_mfma_f32_32x32x16_bf16(a0_, b0_, acc[0], 0, 0, 0); acc[1] = __builtin_amdgcn_mfma_f32_32x32x16_bf16(a1_, b0_, acc[1], 0, 0, 0); \
                acc[2] = __builtin_amdgcn_mfma_f32_32x32x16_bf16(a0_, b1_, acc[2], 0, 0, 0); acc[3] = __builtin_amdgcn_mfma_f32_32x32x16_bf16(a1_, b1_, acc[3], 0, 0, 0); \
            __builtin_amdgcn_sched_barrier(0); } } while (0)
        f32x16 acc[4];
#pragma unroll
        for (int nt = 0; nt < 4; ++nt)
#pragma unroll
            for (int i = 0; i < 16; ++i) acc[nt][i] = 0.f;
#define SC_STEP(tt, aCur, wCur, aNext, wNext) do { \
            if ((tt) + 4 < 16) SC_LOADA(aCur, (tt) + 4);        \
            if ((tt) + 2 < 16) SC_LOADW(wCur, (tt) + 2); \
            __builtin_amdgcn_sched_barrier(0); \
            SC_COMPUTE((tt) & 1); \
            __builtin_amdgcn_sched_barrier(0); \
            if ((tt) + 1 < 16) SC_STORE(aNext, wNext, ((tt) + 1) & 1); \
            __syncthreads(); } while (0)
        SC_LOADA(av0, 0); SC_LOADW(wv0, 0); SC_LOADA(av1, 1); SC_LOADW(wv1, 1); SC_LOADA(av2, 2); SC_LOADA(av3, 3);
        SC_STORE(av0, wv0, 0); __syncthreads();
        for (int tt = 0; tt < 16; tt += 4) {
            SC_STEP(tt,     av0, wv0, av1, wv1);
            SC_STEP(tt + 1, av1, wv1, av2, wv0);
            SC_STEP(tt + 2, av2, wv0, av3, wv1);
            SC_STEP(tt + 3, av3, wv1, av0, wv0);
        }
#undef SC_STEP
#undef SC_LOADA
#undef SC_LOADW
#define SC_LOAD 0
#undef SC_COMPUTE
#undef SC_LOAD
#undef SC_STORE
        float* prow = P + (size_t)kv * CMP_ROWS * 256 + (size_t)(CMP_ROWS_P + (b * 128 + 32 * jb) * 4 + 64 * (w & 1) + r) * 256 + 64 * (w >> 1) + 4 * h;
#pragma unroll
        for (int ri = 0; ri < 2; ++ri)
#pragma unroll
            for (int ni = 0; ni < 2; ++ni)
#pragma unroll
                for (int g4 = 0; g4 < 4; ++g4) *(f32x4*)(prow + (size_t)ri * 32 * 256 + 32 * ni + 8 * g4) = (f32x4){acc[2 * ri + ni][4 * g4], acc[2 * ri + ni][4 * g4 + 1], acc[2 * ri + ni][4 * g4 + 2], acc[2 * ri + ni][4 * g4 + 3]};
    }
}

__device__ __forceinline__ void p5_prompt_compress(Frame& F) {
    const int tid = F.tid, lane = F.lane, w = F.wave, r = lane & 31, h = lane >> 5, rb = w & 3, nh = w >> 2;
    float* P = WSP(float, WS_CMPP); const bf16* W1 = WSP(bf16, WS_W1CAT); const bf16* CA = WSP(bf16, WS_CMPA);
    for (int u = (int)blockIdx.x; u < 2 * CMP_ROWS_P / 128; u += F.G) {
        const int kv = u & 1, rblk = u >> 1;
        const bf16* asrc = CA + (size_t)kv * CMP_ROWS * D + (size_t)(rblk * 128 + (tid >> 3)) * D + 8 * (tid & 7);
        const bf16* wsrc = W1 + ((size_t)kv * 256 + (tid >> 3)) * D + 8 * (tid & 7);
        v4u aa[2], wv[4];
#define PC_LOAD(tt) do { _Pragma("unroll") for (int e = 0; e < 2; ++e) aa[e] = *(const v4u*)(asrc + (size_t)e * 64 * D + 64 * (tt)); _Pragma("unroll") for (int e = 0; e < 4; ++e) wv[e] = *(const v4u*)(wsrc + (size_t)e * 64 * D + 64 * (tt)); } while (0)
#define PC_STORE(bf) do { _Pragma("unroll") for (int e = 0; e < 2; ++e) *(LAS v4u*)(F.lds + (bf) * SC_BUF + SC_ACT + ((tid >> 3) + 64 * e) * KSTR + 16 * (tid & 7)) = aa[e]; \
            _Pragma("unroll") for (int e = 0; e < 4; ++e) *(LAS v4u*)(F.lds + (bf) * SC_BUF + SC_W + ((tid >> 3) + 64 * e) * KSTR + 16 * (tid & 7)) = wv[e]; } while (0)
        f32x16 acc[4];
#pragma unroll
        for (int nt = 0; nt < 4; ++nt)
#pragma unroll
            for (int i = 0; i < 16; ++i) acc[nt][i] = 0.f;
        __syncthreads();
        PC_LOAD(0); PC_STORE(0); __syncthreads();
        for (int tt = 0; tt < 16; ++tt) {
            const int bf = tt & 1;
            if (tt + 1 < 16) PC_LOAD(tt + 1);
            __builtin_amdgcn_sched_barrier(0);
            const LAS unsigned char* At = F.lds + bf * SC_BUF + SC_ACT + (32 * rb + r) * KSTR + h * 16; const LAS unsigned char* Wt = F.lds + bf * SC_BUF + SC_W + (128 * nh + r) * KSTR + h * 16;
            bf16x8 bfr_[4], afr_[4][4];
#pragma unroll
            for (int ks = 0; ks < 4; ++ks) { bfr_[ks] = *(const LAS bf16x8*)(At + ks * 32);
#pragma unroll
                for (int nt = 0; nt < 4; ++nt) afr_[ks][nt] = *(const LAS bf16x8*)(Wt + 32 * nt * KSTR + ks * 32); }
            __builtin_amdgcn_sched_barrier(0);
#pragma unroll
            for (int ks = 0; ks < 4; ++ks)
#pragma unroll
                for (int nt = 0; nt < 4; ++nt) acc[nt] = __builtin_amdgcn_mfma_f32_32x32x16_bf16(afr_[ks][nt], bfr_[ks], acc[nt], 0, 0, 0);
            __builtin_amdgcn_sched_barrier(0);
            if (tt + 1 < 16) PC_STORE(bf ^ 1);
            __syncthreads();
        }
#undef PC_LOAD
#undef PC_STORE
        float* prow = P + (size_t)kv * CMP_ROWS * 256 + (size_t)(rblk * 128 + 32 * rb + r) * 256 + 128 * nh + 4 * h;
#pragma unroll
        for (int nt = 0; nt < 4; ++nt)
#pragma unroll
            for (int g4 = 0; g4 < 4; ++g4) *(f32x4*)(prow + 32 * nt + 8 * g4) = (f32x4){acc[nt][4 * g4], acc[nt][4 * g4 + 1], acc[nt][4 * g4 + 2], acc[nt][4 * g4 + 3]};
    }
}

constexpr int W2T_STR = 136;
__device__ __forceinline__ void p6_combine(Frame& F, int part, int cu, int ncu) {
    LAS bf16* W2T = (LAS bf16*)F.lds;
    LAS float* CBL = (LAS float*)(F.lds + 2 * 64 * W2T_STR * 2);
    const float* P = WSP(float, WS_CMPP); bf16* KC = WSP(bf16, WS_KC); float* KCS = WSP(float, WS_KCS);
    for (int i = F.tid; i < 2 * 128 * 64; i += 512) { const int kv = i >> 13, k = (i >> 6) & 127, d = i & 63; W2T[(kv * 64 + d) * W2T_STR + k] = (bf16)f2bf(F.cmp_w2[i]); }
    if (F.tid < 256) { const float* CB = WSP(float, WS_CBIAS) + (size_t)(F.tid >> 7) * 32 * 128 + (F.tid & 127); float a = 0.f;
#pragma unroll 8
        for (int c = 0; c < 32; ++c) a += CB[c * 128];
        CBL[F.tid] = a; }
    __syncthreads();
    const int lane = F.lane, ml = lane & 15, fq = lane >> 4;
    const int gw = cu * NWAVES + F.wave, NGW = ncu * NWAVES;
    constexpr int NT_P = CMP_ROWS_P / 16, NT_S = CMP_ROWS_S / 16;
    const bool prompt = part == 1; const int ntp = prompt ? NT_P : NT_S;
    f32x4 loA[4][2], hiA[4][2], loB[4][2], hiB[4][2];
#define CB_LOAD(lo_, hi_, task_) do { const int kv_ = (task_) / ntp, r0_ = ((task_) % ntp) * 16; const int prow_ = (prompt ? r0_ : CMP_ROWS_P + r0_) + ml; \
        const float* plo_ = P + (size_t)kv_ * CMP_ROWS * 256 + (size_t)prow_ * 256 + 8 * fq; const float* phi_ = plo_ + 4 * 256 + 128; \
        _Pragma("unroll") for (int ks = 0; ks < 4; ++ks) { lo_[ks][0] = *(const f32x4*)(plo_ + 32 * ks); lo_[ks][1] = *(const f32x4*)(plo_ + 32 * ks + 4); hi_[ks][0] = *(const f32x4*)(phi_ + 32 * ks); hi_[ks][1] = *(const f32x4*)(phi_ + 32 * ks + 4); } } while (0)
#define CB_FINISH(lo_, hi_, task_) do { const int kv = (task_) / ntp, r0 = ((task_) % ntp) * 16; const int nimask = prompt ? 255 : 127; \
        const int ro = r0 + ml, i_blk = (ro >> 2) & nimask; const bool valid = i_blk < nimask; \
        bf16x8 hb[4]; \
        _Pragma("unroll") for (int ks = 0; ks < 4; ++ks) { f32x4 z[2]; \
            _Pragma("unroll") for (int e = 0; e < 2; ++e) { z[e] = lo_[ks][e] + hi_[ks][e] + *(const LAS f32x4*)(CBL + kv * 128 + 32 * ks + 8 * fq + 4 * e); \
                _Pragma("unroll") for (int q = 0; q < 4; ++q) { const float zz = z[e][q]; z[e][q] = valid ? zz / (1.0f + __expf(-zz)) : 0.f; } } \
            hb[ks] = cvt8(z[0], z[1]); } \
        _Pragma("unroll") for (int db = 0; db < 4; ++db) { f32x4 acc = (f32x4){0.f, 0.f, 0.f, 0.f}; \
            _Pragma("unroll") for (int ks = 0; ks < 4; ++ks) { const bf16x8 a = *(const LAS bf16x8*)(W2T + (kv * 64 + 16 * db + ml) * W2T_STR + 32 * ks + 8 * fq); acc = __builtin_amdgcn_mfma_f32_16x16x32_bf16(a, hb[ks], acc, 0, 0, 0); } \
            const int g = ro & 3, d0 = 16 * db + 4 * fq; \
            if (prompt) { const int b = ro >> 10; v2u o; o.x = cvtpk(acc[0], acc[1]); o.y = cvtpk(acc[2], acc[3]); *(v2u*)(KC + ((size_t)((kv * 4 + b) * 4 + g) * 256 + i_blk) * 64 + d0) = o; } \
            else { const int b = ro >> 9; *(f32x4*)(KCS + ((size_t)((kv * 128 + b) * 4 + g) * 128 + i_blk) * 64 + d0) = acc; } } } while (0)
    const int ntask = 2 * ntp;
    int task = gw;
    if (task < ntask) CB_LOAD(loA, hiA, task);
    while (task < ntask) {
        int t2 = task + NGW; if (t2 < ntask) CB_LOAD(loB, hiB, t2);
        CB_FINISH(loA, hiA, task);
        task = t2; if (task >= ntask) break;
        t2 = task + NGW; if (t2 < ntask) CB_LOAD(loA, hiA, t2);
        CB_FINISH(loB, hiB, task);
        task = t2;
    }
#undef CB_LOAD
#undef CB_FINISH
}

constexpr int VSTR = 192;
constexpr int AT_K = 0, AT_V = 64 * KSTR, AT_BUF = 64 * KSTR + 64 * VSTR  , AT_CK = 0, AT_CV = 4 * 64 * KSTR  , AT_T = AT_CV + 4 * 64 * VSTR, AT_TS = 66, AT_U = AT_T + 64 * AT_TS * 4,
    AT_SEL = AT_U + 64 * AT_TS * 4, AT_WUNI = AT_SEL + 512, AT_END = AT_WUNI + 64, AT_OF = 2 * AT_BUF  ;
static_assert(AT_OF + 8 * 32 * 64 * 4 <= AT_SEL, "attention LDS");
static_assert(AT_END <= RING_BYTES, "attention LDS");

__device__ __forceinline__ v4i16_t vtr(const LAS unsigned char* p) { return __builtin_amdgcn_ds_read_tr16_b64_v4i16((LAS v4i16_t*)p); }

struct KvRegs { v4u k, v; };
__device__ __forceinline__ void load_kv(Frame& F, KvRegs& R, const bf16* ksrc, const bf16* vsrc, int pitch) {
    const int key = F.tid >> 3, ch = F.tid & 7;
    R.k = *(const v4u*)(ksrc + (size_t)key * pitch + ch * 8);
    R.v = *(const v4u*)(vsrc + (size_t)key * pitch + ch * 8);
}
__device__ __forceinline__ void store_kv(Frame& F, const KvRegs& R, int buf) {
    const int key = F.tid >> 3, ch = F.tid & 7;
    *(LAS v4u*)(F.lds + buf * AT_BUF + AT_K + key * KSTR + ch * 16) = R.k;
    *(LAS v4u*)(F.lds + buf * AT_BUF + AT_V + key * VSTR + ch * 16) = R.v;
}

constexpr float ATT_THR = 8.0f;
__device__ __forceinline__ float quad_xor1(float x) { return __builtin_bit_cast(float, __builtin_amdgcn_update_dpp(0, __builtin_bit_cast(int, x), 0xB1, 0xF, 0xF, true)); }
__device__ __forceinline__ float quad_xor2(float x) { return __builtin_bit_cast(float, __builtin_amdgcn_update_dpp(0, __builtin_bit_cast(int, x), 0x4E, 0xF, 0xF, true)); }
__device__ __forceinline__ float half_max(float x) { auto rr = __builtin_amdgcn_permlane32_swap(__float_as_uint(x), __float_as_uint(x), false, false); return fmaxf(__uint_as_float(rr[0]), __uint_as_float(rr[1])); }
struct AugState { unsigned q0, q1, mw2, mw3, kj0, kj1, hsel; };
__device__ __forceinline__ unsigned bf16_hi_bits(float f) { return f2bf(f); }
__device__ __forceinline__ void aug_set_m(AugState& A, float m) {
    const float a = -m; const unsigned h1 = f2bf(a); const float r1 = a - bf2f((unsigned short)h1); const unsigned h2 = f2bf(r1); const float r2 = r1 - bf2f((unsigned short)h2); const unsigned h3 = f2bf(r2);
    A.mw2 = h1 << 16; A.mw3 = h2 | (h3 << 16);
}
template <int MODE>
__device__ __forceinline__ void attn_tile(Frame& F, bool MASKED, int kofs_b, int vofs_b, const bf16x8 (&qf)[4], AugState& A, int blk, int relb, float slope2, bool rowok, float& m, float& l, bool& any, f32x16& o0, f32x16& o1,
                                          float mfin, float invl, LAS float* Tq, LAS float* Uq, int sig0) {
    const int lane = F.lane, r = lane & 31, h = lane >> 5;
    const LAS unsigned char* Kt = F.lds + kofs_b; const LAS unsigned char* Vt = F.lds + vofs_b;
    constexpr int PM = (MODE <= 1) ? 16 : 1;
    const float NEG = -INFINITY;
    float c0 = slope2 * (float)relb - ((MODE == 1) ? mfin : m);
    if (!rowok) c0 = NEG;
    const float k32 = slope2 * (float)(32 * PM);
    f32x16 p0, p1;
    if (MODE <= 1) {
#pragma unroll
        for (int i = 0; i < 16; ++i) { p0[i] = fmaf(slope2, (float)(PM * ((i & 3) + 8 * (i >> 2))), c0); p1[i] = p0[i] + k32; }
    }
    bf16x8 kfr[8];
#pragma unroll
    for (int ks = 0; ks < 4; ++ks) { kfr[2 * ks] = *(const LAS bf16x8*)(Kt + r * KSTR + ks * 32 + h * 16); kfr[2 * ks + 1] = *(const LAS bf16x8*)(Kt + (32 + r) * KSTR + ks * 32 + h * 16); }
    v4i16_t vlo[4][2], vhi[4][2];
    if (MODE != 0) { const LAS unsigned char* vb = Vt + (((lane & 15) >> 2) + 4 * h) * VSTR + (16 * ((lane >> 4) & 1) + 4 * (lane & 3)) * 2;
#pragma unroll
        for (int sp = 0; sp < 4; ++sp)
#pragma unroll
            for (int db = 0; db < 2; ++db) { vlo[sp][db] = vtr(vb + (16 * sp) * VSTR + 64 * db); vhi[sp][db] = vtr(vb + (16 * sp + 8) * VSTR + 64 * db); } }
    __builtin_amdgcn_sched_barrier(0);
    if (MODE >= 2) {
        const unsigned bw = (__float_as_uint((float)blk) >> 16) * 0x10001u & A.hsel;
        const v4u ka0 = (v4u){bw, A.kj0, 0x3f803f80u & A.hsel, 0x3f803f80u & A.hsel}, ka1 = (v4u){bw, A.kj1, 0x3f803f80u & A.hsel, 0x3f803f80u & A.hsel};
        const v4u qa = (v4u){A.q0, A.q1, (rowok ? 0u : 0xc6eau) | A.mw2, A.mw3};
        const f32x16 z = {0.f, 0.f, 0.f, 0.f, 0.f, 0.f, 0.f, 0.f, 0.f, 0.f, 0.f, 0.f, 0.f, 0.f, 0.f, 0.f};
        p0 = __builtin_amdgcn_mfma_f32_32x32x16_bf16(__builtin_bit_cast(bf16x8, ka0), __builtin_bit_cast(bf16x8, qa), z, 0, 0, 0);
        p1 = __builtin_amdgcn_mfma_f32_32x32x16_bf16(__builtin_bit_cast(bf16x8, ka1), __builtin_bit_cast(bf16x8, qa), z, 0, 0, 0);
    }
#pragma unroll
    for (int ks = 0; ks < 4; ++ks) {
        p0 = __builtin_amdgcn_mfma_f32_32x32x16_bf16(kfr[2 * ks], qf[ks], p0, 0, 0, 0);
        p1 = __builtin_amdgcn_mfma_f32_32x32x16_bf16(kfr[2 * ks + 1], qf[ks], p1, 0, 0, 0);
    }
    __builtin_amdgcn_sched_barrier(0);
    if (MASKED) {
#pragma unroll
        for (int i = 0; i < 16; ++i) {
            const int kofs = PM * ((i & 3) + 8 * (i >> 2));
            const int rel0 = relb + kofs, rel1 = rel0 + PM * 32;
            bool ok0 = rel0 <= 0, ok1 = rel1 <= 0;
            if (MODE == 3) { ok0 = ok0 && rel0 > -512; ok1 = ok1 && rel1 > -512; }
            p0[i] = ok0 ? p0[i] : NEG; p1[i] = ok1 ? p1[i] : NEG;
        }
    }
    if (MODE == 1) {
#pragma unroll
        for (int i = 0; i < 16; ++i) { p0[i] = __builtin_amdgcn_exp2f(p0[i]) * invl; p1[i] = __builtin_amdgcn_exp2f(p1[i]) * invl; }
#pragma unroll
        for (int hf = 0; hf < 2; ++hf)
#pragma unroll
            for (int g4 = 0; g4 < 4; ++g4) {
                const float pa = hf ? p1[4 * g4] : p0[4 * g4], pb = hf ? p1[4 * g4 + 1] : p0[4 * g4 + 1], pc = hf ? p1[4 * g4 + 2] : p0[4 * g4 + 2], pd = hf ? p1[4 * g4 + 3] : p0[4 * g4 + 3];
                float tv = 2.f * ((pa + pb) + pc) + pd, uv = pd;
                tv += quad_xor1(tv); uv += quad_xor1(uv); tv += quad_xor2(tv); uv += quad_xor2(uv);
                const int sg = sig0 + 8 * hf + 2 * g4 + h;
                if ((lane & 3) == 0) { Tq[sg] = tv; Uq[sg + 1] = uv; }
            }
    } else {
        float mxa = fmaxf(fmaxf(p0[0], p0[1]), p1[0]), mxb = fmaxf(fmaxf(p0[2], p0[3]), p1[1]); mxa = fmaxf(fmaxf(mxa, p1[2]), p1[3]);
#pragma unroll
        for (int i = 4; i < 16; i += 4) { mxa = fmaxf(fmaxf(mxa, p0[i]), p0[i + 1]); mxb = fmaxf(fmaxf(mxb, p0[i + 2]), p0[i + 3]); mxa = fmaxf(fmaxf(mxa, p1[i]), p1[i + 1]); mxb = fmaxf(fmaxf(mxb, p1[i + 2]), p1[i + 3]); }
        float mx = half_max(fmaxf(mxa, mxb));
        const float VLD = (MODE >= 2) ? -1.0e4f : NEG;
        const bool need = (mx > ATT_THR) || (!any && mx > VLD);
        if (__any(need)) {
            const float dl = need ? mx : 0.f; const float f = any ? __builtin_amdgcn_exp2f(-dl) : 1.f;
            m += dl; l *= f;
            if (MODE >= 2) aug_set_m(A, m);
#pragma unroll
            for (int i = 0; i < 16; ++i) { p0[i] -= dl; p1[i] -= dl; }
            if (MODE >= 2) {
#pragma unroll
                for (int i = 0; i < 16; ++i) { o0[i] *= f; o1[i] *= f; } }
        }
        any = any || (mx > VLD);
        float rs0 = 0.f, rs1 = 0.f;
#pragma unroll
        for (int i = 0; i < 16; ++i) { p0[i] = __builtin_amdgcn_exp2f(p0[i]); p1[i] = __builtin_amdgcn_exp2f(p1[i]); rs0 += p0[i]; rs1 += p1[i]; }
        l += rs0 + rs1;
        if (MODE == 0) return;
    }
    __builtin_amdgcn_sched_barrier(0);
#pragma unroll
    for (int sp = 0; sp < 4; ++sp) {
        v4u pw;
        if (sp < 2) { const int b8 = 8 * sp; pw.x = cvtpk(p0[b8], p0[b8 + 1]); pw.y = cvtpk(p0[b8 + 2], p0[b8 + 3]); pw.z = cvtpk(p0[b8 + 4], p0[b8 + 5]); pw.w = cvtpk(p0[b8 + 6], p0[b8 + 7]); }
        else { const int b8 = 8 * (sp - 2); pw.x = cvtpk(p1[b8], p1[b8 + 1]); pw.y = cvtpk(p1[b8 + 2], p1[b8 + 3]); pw.z = cvtpk(p1[b8 + 4], p1[b8 + 5]); pw.w = cvtpk(p1[b8 + 6], p1[b8 + 7]); }
        const bf16x8 pbf = __builtin_bit_cast(bf16x8, pw);
#pragma unroll
        for (int db = 0; db < 2; ++db) {
            const v4i16_t lo = vlo[sp][db], hi = vhi[sp][db];
            const bf16x8 vf = (bf16x8){lo[0], lo[1], lo[2], lo[3], hi[0], hi[1], hi[2], hi[3]};
            if (db == 0) o0 = __builtin_amdgcn_mfma_f32_32x32x16_bf16(vf, pbf, o0, 0, 0, 0);
            else o1 = __builtin_amdgcn_mfma_f32_32x32x16_bf16(vf, pbf, o1, 0, 0, 0);
        }
    }
}

struct BgCopy {
    size_t base; int k, pend; f32x4 v0;
    __device__ __forceinline__ void init(Frame& F) { const int b = F.vcu >> 1, hb = F.vcu & 1; k = (F.G == 256) ? 0 : 64; pend = 0; base = (size_t)b * 65536 + hb * 32704; }
    __device__ __forceinline__ void step(Frame& F) {
        const f32x4* src = (const f32x4*)F.state_win + base + 128 + F.tid; f32x4* dst = (f32x4*)(F.out + OUT_WIN_S) + base + F.tid;
        if (pend) { if (k - 1 < 63 || F.tid < 448) dst[512 * (k - 1)] = v0; pend = 0; }
        if (k < 64) { if (k < 63 || F.tid < 448) v0 = src[512 * k]; k += 1; pend = 1; }
    }
    __device__ __forceinline__ void finish(Frame& F) { while (k < 64 || pend) step(F); }
};

__device__ __forceinline__ void attn_prompt_unit(Frame& F, BgCopy& BG, int b, int g, int qb) {
    const int lane = F.lane, r = lane & 31, h = lane >> 5, w = F.wave;
    const int c0 = qb * 64, cur = qb, ql = 8 * w + (r >> 2), tq = c0 + ql, hd = g * 4 + (r & 3);
    const bf16* Q = WSP(bf16, WS_Q); const bf16* KVS = WSP(bf16, WS_KVS); const bf16* KVW = WSP(bf16, WS_KVW); const bf16* KC = WSP(bf16, WS_KC); const float* GATE = WSP(float, WS_GATE);
    bf16* O = WSP(bf16, WS_DIFF);
    const size_t row = (size_t)b * SEQ + tq;
    bf16x8 qf[4];
#pragma unroll
    for (int ks = 0; ks < 4; ++ks) qf[ks] = *(const bf16x8*)(Q + row * D + hd * 64 + ks * 16 + h * 8);
    const float slope2 = exp2f(-0.5f * (float)(hd + 1)) * LOG2E;
    AugState AG;
    { const unsigned sh = f2bf(slope2); const float shf = bf2f((unsigned short)sh); const unsigned sl = f2bf(slope2 - shf); const float slf = bf2f((unsigned short)sl);
      const unsigned hs = h ? 0u : 0xffffffffu; AG.hsel = hs;
      AG.q0 = (f2bf(64.f * shf) | (f2bf(64.f * slf) << 16)) & hs; AG.q1 = (sh | (sl << 16)) & hs; AG.mw2 = 0u; AG.mw3 = 0u;
      const unsigned j0 = __float_as_uint((float)r) >> 16, j1 = __float_as_uint((float)(32 + r)) >> 16; AG.kj0 = (j0 * 0x10001u) & hs; AG.kj1 = (j1 * 0x10001u) & hs; }
    const float g0 = GATE[row * 48 + hd * 3 + 0], g1 = GATE[row * 48 + hd * 3 + 1], g2 = GATE[row * 48 + hd * 3 + 2];
    LAS float* T = (LAS float*)(F.lds + AT_T); LAS float* U = (LAS float*)(F.lds + AT_U);
    LAS unsigned* SELM = (LAS unsigned*)(F.lds + AT_SEL); LAS unsigned* WUNI = (LAS unsigned*)(F.lds + AT_WUNI);
    for (int i = F.tid; i < 2 * 64 * AT_TS; i += 512) T[i] = 0.f;
    f32x16 of0, of1, o0, o1;
#pragma unroll
    for (int i = 0; i < 16; ++i) { of0[i] = 0.f; of1[i] = 0.f; o0[i] = 0.f; o1[i] = 0.f; }
    const float NEG = -INFINITY;
    const int nmax = c0 / 16 + 2;
    const int ntile = (nmax >= 255 ? 254 : nmax) / 64 + 1;
    const bf16* kc = KC + (size_t)((0 * 4 + b) * 4 + g) * 256 * 64; const bf16* vc = KC + (size_t)((1 * 4 + b) * 4 + g) * 256 * 64;
    SEG_BEGIN(23);
    float m = 0.f, l = 0.f; bool any = false;
    KvRegs R; int cb = 0;
    {
        KvRegs Rc[4]; const int key = F.tid >> 3, ch = F.tid & 7;
#pragma unroll
        for (int tl = 0; tl < 4; ++tl) if (tl < ntile) load_kv(F, Rc[tl], kc + (size_t)tl * 64 * 64, vc + (size_t)tl * 64 * 64, 64);
        BG.step(F);
#pragma unroll
        for (int tl = 0; tl < 4; ++tl) if (tl < ntile) { *(LAS v4u*)(F.lds + AT_CK + tl * 64 * KSTR + key * KSTR + ch * 16) = Rc[tl].k; *(LAS v4u*)(F.lds + AT_CV + tl * 64 * VSTR + key * VSTR + ch * 16) = Rc[tl].v; }
        __syncthreads();
    }
    for (int tl = 0; tl < ntile; ++tl)
        attn_tile<0>(F, !(1024 * tl + 1039 <= c0 + 8 * w), AT_CK + tl * 64 * KSTR, AT_CV + tl * 64 * VSTR, qf, AG, 0, 16 * 64 * tl + 31 + 16 * 4 * h - tq, slope2, true, m, l, any, o0, o1, 0.f, 0.f, nullptr, nullptr, 0);
    { const float lt = l + __shfl_xor(l, 32); const float invl = lt > 0.f ? 1.0f / lt : 0.f;
      LAS float* Tq = T + ql * AT_TS; LAS float* Uq = U + ql * AT_TS;
      for (int tl = 0; tl < ntile; ++tl)
          attn_tile<1>(F, !(1024 * tl + 1039 <= c0 + 8 * w), AT_CK + tl * 64 * KSTR, AT_CV + tl * 64 * VSTR, qf, AG, 0, 16 * 64 * tl + 31 + 16 * 4 * h - tq, slope2, true, m, l, any, o0, o1, m, invl, Tq, Uq, 16 * tl);
#pragma unroll
      for (int i = 0; i < 16; ++i) { of0[i] = g0 * o0[i]; of1[i] = g0 * o1[i]; o0[i] = 0.f; o1[i] = 0.f; } }
    __syncthreads(); SEG_END(23);
    SEG_BEGIN(22);
    unsigned long long wuni = 0ull;
    if (cur <= 15) {
        const unsigned long long msk = (1ull << (cur + 1)) - 1ull;
        if (lane < 8) { SELM[2 * (8 * w + lane)] = (unsigned)msk; SELM[2 * (8 * w + lane) + 1] = (unsigned)(msk >> 32); }
        wuni = msk;
    } else {
#pragma unroll
        for (int q4 = 0; q4 < 4; ++q4) {
            const int qb4 = 8 * w + 2 * q4; float v[2]; int rank[2];
#pragma unroll
            for (int e = 0; e < 2; ++e) { v[e] = T[(qb4 + e) * AT_TS + lane] + U[(qb4 + e) * AT_TS + lane]; rank[e] = 0; }
#pragma unroll
            for (int e = 0; e < 2; ++e) T[(qb4 + e) * AT_TS + lane] = v[e];
            LDS_WAIT(); asm volatile("" ::: "memory");
            for (int s2 = 1; s2 <= cur - 2; ++s2) {
                float o[2];
#pragma unroll
                for (int e = 0; e < 2; ++e) o[e] = T[(qb4 + e) * AT_TS + s2];
                const bool before = s2 < lane;
#pragma unroll
                for (int e = 0; e < 2; ++e) rank[e] += (o[e] > v[e] || (o[e] == v[e] && before)) ? 1 : 0;
            }
#pragma unroll
            for (int e = 0; e < 2; ++e) {
                const bool sel = (lane <= cur) && (lane == 0 || lane >= cur - 1 || rank[e] < 13);
                const unsigned long long msk = __ballot(sel);
                if (lane == 0) { SELM[2 * (qb4 + e)] = (unsigned)msk; SELM[2 * (qb4 + e) + 1] = (unsigned)(msk >> 32); }
                wuni |= msk;
            }
        }
    }
    wuni = ((unsigned long long)(unsigned)__builtin_amdgcn_readfirstlane((int)(unsigned)(wuni >> 32)) << 32) | (unsigned long long)(unsigned)__builtin_amdgcn_readfirstlane((int)(unsigned)wuni);
    if (lane == 0) { WUNI[2 * w] = (unsigned)wuni; WUNI[2 * w + 1] = (unsigned)(wuni >> 32); }
    SEG_END(22);
    __syncthreads();
    unsigned long long guni = 0ull;
#pragma unroll
    for (int i = 0; i < 8; ++i) guni |= (unsigned long long)WUNI[2 * i] | ((unsigned long long)WUNI[2 * i + 1] << 32);
    const unsigned long long mym = (unsigned long long)SELM[2 * ql] | ((unsigned long long)SELM[2 * ql + 1] << 32);
    LAS float* OFP = (LAS float*)(F.lds + AT_OF) + w * 32 * 64 + lane;
#pragma unroll
    for (int i = 0; i < 16; ++i) { OFP[i * 64] = of0[i]; OFP[(16 + i) * 64] = of1[i]; }
    m = 0.f; l = 0.f; any = false; AG.mw2 = 0u; AG.mw3 = 0u;
    { const bf16* ks = KVS + (size_t)b * SEQ * 512 + g * 64; const bf16* vs = ks + 256;
      unsigned long long rem = guni;
      int s = __builtin_ctzll(rem); rem &= rem - 1ull;
      load_kv(F, R, ks + (size_t)s * 64 * 512, vs + (size_t)s * 64 * 512, 512); __syncthreads(); store_kv(F, R, 0); __syncthreads(); cb = 0;
      for (;;) {
          const bool more = rem != 0ull; const int sn = more ? __builtin_ctzll(rem) : 0; rem &= rem - 1ull; BG.step(F);
          if (more) load_kv(F, R, ks + (size_t)sn * 64 * 512, vs + (size_t)sn * 64 * 512, 512);
          if ((wuni >> s) & 1ull) attn_tile<2>(F, s == cur, cb * AT_BUF + AT_K, cb * AT_BUF + AT_V, qf, AG, s - cur, 64 * s + 4 * h - tq, slope2, ((mym >> s) & 1ull) != 0ull, m, l, any, o0, o1, 0.f, 0.f, nullptr, nullptr, 0);
          if (!more) break;
          store_kv(F, R, cb ^ 1); __syncthreads(); cb ^= 1; s = sn;
      }
      const float lt = l + __shfl_xor(l, 32); const float sc = lt > 0.f ? g1 / lt : 0.f;
#pragma unroll
      for (int i = 0; i < 16; ++i) { OFP[i * 64] += sc * o0[i]; OFP[(16 + i) * 64] += sc * o1[i]; o0[i] = 0.f; o1[i] = 0.f; } }
    m = 0.f; l = 0.f; any = false; AG.mw2 = 0u; AG.mw3 = 0u;
    { const bf16* kw = KVW + (size_t)b * SEQ * 512 + g * 64; const bf16* vw = kw + 256;
      const int j0 = (c0 >= 512) ? 0 : (512 - c0) / 64;
      { const int pos0 = c0 - 512 + 64 * j0; load_kv(F, R, kw + (size_t)pos0 * 512, vw + (size_t)pos0 * 512, 512); __syncthreads(); store_kv(F, R, 0); __syncthreads(); cb = 0; }
      for (int j = j0; j < 9; ++j) {
          const int pos0 = c0 - 512 + 64 * j; const bool more = j + 1 < 9; BG.step(F);
          if (more) load_kv(F, R, kw + (size_t)(pos0 + 64) * 512, vw + (size_t)(pos0 + 64) * 512, 512);
          attn_tile<3>(F, j == 0 || j == 8, cb * AT_BUF + AT_K, cb * AT_BUF + AT_V, qf, AG, j - 8, pos0 + 4 * h - tq, slope2, true, m, l, any, o0, o1, 0.f, 0.f, nullptr, nullptr, 0);
          if (more) { store_kv(F, R, cb ^ 1); __syncthreads(); cb ^= 1; }
      }
      const float lt = l + __shfl_xor(l, 32); const float sc = lt > 0.f ? g2 / lt : 0.f;
#pragma unroll
      for (int i = 0; i < 16; ++i) { of0[i] = OFP[i * 64] + sc * o0[i]; of1[i] = OFP[(16 + i) * 64] + sc * o1[i]; } }
    bf16* orow = O + row * D + hd * 64;
#pragma unroll
    for (int g4 = 0; g4 < 4; ++g4) {
        v2u a; a.x = cvtpk(of0[4 * g4], of0[4 * g4 + 1]); a.y = cvtpk(of0[4 * g4 + 2], of0[4 * g4 + 3]);
        v2u c; c.x = cvtpk(of1[4 * g4], of1[4 * g4 + 1]); c.y = cvtpk(of1[4 * g4 + 2], of1[4 * g4 + 3]);
        *(v2u*)(orow + 8 * g4 + 4 * h) = a; *(v2u*)(orow + 32 + 8 * g4 + 4 * h) = c;
    }
    __syncthreads();
}

constexpr int SA_QS = 0, SA_SC = 1024, SA_NK = 1664, SA_IMP = SA_SC + SA_NK * 16, SA_LIST = SA_IMP + 256, SA_BLK = SA_LIST + 64, SA_RED = SA_BLK + 128, SA_END = SA_RED + 512 * 64;
constexpr int SK_CMP = 0, SK_SEL = 128, SK_WIN = 1088, SK_NSEL = 1600, SK_NWIN = 1601;
static_assert(SA_END <= RING_BYTES, "sample attention LDS");

__device__ __forceinline__ f32x4 wave_max4(f32x4 v) {
#pragma unroll
    for (int o = 1; o < 64; o <<= 1) { v[0] = fmaxf(v[0], __shfl_xor(v[0], o)); v[1] = fmaxf(v[1], __shfl_xor(v[1], o)); v[2] = fmaxf(v[2], __shfl_xor(v[2], o)); v[3] = fmaxf(v[3], __shfl_xor(v[3], o)); }
    return v;
}
__device__ __forceinline__ f32x4 wave_sum4(f32x4 v) {
#pragma unroll
    for (int o = 1; o < 64; o <<= 1) { v[0] += __shfl_xor(v[0], o); v[1] += __shfl_xor(v[1], o); v[2] += __shfl_xor(v[2], o); v[3] += __shfl_xor(v[3], o); }
    return v;
}
__device__ __forceinline__ void sa_softmax4(LAS f32x4* SC, int k0, int nk, int kx, f32x4 post, int lane) {
    f32x4 mx = (f32x4){-INFINITY, -INFINITY, -INFINITY, -INFINITY};
    for (int i = lane; i < nk; i += 64) { const f32x4 s = SC[k0 + i]; mx[0] = fmaxf(mx[0], s[0]); mx[1] = fmaxf(mx[1], s[1]); mx[2] = fmaxf(mx[2], s[2]); mx[3] = fmaxf(mx[3], s[3]); }
    if (kx >= 0) { const f32x4 s = SC[kx]; mx[0] = fmaxf(mx[0], s[0]); mx[1] = fmaxf(mx[1], s[1]); mx[2] = fmaxf(mx[2], s[2]); mx[3] = fmaxf(mx[3], s[3]); }
    mx = wave_max4(mx);
#pragma unroll
    for (int q = 0; q < 4; ++q) if (mx[q] == -INFINITY) mx[q] = 0.f;
    f32x4 sum = (f32x4){0.f, 0.f, 0.f, 0.f};
    for (int i = lane; i < nk; i += 64) { f32x4 s = SC[k0 + i];
#pragma unroll
        for (int q = 0; q < 4; ++q) s[q] = __builtin_amdgcn_exp2f(s[q] - mx[q]);
        SC[k0 + i] = s; sum += s; }
    sum = wave_sum4(sum);
    f32x4 ex = (f32x4){0.f, 0.f, 0.f, 0.f};
    if (kx >= 0) { const f32x4 s = SC[kx];
#pragma unroll
        for (int q = 0; q < 4; ++q) ex[q] = __builtin_amdgcn_exp2f(s[q] - mx[q]);
        sum += ex; }
    f32x4 sc;
#pragma unroll
    for (int q = 0; q < 4; ++q) sc[q] = sum[q] > 0.f ? post[q] / sum[q] : 0.f;
    LDS_WAIT(); asm volatile("" ::: "memory");
    for (int i = lane; i < nk; i += 64) SC[k0 + i] = SC[k0 + i] * sc;
    if (kx >= 0 && lane == 0) SC[kx] = ex * sc;
}

#define SA_LOADK(dst, kr) do { dst[0] = *(const f32x4*)(kr); dst[1] = *(const f32x4*)((kr) + 4); dst[2] = *(const f32x4*)((kr) + 32); dst[3] = *(const f32x4*)((kr) + 36); } while (0)
#define SA_SCORE(acc, kf) do { acc = __builtin_amdgcn_mfma_f32_16x16x32_bf16(af[0], cvt8(kf[0], kf[1]), (f32x4){0.f, 0.f, 0.f, 0.f}, 0, 0, 0); acc = __builtin_amdgcn_mfma_f32_16x16x32_bf16(af[1], cvt8(kf[2], kf[3]), acc, 0, 0, 0); } while (0)

__device__ __forceinline__ void attn_sample_unit(Frame& F, int b, int g) {
    const int tid = F.tid, lane = F.lane, w = F.wave; const int row = MP + b;
    const bf16* Q = WSP(bf16, WS_Q); const bf16* KVS = WSP(bf16, WS_KVS); const bf16* KVW = WSP(bf16, WS_KVW); const float* KCS = WSP(float, WS_KCS); const float* GATE = WSP(float, WS_GATE);
    bf16* O = WSP(bf16, WS_DIFF);
    LAS f32x4* SC = (LAS f32x4*)(F.lds + SA_SC); LAS float* IMP = (LAS float*)(F.lds + SA_IMP);
    LAS int* LIST = (LAS int*)(F.lds + SA_LIST); LAS int* BLK = (LAS int*)(F.lds + SA_BLK); LAS float* RED = (LAS float*)(F.lds + SA_RED);
    const float* kc = KCS + (size_t)((0 * 128 + b) * 4 + g) * 128 * 64; const float* vc = KCS + (size_t)((1 * 128 + b) * 4 + g) * 128 * 64;
    const float* sw = F.state_win + (size_t)b * 512 * 512;
    __syncthreads();
    bf16x8 af[2];
#pragma unroll
    for (int ks = 0; ks < 2; ++ks) { af[ks] = (bf16x8){0, 0, 0, 0, 0, 0, 0, 0}; if ((lane & 15) < 4) af[ks] = *(const bf16x8*)(Q + (size_t)row * D + (g * 4 + (lane & 15)) * 64 + 32 * ks + 8 * (lane >> 4)); }
    f32x4 sl2;
#pragma unroll
    for (int i = 0; i < 4; ++i) sl2[i] = exp2f(-0.5f * (float)(g * 4 + i + 1)) * LOG2E;
    f32x4 gt0, gt1, gt2;
    { const float* gp = GATE + (size_t)row * 48 + g * 12;
#pragma unroll
      for (int i = 0; i < 4; ++i) { gt0[i] = gp[i * 3 + 0]; gt1[i] = gp[i * 3 + 1]; gt2[i] = gp[i * 3 + 2]; } }
    const int kl = lane & 15, kc8 = 8 * (lane >> 4);
    { f32x4 kf[5][4];
      { const float* kr = kc + (size_t)(16 * w + kl) * 64 + kc8; SA_LOADK(kf[0], kr); }
#pragma unroll
      for (int j = 1; j < 5; ++j) { const float* kr = sw + (size_t)(16 * (w + 8 * (j - 1)) + kl) * 512 + g * 64 + kc8; SA_LOADK(kf[j], kr); }
      f32x4 acc;
      SA_SCORE(acc, kf[0]);
      if (lane < 16) { const int n = 16 * w + kl; const float rel = (float)(16 * n + 31 - PAST); f32x4 s;
#pragma unroll
          for (int i = 0; i < 4; ++i) s[i] = (n < 127) ? acc[i] + sl2[i] * rel : -INFINITY;
          SC[SK_CMP + n] = s; }
#pragma unroll
      for (int j = 1; j < 5; ++j) { SA_SCORE(acc, kf[j]);
          if (lane < 16) { const int i2 = 16 * (w + 8 * (j - 1)) + kl; const float rel = (float)(i2 - 512); f32x4 s;
#pragma unroll
              for (int i = 0; i < 4; ++i) s[i] = (i2 >= 1) ? acc[i] + sl2[i] * rel : -INFINITY;
              SC[SK_WIN + i2] = s; } }
      if (w == 7) {
          f32x4 a, c2; const float kwn = bf2f(KVW[(size_t)row * 512 + g * 64 + lane]), ksn = bf2f(KVS[(size_t)row * 512 + g * 64 + lane]);
#pragma unroll
          for (int i = 0; i < 4; ++i) { const float qv = bf2f(Q[(size_t)row * D + (g * 4 + i) * 64 + lane]); a[i] = qv * kwn; c2[i] = qv * ksn; }
          a = wave_sum4(a); c2 = wave_sum4(c2);
          if (lane == 0) { SC[SK_NWIN] = a; SC[SK_NSEL] = c2; }
      }
    }
    __syncthreads();
    if (w == 0) {
        sa_softmax4(SC, SK_CMP, 128, -1, (f32x4){1.f, 1.f, 1.f, 1.f}, lane);
        LDS_WAIT(); asm volatile("" ::: "memory");
        if (lane < 33) { float a = 0.f;
#pragma unroll
            for (int dn = -1; dn <= 3; ++dn) { const int n = 4 * lane + dn; if (n >= 0 && n < 127) { const f32x4 p = SC[SK_CMP + n]; a += ((dn == -1 || dn == 3) ? 1.f : 2.f) * ((p[0] + p[1]) + (p[2] + p[3])); } }
            IMP[lane] = a; }
        LDS_WAIT(); asm volatile("" ::: "memory");
        const float v = (lane <= 32) ? IMP[lane] : 0.f; int rank = 0;
        for (int s2 = 1; s2 <= 30; ++s2) { const float o = IMP[s2]; rank += (o > v || (o == v && s2 < lane)) ? 1 : 0; }
        const bool sel = (lane == 0) || (lane == 31) || (lane >= 1 && lane <= 30 && rank < 13);
        const unsigned long long msk = __ballot(sel);
        if (sel) { const int pos = __builtin_popcountll(msk & ((1ull << lane) - 1ull)); LIST[pos] = lane;
            const int page = F.page_table[b * 16 + (lane >> 1)]; BLK[pos] = page * 128 + (lane & 1) * 64; }
        LDS_WAIT(); asm volatile("" ::: "memory");
        for (int i = lane; i < 128; i += 64) SC[SK_CMP + i] = SC[SK_CMP + i] * gt0;
    }
    __syncthreads();
#pragma unroll
    for (int bt = 0; bt < 2; ++bt) {
        f32x4 kf[4][4];
#pragma unroll
        for (int j = 0; j < 4; ++j) { const int st = w + 8 * (4 * bt + j); if (st < 60) { const int bi = st >> 2, kk = 16 * (st & 3) + kl;
            const float* kr = F.cache + ((size_t)(BLK[bi] + kk) * 4 + 2) * 256 + g * 64 + kc8; SA_LOADK(kf[j], kr); } }
#pragma unroll
        for (int j = 0; j < 4; ++j) { const int st = w + 8 * (4 * bt + j); if (st < 60) { const int bi = st >> 2, kk = 16 * (st & 3) + kl; f32x4 acc; SA_SCORE(acc, kf[j]);
            if (lane < 16) { const float rel = (float)(64 * LIST[bi] + kk - PAST); f32x4 s;
#pragma unroll
                for (int i = 0; i < 4; ++i) s[i] = acc[i] + sl2[i] * rel;
                SC[SK_SEL + 64 * bi + kk] = s; } } }
    }
    if (w == 1) sa_softmax4(SC, SK_WIN, 512, SK_NWIN, gt2, lane);
    __syncthreads();
    if (w == 0) sa_softmax4(SC, SK_SEL, 960, SK_NSEL, gt1, lane);
    __syncthreads();
    { const int kq = lane >> 4, c4 = 4 * (lane & 15);
      f32x4 acc[4];
#pragma unroll
      for (int i = 0; i < 4; ++i) acc[i] = (f32x4){0.f, 0.f, 0.f, 0.f};
      { f32x4 vv[4];
#pragma unroll
        for (int it = 0; it < 4; ++it) vv[it] = *(const f32x4*)(vc + (size_t)(32 * it + 4 * w + kq) * 64 + c4);
#pragma unroll
        for (int it = 0; it < 4; ++it) { const f32x4 p = SC[SK_CMP + 32 * it + 4 * w + kq];
#pragma unroll
            for (int i = 0; i < 4; ++i) acc[i] += vv[it] * p[i]; } }
#pragma unroll
      for (int bt = 0; bt < 1; ++bt) { f32x4 vv[16];
#pragma unroll
        for (int j = 0; j < 16; ++j) vv[j] = *(const f32x4*)(sw + (size_t)(32 * j + 4 * w + kq) * 512 + 256 + g * 64 + c4);
#pragma unroll
        for (int j = 0; j < 16; ++j) { const f32x4 p = SC[SK_WIN + 32 * j + 4 * w + kq];
#pragma unroll
            for (int i = 0; i < 4; ++i) acc[i] += vv[j] * p[i]; } }
#pragma unroll
      for (int bt = 0; bt < 2; ++bt) { f32x4 vv[15];
#pragma unroll
        for (int j = 0; j < 15; ++j) { const int k = 32 * (15 * bt + j) + 4 * w + kq; vv[j] = *(const f32x4*)(F.cache + ((size_t)(BLK[k >> 6] + (k & 63)) * 4 + 3) * 256 + g * 64 + c4); }
#pragma unroll
        for (int j = 0; j < 15; ++j) { const f32x4 p = SC[SK_SEL + 32 * (15 * bt + j) + 4 * w + kq];
#pragma unroll
            for (int i = 0; i < 4; ++i) acc[i] += vv[j] * p[i]; } }
#pragma unroll
      for (int i = 0; i < 4; ++i) *(LAS f32x4*)(RED + tid * 16 + 4 * i) = acc[i];
    }
    __syncthreads();
    if (tid < 256) { const int hd = tid >> 6, d = tid & 63; float a = 0.f;
#pragma unroll 8
        for (int j = 0; j < 32; ++j) a += RED[((j >> 2) * 64 + (j & 3) * 16 + (d >> 2)) * 16 + hd * 4 + (d & 3)];
        { const f32x4 ps = SC[SK_NSEL], pw = SC[SK_NWIN];
          a += ps[hd] * bf2f(KVS[(size_t)row * 512 + 256 + g * 64 + d]) + pw[hd] * bf2f(KVW[(size_t)row * 512 + 256 + g * 64 + d]); }
        O[(size_t)row * D + (g * 4 + hd) * 64 + d] = (bf16)f2bf(a); }
    __syncthreads();
}

__device__ __forceinline__ void p7_attention(Frame& F) {
    BgCopy BG; BG.init(F);
    const bool sfirst = (blockIdx.x & 1) == 0;
    SEG_BEGIN(20); if (sfirst) for (int i = F.vcu; i < DB * 4; i += F.G) attn_sample_unit(F, i >> 2, i & 3); SEG_END(20);
    SEG_BEGIN(21);
    for (int i = F.vcu; i < 1024; i += F.G) { const int k = i >> 8, c = i & 255, bg = c >> 4, s = c & 15; const int qb = (k == 0) ? s : (k == 1) ? 31 - s : (k == 2) ? 32 + s : 63 - s;
        attn_prompt_unit(F, BG, bg >> 2, bg & 3, qb); }
    BG.finish(F); SEG_END(21);
    SEG_BEGIN(20); if (!sfirst) for (int i = F.vcu; i < DB * 4; i += F.G) attn_sample_unit(F, i >> 2, i & 3); SEG_END(20);
}

enum { SG_POOL = 0, SG_UP = 1, SG_DOWN = 2, SG_KVQG = 3, SG_WO = 4 };
constexpr int SG_RED = 0, SG_SSQ = 2 * 8 * 16 * 64 * 4;
template <int KIND>
__device__ __forceinline__ void small_gemm(Frame& F, int layer) {
    constexpr bool F32B = (KIND == SG_UP || KIND == SG_KVQG);
    constexpr int KR = (KIND == SG_POOL) ? 256 : 1024;
    constexpr int KSPLIT = (KIND == SG_DOWN) ? 4 : 1;
    constexpr int NSL = (KIND == SG_POOL) ? 32 : (KIND == SG_UP) ? 128 : (KIND == SG_KVQG) ? 82 : 32;
    constexpr int KW = KR / 8, NKS = KW / 16;
    const int lane = F.lane, w = F.wave, r = lane & 31, h = lane >> 5;
    float* X = WSP(float, WS_X);
    LAS float* RED = (LAS float*)(F.lds + SG_RED); LAS float* SSQ = (LAS float*)(F.lds + SG_SSQ);
    for (int item = F.vcu; item < (NSL / 2) * 4 * KSPLIT; item += F.G) {
        const int kr = item % KSPLIT, tt = item / KSPLIT, rbk = tt & 3, np = tt >> 2;
        const int row = MP + 32 * rbk + r, b = 32 * rbk + r;
        const int kb = kr * KR + w * KW + 8 * h;
        int n0[2]; const bf16* wrow[2]; const bf16* b16 = nullptr; const float* b32 = nullptr;
#pragma unroll
        for (int t = 0; t < 2; ++t) { const int ns = 2 * np + t; n0[t] = ns * 32;
            if (KIND == SG_POOL) { const int g = ns >> 3; n0[t] = (ns & 7) * 32; wrow[t] = WSP(bf16, WS_WPOOL) + (size_t)g * 65536 + (size_t)(n0[t] + r) * 256 + kb; b16 = WSP(bf16, WS_DIFF) + (size_t)row * D + g * 256 + kb; n0[t] += g * 256; }
            else if (KIND == SG_UP) { wrow[t] = WSP(bf16, WS_WUP) + (size_t)layer * FF * D + (size_t)(n0[t] + r) * D + kb; b32 = X + (size_t)row * D + kb; }
            else if (KIND == SG_DOWN) { wrow[t] = WSP(bf16, WS_WDN) + (size_t)layer * D * FF + (size_t)(n0[t] + r) * FF + kb; b16 = WSP(bf16, WS_H) + (size_t)row * FF + kb; }
            else if (KIND == SG_KVQG) { wrow[t] = WSP(bf16, WS_WKVQG) + (size_t)(n0[t] + r) * D + kb; b32 = X + (size_t)row * D + kb; }
            else { wrow[t] = WSP(bf16, WS_WO) + (size_t)(n0[t] + r) * D + kb; b16 = WSP(bf16, WS_DIFF) + (size_t)row * D + kb; } }
        bf16x8 a0[NKS], a1[NKS], bb[NKS]; f32x4 x0[NKS], x1[NKS];
#pragma unroll
        for (int j = 0; j < NKS; ++j) { a0[j] = *(const bf16x8*)(wrow[0] + 16 * j); a1[j] = *(const bf16x8*)(wrow[1] + 16 * j);
            if (F32B) { x0[j] = *(const f32x4*)(b32 + 16 * j); x1[j] = *(const f32x4*)(b32 + 16 * j + 4); } else bb[j] = *(const bf16x8*)(b16 + 16 * j); }
        f32x16 acc0, acc1; float ssq = 0.f;
#pragma unroll
        for (int i = 0; i < 16; ++i) { acc0[i] = 0.f; acc1[i] = 0.f; }
#pragma unroll
        for (int j = 0; j < NKS; ++j) {
            if (F32B) { ssq += (x0[j][0] * x0[j][0] + x0[j][1] * x0[j][1]) + (x0[j][2] * x0[j][2] + x0[j][3] * x0[j][3]) + (x1[j][0] * x1[j][0] + x1[j][1] * x1[j][1]) + (x1[j][2] * x1[j][2] + x1[j][3] * x1[j][3]); bb[j] = cvt8(x0[j], x1[j]); }
            acc0 = __builtin_amdgcn_mfma_f32_32x32x16_bf16(a0[j], bb[j], acc0, 0, 0, 0);
            acc1 = __builtin_amdgcn_mfma_f32_32x32x16_bf16(a1[j], bb[j], acc1, 0, 0, 0);
        }
        __syncthreads();
#pragma unroll
        for (int i = 0; i < 16; ++i) { RED[(w * 16 + i) * 64 + lane] = acc0[i]; RED[((8 + w) * 16 + i) * 64 + lane] = acc1[i]; }
        if (F32B) SSQ[w * 64 + lane] = ssq;
        __syncthreads();
        {
            const int te = w >> 2, wq = w & 3;
            f32x4 v = (f32x4){0.f, 0.f, 0.f, 0.f};
#pragma unroll
            for (int ww = 0; ww < 8; ++ww)
#pragma unroll
                for (int e = 0; e < 4; ++e) v[e] += RED[((8 * te + ww) * 16 + 4 * wq + e) * 64 + lane];
            float rstd = 1.f;
            if (F32B) { float q = 0.f;
#pragma unroll
                for (int ww = 0; ww < 8; ++ww) q += SSQ[ww * 64 + r] + SSQ[ww * 64 + 32 + r];
                rstd = 1.0f / sqrtf(q * (1.0f / D) + RMS_EPS); }
            const int nb = te ? n0[1] : n0[0]; const int col = nb + 8 * wq + 4 * h;
            if (KIND == SG_POOL) {
                *(f32x4*)(X + (size_t)row * D + col) = *(const f32x4*)(F.x_s + (size_t)b * D + col) + v * *(const f32x4*)(F.pool_scale + col);
            } else if (KIND == SG_UP) {
                v = v * rstd;
#pragma unroll
                for (int e = 0; e < 4; ++e) { const float t = fmaxf(v[e], 0.f); v[e] = t * t; }
                v2u o; o.x = cvtpk(v[0], v[1]); o.y = cvtpk(v[2], v[3]); *(v2u*)(WSP(bf16, WS_H) + (size_t)row * FF + col) = o;
            } else if (KIND == SG_DOWN || KIND == SG_WO) {
#pragma unroll
                for (int e = 0; e < 4; ++e) unsafeAtomicAdd(X + (size_t)row * D + col + e, v[e]);
            } else {
                v = v * rstd; v2u o; o.x = cvtpk(v[0], v[1]); o.y = cvtpk(v[2], v[3]);
                if (nb < 1024) { *(f32x4*)(F.out + OUT_KV_S + (size_t)b * D + col) = v; if (nb >= 512) *(v2u*)(WSP(bf16, WS_KVS) + (size_t)row * 512 + col - 512) = o; }
                else if (nb < 1536) { *(v2u*)(WSP(bf16, WS_KVW) + (size_t)row * 512 + col - 1024) = o; *(f32x4*)(F.out + OUT_WIN_S + ((size_t)b * 512 + 511) * 512 + col - 1024) = v; }
                else if (nb < 2560) { *(v2u*)(WSP(bf16, WS_Q) + (size_t)row * D + col - 1536) = o; }
                else if (col < 2608) { float* gp = WSP(float, WS_GATE) + (size_t)row * 48 + col - 2560;
#pragma unroll
                    for (int e = 0; e < 4; ++e) gp[e] = 1.0f / (1.0f + __expf(-(v[e] + F.b_gate[col - 2560 + e]))); }
            }
        }
    }
    VM_WAIT(); __syncthreads();
}

__device__ __forceinline__ void p11_final(Frame& F) {
    const int gw = F.vcu * NWAVES + F.wave, NGW = F.G * NWAVES, lane = F.lane; const float* X = WSP(float, WS_X); const bf16* XB = WSP(bf16, WS_XB);
    for (int row = gw; row < MT; row += NGW) {
        f32x4 v[4]; float ss = 0.f;
        if (row < MP) { const v2u* xr = (const v2u*)(XB + (size_t)row * D) + lane;
#pragma unroll
            for (int j = 0; j < 4; ++j) { const v2u q = xr[64 * j]; v[j] = (f32x4){__builtin_bit_cast(float, q.x << 16), __builtin_bit_cast(float, q.x & 0xffff0000u), __builtin_bit_cast(float, q.y << 16), __builtin_bit_cast(float, q.y & 0xffff0000u)}; } }
        else { const f32x4* xr = (const f32x4*)(X + (size_t)row * D) + lane;
#pragma unroll
            for (int j = 0; j < 4; ++j) v[j] = xr[64 * j]; }
#pragma unroll
        for (int j = 0; j < 4; ++j) ss += (v[j][0] * v[j][0] + v[j][1] * v[j][1]) + (v[j][2] * v[j][2] + v[j][3] * v[j][3]);
        const float rstd = 1.0f / sqrtf(wave_sum(ss) * (1.0f / D) + RMS_EPS);
        float* o = (row < MP) ? F.out + OUT_Y_P + (size_t)row * D : F.out + OUT_Y_S + (size_t)(row - MP) * D;
#pragma unroll
        for (int j = 0; j < 4; ++j) *((f32x4*)o + lane + 64 * j) = v[j] * rstd * *((const f32x4*)F.norm_final + lane + 64 * j);
    }
}

constexpr int NPHASE = 12;
struct Args { const void* in[21]; float* out; unsigned char* ws; int ph_lo, ph_hi; };
__global__ void __launch_bounds__(NWAVES * 64, 2) yoco_fwd(Args args) {
    extern __shared__ __attribute__((aligned(16))) unsigned char lds[];
    Frame F;
    F.lds = (LAS unsigned char*)lds;
    F.tid = threadIdx.x; F.lane = F.tid & 63; F.wave = __builtin_amdgcn_readfirstlane(F.tid >> 6);
    F.G = gridDim.x; { const int bx = blockIdx.x; F.vcu = (F.G % 8 == 0) ? (bx % 8) * (F.G / 8) + bx / 8 : bx; }
    F.x_p = (const float*)args.in[0]; F.x_s = (const float*)args.in[1]; F.state_pool = (const float*)args.in[2]; F.cache = (const float*)args.in[3]; F.state_win = (const float*)args.in[4];
    F.page_table = (const int*)args.in[5]; F.norm_mix = (const float*)args.in[6]; F.norm_mlp = (const float*)args.in[7]; F.w_up = (const float*)args.in[8]; F.w_down = (const float*)args.in[9];
    F.pool_w = (const float*)args.in[10]; F.pool_scale = (const float*)args.in[11]; F.norm_kv = (const float*)args.in[12]; F.w_kv = (const float*)args.in[13]; F.cmp_pe = (const float*)args.in[14];
    F.cmp_w1 = (const float*)args.in[15]; F.cmp_w2 = (const float*)args.in[16]; F.w_qg = (const float*)args.in[17]; F.b_gate = (const float*)args.in[18]; F.w_o = (const float*)args.in[19];
    F.norm_final = (const float*)args.in[20]; F.out = args.out; F.ws = args.ws;
    volatile LAS unsigned* MISC = (volatile LAS unsigned*)(F.lds + MISC_OFF);
    for (int u = F.tid; u < (LDS_BYTES - RING_BYTES) / 4; u += NWAVES * 64) ((LAS unsigned*)(F.lds + RING_BYTES))[u] = 0u;
    __syncthreads();
    unsigned* ctl = (unsigned*)(F.ws + WS_CTL);
#if MK_MULTI
#define GRID_BAR() do { } while (0)
#else
    XcdBarrier bar = xcd_barrier_post(ctl + CW_BAR, MISC + 8);
#define GRID_BAR() xcd_barrier(bar)
#endif
    F.seg_t0 = 0ull; F.seg_dt = 0ull;
    const int lo = args.ph_lo, hi = args.ph_hi;
#define IN(k) (lo <= (k) && (k) < hi)
#define SEAM(k) do { SEG_BEGIN(100 + (k)); if (IN(k) && IN((k) + 1)) GRID_BAR(); SEG_END(100 + (k)); SEG_END(k); SEG_BEGIN((k) + 1); } while (0)
    using namespace pg8;
    float* X = WSP(float, WS_X); bf16* XB = WSP(bf16, WS_XB); float* RS = WSP(float, WS_RS);

    SEG_BEGIN(0);
    if (IN(0)) { for (int rep = 0; rep < REP(0); ++rep) { p0_prologue(F); __syncthreads(); } } SEAM(0);
    if (IN(1)) {
        for (int rep = 0; rep < REP(16); ++rep) small_gemm<SG_POOL>(F, 0);
        Gemm g{WSP(bf16_t, WS_DIFF), WSP(bf16_t, WS_WPOOL), MP, 1024, 256, 1024, 256, (size_t)512}; StaticOrder S; S.init(MP, 1024, F.G, (int)blockIdx.x);
        EpiResid E{F.x_p, XB, RS, F.pool_scale};
        gemm_phase<EpiResid, StaticOrder, true, true>(F.lds, g, S, E);
    } SEAM(1);
    if (IN(2)) {
        SEG_BEGIN(60); for (int rep = 0; rep < REP(14); ++rep) small_gemm<SG_UP>(F, 0); SEG_END(60); SEG_BEGIN(61);
        Gemm g{XB, WSP(bf16_t, WS_WUP), MP, FF, D, D, D, (size_t)0}; StaticOrder S; S.init(MP, FF, F.G, (int)blockIdx.x);
        EpiUp E{WSP(bf16_t, WS_H), RS};
        for (int rep = 0; rep < REP(2); ++rep) { gemm_phase<EpiUp, StaticOrder, true, true>(F.lds, g, S, E); __syncthreads(); } SEG_END(61);
    } SEAM(2);
    if (IN(3)) {
        small_gemm<SG_DOWN>(F, 0);
        Gemm g{WSP(bf16_t, WS_H), WSP(bf16_t, WS_WDN), MP, D, FF, FF, FF, (size_t)0}; StaticOrder S; S.init(MP, D, F.G, (int)blockIdx.x);
        EpiResid E{nullptr, XB, RS, nullptr};
        gemm_phase<EpiResid, StaticOrder, true, true>(F.lds, g, S, E);
    } SEAM(3);
    if (IN(4)) {
        SEG_BEGIN(30); for (int rep = 0; rep < REP(15); ++rep) small_gemm<SG_KVQG>(F, 0); SEG_END(30);
        SEG_BEGIN(31); if ((blockIdx.x & 1) == 0) p5_sample_compress(F, ctl + CW_QUEUE, 3); SEG_END(31); SEG_BEGIN(32);
        Gemm g{XB, WSP(bf16_t, WS_WKVQG), MP, NKVQG, D, D, D, (size_t)0}; StaticOrder S; S.init(MP, NKVQG, F.G, (int)blockIdx.x);
        EpiKvqg E{RS, F.b_gate, F.out + OUT_KV_P, F.out + OUT_KV_S, F.out + OUT_WIN_P, F.out + OUT_WIN_S, WSP(bf16_t, WS_CMPA), WSP(bf16_t, WS_KVS), WSP(bf16_t, WS_KVW), WSP(bf16_t, WS_Q), WSP(float, WS_GATE)};
        gemm_phase<EpiKvqg, StaticOrder, true, true>(F.lds, g, S, E);
        __syncthreads(); SEG_END(32); SEG_BEGIN(33);
        p5_sample_compress(F, ctl + CW_QUEUE, 1 << 30); SEG_END(33);
    } SEAM(4);
    if (IN(5)) {
        SEG_BEGIN(50); p5_prompt_compress(F); SEG_END(50); SEG_BEGIN(51);
        if (F.G > 64) { if ((int)blockIdx.x >= 64) p6_combine(F, 0, (int)blockIdx.x - 64, F.G - 64); } else { __syncthreads(); p6_combine(F, 0, (int)blockIdx.x, F.G); } SEG_END(51);
    } SEAM(5);
    if (IN(6)) { p6_combine(F, 1, (int)blockIdx.x, F.G); } SEAM(6);
    if (IN(7)) { p7_attention(F); } SEAM(7);
    if (IN(8)) {
        SEG_BEGIN(70); small_gemm<SG_WO>(F, 0); SEG_END(70); SEG_BEGIN(71);
        Gemm g{WSP(bf16_t, WS_DIFF), WSP(bf16_t, WS_WO), MP, D, D, D, D, (size_t)0}; StaticOrder S; S.init(MP, D, F.G, (int)blockIdx.x);
        EpiResid E{nullptr, XB, RS, nullptr};
        gemm_phase<EpiResid, StaticOrder, true, true>(F.lds, g, S, E); SEG_END(71);
    } SEAM(8);
    if (IN(9)) {
        small_gemm<SG_UP>(F, 1);
        Gemm g{XB, WSP(bf16_t, WS_WUP) + (size_t)FF * D, MP, FF, D, D, D, (size_t)0}; StaticOrder S; S.init(MP, FF, F.G, (int)blockIdx.x);
        EpiUp E{WSP(bf16_t, WS_H), RS};
        gemm_phase<EpiUp, StaticOrder, true, true>(F.lds, g, S, E);
    } SEAM(9);
    if (IN(10)) {
        small_gemm<SG_DOWN>(F, 1);
        Gemm g{WSP(bf16_t, WS_H), WSP(bf16_t, WS_WDN) + (size_t)D * FF, MP, D, FF, FF, FF, (size_t)0}; StaticOrder S; S.init(MP, D, F.G, (int)blockIdx.x);
        EpiResid E{nullptr, XB, RS, nullptr};
        gemm_phase<EpiResid, StaticOrder, true, true>(F.lds, g, S, E);
    } SEAM(10);
    if (IN(11)) { p11_final(F); }
    SEG_END(11);
    if (PROBE_SEG >= 0) { __syncthreads(); const unsigned long long t1 = __builtin_amdgcn_s_memrealtime(); while (__builtin_amdgcn_s_memrealtime() - t1 < F.seg_dt) __builtin_amdgcn_s_sleep(8); }
#undef IN
#undef SEAM
}

extern "C" void kernel_launch(void* const* d_in, const int* in_sizes, int n_in, void* d_out, int out_size, void* d_ws, size_t ws_size, hipStream_t stream) {
    static int grid = 0;
    if (grid == 0) {
        if (n_in != 21 || (size_t)out_size != OUT_TOTAL || ws_size < WS_END) { fprintf(stderr, "kernel_launch: unexpected sizes n_in %d out %d ws %zu\n", n_in, out_size, ws_size); grid = -1; return; }
        int dev = 0, cus = 0, per_cu = 0;
        if (hipGetDevice(&dev) != hipSuccess || hipDeviceGetAttribute(&cus, hipDeviceAttributeMultiprocessorCount, dev) != hipSuccess) { grid = -1; return; }
        if (hipFuncSetAttribute((const void*)yoco_fwd, hipFuncAttributeMaxDynamicSharedMemorySize, LDS_BYTES) != hipSuccess) { fprintf(stderr, "kernel_launch: hipFuncSetAttribute failed\n"); grid = -1; return; }
        if (hipOccupancyMaxActiveBlocksPerMultiprocessor(&per_cu, (const void*)yoco_fwd, NWAVES * 64, LDS_BYTES) != hipSuccess || per_cu < 1) fprintf(stderr, "kernel_launch: occupancy query says %d\n", per_cu);
        (void)hipGetLastError();
        grid = cus;
    }
    if (grid < 0) return;
    (void)hipMemsetAsync((char*)d_ws + WS_CTL, 0, CTL_ZERO_BYTES, stream);
    Args a{};
    for (int i = 0; i < 21; ++i) a.in[i] = d_in[i];
    a.out = (float*)d_out; a.ws = (unsigned char*)d_ws;
#if MK_MULTI
    for (int p = 0; p < NPHASE; ++p) { a.ph_lo = p; a.ph_hi = p + 1; hipLaunchKernelGGL(yoco_fwd, dim3(grid), dim3(NWAVES * 64), LDS_BYTES, stream, a); }
#else
    a.ph_lo = 0; a.ph_hi = NPHASE;
    hipLaunchKernelGGL(yoco_fwd, dim3(grid), dim3(NWAVES * 64), LDS_BYTES, stream, a);
#endif
    const hipError_t le = hipPeekAtLastError();
    if (le != hipSuccess) fprintf(stderr, "kernel_launch: launch failed: %s\n", hipGetErrorName(le));
}
```

```cpp
#include <hip/hip_runtime.h>
#include <hip/hip_bf16.h>
#include <cstdio>
#include <cstdint>
#include <cmath>

#ifndef MK_MULTI
#define MK_MULTI 0
#endif

constexpr int D = 1024, FF = 4096, SEQ = 4096, NB = 4, DB = 128, PAST = 2048;
constexpr int MP = NB * SEQ;
constexpr int MT = MP + DB;
constexpr int MPAD = 16640;
constexpr int NKVQG = 2816;
constexpr int CMP_ROWS_P = NB * 256 * 4;
constexpr int CMP_ROWS_S = DB * 128 * 4;
constexpr int CMP_ROWS = CMP_ROWS_P + CMP_ROWS_S;
constexpr float RMS_EPS = 1e-6f;
constexpr float LOG2E = 1.4426950408889634f;
constexpr float QSCALE = 0.125f * LOG2E;

namespace pg8 {
#define PG8_LAS __attribute__((address_space(3)))
typedef unsigned short bf16_t;
typedef short bf16x8 __attribute__((ext_vector_type(8)));
typedef float f32x4 __attribute__((ext_vector_type(4)));
typedef float f32x2 __attribute__((ext_vector_type(2)));
typedef unsigned u32x4 __attribute__((ext_vector_type(4)));
typedef unsigned u32x2 __attribute__((ext_vector_type(2)));
constexpr int BM = 256, BK = 64, HALF = 128, HTB = HALF * BK * 2, STAGE_BYTES = 8 * HTB, NXCD = 8, WGM = 8;

__host__ __device__ __forceinline__ int lds_byte(int r, int c) { const int st = (r >> 4) * 2 + (c >> 5), rr = r & 15, cc = c & 31, ob = rr * 64 + cc * 2; return st * 1024 + (ob ^ (((ob >> 9) & 1) << 5)); }
__host__ __device__ __forceinline__ void stage_rc(int b, int& R, int& C) { const int st = b / 1024, sb = b % 1024, swz = sb ^ (((sb >> 9) & 1) << 5); R = (st >> 1) * 16 + swz / 64; C = (st & 1) * 32 + (swz % 64) / 2; }
__host__ __device__ __forceinline__ int perm32(int rho) { const int n = rho >> 4, i = rho & 15; return 8 * (i >> 2) + 4 * n + (i & 3); }

struct Unit { int pm, pn; };
struct Gemm { const bf16_t* A; const bf16_t* Bt; int M, N, K, lda, ldb; size_t a_pn_off; };

struct StaticOrder {
    int nM, nN, nwg, G, c;
    __host__ __device__ void init(int M, int N, int G_, int c_) { nM = M / BM; nN = N / BM; nwg = nM * nN; G = G_; c = c_; }
    __host__ __device__ bool next(int i, Unit& u) const {
        const long L = (long)i * G + c; if (L >= nwg) return false;
        int wgid = (int)L; { const int q = nwg / NXCD, r = nwg % NXCD, xcd = wgid % NXCD, off = wgid / NXCD; wgid = (xcd < r ? xcd * (q + 1) : r * (q + 1) + (xcd - r) * q) + off; }
        const int nig = WGM * nN, gid = wgid / nig, fm = gid * WGM, gsz = (nM - fm) < WGM ? (nM - fm) : WGM;
        u.pm = fm + ((wgid % nig) % gsz); u.pn = (wgid % nig) / gsz; return true;
    }
    __device__ __forceinline__ void a_ready(const Unit&) const {}
    __device__ __forceinline__ void done(const Unit&) const {}
};

__device__ __forceinline__ unsigned cvt_pk_bf16(float lo, float hi) { unsigned r; asm volatile("v_cvt_pk_bf16_f32 %0, %1, %2" : "=v"(r) : "v"(lo), "v"(hi)); return r; }

__device__ __forceinline__ float row_rstd(const float* rs, int row) {
    const f32x4* p = (const f32x4*)(rs + (size_t)row * 16); const f32x4 a = p[0], b = p[1], c = p[2], d = p[3];
    const float s = ((a[0] + a[1]) + (a[2] + a[3])) + ((b[0] + b[1]) + (b[2] + b[3])) + ((c[0] + c[1]) + (c[2] + c[3])) + ((d[0] + d[1]) + (d[2] + d[3]));
    return 1.0f / sqrtf(s * (1.0f / 1024.0f) + RMS_EPS);
}

struct EpiResid {
    static constexpr bool PERM = false, AFTER_DRAIN = false;
    const float* base_f; bf16_t* XB; float* RS; const float* scale;
    __device__ __forceinline__ void operator()(const f32x4 (&acc)[2][2][4][2], const Unit& u, int wr, int wc, int fr, int fq) const {
        const int col0 = u.pn * BM + wc * 32 + 4 * fq;
        f32x4 sc[2][2];
#pragma unroll
        for (int bj = 0; bj < 2; ++bj)
#pragma unroll
            for (int n = 0; n < 2; ++n) sc[bj][n] = scale ? *(const f32x4*)(scale + col0 + bj * HALF + n * 16) : (f32x4){1.f, 1.f, 1.f, 1.f};
#pragma unroll
        for (int ai = 0; ai < 2; ++ai) {
#pragma unroll
            for (int m = 0; m < 4; ++m) {
                const int row = u.pm * BM + ai * HALF + wr * 64 + m * 16 + fr;
                float ss = 0.f;
#pragma unroll
                for (int bj = 0; bj < 2; ++bj)
#pragma unroll
                    for (int n = 0; n < 2; ++n) {
                        const int col = col0 + bj * HALF + n * 16;
                        f32x4 bv;
                        if (base_f) bv = *(const f32x4*)(base_f + (size_t)row * D + col);
                        else { const u32x2 q = *(const u32x2*)(XB + (size_t)row * D + col); bv = (f32x4){__builtin_bit_cast(float, q.x << 16), __builtin_bit_cast(float, q.x & 0xffff0000u), __builtin_bit_cast(float, q.y << 16), __builtin_bit_cast(float, q.y & 0xffff0000u)}; }
                        const f32x4 v = bv + acc[ai][bj][m][n] * sc[bj][n];
                        u32x2 w; w.x = cvt_pk_bf16(v[0], v[1]); w.y = cvt_pk_bf16(v[2], v[3]);
                        *(u32x2*)(XB + (size_t)row * D + col) = w;
                        ss += (v[0] * v[0] + v[1] * v[1]) + (v[2] * v[2] + v[3] * v[3]);
                    }
                ss += __shfl_xor(ss, 16); ss += __shfl_xor(ss, 32);
                if (fq == 0) RS[(size_t)row * 16 + u.pn * 4 + wc] = ss;
            }
        }
    }
};

struct EpiUp {
    static constexpr bool PERM = true, AFTER_DRAIN = false;
    bf16_t* H; const float* RS;
    __device__ __forceinline__ void operator()(const f32x4 (&acc)[2][2][4][2], const Unit& u, int wr, int wc, int fr, int fq) const {
        const int col0 = u.pn * BM + wc * 32 + 8 * fq;
#pragma unroll
        for (int ai = 0; ai < 2; ++ai) {
            if (u.pm * BM + ai * HALF >= MT) continue;
#pragma unroll
            for (int m = 0; m < 4; ++m) {
                const int row = u.pm * BM + ai * HALF + wr * 64 + m * 16 + fr;
                const float rstd = row_rstd(RS, row);
#pragma unroll
                for (int bj = 0; bj < 2; ++bj) {
                    f32x4 v0 = acc[ai][bj][m][0] * rstd, v1 = acc[ai][bj][m][1] * rstd;
#pragma unroll
                    for (int e = 0; e < 4; ++e) { const float a = fmaxf(v0[e], 0.f), b = fmaxf(v1[e], 0.f); v0[e] = a * a; v1[e] = b * b; }
                    u32x4 w; w.x = cvt_pk_bf16(v0[0], v0[1]); w.y = cvt_pk_bf16(v0[2], v0[3]); w.z = cvt_pk_bf16(v1[0], v1[1]); w.w = cvt_pk_bf16(v1[2], v1[3]);
                    *(u32x4*)(H + (size_t)row * FF + col0 + bj * HALF) = w;
                }
            }
        }
    }
};

struct EpiKvqg {
    static constexpr bool PERM = true, AFTER_DRAIN = false;
    const float* RS; const float* bgate;
    float* kv_p; float* kv_s; float* win_p; float* win_s;
    bf16_t* CMPA; bf16_t* KVS; bf16_t* KVW; bf16_t* Q; float* GATE;
    __device__ __forceinline__ void operator()(const f32x4 (&acc)[2][2][4][2], const Unit& u, int wr, int wc, int fr, int fq) const {
        const int pn = u.pn;
#pragma unroll
        for (int ai = 0; ai < 2; ++ai) {
            if (u.pm * BM + ai * HALF >= MT) continue;
#pragma unroll
            for (int m = 0; m < 4; ++m) {
                const int row = u.pm * BM + ai * HALF + wr * 64 + m * 16 + fr;
                const float rstd = row_rstd(RS, row);
                const bool prompt = row < MP; const int b = prompt ? (row >> 12) : (row - MP), t = row & (SEQ - 1);
#pragma unroll
                for (int bj = 0; bj < 2; ++bj) {
                    const int cin = bj * HALF + wc * 32 + 8 * fq;
                    const f32x4 v0 = acc[ai][bj][m][0] * rstd, v1 = acc[ai][bj][m][1] * rstd;
                    u32x4 w; w.x = cvt_pk_bf16(v0[0], v0[1]); w.y = cvt_pk_bf16(v0[2], v0[3]); w.z = cvt_pk_bf16(v1[0], v1[1]); w.w = cvt_pk_bf16(v1[2], v1[3]);
                    if (pn < 4) {
                        float* o = prompt ? kv_p + (size_t)row * D : kv_s + (size_t)b * D;
                        __builtin_nontemporal_store(v0, (f32x4*)(o + pn * BM + cin)); __builtin_nontemporal_store(v1, (f32x4*)(o + pn * BM + cin + 4));
                        if (pn < 2) {
                            if (prompt) { const int g = cin >> 6, d = cin & 63;
                                *(u32x4*)(CMPA + (size_t)pn * CMP_ROWS * D + (size_t)(((b * 256 + (t >> 4)) * 4 + g)) * D + (t & 15) * 64 + d) = w; }
                        } else *(u32x4*)(KVS + (size_t)row * 512 + (pn - 2) * BM + cin) = w;
                    } else if (pn < 6) {
                        const int c = (pn - 4) * BM + cin;
                        *(u32x4*)(KVW + (size_t)row * 512 + c) = w;
                        if (prompt) { if (t >= SEQ - 512) { float* o = win_p + ((size_t)b * 512 + (t - (SEQ - 512))) * 512 + c; *(f32x4*)o = v0; *(f32x4*)(o + 4) = v1; } }
                        else { float* o = win_s + ((size_t)b * 512 + 511) * 512 + c; *(f32x4*)o = v0; *(f32x4*)(o + 4) = v1; }
                    } else if (pn < 10) {
                        *(u32x4*)(Q + (size_t)row * D + (pn - 6) * BM + cin) = w;
                    } else {
                        if (cin < 48) {
#pragma unroll
                            for (int e = 0; e < 4; ++e) { GATE[(size_t)row * 48 + cin + e] = 1.0f / (1.0f + __expf(-(v0[e] + bgate[cin + e]))); GATE[(size_t)row * 48 + cin + 4 + e] = 1.0f / (1.0f + __expf(-(v1[e] + bgate[cin + 4 + e]))); }
                        }
                    }
                }
            }
        }
    }
};

struct EpiCmp {
    static constexpr bool PERM = false, AFTER_DRAIN = false;
    float* P;
    __device__ __forceinline__ void operator()(const f32x4 (&acc)[2][2][4][2], const Unit& u, int wr, int wc, int fr, int fq) const {
        float* base = P + (size_t)u.pn * CMP_ROWS * 256;
#pragma unroll
        for (int ai = 0; ai < 2; ++ai)
#pragma unroll
            for (int m = 0; m < 4; ++m) {
                const int row = u.pm * BM + ai * HALF + wr * 64 + m * 16 + fr;
#pragma unroll
                for (int bj = 0; bj < 2; ++bj)
#pragma unroll
                    for (int n = 0; n < 2; ++n) *(f32x4*)(base + (size_t)row * 256 + bj * HALF + wc * 32 + n * 16 + 4 * fq) = acc[ai][bj][m][n];
            }
    }
};

template <class Epi, class Sched, bool ALIGN_EPI = false, bool SP2 = false>
__device__ __forceinline__ void gemm_phase(PG8_LAS unsigned char* lds, const Gemm g, const Sched& S, const Epi& E) {
    const int tid = threadIdx.x, wid = __builtin_amdgcn_readfirstlane(tid >> 6), lane = tid & 63, wr = wid >> 2, wc = wid & 3, fr = lane & 15, fq = lane >> 4;
    const int K = g.K, nt = K / BK;
    unsigned voffA[2], voffB[2];
#pragma unroll
    for (int i = 0; i < 2; ++i) { int R, C; stage_rc(tid * 16 + i * 8192, R, C); const int Rb = Epi::PERM ? ((R & ~31) + perm32(R & 31)) : R;
        voffA[i] = (unsigned)(R * g.lda + C) * 2u; voffB[i] = (unsigned)(Rb * g.ldb + C) * 2u; }
    const size_t kstep = (size_t)(BK * 2);
    const size_t hstepA = (size_t)HALF * g.lda * 2, hstepB = (size_t)HALF * g.ldb * 2;
    const size_t tstepA = 2 * hstepA, tstepB = 2 * hstepB;
    const unsigned ldsw = (unsigned)wid * 1024u;
    const int aoff = lds_byte(wr * 64 + fr, fq * 8), boff = lds_byte(wc * 32 + fr, fq * 8);
#define PG8_SA(b, h) (((b) * 2 + (h)) * HTB)
#define PG8_SB(b, h) ((4 + (b) * 2 + (h)) * HTB)
#define PG8_STAGE(bufoff, gbase, voff) do { _Pragma("unroll") for (int _i = 0; _i < 2; ++_i) \
        __builtin_amdgcn_global_load_lds((const unsigned*)((const char*)(gbase) + (voff)[_i]), (PG8_LAS unsigned*)(lds + (bufoff) + ldsw + _i * 8192), 16, 0, 0); } while (0)
#define PG8_LDA(dst, b, h) do { _Pragma("unroll") for (int m = 0; m < 4; ++m) _Pragma("unroll") for (int k = 0; k < 2; ++k) dst[m][k] = *(const PG8_LAS bf16x8*)(lds + PG8_SA(b, h) + aoff + m * 2048 + k * 1024); } while (0)
#define PG8_LDB(dst, b, h) do { _Pragma("unroll") for (int n = 0; n < 2; ++n) _Pragma("unroll") for (int k = 0; k < 2; ++k) dst[n][k] = *(const PG8_LAS bf16x8*)(lds + PG8_SB(b, h) + boff + n * 2048 + k * 1024); } while (0)
#define PG8_MMA(ai, bj, At, Bt) do { __builtin_amdgcn_s_setprio(1); _Pragma("unroll") for (int m = 0; m < 4; ++m) _Pragma("unroll") for (int n = 0; n < 2; ++n) _Pragma("unroll") for (int k = 0; k < 2; ++k) \
        acc[ai][bj][m][n] = __builtin_amdgcn_mfma_f32_16x16x32_bf16(Bt[n][k], At[m][k], acc[ai][bj][m][n], 0, 0, 0); __builtin_amdgcn_s_setprio(0); } while (0)
#define PG8_WAIT_V(n) asm volatile("s_waitcnt vmcnt(" #n ")" ::: "memory")
#define PG8_WAIT_L(n) asm volatile("s_waitcnt lgkmcnt(" #n ")" ::: "memory")
#define PG8_BAR __builtin_amdgcn_s_barrier()
#define PG8_SCHED __builtin_amdgcn_sched_barrier(0)
    Unit cur, nxt; int ui = 0;
    if (!S.next(0, cur)) return;
    f32x4 acc[2][2][4][2];
#pragma unroll
    for (int a = 0; a < 2; ++a)
#pragma unroll
        for (int b = 0; b < 2; ++b)
#pragma unroll
            for (int m = 0; m < 4; ++m)
#pragma unroll
                for (int n = 0; n < 2; ++n) acc[a][b][m][n] = (f32x4){0.f, 0.f, 0.f, 0.f};
    bf16x8 At[4][2], B0[2][2], B1[2][2];
    const char* cA = (const char*)g.A + (size_t)cur.pm * tstepA + (size_t)cur.pn * g.a_pn_off; const char* cB = (const char*)g.Bt + (size_t)cur.pn * tstepB;
    S.a_ready(cur);
    if constexpr (SP2) {
        PG8_STAGE(PG8_SB(0, 0), cB, voffB); PG8_STAGE(PG8_SB(0, 1), cB + hstepB, voffB); PG8_STAGE(PG8_SA(0, 0), cA, voffA); PG8_STAGE(PG8_SA(0, 1), cA + hstepA, voffA);
        if (wr == 1) PG8_BAR;
        PG8_WAIT_V(2); PG8_BAR;
        PG8_STAGE(PG8_SB(1, 0), cB + kstep, voffB); PG8_STAGE(PG8_SA(1, 0), cA + kstep, voffA); PG8_STAGE(PG8_SB(1, 1), cB + hstepB + kstep, voffB);
        PG8_WAIT_V(6); PG8_BAR;
    } else {
        PG8_STAGE(PG8_SB(0, 0), cB, voffB); PG8_STAGE(PG8_SA(0, 0), cA, voffA); PG8_STAGE(PG8_SB(0, 1), cB + hstepB, voffB); PG8_STAGE(PG8_SA(0, 1), cA + hstepA, voffA);
        if (wr == 1) PG8_BAR;
        PG8_WAIT_V(4); PG8_BAR;
        PG8_STAGE(PG8_SB(1, 0), cB + kstep, voffB); PG8_STAGE(PG8_SA(1, 0), cA + kstep, voffA); PG8_STAGE(PG8_SB(1, 1), cB + hstepB + kstep, voffB);
        PG8_WAIT_V(6); PG8_BAR;
    }
    for (;;) {
        const bool has_next = S.next(ui + 1, nxt);
        const char* nA = has_next ? (const char*)g.A + (size_t)nxt.pm * tstepA + (size_t)nxt.pn * g.a_pn_off : cA; const char* nB = has_next ? (const char*)g.Bt + (size_t)nxt.pn * tstepB : cB;
        for (int t = 0; t < nt; t += 2) {
            const bool last = (t == nt - 2);
            const char* a1 = cA + (size_t)(t + 1) * kstep;
            const char* a2 = last ? nA : cA + (size_t)(t + 2) * kstep; const char* b2 = last ? nB : cB + (size_t)(t + 2) * kstep;
            const char* a3 = a2 + kstep; const char* b3 = b2 + kstep;
            if (last && has_next) S.a_ready(nxt);
            if constexpr (SP2) {
            PG8_LDB(B0, 0, 0); PG8_LDB(B1, 0, 1); PG8_SCHED; PG8_LDA(At, 0, 0); PG8_STAGE(PG8_SA(1, 1), a1 + hstepA, voffA);
            PG8_WAIT_V(8); PG8_WAIT_L(0); PG8_BAR; PG8_MMA(0, 0, At, B0); PG8_MMA(0, 1, At, B1); PG8_BAR; PG8_SCHED;
            PG8_LDA(At, 0, 1); PG8_STAGE(PG8_SB(0, 0), b2, voffB); PG8_STAGE(PG8_SB(0, 1), b2 + hstepB, voffB); PG8_STAGE(PG8_SA(0, 0), a2, voffA);
            PG8_WAIT_V(8); PG8_WAIT_L(0); PG8_BAR; PG8_MMA(1, 0, At, B0); PG8_MMA(1, 1, At, B1); PG8_BAR; PG8_SCHED;
            PG8_LDB(B0, 1, 0); PG8_LDB(B1, 1, 1); PG8_SCHED; PG8_LDA(At, 1, 0); PG8_STAGE(PG8_SA(0, 1), a2 + hstepA, voffA);
            PG8_WAIT_V(8); PG8_WAIT_L(0); PG8_BAR; PG8_MMA(0, 0, At, B0); PG8_MMA(0, 1, At, B1); PG8_BAR; PG8_SCHED;
            PG8_LDA(At, 1, 1); PG8_STAGE(PG8_SB(1, 0), b3, voffB); PG8_STAGE(PG8_SB(1, 1), b3 + hstepB, voffB); PG8_STAGE(PG8_SA(1, 0), a3, voffA);
            PG8_WAIT_V(8); PG8_WAIT_L(0); PG8_BAR; PG8_MMA(1, 0, At, B0); PG8_MMA(1, 1, At, B1); PG8_BAR; PG8_SCHED;
            } else {
            PG8_LDB(B0, 0, 0); PG8_SCHED; PG8_LDA(At, 0, 0); PG8_STAGE(PG8_SA(1, 1), a1 + hstepA, voffA);
            PG8_WAIT_L(8); PG8_BAR; PG8_WAIT_L(0); PG8_MMA(0, 0, At, B0); PG8_BAR; PG8_SCHED;
            PG8_LDB(B1, 0, 1); PG8_STAGE(PG8_SB(0, 0), b2, voffB);
            PG8_BAR; PG8_WAIT_L(0); PG8_MMA(0, 1, At, B1); PG8_BAR;
            PG8_LDA(At, 0, 1); PG8_STAGE(PG8_SA(0, 0), a2, voffA);
            PG8_BAR; PG8_WAIT_L(0); PG8_MMA(1, 0, At, B0); PG8_BAR; PG8_SCHED;
            PG8_STAGE(PG8_SB(0, 1), b2 + hstepB, voffB);
            PG8_WAIT_V(6); PG8_BAR; PG8_MMA(1, 1, At, B1); PG8_BAR;
            PG8_LDB(B0, 1, 0); PG8_SCHED; PG8_LDA(At, 1, 0); PG8_STAGE(PG8_SA(0, 1), a2 + hstepA, voffA);
            PG8_WAIT_L(8); PG8_BAR; PG8_WAIT_L(0); PG8_MMA(0, 0, At, B0); PG8_BAR; PG8_SCHED;
            PG8_LDB(B1, 1, 1); PG8_STAGE(PG8_SB(1, 0), b3, voffB);
            PG8_BAR; PG8_WAIT_L(0); PG8_MMA(0, 1, At, B1); PG8_BAR;
            PG8_LDA(At, 1, 1); PG8_STAGE(PG8_SA(1, 0), a3, voffA);
            PG8_BAR; PG8_WAIT_L(0); PG8_MMA(1, 0, At, B0); PG8_BAR; PG8_SCHED;
            PG8_STAGE(PG8_SB(1, 1), b3 + hstepB, voffB);
            PG8_WAIT_V(6); PG8_BAR; PG8_MMA(1, 1, At, B1); PG8_BAR;
            }
        }
        if constexpr (ALIGN_EPI) { if (wr == 0) PG8_BAR; }
        if constexpr (!Epi::AFTER_DRAIN) { E(acc, cur, wr, wc, fr, fq); S.done(cur); }
        if (!has_next) break;
#pragma unroll
        for (int a = 0; a < 2; ++a)
#pragma unroll
            for (int b = 0; b < 2; ++b)
#pragma unroll
                for (int m = 0; m < 4; ++m)
#pragma unroll
                    for (int n = 0; n < 2; ++n) acc[a][b][m][n] = (f32x4){0.f, 0.f, 0.f, 0.f};
        cur = nxt; cA = nA; cB = nB; ++ui;
        if constexpr (ALIGN_EPI) { if (wr == 1) PG8_BAR; }
    }
    PG8_WAIT_V(0);
    if constexpr (!ALIGN_EPI) { if (wr == 0) PG8_BAR; }
    PG8_BAR;
    if constexpr (Epi::AFTER_DRAIN) { E.fused(acc, cur, wr, wc, fr, fq, lds, wid, lane); S.done(cur); }
#undef PG8_SA
#undef PG8_SB
#undef PG8_STAGE
#undef PG8_LDA
#undef PG8_LDB
#undef PG8_MMA
#undef PG8_WAIT_V
#undef PG8_WAIT_L
#undef PG8_BAR
#undef PG8_SCHED
}
}

#define GAS __attribute__((address_space(1)))
#define LAS __attribute__((address_space(3)))
typedef unsigned short bf16;
typedef unsigned v4u __attribute__((ext_vector_type(4)));
typedef unsigned v2u __attribute__((ext_vector_type(2)));
typedef float f32x4 __attribute__((ext_vector_type(4)));
typedef float f32x2 __attribute__((ext_vector_type(2)));
typedef float f32x16 __attribute__((ext_vector_type(16)));
typedef short bf16x8 __attribute__((ext_vector_type(8)));
typedef short v4i16_t __attribute__((ext_vector_type(4)));
typedef GAS unsigned gu32;
typedef GAS unsigned long long gu64;
#define RLX_AGENT __ATOMIC_RELAXED, __HIP_MEMORY_SCOPE_AGENT
#define LDS_WAIT() asm volatile("s_waitcnt lgkmcnt(0)" ::: "memory")
#define VM_WAIT() asm volatile("s_waitcnt vmcnt(0)" ::: "memory")
__device__ __forceinline__ unsigned f2bf(float f) { unsigned u = __builtin_bit_cast(unsigned, f); return (u + 0x7fffu + ((u >> 16) & 1u)) >> 16; }
__device__ __forceinline__ unsigned pk2(float lo, float hi) { return f2bf(lo) | (f2bf(hi) << 16); }
__device__ __forceinline__ float bf2f(unsigned short h) { return __builtin_bit_cast(float, (unsigned)h << 16); }

#define XB_TMO      128
#define XB_XCNT(j)  (256  + 64 * (j))
#define XB_XSUB(j)  (1280 + 64 * (j))
#define XB_XGEN(j)  (2304 + 64 * (j))
#define XB_TOP      3328
#define XB_TOPGEN   3392
#define XCD_BAR_WORDS 3456
#define XB_SPIN_CAP (1u << 18)

__device__ __forceinline__ unsigned xb_ld(unsigned* p)              { return __hip_atomic_load(p, __ATOMIC_RELAXED, __HIP_MEMORY_SCOPE_AGENT); }
__device__ __forceinline__ unsigned xb_add(unsigned* p, unsigned v) { return __hip_atomic_fetch_add(p, v, __ATOMIC_RELAXED, __HIP_MEMORY_SCOPE_AGENT); }
__device__ __forceinline__ unsigned xb_xcc_id() { return (unsigned)__builtin_amdgcn_s_getreg((3 << 11) | 20) & 0xFu; }
#define XB_SPIN(cond, bar) do { unsigned _sp = 0; while (cond) { __builtin_amdgcn_s_sleep(1); \
    if ((++_sp & 255u) == 0u) { if (xb_ld(&(bar)[XB_TMO])) break; if (_sp > XB_SPIN_CAP) { atomicAdd(&(bar)[XB_TMO], 1u); break; } } } } while (0)

struct XcdBarrier {
    unsigned* bar; unsigned x;
    volatile LAS unsigned* st;
};

__device__ __forceinline__ XcdBarrier xcd_barrier_post(unsigned* bar, volatile LAS unsigned* st) {
    XcdBarrier b; b.bar = bar; b.x = xb_xcc_id(); b.st = st;
    if (threadIdx.x == 0) (void)xb_add(&bar[XB_XCNT(b.x)], 1u);
    return b;
}
__device__ __forceinline__ void xcd_barrier_complete(unsigned* bar, unsigned x, unsigned& nloc, unsigned& nx) {
    const unsigned G = gridDim.x * gridDim.y * gridDim.z;
    unsigned sum, cnt, mine, sp = 0u;
    for (;;) {
        sum = 0u; cnt = 0u; mine = 0u;
#pragma unroll
        for (unsigned j = 0; j < 16; ++j) { const unsigned c = xb_ld(&bar[XB_XCNT(j)]); sum += c; cnt += (c > 0u) ? 1u : 0u; mine = (j == x) ? c : mine; }
        if (sum == G) break;
        __builtin_amdgcn_s_sleep(1);
        if ((++sp & 255u) == 0u) { if (xb_ld(&bar[XB_TMO])) break; if (sp > XB_SPIN_CAP) { atomicAdd(&bar[XB_TMO], 1u); break; } }
    }
    nloc = mine > 0u ? mine : 1u; nx = cnt > 0u ? cnt : 1u;
}

__device__ __forceinline__ void xcd_barrier(const XcdBarrier& b) {
    asm volatile("s_waitcnt vmcnt(0)" ::: "memory");
    __syncthreads();
    if (threadIdx.x == 0) {
        unsigned* bar = b.bar;
        __builtin_amdgcn_s_waitcnt(0);
        unsigned nloc = b.st[0], nx = b.st[1];
        if (nloc == 0u) { xcd_barrier_complete(bar, b.x, nloc, nx); b.st[0] = nloc; b.st[1] = nx; }
        const unsigned old = xb_add(&bar[XB_XSUB(b.x)], 1u);
        const unsigned gen = old / nloc;
        if (old + 1u == (gen + 1u) * nloc) {
            __builtin_amdgcn_fence(__ATOMIC_RELEASE, "agent");
            asm volatile("s_waitcnt vmcnt(0)" ::: "memory");
            const unsigned og = xb_add(&bar[XB_TOP], 1u);
            const unsigned tg = og / nx;
            if (og + 1u == (tg + 1u) * nx) xb_add(&bar[XB_TOPGEN], 1u);
            else XB_SPIN(xb_ld(&bar[XB_TOPGEN]) == tg, bar);
            __builtin_amdgcn_fence(__ATOMIC_ACQUIRE, "agent");
            xb_add(&bar[XB_XGEN(b.x)], 1u);
            asm volatile("s_waitcnt vmcnt(0)" ::: "memory");
        } else {
            XB_SPIN(xb_ld(&bar[XB_XGEN(b.x)]) == gen, bar);
            __builtin_amdgcn_fence(__ATOMIC_ACQUIRE, "agent");
            asm volatile("s_waitcnt vmcnt(0)" ::: "memory");
        }
    }
    __syncthreads();
}

constexpr size_t MiB = 1u << 20;
constexpr size_t WS_CTL = 0, CTL_ZERO_BYTES = 1 * MiB;
constexpr size_t WS_WUP = 2 * MiB;
constexpr size_t WS_WDN = 18 * MiB;
constexpr size_t WS_WKVQG = 34 * MiB;
constexpr size_t WS_WO = 40 * MiB;
constexpr size_t WS_WPOOL = 42 * MiB;
constexpr size_t WS_W1CAT = 43 * MiB;
constexpr size_t WS_CBIAS = 44 * MiB;
constexpr size_t WS_RS = 45 * MiB;
constexpr size_t WS_GATE = 47 * MiB;
constexpr size_t WS_X = 52 * MiB;
constexpr size_t WS_XB = 118 * MiB;
constexpr size_t WS_DIFF = 152 * MiB;
constexpr size_t WS_Q = 186 * MiB;
constexpr size_t WS_KVS = 220 * MiB;
constexpr size_t WS_KVW = 238 * MiB;
constexpr size_t WS_KC = 256 * MiB;
constexpr size_t WS_KCS = 258 * MiB;
constexpr size_t WS_H = 292 * MiB;
constexpr size_t WS_CMPA = 424 * MiB;
constexpr size_t WS_CMPP = 700 * MiB;
constexpr size_t WS_END = 840 * MiB;
constexpr int CW_BAR = 4096;

constexpr size_t OUT_Y_P = 0, OUT_Y_S = 16777216, OUT_POOL_P = 16908288, OUT_POOL_S = 16969728, OUT_KV_P = 18935808, OUT_KV_S = 35713024, OUT_WIN_P = 35844096, OUT_WIN_S = 36892672, OUT_TOTAL = 70447104;

#ifndef PROBE_DUP
#define PROBE_DUP 0
#endif
#define REP(k) (1 + ((PROBE_DUP >> (k)) & 1))
constexpr int NWAVES = 8;
constexpr int RING_BYTES = 131072, MISC_OFF = RING_BYTES + 320, LDS_BYTES = 147456;

#ifndef PROBE_SEG
#define PROBE_SEG -1
#endif
#define SEG_BEGIN(id) do { if (PROBE_SEG == (id)) F.seg_t0 = __builtin_amdgcn_s_memrealtime(); } while (0)
#define SEG_END(id) do { if (PROBE_SEG == (id)) F.seg_dt += __builtin_amdgcn_s_memrealtime() - F.seg_t0; } while (0)
struct Frame {
    unsigned long long seg_t0, seg_dt;
    LAS unsigned char* lds;
    int tid, lane, wave, vcu, G;
    const float *x_p, *x_s, *state_pool, *cache, *state_win; const int* page_table;
    const float *norm_mix, *norm_mlp, *w_up, *w_down, *pool_w, *pool_scale, *norm_kv, *w_kv, *cmp_pe, *cmp_w1, *cmp_w2, *w_qg, *b_gate, *w_o, *norm_final;
    float* out; unsigned char* ws;
};
#define WSP(T, off) ((T*)(F.ws + (off)))

__device__ __forceinline__ unsigned cvtpk(float lo, float hi) { typedef __bf16 bf16x2_t __attribute__((ext_vector_type(2))); f32x2 v = {lo, hi}; bf16x2_t b = __builtin_convertvector(v, bf16x2_t); return __builtin_bit_cast(unsigned, b); }
__device__ __forceinline__ bf16x8 cvt8(const f32x4 a, const f32x4 b) { v4u w; w.x = cvtpk(a[0], a[1]); w.y = cvtpk(a[2], a[3]); w.z = cvtpk(b[0], b[1]); w.w = cvtpk(b[2], b[3]); return __builtin_bit_cast(bf16x8, w); }
__device__ __forceinline__ float wave_sum(float v) {
#pragma unroll
    for (int o = 1; o < 64; o <<= 1) v += __shfl_xor(v, o);
    return v;
}
__device__ __forceinline__ float wave_max(float v) {
#pragma unroll
    for (int o = 1; o < 64; o <<= 1) v = fmaxf(v, __shfl_xor(v, o));
    return v;
}

struct TItem { const float* W; bf16* WT; const float* kscale; int N, ldt, row_off, kb, nb; float scale; };
constexpr int TP = 260;
__device__ __forceinline__ void ti_load(const TItem& t, f32x4 (&wv)[8], int tid) {
    const int k0 = 64 * t.kb, col = 256 * t.nb + 4 * (tid & 63);
#pragma unroll
    for (int e = 0; e < 8; ++e) wv[e] = (col < t.N) ? *(const f32x4*)(t.W + (size_t)(k0 + (tid >> 6) + 8 * e) * t.N + col) : (f32x4){0.f, 0.f, 0.f, 0.f};
}
__device__ __forceinline__ void ti_stage(const f32x4 (&wv)[8], LAS float* T, int tid) {
#pragma unroll
    for (int e = 0; e < 8; ++e) *(LAS f32x4*)(T + ((tid >> 6) + 8 * e) * TP + 4 * (tid & 63)) = wv[e];
}
__device__ __forceinline__ void ti_write(const TItem& t, const LAS float* T, int tid) {
    const int n = tid >> 1, kh = 32 * (tid & 1), k0 = 64 * t.kb;
    float ks[32];
#pragma unroll
    for (int i = 0; i < 8; ++i) { const f32x4 q = t.kscale ? *(const f32x4*)(t.kscale + k0 + kh + 4 * i) : (f32x4){1.f, 1.f, 1.f, 1.f}; ks[4 * i] = q[0] * t.scale; ks[4 * i + 1] = q[1] * t.scale; ks[4 * i + 2] = q[2] * t.scale; ks[4 * i + 3] = q[3] * t.scale; }
    const LAS float* c = T + kh * TP + n;
    if (256 * t.nb + n < t.N) {
        bf16* dst = t.WT + (size_t)(t.row_off + 256 * t.nb + n) * t.ldt + k0 + kh;
#pragma unroll
        for (int j = 0; j < 4; ++j) { v4u o;
            o.x = pk2(c[(8 * j + 0) * TP] * ks[8 * j + 0], c[(8 * j + 1) * TP] * ks[8 * j + 1]); o.y = pk2(c[(8 * j + 2) * TP] * ks[8 * j + 2], c[(8 * j + 3) * TP] * ks[8 * j + 3]);
            o.z = pk2(c[(8 * j + 4) * TP] * ks[8 * j + 4], c[(8 * j + 5) * TP] * ks[8 * j + 5]); o.w = pk2(c[(8 * j + 6) * TP] * ks[8 * j + 6], c[(8 * j + 7) * TP] * ks[8 * j + 7]);
            *(v4u*)(dst + 8 * j) = o; }
    }
}

__device__ __forceinline__ void p0_prologue(Frame& F) {
    const int gw = F.vcu * NWAVES + F.wave, NGW = F.G * NWAVES, lane = F.lane;
    bf16* WUP = WSP(bf16, WS_WUP); bf16* WDN = WSP(bf16, WS_WDN); bf16* WKVQG = WSP(bf16, WS_WKVQG); bf16* WO = WSP(bf16, WS_WO); bf16* WPOOL = WSP(bf16, WS_WPOOL); bf16* W1CAT = WSP(bf16, WS_W1CAT);
    SEG_BEGIN(40);
    constexpr int I_UP = 256, I_DN = 256, I_KV = 96, I_QG = 80, I_WO = 64, I_PL = 4, I_C1 = 16;
    constexpr int NITEMS = 2 * I_UP + 2 * I_DN + I_KV + I_QG + I_WO + 4 * I_PL + 4 * I_C1;
    auto decode = [&](int it) -> TItem {
        int r = it; TItem t;
        if (r < 2 * I_UP) { const int l = r / I_UP; r %= I_UP; t = TItem{F.w_up + (size_t)l * D * FF, WUP + (size_t)l * FF * D, F.norm_mlp + l * D, FF, D, 0, r / 16, r % 16, 1.f}; return t; } r -= 2 * I_UP;
        if (r < 2 * I_DN) { const int l = r / I_DN; r %= I_DN; t = TItem{F.w_down + (size_t)l * FF * D, WDN + (size_t)l * D * FF, nullptr, D, FF, 0, r / 4, r % 4, 1.f}; return t; } r -= 2 * I_DN;
        if (r < I_KV) { t = TItem{F.w_kv, WKVQG, F.norm_kv, 1536, D, 0, r / 6, r % 6, 1.f}; return t; } r -= I_KV;
        if (r < I_QG) { const int nb = r % 5; t = TItem{F.w_qg, WKVQG, F.norm_mix + D, 1072, D, 1536, r / 5, nb, nb < 4 ? QSCALE : 1.f}; return t; } r -= I_QG;
        if (r < I_WO) { t = TItem{F.w_o, WO, nullptr, D, D, 0, r / 4, r % 4, 1.f}; return t; } r -= I_WO;
        if (r < 4 * I_PL) { const int g = r / I_PL; r %= I_PL; t = TItem{F.pool_w + (size_t)g * 65536, WPOOL + (size_t)g * 65536, nullptr, 256, 256, 0, r, 0, 1.f}; return t; } r -= 4 * I_PL;
        { const int kvh = r / I_C1; r %= I_C1; const int kv = kvh >> 1, half = kvh & 1;
          t = TItem{F.cmp_w1 + (size_t)kv * 2048 * 128 + (size_t)half * 1024 * 128, W1CAT + (size_t)kv * 256 * D, nullptr, 128, D, half * 128, r, 0, 1.f}; return t; }
    };
    {
        LAS float* T = (LAS float*)F.lds; f32x4 wv[8];
        int it = F.vcu; TItem tc;
        if (it < NITEMS) { tc = decode(it); ti_load(tc, wv, F.tid); }
        while (it < NITEMS) {
            ti_stage(wv, T, F.tid);
            __syncthreads();
            const int i2 = it + F.G; TItem tn = tc; if (i2 < NITEMS) { tn = decode(i2); ti_load(tn, wv, F.tid); }
            ti_write(tc, T, F.tid);
            __syncthreads();
            tc = tn; it = i2;
        }
    }
    { const int gt = F.vcu * 512 + F.tid, NT = F.G * 512; v4u* z = (v4u*)(WKVQG + (size_t)2608 * D);
      for (int i = gt; i < 208 * D / 8; i += NT) z[i] = (v4u){0u, 0u, 0u, 0u}; }
    { float* CB = WSP(float, WS_CBIAS);
      const int cb0 = (NGW >= 1024) ? 512 : 0;
      for (int it = gw - cb0; it >= 0 && it < 64; it += NGW) { const int kv = it >> 5, kc0 = (it & 31) * 64; float a0 = 0.f, a1 = 0.f;
#pragma unroll 16
          for (int k = 0; k < 64; ++k) { const float p = F.cmp_pe[kv * 2048 + kc0 + k]; const float* wr = F.cmp_w1 + ((size_t)kv * 2048 + kc0 + k) * 128; a0 += p * wr[lane]; a1 += p * wr[64 + lane]; }
          CB[(size_t)it * 128 + lane] = a0; CB[(size_t)it * 128 + 64 + lane] = a1; } }
    SEG_END(40); SEG_BEGIN(41);
    bf16* DIFF = WSP(bf16, WS_DIFF);
    if (F.wave == 0)
    for (int b = F.G - 1 - F.vcu; b < DB; b += F.G) {
        const f32x4* xr = (const f32x4*)(F.x_s + (size_t)b * D) + lane; f32x4 v[4]; float ss = 0.f;
#pragma unroll
        for (int j = 0; j < 4; ++j) { v[j] = xr[64 * j]; ss += (v[j][0] * v[j][0] + v[j][1] * v[j][1]) + (v[j][2] * v[j][2] + v[j][3] * v[j][3]); }
        const float rstd = 1.0f / sqrtf(wave_sum(ss) * (1.0f / D) + RMS_EPS);
        const float* sp = F.state_pool + (size_t)b * 15 * D; float* ps = F.out + OUT_POOL_S + (size_t)b * 15 * D;
#pragma unroll
        for (int j = 0; j < 4; ++j) {
            const int col = 256 * j + 4 * lane; const f32x4 gg = *(const f32x4*)(F.norm_mix + col); const f32x4 u = v[j] * rstd * gg;
            f32x4 st[15];
#pragma unroll
            for (int r = 0; r < 15; ++r) st[r] = *(const f32x4*)(sp + (size_t)r * D + col);
            f32x4 sum = u; const int w = 2 << j;
#pragma unroll
            for (int r = 0; r < 15; ++r) if (r < w - 1) sum += st[14 - r];
            const f32x4 df = sum * (1.0f / (float)w) - u;
            v2u o; o.x = pk2(df[0], df[1]); o.y = pk2(df[2], df[3]); *(v2u*)(DIFF + (size_t)(MP + b) * D + col) = o;
            *(f32x4*)(ps + (size_t)14 * D + col) = u;
#pragma unroll
            for (int r = 0; r < 14; ++r) *(f32x4*)(ps + (size_t)r * D + col) = st[r + 1];
        }
    }
    SEG_END(41);
    if (F.G != 256) { const size_t gt = (size_t)F.vcu * 512 + F.tid, NT = (size_t)F.G * 512; const f32x4* src = (const f32x4*)F.state_win; f32x4* dst = (f32x4*)(F.out + OUT_WIN_S);
      for (int rep = 0; rep < REP(19); ++rep)
      for (size_t e = gt; e < (size_t)DB * 511 * 128; e += NT) { const size_t b = e / (511 * 128), rem = e - b * (511 * 128); dst[b * 65536 + rem] = src[b * 65536 + rem + 128]; } }
    __syncthreads();
    LAS float* U = (LAS float*)F.lds;
    SEG_BEGIN(42);
    for (int rep = 0; rep < REP(20); ++rep)
    for (int task = F.vcu; task < MP / 64; task += F.G) {
        const int b = task >> 6, t0 = (task & 63) * 64;
        const float* xb = F.x_p + (size_t)b * SEQ * D;
        f32x4 gmix[4];
#pragma unroll
        for (int j = 0; j < 4; ++j) gmix[j] = *(const f32x4*)(F.norm_mix + 256 * j + 4 * lane);
        f32x4 ra[4], rb2[4];
#define DF_LOAD(T) do { const int ta_ = (T) + 2 * F.wave, tb_ = ta_ + 1; _Pragma("unroll") for (int j = 0; j < 4; ++j) { \
            ra[j] = (ta_ >= 0) ? *((const f32x4*)(xb + (size_t)ta_ * D) + lane + 64 * j) : (f32x4){0.f, 0.f, 0.f, 0.f}; rb2[j] = (tb_ >= 0) ? *((const f32x4*)(xb + (size_t)tb_ * D) + lane + 64 * j) : (f32x4){0.f, 0.f, 0.f, 0.f}; } } while (0)
#define DF_STORE1(rr, tt_) do { float ss = 0.f; _Pragma("unroll") for (int j = 0; j < 4; ++j) ss += (rr[j][0] * rr[j][0] + rr[j][1] * rr[j][1]) + (rr[j][2] * rr[j][2] + rr[j][3] * rr[j][3]); \
            const float rstd = 1.0f / sqrtf(wave_sum(ss) * (1.0f / D) + RMS_EPS); \
            _Pragma("unroll") for (int j = 0; j < 4; ++j) { const f32x4 u = rr[j] * rstd * gmix[j]; *(LAS f32x4*)(U + ((tt_) & 31) * 1024 + 256 * j + 4 * lane) = u; \
                if ((tt_) >= SEQ - 15) *(f32x4*)(F.out + OUT_POOL_P + ((size_t)b * 15 + ((tt_) - (SEQ - 15))) * D + 256 * j + 4 * lane) = u; } } while (0)
#define DF_STORE(T) do { const int ta_ = (T) + 2 * F.wave; DF_STORE1(ra, ta_); DF_STORE1(rb2, ta_ + 1); } while (0)
        DF_LOAD(t0 - 16); DF_STORE(t0 - 16);
        DF_LOAD(t0);
        const int c = 2 * F.tid, w = 2 << (F.tid >> 7);
        f32x2 S = (f32x2){0.f, 0.f};
        for (int sub = 0; sub < 4; ++sub) {
            const int T = t0 + 16 * sub;
            DF_STORE(T);
            __syncthreads();
            if (sub < 3) DF_LOAD(T + 16);
            if (sub == 0) { for (int j = 1; j < w; ++j) S += *(const LAS f32x2*)(U + ((T - j) & 31) * 1024 + c); }
            for (int tt = 0; tt < 16; ++tt) { const int t = T + tt; const int cnt = (t + 1 < w) ? (t + 1) : w;
                const f32x2 cur = *(const LAS f32x2*)(U + (t & 31) * 1024 + c);
                S += cur; const float inv = 1.0f / (float)cnt;
                *(unsigned*)(DIFF + ((size_t)b * SEQ + t) * D + c) = pk2(S[0] * inv - cur[0], S[1] * inv - cur[1]);
                S -= *(const LAS f32x2*)(U + ((t - w + 1) & 31) * 1024 + c); }
            __syncthreads();
        }
#undef DF_LOAD
#undef DF_STORE1
#undef DF_STORE
    }
    SEG_END(42);
}

constexpr int KSTR = 144;
constexpr int SC_ACT = 0, SC_W = 128 * KSTR, SC_BUF = SC_W + 256 * KSTR, SC_UNIT = 2 * SC_BUF, CW_QUEUE = 8192;
static_assert(SC_UNIT + 64 <= RING_BYTES, "sample compress LDS");
__device__ __forceinline__ void p5_sample_compress(Frame& F, unsigned* qctr, int quota) {
    LAS int* UNIT = (LAS int*)(F.lds + SC_UNIT);
    const int tid = F.tid, lane = F.lane, w = F.wave, r = lane & 31, h = lane >> 5, rb = w & 3, nh = w >> 2;
    float* P = WSP(float, WS_CMPP); const bf16* W1 = WSP(bf16, WS_W1CAT);
    for (int nu = 0; nu < quota; ++nu) {
        __syncthreads();
        if (tid == 0) UNIT[0] = (int)atomicAdd(qctr, 1u);
        __syncthreads();
        const int u = UNIT[0]; if (u >= DB * 8) break;
        const int b = u >> 3, jb = (u >> 1) & 3, kv = u & 1;
        size_t aoff[4]; const bf16* wsrc = W1 + ((size_t)kv * 256 + (tid >> 3)) * D + 8 * (tid & 7);
#pragma unroll
        for (int e = 0; e < 4; ++e) { const int j = 32 * jb + (tid >> 6) + 8 * e; const int page = F.page_table[b * 16 + (j >> 3)]; aoff[e] = ((size_t)page * 128 + (j & 7) * 16) * 1024 + kv * 256 + 4 * (tid & 63); }
        f32x4 av0[4], av1[4], av2[4], av3[4]; v4u wv0[4], wv1[4];
#define SC_LOADA(av, tt) do { _Pragma("unroll") for (int e = 0; e < 4; ++e) av[e] = *(const f32x4*)(F.cache + aoff[e] + (size_t)(tt) * 1024); } while (0)
#define SC_LOADW(wv, tt) do { _Pragma("unroll") for (int e = 0; e < 4; ++e) wv[e] = *(const v4u*)(wsrc + (size_t)e * 64 * D + 64 * (tt)); } while (0)
#define SC_STORE(av, wv, bf) do { _Pragma("unroll") for (int e = 0; e < 4; ++e) { v2u o; o.x = cvtpk(av[e][0], av[e][1]); o.y = cvtpk(av[e][2], av[e][3]); \
            *(LAS v2u*)(F.lds + (bf) * SC_BUF + SC_ACT + ((((tid >> 6) + 8 * e) << 2) + ((tid & 63) >> 4)) * KSTR + 8 * (tid & 15)) = o; *(LAS v4u*)(F.lds + (bf) * SC_BUF + SC_W + ((tid >> 3) + 64 * e) * KSTR + 16 * (tid & 7)) = wv[e]; } } while (0)
#define SC_COMPUTE(bf) do { const LAS unsigned char* At = F.lds + (bf) * SC_BUF + SC_ACT + (64 * (w & 1) + r) * KSTR + h * 16; const LAS unsigned char* Wt = F.lds + (bf) * SC_BUF + SC_W + (64 * (w >> 1) + r) * KSTR + h * 16; \
            _Pragma("unroll") for (int ks = 0; ks < 4; ++ks) { \
                const bf16x8 b0_ = *(const LAS bf16x8*)(At + ks * 32), b1_ = *(const LAS bf16x8*)(At + 32 * KSTR + ks * 32), a0_ = *(const LAS bf16x8*)(Wt + ks * 32), a1_ = *(const LAS bf16x8*)(Wt + 32 * KSTR + ks * 32); \
            __builtin_amdgcn_sched_barrier(0); \
                acc[0] = __builtin_amdgcn_mfma_f32_32x32x16_bf16(a0_, b0_, acc[0], 0, 0, 0); acc[1] = __builtin_amdgcn_mfma_f32_32x32x16_bf16(a1_, b0_, acc[1], 0, 0, 0); \
                acc[2] = __builtin_amdgcn_mfma_f32_32x32x16_bf16(a0_, b1_, acc[2], 0, 0, 0); acc[3] = __builtin_amdgcn_mfma_f32_32x32x16_bf16(a1_, b1_, acc[3], 0, 0, 0); \
            __builtin_amdgcn_sched_barrier(0); } } while (0)
        f32x16 acc[4];
#pragma unroll
        for (int nt = 0; nt < 4; ++nt)
#pragma unroll
            for (int i = 0; i < 16; ++i) acc[nt][i] = 0.f;
#define SC_STEP(tt, aCur, wCur, aNext, wNext) do { \
            if ((tt) + 4 < 16) SC_LOADA(aCur, (tt) + 4);        \
            if ((tt) + 2 < 16) SC_LOADW(wCur, (tt) + 2); \
            __builtin_amdgcn_sched_barrier(0); \
            SC_COMPUTE((tt) & 1); \
            __builtin_amdgcn_sched_barrier(0); \
            if ((tt) + 1 < 16) SC_STORE(aNext, wNext, ((tt) + 1) & 1); \
            __syncthreads(); } while (0)
        SC_LOADA(av0, 0); SC_LOADW(wv0, 0); SC_LOADA(av1, 1); SC_LOADW(wv1, 1); SC_LOADA(av2, 2); SC_LOADA(av3, 3);
        SC_STORE(av0, wv0, 0); __syncthreads();
        for (int tt = 0; tt < 16; tt += 4) {
            SC_STEP(tt,     av0, wv0, av1, wv1);
            SC_STEP(tt + 1, av1, wv1, av2, wv0);
            SC_STEP(tt + 2, av2, wv0, av3, wv1);
            SC_STEP(tt + 3, av3, wv1, av0, wv0);
        }
#undef SC_STEP
#undef SC_LOADA
#undef SC_LOADW
#define SC_LOAD 0
#undef SC_COMPUTE
#undef SC_LOAD
#undef SC_STORE
        float* prow = P + (size_t)kv * CMP_ROWS * 256 + (size_t)(CMP_ROWS_P + (b * 128 + 32 * jb) * 4 + 64 * (w & 1) + r) * 256 + 64 * (w >> 1) + 4 * h;
        constexpr int HXP = 132; LAS float* HX = (LAS float*)F.lds;
        if (w >= 4) {
            LAS float* hx = HX + (64 * (w & 1) + r) * HXP + 64 * ((w >> 1) - 2) + 4 * h;
#pragma unroll
            for (int ri = 0; ri < 2; ++ri)
#pragma unroll
                for (int ni = 0; ni < 2; ++ni)
#pragma unroll
                    for (int g4 = 0; g4 < 4; ++g4) *(LAS f32x4*)(hx + ri * 32 * HXP + 32 * ni + 8 * g4) = (f32x4){acc[2 * ri + ni][4 * g4], acc[2 * ri + ni][4 * g4 + 1], acc[2 * ri + ni][4 * g4 + 2], acc[2 * ri + ni][4 * g4 + 3]};
            if ((w & 1) == 0 && r < 4) {
#pragma unroll
                for (int ni = 0; ni < 2; ++ni)
#pragma unroll
                    for (int g4 = 0; g4 < 4; ++g4) *(f32x4*)(prow + 32 * ni + 8 * g4) = (f32x4){acc[ni][4 * g4], acc[ni][4 * g4 + 1], acc[ni][4 * g4 + 2], acc[ni][4 * g4 + 3]};
            }
        }
        __syncthreads();
        if (w < 4) {
#pragma unroll
            for (int ri = 0; ri < 2; ++ri) {
                const int row = 64 * (w & 1) + 32 * ri + r; const bool in = row + 4 < 128;
                const LAS float* hx = HX + (in ? row + 4 : row) * HXP + 64 * (w >> 1) + 4 * h;
#pragma unroll
                for (int ni = 0; ni < 2; ++ni)
#pragma unroll
                    for (int g4 = 0; g4 < 4; ++g4) {
                        f32x4 v = (f32x4){acc[2 * ri + ni][4 * g4], acc[2 * ri + ni][4 * g4 + 1], acc[2 * ri + ni][4 * g4 + 2], acc[2 * ri + ni][4 * g4 + 3]};
                        const f32x4 hv = *(const LAS f32x4*)(hx + 32 * ni + 8 * g4);
                        if (in) v += hv;
                        *(f32x4*)(prow + (size_t)ri * 32 * 256 + 32 * ni + 8 * g4) = v; }
            }
        }
        __syncthreads();
    }
}

__device__ __forceinline__ void p5_prompt_compress(Frame& F) {
    const int tid = F.tid, lane = F.lane, w = F.wave, r = lane & 31, h = lane >> 5, rb = w & 3, nh = w >> 2;
    float* P = WSP(float, WS_CMPP); const bf16* W1 = WSP(bf16, WS_W1CAT); const bf16* CA = WSP(bf16, WS_CMPA);
    for (int u = (int)blockIdx.x; u < 2 * CMP_ROWS_P / 128; u += F.G) {
        const int kv = u & 1, rblk = u >> 1;
        const bf16* asrc = CA + (size_t)kv * CMP_ROWS * D + (size_t)(rblk * 128 + (tid >> 3)) * D + 8 * (tid & 7);
        const bf16* wsrc = W1 + ((size_t)kv * 256 + (tid >> 3)) * D + 8 * (tid & 7);
        v4u aa[2], wv[4], ab[2], wb[4];
#define PC_LOAD(A_, W_, tt) do { _Pragma("unroll") for (int e = 0; e < 2; ++e) A_[e] = *(const v4u*)(asrc + (size_t)e * 64 * D + 64 * (tt)); _Pragma("unroll") for (int e = 0; e < 4; ++e) W_[e] = *(const v4u*)(wsrc + (size_t)e * 64 * D + 64 * (tt)); } while (0)
#define PC_STORE(A_, W_, bf) do { _Pragma("unroll") for (int e = 0; e < 2; ++e) *(LAS v4u*)(F.lds + (bf) * SC_BUF + SC_ACT + ((tid >> 3) + 64 * e) * KSTR + 16 * (tid & 7)) = A_[e]; \
            _Pragma("unroll") for (int e = 0; e < 4; ++e) *(LAS v4u*)(F.lds + (bf) * SC_BUF + SC_W + ((tid >> 3) + 64 * e) * KSTR + 16 * (tid & 7)) = W_[e]; } while (0)
#define PC_COMPUTE(bf) do { \
            __builtin_amdgcn_sched_barrier(0); \
            const LAS unsigned char* At = F.lds + (bf) * SC_BUF + SC_ACT + (32 * rb + r) * KSTR + h * 16; const LAS unsigned char* Wt = F.lds + (bf) * SC_BUF + SC_W + (128 * nh + r) * KSTR + h * 16; \
            bf16x8 bfr_[4], afr_[4][4]; \
            _Pragma("unroll") for (int ks = 0; ks < 4; ++ks) { bfr_[ks] = *(const LAS bf16x8*)(At + ks * 32); \
                _Pragma("unroll") for (int nt = 0; nt < 4; ++nt) afr_[ks][nt] = *(const LAS bf16x8*)(Wt + 32 * nt * KSTR + ks * 32); } \
            __builtin_amdgcn_sched_barrier(0); \
            _Pragma("unroll") for (int ks = 0; ks < 4; ++ks) \
                _Pragma("unroll") for (int nt = 0; nt < 4; ++nt) acc[nt] = __builtin_amdgcn_mfma_f32_32x32x16_bf16(afr_[ks][nt], bfr_[ks], acc[nt], 0, 0, 0); \
            __builtin_amdgcn_sched_barrier(0); } while (0)
        f32x16 acc[4];
#pragma unroll
        for (int nt = 0; nt < 4; ++nt)
#pragma unroll
            for (int i = 0; i < 16; ++i) acc[nt][i] = 0.f;
        __syncthreads();
        PC_LOAD(aa, wv, 0); PC_LOAD(ab, wb, 1); PC_STORE(aa, wv, 0); __syncthreads();
        for (int t2 = 0; t2 < 16; t2 += 2) {
            if (t2 + 2 < 16) PC_LOAD(aa, wv, t2 + 2);
            PC_COMPUTE(0);
            PC_STORE(ab, wb, 1);
            __syncthreads();
            if (t2 + 3 < 16) PC_LOAD(ab, wb, t2 + 3);
            PC_COMPUTE(1);
            if (t2 + 2 < 16) PC_STORE(aa, wv, 0);
            __syncthreads();
        }
#undef PC_LOAD
#undef PC_STORE
#undef PC_COMPUTE
        float* prow = P + (size_t)kv * CMP_ROWS * 256 + (size_t)(rblk * 128 + 32 * rb + r) * 256 + 128 * nh + 4 * h;
#pragma unroll
        for (int nt = 0; nt < 4; ++nt)
#pragma unroll
            for (int g4 = 0; g4 < 4; ++g4) *(f32x4*)(prow + 32 * nt + 8 * g4) = (f32x4){acc[nt][4 * g4], acc[nt][4 * g4 + 1], acc[nt][4 * g4 + 2], acc[nt][4 * g4 + 3]};
    }
}

constexpr int W2T_STR = 136;
__device__ __forceinline__ void p6_combine(Frame& F, int part, int cu, int ncu) {
    LAS bf16* W2T = (LAS bf16*)F.lds;
    LAS float* CBL = (LAS float*)(F.lds + 2 * 64 * W2T_STR * 2);
    const float* P = WSP(float, WS_CMPP); bf16* KC = WSP(bf16, WS_KC); float* KCS = WSP(float, WS_KCS);
    for (int i = F.tid; i < 2 * 128 * 64; i += 512) { const int kv = i >> 13, k = (i >> 6) & 127, d = i & 63; W2T[(kv * 64 + d) * W2T_STR + k] = (bf16)f2bf(F.cmp_w2[i]); }
    if (F.tid < 256) { const float* CB = WSP(float, WS_CBIAS) + (size_t)(F.tid >> 7) * 32 * 128 + (F.tid & 127); float a = 0.f;
#pragma unroll 8
        for (int c = 0; c < 32; ++c) a += CB[c * 128];
        CBL[F.tid] = a; }
    __syncthreads();
    const int lane = F.lane, ml = lane & 15, fq = lane >> 4;
    const int gw = cu * NWAVES + F.wave, NGW = ncu * NWAVES;
    constexpr int NT_P = CMP_ROWS_P / 16, NT_S = CMP_ROWS_S / 16;
    const bool prompt = part == 1; const int ntp = prompt ? NT_P : NT_S;
    f32x4 loA[4][2], hiA[4][2], loB[4][2], hiB[4][2];
#define CB_LOAD(lo_, hi_, task_) do { const int kv_ = (task_) / ntp, r0_ = ((task_) % ntp) * 16; const int prow_ = (prompt ? r0_ : CMP_ROWS_P + r0_) + ml; \
        const float* plo_ = P + (size_t)kv_ * CMP_ROWS * 256 + (size_t)prow_ * 256 + 8 * fq; const float* phi_ = plo_ + 4 * 256 + 128; \
        const bool nh_ = prompt || ((((r0_ + ml) >> 2) & 31) == 31);        \
        _Pragma("unroll") for (int ks = 0; ks < 4; ++ks) { lo_[ks][0] = *(const f32x4*)(plo_ + 32 * ks); lo_[ks][1] = *(const f32x4*)(plo_ + 32 * ks + 4); \
            hi_[ks][0] = nh_ ? *(const f32x4*)(phi_ + 32 * ks) : (f32x4){0.f, 0.f, 0.f, 0.f}; hi_[ks][1] = nh_ ? *(const f32x4*)(phi_ + 32 * ks + 4) : (f32x4){0.f, 0.f, 0.f, 0.f}; } } while (0)
#define CB_FINISH(lo_, hi_, task_) do { const int kv = (task_) / ntp, r0 = ((task_) % ntp) * 16; const int nimask = prompt ? 255 : 127; \
        const int ro = r0 + ml, i_blk = (ro >> 2) & nimask; const bool valid = i_blk < nimask; \
        bf16x8 hb[4]; \
        _Pragma("unroll") for (int ks = 0; ks < 4; ++ks) { f32x4 z[2]; \
            _Pragma("unroll") for (int e = 0; e < 2; ++e) { z[e] = lo_[ks][e] + hi_[ks][e] + *(const LAS f32x4*)(CBL + kv * 128 + 32 * ks + 8 * fq + 4 * e); \
                _Pragma("unroll") for (int q = 0; q < 4; ++q) { const float zz = z[e][q]; z[e][q] = valid ? zz / (1.0f + __expf(-zz)) : 0.f; } } \
            hb[ks] = cvt8(z[0], z[1]); } \
        _Pragma("unroll") for (int db = 0; db < 4; ++db) { f32x4 acc = (f32x4){0.f, 0.f, 0.f, 0.f}; \
            _Pragma("unroll") for (int ks = 0; ks < 4; ++ks) { const bf16x8 a = *(const LAS bf16x8*)(W2T + (kv * 64 + 16 * db + ml) * W2T_STR + 32 * ks + 8 * fq); acc = __builtin_amdgcn_mfma_f32_16x16x32_bf16(a, hb[ks], acc, 0, 0, 0); } \
            const int g = ro & 3, d0 = 16 * db + 4 * fq; \
            if (prompt) { const int b = ro >> 10; v2u o; o.x = cvtpk(acc[0], acc[1]); o.y = cvtpk(acc[2], acc[3]); *(v2u*)(KC + ((size_t)((kv * 4 + b) * 4 + g) * 256 + i_blk) * 64 + d0) = o; } \
            else { const int b = ro >> 9; *(f32x4*)(KCS + ((size_t)((kv * 128 + b) * 4 + g) * 128 + i_blk) * 64 + d0) = acc; } } } while (0)
    const int ntask = 2 * ntp;
    int task = gw;
    if (task < ntask) CB_LOAD(loA, hiA, task);
    while (task < ntask) {
        int t2 = task + NGW; if (t2 < ntask) CB_LOAD(loB, hiB, t2);
        CB_FINISH(loA, hiA, task);
        task = t2; if (task >= ntask) break;
        t2 = task + NGW; if (t2 < ntask) CB_LOAD(loA, hiA, t2);
        CB_FINISH(loB, hiB, task);
        task = t2;
    }
#undef CB_LOAD
#undef CB_FINISH
}

constexpr int VSTR = 192;
constexpr int AT_K = 0, AT_V = 64 * KSTR, AT_BUF = 64 * KSTR + 64 * VSTR  , AT_CK = 0, AT_CV = 4 * 64 * KSTR  , AT_T = AT_CV + 4 * 64 * VSTR, AT_TS = 66, AT_U = AT_T + 64 * AT_TS * 4,
    AT_SEL = AT_U + 64 * AT_TS * 4, AT_WUNI = AT_SEL + 512, AT_END = AT_WUNI + 64, AT_OF = 2 * AT_BUF  ;
static_assert(AT_OF + 8 * 32 * 64 * 4 <= AT_SEL, "attention LDS");
static_assert(AT_END <= RING_BYTES, "attention LDS");

__device__ __forceinline__ v4i16_t vtr(const LAS unsigned char* p) { return __builtin_amdgcn_ds_read_tr16_b64_v4i16((LAS v4i16_t*)p); }

struct KvRegs { v4u k, v; };
__device__ __forceinline__ void load_kv(Frame& F, KvRegs& R, const bf16* ksrc, const bf16* vsrc, int pitch) {
    const int key = F.tid >> 3, ch = F.tid & 7;
    R.k = *(const v4u*)(ksrc + (size_t)key * pitch + ch * 8);
    R.v = *(const v4u*)(vsrc + (size_t)key * pitch + ch * 8);
}
__device__ __forceinline__ void store_kv(Frame& F, const KvRegs& R, int buf) {
    const int key = F.tid >> 3, ch = F.tid & 7;
    *(LAS v4u*)(F.lds + buf * AT_BUF + AT_K + key * KSTR + ch * 16) = R.k;
    *(LAS v4u*)(F.lds + buf * AT_BUF + AT_V + key * VSTR + ch * 16) = R.v;
}

constexpr float ATT_THR = 80.0f;
__device__ __forceinline__ float quad_xor1(float x) { return __builtin_bit_cast(float, __builtin_amdgcn_update_dpp(0, __builtin_bit_cast(int, x), 0xB1, 0xF, 0xF, true)); }
__device__ __forceinline__ float quad_xor2(float x) { return __builtin_bit_cast(float, __builtin_amdgcn_update_dpp(0, __builtin_bit_cast(int, x), 0x4E, 0xF, 0xF, true)); }
__device__ __forceinline__ float half_max(float x) { auto rr = __builtin_amdgcn_permlane32_swap(__float_as_uint(x), __float_as_uint(x), false, false); return fmaxf(__uint_as_float(rr[0]), __uint_as_float(rr[1])); }
struct AugState { unsigned q0, q1, mw2, mw3, kj0, kj1, hsel; };
__device__ __forceinline__ unsigned bf16_hi_bits(float f) { return f2bf(f); }
__device__ __forceinline__ void aug_set_m(AugState& A, float m) {
    const float a = -m; const unsigned h1 = f2bf(a); const float r1 = a - bf2f((unsigned short)h1); const unsigned h2 = f2bf(r1); const float r2 = r1 - bf2f((unsigned short)h2); const unsigned h3 = f2bf(r2);
    A.mw2 = h1 << 16; A.mw3 = h2 | (h3 << 16);
}
template <int MODE>
__device__ __forceinline__ void attn_tile(Frame& F, bool MASKED, int kofs_b, int vofs_b, const bf16x8 (&qf)[4], AugState& A, int blk, int relb, float slope2, bool rowok, float& m, float& l, bool& any, f32x16& o0, f32x16& o1,
                                          float mfin, float invl, LAS float* Tq, LAS float* Uq, int sig0) {
    const int lane = F.lane, r = lane & 31, h = lane >> 5;
    const LAS unsigned char* Kt = F.lds + kofs_b; const LAS unsigned char* Vt = F.lds + vofs_b;
    constexpr int PM = (MODE <= 1) ? 16 : 1;
    const float NEG = -INFINITY;
    float c0 = slope2 * (float)relb - ((MODE == 1) ? mfin : m);
    if (!rowok) c0 = NEG;
    const float k32 = slope2 * (float)(32 * PM);
    f32x16 p0, p1;
    if (MODE <= 1) {
#pragma unroll
        for (int i = 0; i < 16; ++i) { p0[i] = fmaf(slope2, (float)(PM * ((i & 3) + 8 * (i >> 2))), c0); p1[i] = p0[i] + k32; }
    }
    bf16x8 kfr[8];
#pragma unroll
    for (int ks = 0; ks < 4; ++ks) { kfr[2 * ks] = *(const LAS bf16x8*)(Kt + r * KSTR + ks * 32 + h * 16); kfr[2 * ks + 1] = *(const LAS bf16x8*)(Kt + (32 + r) * KSTR + ks * 32 + h * 16); }
    v4i16_t vlo[4][2], vhi[4][2];
    if (MODE != 0) { const LAS unsigned char* vb = Vt + (((lane & 15) >> 2) + 4 * h) * VSTR + (16 * ((lane >> 4) & 1) + 4 * (lane & 3)) * 2;
#pragma unroll
        for (int sp = 0; sp < 4; ++sp)
#pragma unroll
            for (int db = 0; db < 2; ++db) { vlo[sp][db] = vtr(vb + (16 * sp) * VSTR + 64 * db); vhi[sp][db] = vtr(vb + (16 * sp + 8) * VSTR + 64 * db); } }
    __builtin_amdgcn_sched_barrier(0);
    if (MODE >= 2) {
        const unsigned bw = (__float_as_uint((float)blk) >> 16) * 0x10001u & A.hsel;
        const v4u ka0 = (v4u){bw, A.kj0, 0x3f803f80u & A.hsel, 0x3f803f80u & A.hsel}, ka1 = (v4u){bw, A.kj1, 0x3f803f80u & A.hsel, 0x3f803f80u & A.hsel};
        const v4u qa = (v4u){A.q0, A.q1, (rowok ? 0u : 0xc6eau) | A.mw2, A.mw3};
        const f32x16 z = {0.f, 0.f, 0.f, 0.f, 0.f, 0.f, 0.f, 0.f, 0.f, 0.f, 0.f, 0.f, 0.f, 0.f, 0.f, 0.f};
        p0 = __builtin_amdgcn_mfma_f32_32x32x16_bf16(__builtin_bit_cast(bf16x8, ka0), __builtin_bit_cast(bf16x8, qa), z, 0, 0, 0);
        p1 = __builtin_amdgcn_mfma_f32_32x32x16_bf16(__builtin_bit_cast(bf16x8, ka1), __builtin_bit_cast(bf16x8, qa), z, 0, 0, 0);
    }
#pragma unroll
    for (int ks = 0; ks < 4; ++ks) {
        p0 = __builtin_amdgcn_mfma_f32_32x32x16_bf16(kfr[2 * ks], qf[ks], p0, 0, 0, 0);
        p1 = __builtin_amdgcn_mfma_f32_32x32x16_bf16(kfr[2 * ks + 1], qf[ks], p1, 0, 0, 0);
    }
    __builtin_amdgcn_sched_barrier(0);
    if (MASKED) {
#pragma unroll
        for (int i = 0; i < 16; ++i) {
            const int kofs = PM * ((i & 3) + 8 * (i >> 2));
            const int rel0 = relb + kofs, rel1 = rel0 + PM * 32;
            bool ok0 = rel0 <= 0, ok1 = rel1 <= 0;
            if (MODE == 3) { ok0 = ok0 && rel0 > -512; ok1 = ok1 && rel1 > -512; }
            p0[i] = ok0 ? p0[i] : NEG; p1[i] = ok1 ? p1[i] : NEG;
        }
    }
    if (MODE == 1) {
#pragma unroll
        for (int i = 0; i < 16; ++i) { p0[i] = __builtin_amdgcn_exp2f(p0[i]) * invl; p1[i] = __builtin_amdgcn_exp2f(p1[i]) * invl; }
#pragma unroll
        for (int hf = 0; hf < 2; ++hf)
#pragma unroll
            for (int g4 = 0; g4 < 4; ++g4) {
                const float pa = hf ? p1[4 * g4] : p0[4 * g4], pb = hf ? p1[4 * g4 + 1] : p0[4 * g4 + 1], pc = hf ? p1[4 * g4 + 2] : p0[4 * g4 + 2], pd = hf ? p1[4 * g4 + 3] : p0[4 * g4 + 3];
                float tv = 2.f * ((pa + pb) + pc) + pd, uv = pd;
                tv += quad_xor1(tv); uv += quad_xor1(uv); tv += quad_xor2(tv); uv += quad_xor2(uv);
                const int sg = sig0 + 8 * hf + 2 * g4 + h;
                if ((lane & 3) == 0) { Tq[sg] = tv; Uq[sg + 1] = uv; }
            }
    } else {
        float mxa = fmaxf(fmaxf(p0[0], p0[1]), p1[0]), mxb = fmaxf(fmaxf(p0[2], p0[3]), p1[1]); mxa = fmaxf(fmaxf(mxa, p1[2]), p1[3]);
#pragma unroll
        for (int i = 4; i < 16; i += 4) { mxa = fmaxf(fmaxf(mxa, p0[i]), p0[i + 1]); mxb = fmaxf(fmaxf(mxb, p0[i + 2]), p0[i + 3]); mxa = fmaxf(fmaxf(mxa, p1[i]), p1[i + 1]); mxb = fmaxf(fmaxf(mxb, p1[i + 2]), p1[i + 3]); }
        float mx = half_max(fmaxf(mxa, mxb));
        const float VLD = (MODE >= 2) ? -1.0e4f : NEG;
        const bool need = (mx > ATT_THR) || (!any && mx > VLD);
        if (__any(need)) {
            const float dl = need ? mx : 0.f; const float f = any ? __builtin_amdgcn_exp2f(-dl) : 1.f;
            m += dl; l *= f;
            if (MODE >= 2) aug_set_m(A, m);
#pragma unroll
            for (int i = 0; i < 16; ++i) { p0[i] -= dl; p1[i] -= dl; }
            if (MODE >= 2) {
#pragma unroll
                for (int i = 0; i < 16; ++i) { o0[i] *= f; o1[i] *= f; } }
        }
        any = any || (mx > VLD);
        float rs0 = 0.f, rs1 = 0.f;
#pragma unroll
        for (int i = 0; i < 16; ++i) { p0[i] = __builtin_amdgcn_exp2f(p0[i]); p1[i] = __builtin_amdgcn_exp2f(p1[i]); rs0 += p0[i]; rs1 += p1[i]; }
        l += rs0 + rs1;
        if (MODE == 0) return;
    }
    __builtin_amdgcn_sched_barrier(0);
#pragma unroll
    for (int sp = 0; sp < 4; ++sp) {
        v4u pw;
        if (sp < 2) { const int b8 = 8 * sp; pw.x = cvtpk(p0[b8], p0[b8 + 1]); pw.y = cvtpk(p0[b8 + 2], p0[b8 + 3]); pw.z = cvtpk(p0[b8 + 4], p0[b8 + 5]); pw.w = cvtpk(p0[b8 + 6], p0[b8 + 7]); }
        else { const int b8 = 8 * (sp - 2); pw.x = cvtpk(p1[b8], p1[b8 + 1]); pw.y = cvtpk(p1[b8 + 2], p1[b8 + 3]); pw.z = cvtpk(p1[b8 + 4], p1[b8 + 5]); pw.w = cvtpk(p1[b8 + 6], p1[b8 + 7]); }
        const bf16x8 pbf = __builtin_bit_cast(bf16x8, pw);
#pragma unroll
        for (int db = 0; db < 2; ++db) {
            const v4i16_t lo = vlo[sp][db], hi = vhi[sp][db];
            const bf16x8 vf = (bf16x8){lo[0], lo[1], lo[2], lo[3], hi[0], hi[1], hi[2], hi[3]};
            if (db == 0) o0 = __builtin_amdgcn_mfma_f32_32x32x16_bf16(vf, pbf, o0, 0, 0, 0);
            else o1 = __builtin_amdgcn_mfma_f32_32x32x16_bf16(vf, pbf, o1, 0, 0, 0);
        }
    }
}

struct BgCopy {
    size_t base; int k, pend; f32x4 v0;
    __device__ __forceinline__ void init(Frame& F) { const int b = F.vcu >> 1, hb = F.vcu & 1; k = (F.G == 256) ? 0 : 64; pend = 0; base = (size_t)b * 65536 + hb * 32704; }
    __device__ __forceinline__ void step(Frame& F) {
        const f32x4* src = (const f32x4*)F.state_win + base + 128 + F.tid; f32x4* dst = (f32x4*)(F.out + OUT_WIN_S) + base + F.tid;
        if (pend) { if (k - 1 < 63 || F.tid < 448) dst[512 * (k - 1)] = v0; pend = 0; }
        if (k < 64) { if (k < 63 || F.tid < 448) v0 = src[512 * k]; k += 1; pend = 1; }
    }
    __device__ __forceinline__ void finish(Frame& F) { while (k < 64 || pend) step(F); }
};

__device__ __forceinline__ void attn_prompt_unit(Frame& F, BgCopy& BG, int b, int g, int qb) {
    const int lane = F.lane, r = lane & 31, h = lane >> 5, w = F.wave;
    const int c0 = qb * 64, cur = qb, ql = 8 * w + (r >> 2), tq = c0 + ql, hd = g * 4 + (r & 3);
    const bf16* Q = WSP(bf16, WS_Q); const bf16* KVS = WSP(bf16, WS_KVS); const bf16* KVW = WSP(bf16, WS_KVW); const bf16* KC = WSP(bf16, WS_KC); const float* GATE = WSP(float, WS_GATE);
    bf16* O = WSP(bf16, WS_DIFF);
    const size_t row = (size_t)b * SEQ + tq;
    bf16x8 qf[4];
#pragma unroll
    for (int ks = 0; ks < 4; ++ks) qf[ks] = *(const bf16x8*)(Q + row * D + hd * 64 + ks * 16 + h * 8);
    const float slope2 = exp2f(-0.5f * (float)(hd + 1)) * LOG2E;
    AugState AG;
    { const unsigned sh = f2bf(slope2); const float shf = bf2f((unsigned short)sh); const unsigned sl = f2bf(slope2 - shf); const float slf = bf2f((unsigned short)sl);
      const unsigned hs = h ? 0u : 0xffffffffu; AG.hsel = hs;
      AG.q0 = (f2bf(64.f * shf) | (f2bf(64.f * slf) << 16)) & hs; AG.q1 = (sh | (sl << 16)) & hs; AG.mw2 = 0u; AG.mw3 = 0u;
      const unsigned j0 = __float_as_uint((float)r) >> 16, j1 = __float_as_uint((float)(32 + r)) >> 16; AG.kj0 = (j0 * 0x10001u) & hs; AG.kj1 = (j1 * 0x10001u) & hs; }
    const float g0 = GATE[row * 48 + hd * 3 + 0], g1 = GATE[row * 48 + hd * 3 + 1], g2 = GATE[row * 48 + hd * 3 + 2];
    LAS float* T = (LAS float*)(F.lds + AT_T); LAS float* U = (LAS float*)(F.lds + AT_U);
    LAS unsigned* SELM = (LAS unsigned*)(F.lds + AT_SEL); LAS unsigned* WUNI = (LAS unsigned*)(F.lds + AT_WUNI);
    for (int i = F.tid; i < 2 * 64 * AT_TS; i += 512) T[i] = 0.f;
    f32x16 of0, of1, o0, o1;
#pragma unroll
    for (int i = 0; i < 16; ++i) { of0[i] = 0.f; of1[i] = 0.f; o0[i] = 0.f; o1[i] = 0.f; }
    const float NEG = -INFINITY;
    const int nmax = c0 / 16 + 2;
    const int ntile = (nmax >= 255 ? 254 : nmax) / 64 + 1;
    const bf16* kc = KC + (size_t)((0 * 4 + b) * 4 + g) * 256 * 64; const bf16* vc = KC + (size_t)((1 * 4 + b) * 4 + g) * 256 * 64;
    SEG_BEGIN(23);
    float m = 0.f, l = 0.f; bool any = false;
    KvRegs R; int cb = 0;
    {
        KvRegs Rc[4]; const int key = F.tid >> 3, ch = F.tid & 7;
#pragma unroll
        for (int tl = 0; tl < 4; ++tl) if (tl < ntile) load_kv(F, Rc[tl], kc + (size_t)tl * 64 * 64, vc + (size_t)tl * 64 * 64, 64);
        BG.step(F);
#pragma unroll
        for (int tl = 0; tl < 4; ++tl) if (tl < ntile) { *(LAS v4u*)(F.lds + AT_CK + tl * 64 * KSTR + key * KSTR + ch * 16) = Rc[tl].k; *(LAS v4u*)(F.lds + AT_CV + tl * 64 * VSTR + key * VSTR + ch * 16) = Rc[tl].v; }
        __syncthreads();
    }
    for (int tl = 0; tl < ntile; ++tl)
        attn_tile<0>(F, !(1024 * tl + 1039 <= c0 + 8 * w), AT_CK + tl * 64 * KSTR, AT_CV + tl * 64 * VSTR, qf, AG, 0, 16 * 64 * tl + 31 + 16 * 4 * h - tq, slope2, true, m, l, any, o0, o1, 0.f, 0.f, nullptr, nullptr, 0);
    { const float lt = l + __shfl_xor(l, 32); const float invl = lt > 0.f ? 1.0f / lt : 0.f;
      LAS float* Tq = T + ql * AT_TS; LAS float* Uq = U + ql * AT_TS;
      for (int tl = 0; tl < ntile; ++tl)
          attn_tile<1>(F, !(1024 * tl + 1039 <= c0 + 8 * w), AT_CK + tl * 64 * KSTR, AT_CV + tl * 64 * VSTR, qf, AG, 0, 16 * 64 * tl + 31 + 16 * 4 * h - tq, slope2, true, m, l, any, o0, o1, m, invl, Tq, Uq, 16 * tl);
#pragma unroll
      for (int i = 0; i < 16; ++i) { of0[i] = g0 * o0[i]; of1[i] = g0 * o1[i]; o0[i] = 0.f; o1[i] = 0.f; } }
    __syncthreads(); SEG_END(23);
    SEG_BEGIN(22);
    unsigned long long wuni = 0ull;
    if (cur <= 15) {
        const unsigned long long msk = (1ull << (cur + 1)) - 1ull;
        if (lane < 8) { SELM[2 * (8 * w + lane)] = (unsigned)msk; SELM[2 * (8 * w + lane) + 1] = (unsigned)(msk >> 32); }
        wuni = msk;
    } else {
        LAS unsigned long long* KEY = (LAS unsigned long long*)(F.lds + AT_CK);
#pragma unroll
        for (int q4 = 0; q4 < 1; ++q4) {
            const int qb4 = 8 * w + 8 * q4; unsigned long long key[8]; int rank[8];
#pragma unroll
            for (int e = 0; e < 8; ++e) {
                const float v = T[(qb4 + e) * AT_TS + lane] + U[(qb4 + e) * AT_TS + lane];
                key[e] = ((unsigned long long)__float_as_uint(v) << 32) | (unsigned long long)(unsigned)(63 - lane); rank[e] = 0;
                KEY[(qb4 + e) * 64 + lane] = key[e]; }
            LDS_WAIT(); asm volatile("" ::: "memory");
            for (int s2 = 1; s2 <= cur - 2; ++s2) {
#pragma unroll
                for (int e = 0; e < 8; ++e) rank[e] += (KEY[(qb4 + e) * 64 + s2] > key[e]) ? 1 : 0;
            }
#pragma unroll
            for (int e = 0; e < 8; ++e) {
                const bool sel = (lane <= cur) && (lane == 0 || lane >= cur - 1 || rank[e] < 13);
                const unsigned long long msk = __ballot(sel);
                if (lane == 0) { SELM[2 * (qb4 + e)] = (unsigned)msk; SELM[2 * (qb4 + e) + 1] = (unsigned)(msk >> 32); }
                wuni |= msk;
            }
        }
    }
    wuni = ((unsigned long long)(unsigned)__builtin_amdgcn_readfirstlane((int)(unsigned)(wuni >> 32)) << 32) | (unsigned long long)(unsigned)__builtin_amdgcn_readfirstlane((int)(unsigned)wuni);
    if (lane == 0) { WUNI[2 * w] = (unsigned)wuni; WUNI[2 * w + 1] = (unsigned)(wuni >> 32); }
    SEG_END(22);
    __syncthreads();
    unsigned long long guni = 0ull;
#pragma unroll
    for (int i = 0; i < 8; ++i) guni |= (unsigned long long)WUNI[2 * i] | ((unsigned long long)WUNI[2 * i + 1] << 32);
    const unsigned long long mym = (unsigned long long)SELM[2 * ql] | ((unsigned long long)SELM[2 * ql + 1] << 32);
    LAS float* OFP = (LAS float*)(F.lds + AT_OF) + w * 32 * 64 + lane;
#pragma unroll
    for (int i = 0; i < 16; ++i) { OFP[i * 64] = of0[i]; OFP[(16 + i) * 64] = of1[i]; }
    m = 0.f; l = 0.f; any = false; AG.mw2 = 0u; AG.mw3 = 0u;
    { const bf16* ks = KVS + (size_t)b * SEQ * 512 + g * 64; const bf16* vs = ks + 256;
      unsigned long long rem = guni;
      int s = __builtin_ctzll(rem); rem &= rem - 1ull;
      load_kv(F, R, ks + (size_t)s * 64 * 512, vs + (size_t)s * 64 * 512, 512); __syncthreads(); store_kv(F, R, 0); __syncthreads(); cb = 0;
      for (;;) {
          const bool more = rem != 0ull; const int sn = more ? __builtin_ctzll(rem) : 0; rem &= rem - 1ull; BG.step(F);
          if (more) load_kv(F, R, ks + (size_t)sn * 64 * 512, vs + (size_t)sn * 64 * 512, 512);
          if ((wuni >> s) & 1ull) attn_tile<2>(F, s == cur, cb * AT_BUF + AT_K, cb * AT_BUF + AT_V, qf, AG, s - cur, 64 * s + 4 * h - tq, slope2, ((mym >> s) & 1ull) != 0ull, m, l, any, o0, o1, 0.f, 0.f, nullptr, nullptr, 0);
          if (!more) break;
          store_kv(F, R, cb ^ 1); __syncthreads(); cb ^= 1; s = sn;
      }
      const float lt = l + __shfl_xor(l, 32); const float sc = lt > 0.f ? g1 / lt : 0.f;
#pragma unroll
      for (int i = 0; i < 16; ++i) { OFP[i * 64] += sc * o0[i]; OFP[(16 + i) * 64] += sc * o1[i]; o0[i] = 0.f; o1[i] = 0.f; } }
    m = 0.f; l = 0.f; any = false; AG.mw2 = 0u; AG.mw3 = 0u;
    { const bf16* kw = KVW + (size_t)b * SEQ * 512 + g * 64; const bf16* vw = kw + 256;
      const int j0 = (c0 >= 512) ? 0 : (512 - c0) / 64;
      { const int pos0 = c0 - 512 + 64 * j0; load_kv(F, R, kw + (size_t)pos0 * 512, vw + (size_t)pos0 * 512, 512); __syncthreads(); store_kv(F, R, 0); __syncthreads(); cb = 0; }
      for (int j = j0; j < 9; ++j) {
          const int pos0 = c0 - 512 + 64 * j; const bool more = j + 1 < 9; BG.step(F);
          if (more) load_kv(F, R, kw + (size_t)(pos0 + 64) * 512, vw + (size_t)(pos0 + 64) * 512, 512);
          attn_tile<3>(F, j == 0 || j == 8, cb * AT_BUF + AT_K, cb * AT_BUF + AT_V, qf, AG, j - 8, pos0 + 4 * h - tq, slope2, true, m, l, any, o0, o1, 0.f, 0.f, nullptr, nullptr, 0);
          if (more) { store_kv(F, R, cb ^ 1); __syncthreads(); cb ^= 1; }
      }
      const float lt = l + __shfl_xor(l, 32); const float sc = lt > 0.f ? g2 / lt : 0.f;
#pragma unroll
      for (int i = 0; i < 16; ++i) { of0[i] = OFP[i * 64] + sc * o0[i]; of1[i] = OFP[(16 + i) * 64] + sc * o1[i]; } }
    bf16* orow = O + row * D + hd * 64;
#pragma unroll
    for (int g4 = 0; g4 < 4; ++g4) {
        v2u a; a.x = cvtpk(of0[4 * g4], of0[4 * g4 + 1]); a.y = cvtpk(of0[4 * g4 + 2], of0[4 * g4 + 3]);
        v2u c; c.x = cvtpk(of1[4 * g4], of1[4 * g4 + 1]); c.y = cvtpk(of1[4 * g4 + 2], of1[4 * g4 + 3]);
        *(v2u*)(orow + 8 * g4 + 4 * h) = a; *(v2u*)(orow + 32 + 8 * g4 + 4 * h) = c;
    }
    __syncthreads();
}

constexpr int SA_QS = 0, SA_SC = 1024, SA_NK = 1664, SA_IMP = SA_SC + SA_NK * 16, SA_LIST = SA_IMP + 256, SA_BLK = SA_LIST + 64, SA_RED = SA_BLK + 128, SA_END = SA_RED + 512 * 64;
constexpr int SK_CMP = 0, SK_SEL = 128, SK_WIN = 1088, SK_NSEL = 1600, SK_NWIN = 1601;
static_assert(SA_END <= RING_BYTES, "sample attention LDS");

__device__ __forceinline__ f32x4 wave_max4(f32x4 v) {
#pragma unroll
    for (int o = 1; o < 64; o <<= 1) { v[0] = fmaxf(v[0], __shfl_xor(v[0], o)); v[1] = fmaxf(v[1], __shfl_xor(v[1], o)); v[2] = fmaxf(v[2], __shfl_xor(v[2], o)); v[3] = fmaxf(v[3], __shfl_xor(v[3], o)); }
    return v;
}
__device__ __forceinline__ f32x4 wave_sum4(f32x4 v) {
#pragma unroll
    for (int o = 1; o < 64; o <<= 1) { v[0] += __shfl_xor(v[0], o); v[1] += __shfl_xor(v[1], o); v[2] += __shfl_xor(v[2], o); v[3] += __shfl_xor(v[3], o); }
    return v;
}
__device__ __forceinline__ void sa_softmax4(LAS f32x4* SC, int k0, int nk, int kx, f32x4 post, int lane) {
    f32x4 mx = (f32x4){-INFINITY, -INFINITY, -INFINITY, -INFINITY};
    for (int i = lane; i < nk; i += 64) { const f32x4 s = SC[k0 + i]; mx[0] = fmaxf(mx[0], s[0]); mx[1] = fmaxf(mx[1], s[1]); mx[2] = fmaxf(mx[2], s[2]); mx[3] = fmaxf(mx[3], s[3]); }
    if (kx >= 0) { const f32x4 s = SC[kx]; mx[0] = fmaxf(mx[0], s[0]); mx[1] = fmaxf(mx[1], s[1]); mx[2] = fmaxf(mx[2], s[2]); mx[3] = fmaxf(mx[3], s[3]); }
    mx = wave_max4(mx);
#pragma unroll
    for (int q = 0; q < 4; ++q) if (mx[q] == -INFINITY) mx[q] = 0.f;
    f32x4 sum = (f32x4){0.f, 0.f, 0.f, 0.f};
    for (int i = lane; i < nk; i += 64) { f32x4 s = SC[k0 + i];
#pragma unroll
        for (int q = 0; q < 4; ++q) s[q] = __builtin_amdgcn_exp2f(s[q] - mx[q]);
        SC[k0 + i] = s; sum += s; }
    sum = wave_sum4(sum);
    f32x4 ex = (f32x4){0.f, 0.f, 0.f, 0.f};
    if (kx >= 0) { const f32x4 s = SC[kx];
#pragma unroll
        for (int q = 0; q < 4; ++q) ex[q] = __builtin_amdgcn_exp2f(s[q] - mx[q]);
        sum += ex; }
    f32x4 sc;
#pragma unroll
    for (int q = 0; q < 4; ++q) sc[q] = sum[q] > 0.f ? post[q] / sum[q] : 0.f;
    LDS_WAIT(); asm volatile("" ::: "memory");
    for (int i = lane; i < nk; i += 64) SC[k0 + i] = SC[k0 + i] * sc;
    if (kx >= 0 && lane == 0) SC[kx] = ex * sc;
}

#define SA_LOADK(dst, kr) do { dst[0] = *(const f32x4*)(kr); dst[1] = *(const f32x4*)((kr) + 4); dst[2] = *(const f32x4*)((kr) + 32); dst[3] = *(const f32x4*)((kr) + 36); } while (0)
#define SA_SCORE(acc, kf) do { acc = __builtin_amdgcn_mfma_f32_16x16x32_bf16(af[0], cvt8(kf[0], kf[1]), (f32x4){0.f, 0.f, 0.f, 0.f}, 0, 0, 0); acc = __builtin_amdgcn_mfma_f32_16x16x32_bf16(af[1], cvt8(kf[2], kf[3]), acc, 0, 0, 0); } while (0)

__device__ __forceinline__ void attn_sample_unit(Frame& F, int b, int g) {
    const int tid = F.tid, lane = F.lane, w = F.wave; const int row = MP + b;
    const bf16* Q = WSP(bf16, WS_Q); const bf16* KVS = WSP(bf16, WS_KVS); const bf16* KVW = WSP(bf16, WS_KVW); const float* KCS = WSP(float, WS_KCS); const float* GATE = WSP(float, WS_GATE);
    bf16* O = WSP(bf16, WS_DIFF);
    LAS f32x4* SC = (LAS f32x4*)(F.lds + SA_SC); LAS float* IMP = (LAS float*)(F.lds + SA_IMP);
    LAS int* LIST = (LAS int*)(F.lds + SA_LIST); LAS int* BLK = (LAS int*)(F.lds + SA_BLK); LAS float* RED = (LAS float*)(F.lds + SA_RED);
    const float* kc = KCS + (size_t)((0 * 128 + b) * 4 + g) * 128 * 64; const float* vc = KCS + (size_t)((1 * 128 + b) * 4 + g) * 128 * 64;
    const float* sw = F.state_win + (size_t)b * 512 * 512;
    const int pg = (lane < 32) ? F.page_table[b * 16 + (lane >> 1)] : 0;
    __syncthreads();
    bf16x8 af[2];
#pragma unroll
    for (int ks = 0; ks < 2; ++ks) { af[ks] = (bf16x8){0, 0, 0, 0, 0, 0, 0, 0}; if ((lane & 15) < 4) af[ks] = *(const bf16x8*)(Q + (size_t)row * D + (g * 4 + (lane & 15)) * 64 + 32 * ks + 8 * (lane >> 4)); }
    f32x4 sl2;
#pragma unroll
    for (int i = 0; i < 4; ++i) sl2[i] = exp2f(-0.5f * (float)(g * 4 + i + 1)) * LOG2E;
    f32x4 gt0, gt1, gt2;
    { const float* gp = GATE + (size_t)row * 48 + g * 12;
#pragma unroll
      for (int i = 0; i < 4; ++i) { gt0[i] = gp[i * 3 + 0]; gt1[i] = gp[i * 3 + 1]; gt2[i] = gp[i * 3 + 2]; } }
    const int kl = lane & 15, kc8 = 8 * (lane >> 4);
    { f32x4 kf[5][4];
      { const float* kr = kc + (size_t)(16 * w + kl) * 64 + kc8; SA_LOADK(kf[0], kr); }
#pragma unroll
      for (int j = 1; j < 5; ++j) { const float* kr = sw + (size_t)(16 * (w + 8 * (j - 1)) + kl) * 512 + g * 64 + kc8; SA_LOADK(kf[j], kr); }
      f32x4 acc;
      SA_SCORE(acc, kf[0]);
      if (lane < 16) { const int n = 16 * w + kl; const float rel = (float)(16 * n + 31 - PAST); f32x4 s;
#pragma unroll
          for (int i = 0; i < 4; ++i) s[i] = (n < 127) ? acc[i] + sl2[i] * rel : -INFINITY;
          SC[SK_CMP + n] = s; }
#pragma unroll
      for (int j = 1; j < 5; ++j) { SA_SCORE(acc, kf[j]);
          if (lane < 16) { const int i2 = 16 * (w + 8 * (j - 1)) + kl; const float rel = (float)(i2 - 512); f32x4 s;
#pragma unroll
              for (int i = 0; i < 4; ++i) s[i] = (i2 >= 1) ? acc[i] + sl2[i] * rel : -INFINITY;
              SC[SK_WIN + i2] = s; } }
      if (w == 7) {
          f32x4 a, c2; const float kwn = bf2f(KVW[(size_t)row * 512 + g * 64 + lane]), ksn = bf2f(KVS[(size_t)row * 512 + g * 64 + lane]);
#pragma unroll
          for (int i = 0; i < 4; ++i) { const float qv = bf2f(Q[(size_t)row * D + (g * 4 + i) * 64 + lane]); a[i] = qv * kwn; c2[i] = qv * ksn; }
          a = wave_sum4(a); c2 = wave_sum4(c2);
          if (lane == 0) { SC[SK_NWIN] = a; SC[SK_NSEL] = c2; }
      }
    }
    __syncthreads();
    if (w == 0) {
        sa_softmax4(SC, SK_CMP, 128, -1, (f32x4){1.f, 1.f, 1.f, 1.f}, lane);
        LDS_WAIT(); asm volatile("" ::: "memory");
        if (lane < 33) { float a = 0.f;
#pragma unroll
            for (int dn = -1; dn <= 3; ++dn) { const int n = 4 * lane + dn; if (n >= 0 && n < 127) { const f32x4 p = SC[SK_CMP + n]; a += ((dn == -1 || dn == 3) ? 1.f : 2.f) * ((p[0] + p[1]) + (p[2] + p[3])); } }
            IMP[lane] = a; }
        LDS_WAIT(); asm volatile("" ::: "memory");
        const float v = (lane <= 32) ? IMP[lane] : 0.f; int rank = 0;
        for (int s2 = 1; s2 <= 30; ++s2) { const float o = IMP[s2]; rank += (o > v || (o == v && s2 < lane)) ? 1 : 0; }
        const bool sel = (lane == 0) || (lane == 31) || (lane >= 1 && lane <= 30 && rank < 13);
        const unsigned long long msk = __ballot(sel);
        if (sel) { const int pos = __builtin_popcountll(msk & ((1ull << lane) - 1ull)); LIST[pos] = lane;
            BLK[pos] = pg * 128 + (lane & 1) * 64; }
        LDS_WAIT(); asm volatile("" ::: "memory");
        for (int i = lane; i < 128; i += 64) SC[SK_CMP + i] = SC[SK_CMP + i] * gt0;
    }
    __syncthreads();
#pragma unroll
    for (int bt = 0; bt < 2; ++bt) {
        f32x4 kf[4][4];
#pragma unroll
        for (int j = 0; j < 4; ++j) { const int st = w + 8 * (4 * bt + j); if (st < 60) { const int bi = st >> 2, kk = 16 * (st & 3) + kl;
            const float* kr = F.cache + ((size_t)(BLK[bi] + kk) * 4 + 2) * 256 + g * 64 + kc8; SA_LOADK(kf[j], kr); } }
#pragma unroll
        for (int j = 0; j < 4; ++j) { const int st = w + 8 * (4 * bt + j); if (st < 60) { const int bi = st >> 2, kk = 16 * (st & 3) + kl; f32x4 acc; SA_SCORE(acc, kf[j]);
            if (lane < 16) { const float rel = (float)(64 * LIST[bi] + kk - PAST); f32x4 s;
#pragma unroll
                for (int i = 0; i < 4; ++i) s[i] = acc[i] + sl2[i] * rel;
                SC[SK_SEL + 64 * bi + kk] = s; } } }
    }
    if (w == 1) sa_softmax4(SC, SK_WIN, 512, SK_NWIN, gt2, lane);
    __syncthreads();
    if (w == 0) sa_softmax4(SC, SK_SEL, 960, SK_NSEL, gt1, lane);
    __syncthreads();
    { const int kq = lane >> 4, c4 = 4 * (lane & 15);
      f32x4 acc[4];
#pragma unroll
      for (int i = 0; i < 4; ++i) acc[i] = (f32x4){0.f, 0.f, 0.f, 0.f};
      { f32x4 vv[4];
#pragma unroll
        for (int it = 0; it < 4; ++it) vv[it] = *(const f32x4*)(vc + (size_t)(32 * it + 4 * w + kq) * 64 + c4);
#pragma unroll
        for (int it = 0; it < 4; ++it) { const f32x4 p = SC[SK_CMP + 32 * it + 4 * w + kq];
#pragma unroll
            for (int i = 0; i < 4; ++i) acc[i] += vv[it] * p[i]; } }
#pragma unroll
      for (int bt = 0; bt < 1; ++bt) { f32x4 vv[16];
#pragma unroll
        for (int j = 0; j < 16; ++j) vv[j] = *(const f32x4*)(sw + (size_t)(32 * j + 4 * w + kq) * 512 + 256 + g * 64 + c4);
#pragma unroll
        for (int j = 0; j < 16; ++j) { const f32x4 p = SC[SK_WIN + 32 * j + 4 * w + kq];
#pragma unroll
            for (int i = 0; i < 4; ++i) acc[i] += vv[j] * p[i]; } }
#pragma unroll
      for (int bt = 0; bt < 2; ++bt) { f32x4 vv[15];
#pragma unroll
        for (int j = 0; j < 15; ++j) { const int k = 32 * (15 * bt + j) + 4 * w + kq; vv[j] = *(const f32x4*)(F.cache + ((size_t)(BLK[k >> 6] + (k & 63)) * 4 + 3) * 256 + g * 64 + c4); }
#pragma unroll
        for (int j = 0; j < 15; ++j) { const f32x4 p = SC[SK_SEL + 32 * (15 * bt + j) + 4 * w + kq];
#pragma unroll
            for (int i = 0; i < 4; ++i) acc[i] += vv[j] * p[i]; } }
#pragma unroll
      for (int i = 0; i < 4; ++i) *(LAS f32x4*)(RED + tid * 16 + 4 * i) = acc[i];
    }
    __syncthreads();
    if (tid < 256) { const int hd = tid >> 6, d = tid & 63; float a = 0.f;
#pragma unroll 8
        for (int j = 0; j < 32; ++j) a += RED[((j >> 2) * 64 + (j & 3) * 16 + (d >> 2)) * 16 + hd * 4 + (d & 3)];
        { const f32x4 ps = SC[SK_NSEL], pw = SC[SK_NWIN];
          a += ps[hd] * bf2f(KVS[(size_t)row * 512 + 256 + g * 64 + d]) + pw[hd] * bf2f(KVW[(size_t)row * 512 + 256 + g * 64 + d]); }
        O[(size_t)row * D + (g * 4 + hd) * 64 + d] = (bf16)f2bf(a); }
    __syncthreads();
}

__device__ __forceinline__ void p7_attention(Frame& F) {
    BgCopy BG; BG.init(F);
    const bool sfirst = (blockIdx.x & 1) == 0;
    SEG_BEGIN(20); if (sfirst) for (int i = F.vcu; i < DB * 4; i += F.G) attn_sample_unit(F, i >> 2, i & 3); SEG_END(20);
    SEG_BEGIN(21);
    for (int i = F.vcu; i < 1024; i += F.G) { const int k = i >> 8, c = i & 255, bg = c >> 4, s = c & 15; const int qb = (k == 0) ? s : (k == 1) ? 31 - s : (k == 2) ? 32 + s : 63 - s;
        attn_prompt_unit(F, BG, bg >> 2, bg & 3, qb); }
    BG.finish(F); SEG_END(21);
    SEG_BEGIN(20); if (!sfirst) for (int i = F.vcu; i < DB * 4; i += F.G) attn_sample_unit(F, i >> 2, i & 3); SEG_END(20);
}

enum { SG_POOL = 0, SG_UP = 1, SG_DOWN = 2, SG_KVQG = 3, SG_WO = 4 };
constexpr int SG_RED = 0, SG_SSQ = 2 * 8 * 16 * 64 * 4;
template <int KIND>
__device__ __forceinline__ void small_gemm(Frame& F, int layer) {
    constexpr bool F32B = (KIND == SG_UP || KIND == SG_KVQG);
    constexpr int KR = (KIND == SG_POOL) ? 256 : 1024;
    constexpr int KSPLIT = (KIND == SG_DOWN) ? 4 : 1;
    constexpr int NSL = (KIND == SG_POOL) ? 32 : (KIND == SG_UP) ? 128 : (KIND == SG_KVQG) ? 82 : 32;
    constexpr int KW = KR / 8, NKS = KW / 16;
    const int lane = F.lane, w = F.wave, r = lane & 31, h = lane >> 5;
    float* X = WSP(float, WS_X);
    LAS float* RED = (LAS float*)(F.lds + SG_RED); LAS float* SSQ = (LAS float*)(F.lds + SG_SSQ);
    for (int item = F.vcu; item < (NSL / 2) * 4 * KSPLIT; item += F.G) {
        const int kr = item % KSPLIT, tt = item / KSPLIT, rbk = tt & 3, np = tt >> 2;
        const int row = MP + 32 * rbk + r, b = 32 * rbk + r;
        const int kb = kr * KR + w * KW + 8 * h;
        int n0[2]; const bf16* wrow[2]; const bf16* b16 = nullptr; const float* b32 = nullptr;
#pragma unroll
        for (int t = 0; t < 2; ++t) { const int ns = 2 * np + t; n0[t] = ns * 32;
            if (KIND == SG_POOL) { const int g = ns >> 3; n0[t] = (ns & 7) * 32; wrow[t] = WSP(bf16, WS_WPOOL) + (size_t)g * 65536 + (size_t)(n0[t] + r) * 256 + kb; b16 = WSP(bf16, WS_DIFF) + (size_t)row * D + g * 256 + kb; n0[t] += g * 256; }
            else if (KIND == SG_UP) { wrow[t] = WSP(bf16, WS_WUP) + (size_t)layer * FF * D + (size_t)(n0[t] + r) * D + kb; b32 = X + (size_t)row * D + kb; }
            else if (KIND == SG_DOWN) { wrow[t] = WSP(bf16, WS_WDN) + (size_t)layer * D * FF + (size_t)(n0[t] + r) * FF + kb; b16 = WSP(bf16, WS_H) + (size_t)row * FF + kb; }
            else if (KIND == SG_KVQG) { wrow[t] = WSP(bf16, WS_WKVQG) + (size_t)(n0[t] + r) * D + kb; b32 = X + (size_t)row * D + kb; }
            else { wrow[t] = WSP(bf16, WS_WO) + (size_t)(n0[t] + r) * D + kb; b16 = WSP(bf16, WS_DIFF) + (size_t)row * D + kb; } }
        bf16x8 a0[NKS], a1[NKS], bb[NKS]; f32x4 x0[NKS], x1[NKS];
#pragma unroll
        for (int j = 0; j < NKS; ++j) { a0[j] = *(const bf16x8*)(wrow[0] + 16 * j); a1[j] = *(const bf16x8*)(wrow[1] + 16 * j);
            if (F32B) { x0[j] = *(const f32x4*)(b32 + 16 * j); x1[j] = *(const f32x4*)(b32 + 16 * j + 4); } else bb[j] = *(const bf16x8*)(b16 + 16 * j); }
        f32x16 acc0, acc1; float ssq = 0.f;
#pragma unroll
        for (int i = 0; i < 16; ++i) { acc0[i] = 0.f; acc1[i] = 0.f; }
#pragma unroll
        for (int j = 0; j < NKS; ++j) {
            if (F32B) { ssq += (x0[j][0] * x0[j][0] + x0[j][1] * x0[j][1]) + (x0[j][2] * x0[j][2] + x0[j][3] * x0[j][3]) + (x1[j][0] * x1[j][0] + x1[j][1] * x1[j][1]) + (x1[j][2] * x1[j][2] + x1[j][3] * x1[j][3]); bb[j] = cvt8(x0[j], x1[j]); }
            acc0 = __builtin_amdgcn_mfma_f32_32x32x16_bf16(a0[j], bb[j], acc0, 0, 0, 0);
            acc1 = __builtin_amdgcn_mfma_f32_32x32x16_bf16(a1[j], bb[j], acc1, 0, 0, 0);
        }
        __syncthreads();
#pragma unroll
        for (int i = 0; i < 16; ++i) { RED[(w * 16 + i) * 64 + lane] = acc0[i]; RED[((8 + w) * 16 + i) * 64 + lane] = acc1[i]; }
        if (F32B) SSQ[w * 64 + lane] = ssq;
        __syncthreads();
        {
            const int te = w >> 2, wq = w & 3;
            f32x4 v = (f32x4){0.f, 0.f, 0.f, 0.f};
#pragma unroll
            for (int ww = 0; ww < 8; ++ww)
#pragma unroll
                for (int e = 0; e < 4; ++e) v[e] += RED[((8 * te + ww) * 16 + 4 * wq + e) * 64 + lane];
            float rstd = 1.f;
            if (F32B) { float q = 0.f;
#pragma unroll
                for (int ww = 0; ww < 8; ++ww) q += SSQ[ww * 64 + r] + SSQ[ww * 64 + 32 + r];
                rstd = 1.0f / sqrtf(q * (1.0f / D) + RMS_EPS); }
            const int nb = te ? n0[1] : n0[0]; const int col = nb + 8 * wq + 4 * h;
            if (KIND == SG_POOL) {
                *(f32x4*)(X + (size_t)row * D + col) = *(const f32x4*)(F.x_s + (size_t)b * D + col) + v * *(const f32x4*)(F.pool_scale + col);
            } else if (KIND == SG_UP) {
                v = v * rstd;
#pragma unroll
                for (int e = 0; e < 4; ++e) { const float t = fmaxf(v[e], 0.f); v[e] = t * t; }
                v2u o; o.x = cvtpk(v[0], v[1]); o.y = cvtpk(v[2], v[3]); *(v2u*)(WSP(bf16, WS_H) + (size_t)row * FF + col) = o;
            } else if (KIND == SG_DOWN || KIND == SG_WO) {
#pragma unroll
                for (int e = 0; e < 4; ++e) unsafeAtomicAdd(X + (size_t)row * D + col + e, v[e]);
            } else {
                v = v * rstd; v2u o; o.x = cvtpk(v[0], v[1]); o.y = cvtpk(v[2], v[3]);
                if (nb < 1024) { *(f32x4*)(F.out + OUT_KV_S + (size_t)b * D + col) = v; if (nb >= 512) *(v2u*)(WSP(bf16, WS_KVS) + (size_t)row * 512 + col - 512) = o; }
                else if (nb < 1536) { *(v2u*)(WSP(bf16, WS_KVW) + (size_t)row * 512 + col - 1024) = o; *(f32x4*)(F.out + OUT_WIN_S + ((size_t)b * 512 + 511) * 512 + col - 1024) = v; }
                else if (nb < 2560) { *(v2u*)(WSP(bf16, WS_Q) + (size_t)row * D + col - 1536) = o; }
                else if (col < 2608) { float* gp = WSP(float, WS_GATE) + (size_t)row * 48 + col - 2560;
#pragma unroll
                    for (int e = 0; e < 4; ++e) gp[e] = 1.0f / (1.0f + __expf(-(v[e] + F.b_gate[col - 2560 + e]))); }
            }
        }
    }
    VM_WAIT(); __syncthreads();
}

__device__ __forceinline__ void p11_final(Frame& F) {
    const int gw = F.vcu * NWAVES + F.wave, NGW = F.G * NWAVES, lane = F.lane; const float* X = WSP(float, WS_X); const bf16* XB = WSP(bf16, WS_XB);
    for (int row = gw; row < MT; row += NGW) {
        f32x4 v[4]; float ss = 0.f;
        if (row < MP) { const v2u* xr = (const v2u*)(XB + (size_t)row * D) + lane;
#pragma unroll
            for (int j = 0; j < 4; ++j) { const v2u q = xr[64 * j]; v[j] = (f32x4){__builtin_bit_cast(float, q.x << 16), __builtin_bit_cast(float, q.x & 0xffff0000u), __builtin_bit_cast(float, q.y << 16), __builtin_bit_cast(float, q.y & 0xffff0000u)}; } }
        else { const f32x4* xr = (const f32x4*)(X + (size_t)row * D) + lane;
#pragma unroll
            for (int j = 0; j < 4; ++j) v[j] = xr[64 * j]; }
#pragma unroll
        for (int j = 0; j < 4; ++j) ss += (v[j][0] * v[j][0] + v[j][1] * v[j][1]) + (v[j][2] * v[j][2] + v[j][3] * v[j][3]);
        const float rstd = 1.0f / sqrtf(wave_sum(ss) * (1.0f / D) + RMS_EPS);
        float* o = (row < MP) ? F.out + OUT_Y_P + (size_t)row * D : F.out + OUT_Y_S + (size_t)(row - MP) * D;
#pragma unroll
        for (int j = 0; j < 4; ++j) __builtin_nontemporal_store(v[j] * rstd * *((const f32x4*)F.norm_final + lane + 64 * j), (f32x4*)o + lane + 64 * j);
    }
}

constexpr int NPHASE = 12;
struct Args { const void* in[21]; float* out; unsigned char* ws; int ph_lo, ph_hi; };
__global__ void __launch_bounds__(NWAVES * 64, 2) yoco_fwd(Args args) {
    extern __shared__ __attribute__((aligned(16))) unsigned char lds[];
    Frame F;
    F.lds = (LAS unsigned char*)lds;
    F.tid = threadIdx.x; F.lane = F.tid & 63; F.wave = __builtin_amdgcn_readfirstlane(F.tid >> 6);
    F.G = gridDim.x; { const int bx = blockIdx.x; F.vcu = (F.G % 8 == 0) ? (bx % 8) * (F.G / 8) + bx / 8 : bx; }
    F.x_p = (const float*)args.in[0]; F.x_s = (const float*)args.in[1]; F.state_pool = (const float*)args.in[2]; F.cache = (const float*)args.in[3]; F.state_win = (const float*)args.in[4];
    F.page_table = (const int*)args.in[5]; F.norm_mix = (const float*)args.in[6]; F.norm_mlp = (const float*)args.in[7]; F.w_up = (const float*)args.in[8]; F.w_down = (const float*)args.in[9];
    F.pool_w = (const float*)args.in[10]; F.pool_scale = (const float*)args.in[11]; F.norm_kv = (const float*)args.in[12]; F.w_kv = (const float*)args.in[13]; F.cmp_pe = (const float*)args.in[14];
    F.cmp_w1 = (const float*)args.in[15]; F.cmp_w2 = (const float*)args.in[16]; F.w_qg = (const float*)args.in[17]; F.b_gate = (const float*)args.in[18]; F.w_o = (const float*)args.in[19];
    F.norm_final = (const float*)args.in[20]; F.out = args.out; F.ws = args.ws;
    volatile LAS unsigned* MISC = (volatile LAS unsigned*)(F.lds + MISC_OFF);
    for (int u = F.tid; u < (LDS_BYTES - RING_BYTES) / 4; u += NWAVES * 64) ((LAS unsigned*)(F.lds + RING_BYTES))[u] = 0u;
    __syncthreads();
    unsigned* ctl = (unsigned*)(F.ws + WS_CTL);
#if MK_MULTI
#define GRID_BAR() do { } while (0)
#else
    XcdBarrier bar = xcd_barrier_post(ctl + CW_BAR, MISC + 8);
#define GRID_BAR() xcd_barrier(bar)
#endif
    F.seg_t0 = 0ull; F.seg_dt = 0ull;
    const int lo = args.ph_lo, hi = args.ph_hi;
#define IN(k) (lo <= (k) && (k) < hi)
#define SEAM(k) do { SEG_BEGIN(100 + (k)); if (IN(k) && IN((k) + 1)) GRID_BAR(); SEG_END(100 + (k)); SEG_END(k); SEG_BEGIN((k) + 1); } while (0)
    using namespace pg8;
    float* X = WSP(float, WS_X); bf16* XB = WSP(bf16, WS_XB); float* RS = WSP(float, WS_RS);

    SEG_BEGIN(0);
    if (IN(0)) { for (int rep = 0; rep < REP(0); ++rep) { p0_prologue(F); __syncthreads(); } } SEAM(0);
    if (IN(1)) {
        for (int rep = 0; rep < REP(16); ++rep) small_gemm<SG_POOL>(F, 0);
        Gemm g{WSP(bf16_t, WS_DIFF), WSP(bf16_t, WS_WPOOL), MP, 1024, 256, 1024, 256, (size_t)512}; StaticOrder S; S.init(MP, 1024, F.G, (int)blockIdx.x);
        EpiResid E{F.x_p, XB, RS, F.pool_scale};
        gemm_phase<EpiResid, StaticOrder, true, true>(F.lds, g, S, E);
    } SEAM(1);
    if (IN(2)) {
        SEG_BEGIN(60); for (int rep = 0; rep < REP(14); ++rep) small_gemm<SG_UP>(F, 0); SEG_END(60); SEG_BEGIN(61);
        Gemm g{XB, WSP(bf16_t, WS_WUP), MP, FF, D, D, D, (size_t)0}; StaticOrder S; S.init(MP, FF, F.G, (int)blockIdx.x);
        EpiUp E{WSP(bf16_t, WS_H), RS};
        for (int rep = 0; rep < REP(2); ++rep) { gemm_phase<EpiUp, StaticOrder, true, true>(F.lds, g, S, E); __syncthreads(); } SEG_END(61);
    } SEAM(2);
    if (IN(3)) {
        small_gemm<SG_DOWN>(F, 0);
        Gemm g{WSP(bf16_t, WS_H), WSP(bf16_t, WS_WDN), MP, D, FF, FF, FF, (size_t)0}; StaticOrder S; S.init(MP, D, F.G, (int)blockIdx.x);
        EpiResid E{nullptr, XB, RS, nullptr};
        gemm_phase<EpiResid, StaticOrder, true, true>(F.lds, g, S, E);
    } SEAM(3);
    if (IN(4)) {
        SEG_BEGIN(30); for (int rep = 0; rep < REP(15); ++rep) small_gemm<SG_KVQG>(F, 0); SEG_END(30);
        SEG_BEGIN(31); if ((blockIdx.x & 1) == 0) p5_sample_compress(F, ctl + CW_QUEUE, 3); SEG_END(31); SEG_BEGIN(32);
        Gemm g{XB, WSP(bf16_t, WS_WKVQG), MP, NKVQG, D, D, D, (size_t)0}; StaticOrder S; S.init(MP, NKVQG, F.G, (int)blockIdx.x);
        EpiKvqg E{RS, F.b_gate, F.out + OUT_KV_P, F.out + OUT_KV_S, F.out + OUT_WIN_P, F.out + OUT_WIN_S, WSP(bf16_t, WS_CMPA), WSP(bf16_t, WS_KVS), WSP(bf16_t, WS_KVW), WSP(bf16_t, WS_Q), WSP(float, WS_GATE)};
        gemm_phase<EpiKvqg, StaticOrder, true, true>(F.lds, g, S, E);
        __syncthreads(); SEG_END(32); SEG_BEGIN(33);
        p5_sample_compress(F, ctl + CW_QUEUE, 1 << 30); SEG_END(33);
    } SEAM(4);
    if (IN(5)) {
        SEG_BEGIN(50); p5_prompt_compress(F); SEG_END(50); SEG_BEGIN(51);
        if (F.G > 64) { if ((int)blockIdx.x >= 64) p6_combine(F, 0, (int)blockIdx.x - 64, F.G - 64); } else { __syncthreads(); p6_combine(F, 0, (int)blockIdx.x, F.G); } SEG_END(51);
    } SEAM(5);
    if (IN(6)) { p6_combine(F, 1, (int)blockIdx.x, F.G); } SEAM(6);
    if (IN(7)) { p7_attention(F); } SEAM(7);
    if (IN(8)) {
        SEG_BEGIN(70); small_gemm<SG_WO>(F, 0); SEG_END(70); SEG_BEGIN(71);
        Gemm g{WSP(bf16_t, WS_DIFF), WSP(bf16_t, WS_WO), MP, D, D, D, D, (size_t)0}; StaticOrder S; S.init(MP, D, F.G, (int)blockIdx.x);
        EpiResid E{nullptr, XB, RS, nullptr};
        gemm_phase<EpiResid, StaticOrder, true, true>(F.lds, g, S, E); SEG_END(71);
    } SEAM(8);
    if (IN(9)) {
        small_gemm<SG_UP>(F, 1);
        Gemm g{XB, WSP(bf16_t, WS_WUP) + (size_t)FF * D, MP, FF, D, D, D, (size_t)0}; StaticOrder S; S.init(MP, FF, F.G, (int)blockIdx.x);
        EpiUp E{WSP(bf16_t, WS_H), RS};
        gemm_phase<EpiUp, StaticOrder, true, true>(F.lds, g, S, E);
    } SEAM(9);
    if (IN(10)) {
        small_gemm<SG_DOWN>(F, 1);
        Gemm g{WSP(bf16_t, WS_H), WSP(bf16_t, WS_WDN) + (size_t)D * FF, MP, D, FF, FF, FF, (size_t)0}; StaticOrder S; S.init(MP, D, F.G, (int)blockIdx.x);
        EpiResid E{nullptr, XB, RS, nullptr};
        gemm_phase<EpiResid, StaticOrder, true, true>(F.lds, g, S, E);
    } SEAM(10);
    if (IN(11)) { p11_final(F); }
    SEG_END(11);
    if (PROBE_SEG >= 0) { __syncthreads(); const unsigned long long t1 = __builtin_amdgcn_s_memrealtime(); while (__builtin_amdgcn_s_memrealtime() - t1 < F.seg_dt) __builtin_amdgcn_s_sleep(8); }
#undef IN
#undef SEAM
}

extern "C" void kernel_launch(void* const* d_in, const int* in_sizes, int n_in, void* d_out, int out_size, void* d_ws, size_t ws_size, hipStream_t stream) {
    static int grid = 0;
    if (grid == 0) {
        if (n_in != 21 || (size_t)out_size != OUT_TOTAL || ws_size < WS_END) { fprintf(stderr, "kernel_launch: unexpected sizes n_in %d out %d ws %zu\n", n_in, out_size, ws_size); grid = -1; return; }
        int dev = 0, cus = 0, per_cu = 0;
        if (hipGetDevice(&dev) != hipSuccess || hipDeviceGetAttribute(&cus, hipDeviceAttributeMultiprocessorCount, dev) != hipSuccess) { grid = -1; return; }
        if (hipFuncSetAttribute((const void*)yoco_fwd, hipFuncAttributeMaxDynamicSharedMemorySize, LDS_BYTES) != hipSuccess) { fprintf(stderr, "kernel_launch: hipFuncSetAttribute failed\n"); grid = -1; return; }
        if (hipOccupancyMaxActiveBlocksPerMultiprocessor(&per_cu, (const void*)yoco_fwd, NWAVES * 64, LDS_BYTES) != hipSuccess || per_cu < 1) fprintf(stderr, "kernel_launch: occupancy query says %d\n", per_cu);
        (void)hipGetLastError();
        grid = cus;
    }
    if (grid < 0) return;
    (void)hipMemsetAsync((char*)d_ws + WS_CTL, 0, CTL_ZERO_BYTES, stream);
    Args a{};
    for (int i = 0; i < 21; ++i) a.in[i] = d_in[i];
    a.out = (float*)d_out; a.ws = (unsigned char*)d_ws;
#if MK_MULTI
    for (int p = 0; p < NPHASE; ++p) { a.ph_lo = p; a.ph_hi = p + 1; hipLaunchKernelGGL(yoco_fwd, dim3(grid), dim3(NWAVES * 64), LDS_BYTES, stream, a); }
#else
    a.ph_lo = 0; a.ph_hi = NPHASE;
    hipLaunchKernelGGL(yoco_fwd, dim3(grid), dim3(NWAVES * 64), LDS_BYTES, stream, a);
#endif
    const hipError_t le = hipPeekAtLastError();
    if (le != hipSuccess) fprintf(stderr, "kernel_launch: launch failed: %s\n", hipGetErrorName(le));
}
```
